# Optimizing an MI355X kernel written in HIP

```python
import jax, jax.numpy as jnp
from jax import lax
import numpy as np

D_MODEL = 1024
BATCH = 16
SEQ = 2048
DEPTH = 1

D_MIX = D_MODEL
HEAD_DIM = 64
ATTN_WIDTH = D_MIX // 2
CONV_WIDTH = D_MIX - ATTN_WIDTH
N_HEADS = ATTN_WIDTH // HEAD_DIM
N_KV_HEADS = 2
GQA_GROUP = N_HEADS // N_KV_HEADS
KV_WIDTH = N_KV_HEADS * HEAD_DIM
N_CONV_GROUPS = CONV_WIDTH // HEAD_DIM
WINDOW = 128
CONV_K = 3
IN_WIDTH = ATTN_WIDTH + 2 * KV_WIDTH + 3 * CONV_WIDTH
N_KEYS = 128
N_EXPERTS = N_KEYS * N_KEYS
PEER_HEADS = 8
PEER_TOPK = 16
D_KEY = 256
D_HALF = D_KEY // 2
PEER_CHUNK = 128
EPS = 1e-6
NEG = -1e30

kernel_name = "hybrid_swa_sink_shortconv_peer_adaln"


def rms_norm(x, g):
    x32 = x.astype(jnp.float32)
    y = x32 * lax.rsqrt(jnp.mean(x32 * x32, axis=-1, keepdims=True) + EPS)
    return (y * g.astype(jnp.float32)).astype(x.dtype)


def head_rms_norm(x, g, n_groups):
    shp = x.shape
    xh = x.reshape(shp[:-1] + (n_groups, HEAD_DIM))
    y = rms_norm(xh, g.reshape(n_groups, HEAD_DIM))
    return y.reshape(shp)


def modulate(h, shift, scale):
    return h * (1 + scale[:, None, :]) + shift[:, None, :]


def sliding_window_sink_attention(q, k, v, sinks):
    bsz, s_len = q.shape[0], q.shape[1]
    nb = s_len // WINDOW
    qb = q.reshape(bsz, nb, WINDOW, N_KV_HEADS, GQA_GROUP, HEAD_DIM)
    kb = k.reshape(bsz, nb, WINDOW, N_KV_HEADS, HEAD_DIM)
    vb = v.reshape(bsz, nb, WINDOW, N_KV_HEADS, HEAD_DIM)

    def with_prev(t):
        prev = jnp.pad(t[:, :-1], ((0, 0), (1, 0), (0, 0), (0, 0), (0, 0)))
        return jnp.concatenate([prev, t], axis=2)

    kk, vv = with_prev(kb), with_prev(vb)
    s = jnp.einsum('bnqkgd,bnjkd->bnkgqj', qb, kk).astype(jnp.float32) * (HEAD_DIM ** -0.5)
    qi = jnp.arange(WINDOW)[:, None]
    kj = jnp.arange(2 * WINDOW)[None, :]
    diff = qi + WINDOW - kj
    rel_ok = (diff >= 0) & (diff < WINDOW)
    blk = jnp.arange(nb)[:, None, None]
    valid = rel_ok[None] & ((blk > 0) | (kj[None] >= WINDOW))
    s = jnp.where(valid[None, :, None, None], s, NEG)
    sink = sinks.astype(jnp.float32).reshape(N_KV_HEADS, GQA_GROUP)[None, None, :, :, None, None]
    m = jnp.maximum(jnp.max(s, axis=-1, keepdims=True), sink)
    e = jnp.exp(s - m)
    p = e / (jnp.sum(e, axis=-1, keepdims=True) + jnp.exp(sink - m))
    o = jnp.einsum('bnkgqj,bnjkd->bnqkgd', p.astype(v.dtype), vv)
    return o.reshape(bsz, s_len, ATTN_WIDTH)


def short_gated_conv(b_gate, c_gate, u, conv_w):
    z = c_gate * u
    zp = jnp.pad(z, ((0, 0), (CONV_K - 1, 0), (0, 0)))
    s_len = z.shape[1]
    conv = zp[:, 0:s_len] * conv_w[0] + zp[:, 1:s_len + 1] * conv_w[1] + zp[:, 2:s_len + 2] * conv_w[2]
    return b_gate * conv


def peer_layer(h, w_query, peer_keys1, peer_keys2, peer_u, peer_v):
    bsz, s_len, d = h.shape
    t = bsz * s_len
    hf = h.reshape(t, d)
    q = (hf @ w_query).reshape(t, PEER_HEADS, D_KEY)
    s1 = jnp.einsum('thd,hnd->thn', q[..., :D_HALF], peer_keys1).astype(jnp.float32)
    s2 = jnp.einsum('thd,hnd->thn', q[..., D_HALF:], peer_keys2).astype(jnp.float32)
    v1, i1 = lax.top_k(s1, PEER_TOPK)
    v2, i2 = lax.top_k(s2, PEER_TOPK)
    cand = (v1[..., :, None] + v2[..., None, :]).reshape(t, PEER_HEADS, PEER_TOPK * PEER_TOPK)
    sc, ci = lax.top_k(cand, PEER_TOPK)
    e1 = jnp.take_along_axis(i1, ci // PEER_TOPK, axis=-1)
    e2 = jnp.take_along_axis(i2, ci % PEER_TOPK, axis=-1)
    idx = e1 * N_KEYS + e2
    gates = jax.nn.softmax(sc, axis=-1).astype(h.dtype)

    nchunk = t // PEER_CHUNK
    hc = hf.reshape(nchunk, PEER_CHUNK, d)
    ic = idx.reshape(nchunk, PEER_CHUNK, PEER_HEADS, PEER_TOPK)
    gc = gates.reshape(nchunk, PEER_CHUNK, PEER_HEADS, PEER_TOPK)

    def chunk_fn(args):
        hx, ix, gx = args
        u = peer_u[ix]
        a = jax.nn.gelu(jnp.einsum('td,thkd->thk', hx, u), approximate=False)
        vsel = peer_v[ix]
        return jnp.einsum('thk,thkd->td', gx * a, vsel)

    out = lax.map(chunk_fn, (hc, ic, gc))
    return out.reshape(bsz, s_len, d)


def setup_inputs(seed: int = 0) -> dict:
    key = jax.random.key(seed)
    ks = jax.random.split(key, 20)
    D = D_MODEL
    f32 = jnp.float32
    return {
        "x": jax.random.normal(ks[0], (BATCH, SEQ, D), f32),
        "c": jax.random.normal(ks[1], (BATCH, D), f32),
        "w_ada": jax.random.normal(ks[2], (D, 6 * D), f32) * D ** -0.5,
        "b_ada": jax.random.normal(ks[3], (6 * D,), f32) * 0.02,
        "norm1_g": 1.0 + 0.02 * jax.random.normal(ks[4], (D,), f32),
        "w_in": jax.random.normal(ks[5], (D, IN_WIDTH), f32) * D ** -0.5,
        "b_in": jax.random.normal(ks[6], (IN_WIDTH,), f32) * 0.02,
        "attn_sinks": jax.random.normal(ks[7], (N_HEADS,), f32) * 0.5,
        "conv_w": jax.random.normal(ks[8], (CONV_K, CONV_WIDTH), f32) * CONV_K ** -0.5,
        "attn_out_g": 1.0 + 0.02 * jax.random.normal(ks[9], (ATTN_WIDTH,), f32),
        "conv_out_g": 1.0 + 0.02 * jax.random.normal(ks[10], (CONV_WIDTH,), f32),
        "w_out": jax.random.normal(ks[11], (D_MIX, D), f32) * D_MIX ** -0.5,
        "b_out": jax.random.normal(ks[12], (D,), f32) * 0.02,
        "norm2_g": 1.0 + 0.02 * jax.random.normal(ks[13], (D,), f32),
        "w_query": jax.random.normal(ks[14], (D, PEER_HEADS * D_KEY), f32) * D ** -0.5,
        "peer_keys1": jax.random.normal(ks[15], (PEER_HEADS, N_KEYS, D_HALF), f32) * D_HALF ** -0.5,
        "peer_keys2": jax.random.normal(ks[16], (PEER_HEADS, N_KEYS, D_HALF), f32) * D_HALF ** -0.5,
        "peer_u": jax.random.normal(ks[17], (N_EXPERTS, D), f32) * D ** -0.5,
        "peer_v": jax.random.normal(ks[18], (N_EXPERTS, D), f32) * PEER_HEADS ** -0.5,
        "final_g": 1.0 + 0.02 * jax.random.normal(ks[19], (D,), f32),
    }


def reference(x, c, w_ada, b_ada, norm1_g, w_in, b_in, attn_sinks, conv_w, attn_out_g,
              conv_out_g, w_out, b_out, norm2_g, w_query, peer_keys1, peer_keys2,
              peer_u, peer_v, final_g):
    bsz, s_len, _ = x.shape
    for _layer in range(DEPTH):
        ada = jax.nn.silu(c) @ w_ada + b_ada
        shift1, scale1, gate1, shift2, scale2, gate2 = jnp.split(ada, 6, axis=-1)

        h = modulate(rms_norm(x, norm1_g), shift1, scale1)
        proj = h @ w_in + b_in
        o1 = ATTN_WIDTH
        o2 = o1 + KV_WIDTH
        o3 = o2 + KV_WIDTH
        o4 = o3 + CONV_WIDTH
        o5 = o4 + CONV_WIDTH
        q = proj[..., :o1].reshape(bsz, s_len, N_HEADS, HEAD_DIM)
        k = proj[..., o1:o2].reshape(bsz, s_len, N_KV_HEADS, HEAD_DIM)
        v = proj[..., o2:o3].reshape(bsz, s_len, N_KV_HEADS, HEAD_DIM)
        b_gate = proj[..., o3:o4]
        c_gate = proj[..., o4:o5]
        u_conv = proj[..., o5:]
        attn = head_rms_norm(sliding_window_sink_attention(q, k, v, attn_sinks), attn_out_g, N_HEADS)
        conv = head_rms_norm(short_gated_conv(b_gate, c_gate, u_conv, conv_w), conv_out_g, N_CONV_GROUPS)
        mix = jnp.concatenate([attn, conv], axis=-1) @ w_out + b_out
        x = x + gate1[:, None, :] * mix

        h2 = modulate(rms_norm(x, norm2_g), shift2, scale2)
        x = x + gate2[:, None, :] * peer_layer(h2, w_query, peer_keys1, peer_keys2, peer_u, peer_v)
    return rms_norm(x, final_g)
```

```cpp
#include <hip/hip_runtime.h>
#include <cstdio>
#include <cstdint>
#include <cmath>
namespace pg8 {
#define PG8_LAS __attribute__((address_space(3)))
typedef unsigned short bf16_t;
typedef short bf16x8 __attribute__((ext_vector_type(8)));
typedef float f32x4 __attribute__((ext_vector_type(4)));
typedef unsigned u32x4 __attribute__((ext_vector_type(4)));
constexpr int BM = 256, BK = 64, HALF = 128, HTB = HALF * BK * 2  , STAGE_BYTES = 8 * HTB, NXCD = 8, WGM = 8;

__host__ __device__ __forceinline__ int lds_byte(int r, int c) { const int st = (r >> 4) * 2 + (c >> 5), rr = r & 15, cc = c & 31, ob = rr * 64 + cc * 2; return st * 1024 + (ob ^ (((ob >> 9) & 1) << 5)); }
__host__ __device__ __forceinline__ void stage_rc(int b, int& R, int& C) { const int st = b / 1024, sb = b % 1024, swz = sb ^ (((sb >> 9) & 1) << 5); R = (st >> 1) * 16 + swz / 64; C = (st & 1) * 32 + (swz % 64) / 2; }
__host__ __device__ __forceinline__ int perm32(int rho) { const int n = rho >> 4, i = rho & 15; return 8 * (i >> 2) + 4 * n + (i & 3); }

struct Unit { int pm, pn; };
struct Gemm { const bf16_t* A; const bf16_t* Bt; int M, N, K; };

struct StaticOrder {
    int nM, nN, nwg, G, c;
    __host__ __device__ void init(int M, int N, int G_, int c_) { nM = M / BM; nN = N / BM; nwg = nM * nN; G = G_; c = c_; }
    __host__ __device__ bool next(int i, Unit& u) const {
        const long L = (long)i * G + c; if (L >= nwg) return false;
        int wgid = (int)L; { const int q = nwg / NXCD, r = nwg % NXCD, xcd = wgid % NXCD, off = wgid / NXCD; wgid = (xcd < r ? xcd * (q + 1) : r * (q + 1) + (xcd - r) * q) + off; }
        const int nig = WGM * nN, gid = wgid / nig, fm = gid * WGM, gsz = (nM - fm) < WGM ? (nM - fm) : WGM;
        u.pm = fm + ((wgid % nig) % gsz); u.pn = (wgid % nig) / gsz; return true;
    }
    __device__ __forceinline__ void a_ready(const Unit&) const {}
    __device__ __forceinline__ void done(const Unit&) const {}
};

__device__ __forceinline__ unsigned cvt_pk_bf16(float lo, float hi) { unsigned r; asm volatile("v_cvt_pk_bf16_f32 %0, %1, %2" : "=v"(r) : "v"(lo), "v"(hi)); return r; }
typedef float f32x2 __attribute__((ext_vector_type(2)));
__device__ __forceinline__ f32x2 gelu_pk(f32x2 v) {
    const f32x2 av = __builtin_elementwise_abs(v), d = av * 0.2316418882f + 1.0f;
    f32x2 t; t.x = __builtin_amdgcn_rcpf(d.x); t.y = __builtin_amdgcn_rcpf(d.y);
    f32x2 q = t * 0.5307027145f + (-0.7265760135f); q = q * t + 0.7107068705f; q = q * t + (-0.142248368f); q = q * t + 0.127414796f; q = q * t;
    const f32x2 s = (v * v) * (-0.72134752044f);
    f32x2 e; e.x = __builtin_amdgcn_exp2f(s.x); e.y = __builtin_amdgcn_exp2f(s.y);
    const f32x2 m = v * (q * e), r = v - m;
    f32x2 o; o.x = v.x < 0.f ? m.x : r.x; o.y = v.y < 0.f ? m.y : r.y; return o;
}

template <int ACT  > struct EpiBf16 {
    static constexpr bool PERM = true, AFTER_DRAIN = false; static_assert(ACT == 0 || ACT == 1, "EpiBf16: ACT is 0 (none) or 1 (gelu_pk)");
    bf16_t* O; int ldc; const float* bias; int split_cols; size_t split_stride; float scale0;
    __device__ __forceinline__ void operator()(const f32x4 (&acc)[2][2][4][2], const Unit& u, int wr, int wc, int fr, int fq) const {
        const int row0 = u.pm * BM + wr * 64 + fr; int colt = u.pn * BM; bf16_t* base = O;
        float sc = 1.f; if (split_cols) { const int t = colt / split_cols; base += (size_t)t * split_stride; colt -= t * split_cols; if (t == 0) sc = scale0; }
        const int col0 = colt + wc * 32 + 8 * fq, bcol0 = u.pn * BM + wc * 32 + 8 * fq;
        f32x4 bv[2][2];
#pragma unroll
        for (int bj = 0; bj < 2; ++bj)
#pragma unroll
            for (int n = 0; n < 2; ++n) bv[bj][n] = bias ? *(const f32x4*)(bias + bcol0 + bj * HALF + 4 * n) : (f32x4){0.f, 0.f, 0.f, 0.f};
#pragma unroll
        for (int ai = 0; ai < 2; ++ai)
#pragma unroll
            for (int m = 0; m < 4; ++m) { bf16_t* rowp = base + (size_t)(row0 + ai * HALF + m * 16) * ldc + col0;
#pragma unroll
                for (int bj = 0; bj < 2; ++bj) { f32x4 v0 = acc[ai][bj][m][0] + bv[bj][0], v1 = acc[ai][bj][m][1] + bv[bj][1];
                    if (ACT == 1) { f32x2 a = gelu_pk((f32x2){v0[0], v0[1]}), b = gelu_pk((f32x2){v0[2], v0[3]}), c = gelu_pk((f32x2){v1[0], v1[1]}), d = gelu_pk((f32x2){v1[2], v1[3]});
                        v0 = (f32x4){a.x, a.y, b.x, b.y}; v1 = (f32x4){c.x, c.y, d.x, d.y}; }
                    v0 = v0 * sc; v1 = v1 * sc; u32x4 w; w.x = cvt_pk_bf16(v0[0], v0[1]); w.y = cvt_pk_bf16(v0[2], v0[3]); w.z = cvt_pk_bf16(v1[0], v1[1]); w.w = cvt_pk_bf16(v1[2], v1[3]);
                    *(u32x4*)(rowp + bj * HALF) = w; } }
    }
};

struct EpiResGate {
    static constexpr bool PERM = false, AFTER_DRAIN = false;
    const float* x; float* out; int ldc; const float* bias; const float* ada; int ada_ld, gate_off, tiles_per_batch;
    __device__ __forceinline__ void operator()(const f32x4 (&acc)[2][2][4][2], const Unit& u, int wr, int wc, int fr, int fq) const {
        const int row0 = u.pm * BM + wr * 64 + fr, col0 = u.pn * BM + wc * 32 + 4 * fq;
        const float* gp = ada + (size_t)(u.pm / tiles_per_batch) * ada_ld + gate_off;
        f32x4 bv[2][2], gv[2][2];
#pragma unroll
        for (int bj = 0; bj < 2; ++bj)
#pragma unroll
            for (int n = 0; n < 2; ++n) { bv[bj][n] = *(const f32x4*)(bias + col0 + bj * HALF + n * 16); gv[bj][n] = *(const f32x4*)(gp + col0 + bj * HALF + n * 16); }
#pragma unroll
        for (int ai = 0; ai < 2; ++ai)
#pragma unroll
            for (int m = 0; m < 4; ++m) { const size_t off = (size_t)(row0 + ai * HALF + m * 16) * ldc + col0;
#pragma unroll
                for (int bj = 0; bj < 2; ++bj)
#pragma unroll
                    for (int n = 0; n < 2; ++n) { const f32x4 xv = *(const f32x4*)(x + off + bj * HALF + n * 16);
                        *(f32x4*)(out + off + bj * HALF + n * 16) = xv + gv[bj][n] * (acc[ai][bj][m][n] + bv[bj][n]); }
                asm volatile("" ::: "memory"); }
    }
};

template <class Epi, class Sched, bool ALIGN_EPI = false, bool SP2 = false>
__device__ __forceinline__ void gemm_phase(PG8_LAS unsigned char* lds, const Gemm g, const Sched& S, const Epi& E) {
    const int tid = threadIdx.x, wid = __builtin_amdgcn_readfirstlane(tid >> 6), lane = tid & 63, wr = wid >> 2, wc = wid & 3, fr = lane & 15, fq = lane >> 4;
    const int K = g.K, nt = K / BK;
    unsigned voffA[2], voffB[2];
#pragma unroll
    for (int i = 0; i < 2; ++i) { int R, C; stage_rc(tid * 16 + i * 8192, R, C); const int Rb = Epi::PERM ? ((R & ~31) + perm32(R & 31)) : R;
        voffA[i] = (unsigned)(R * K + C) * 2u; voffB[i] = (unsigned)(Rb * K + C) * 2u; }
    const size_t kstep = (size_t)(BK * 2);
    const size_t hstep = (size_t)HALF * K * 2;
    const size_t tstep = 2 * hstep;
    const unsigned ldsw = (unsigned)wid * 1024u;
    const int aoff = lds_byte(wr * 64 + fr, fq * 8), boff = lds_byte(wc * 32 + fr, fq * 8);
#define PG8_SA(b, h) (((b) * 2 + (h)) * HTB)
#define PG8_SB(b, h) ((4 + (b) * 2 + (h)) * HTB)
#define PG8_STAGE(bufoff, gbase, voff) do { _Pragma("unroll") for (int _i = 0; _i < 2; ++_i) \
        __builtin_amdgcn_global_load_lds((const unsigned*)((const char*)(gbase) + (voff)[_i]), (PG8_LAS unsigned*)(lds + (bufoff) + ldsw + _i * 8192), 16, 0, 0); } while (0)
#define PG8_LDA(dst, b, h) do { _Pragma("unroll") for (int m = 0; m < 4; ++m) _Pragma("unroll") for (int k = 0; k < 2; ++k) dst[m][k] = *(const PG8_LAS bf16x8*)(lds + PG8_SA(b, h) + aoff + m * 2048 + k * 1024); } while (0)
#define PG8_LDB(dst, b, h) do { _Pragma("unroll") for (int n = 0; n < 2; ++n) _Pragma("unroll") for (int k = 0; k < 2; ++k) dst[n][k] = *(const PG8_LAS bf16x8*)(lds + PG8_SB(b, h) + boff + n * 2048 + k * 1024); } while (0)
#define PG8_MMA(ai, bj, At, Bt) do { __builtin_amdgcn_s_setprio(1); _Pragma("unroll") for (int m = 0; m < 4; ++m) _Pragma("unroll") for (int n = 0; n < 2; ++n) _Pragma("unroll") for (int k = 0; k < 2; ++k) \
        acc[ai][bj][m][n] = __builtin_amdgcn_mfma_f32_16x16x32_bf16(Bt[n][k], At[m][k], acc[ai][bj][m][n], 0, 0, 0); __builtin_amdgcn_s_setprio(0); } while (0)
#define PG8_WAIT_V(n) asm volatile("s_waitcnt vmcnt(" #n ")" ::: "memory")
#define PG8_WAIT_L(n) asm volatile("s_waitcnt lgkmcnt(" #n ")" ::: "memory")
#define PG8_BAR __builtin_amdgcn_s_barrier()
#define PG8_SCHED __builtin_amdgcn_sched_barrier(0)
    Unit cur, nxt; int ui = 0;
    if (!S.next(0, cur)) return;
    f32x4 acc[2][2][4][2];
#pragma unroll
    for (int a = 0; a < 2; ++a)
#pragma unroll
        for (int b = 0; b < 2; ++b)
#pragma unroll
            for (int m = 0; m < 4; ++m)
#pragma unroll
                for (int n = 0; n < 2; ++n) acc[a][b][m][n] = (f32x4){0.f, 0.f, 0.f, 0.f};
    bf16x8 At[4][2], B0[2][2], B1[2][2];
    const char* cA = (const char*)g.A + (size_t)cur.pm * tstep; const char* cB = (const char*)g.Bt + (size_t)cur.pn * tstep;
    S.a_ready(cur);
    if constexpr (SP2) {
        PG8_STAGE(PG8_SB(0, 0), cB, voffB); PG8_STAGE(PG8_SB(0, 1), cB + hstep, voffB); PG8_STAGE(PG8_SA(0, 0), cA, voffA); PG8_STAGE(PG8_SA(0, 1), cA + hstep, voffA);
        if (wr == 1) PG8_BAR;
        PG8_WAIT_V(2); PG8_BAR;
        PG8_STAGE(PG8_SB(1, 0), cB + kstep, voffB); PG8_STAGE(PG8_SA(1, 0), cA + kstep, voffA); PG8_STAGE(PG8_SB(1, 1), cB + hstep + kstep, voffB);
        PG8_WAIT_V(6); PG8_BAR;
    } else {
        PG8_STAGE(PG8_SB(0, 0), cB, voffB); PG8_STAGE(PG8_SA(0, 0), cA, voffA); PG8_STAGE(PG8_SB(0, 1), cB + hstep, voffB); PG8_STAGE(PG8_SA(0, 1), cA + hstep, voffA);
        if (wr == 1) PG8_BAR;
        PG8_WAIT_V(4); PG8_BAR;
        PG8_STAGE(PG8_SB(1, 0), cB + kstep, voffB); PG8_STAGE(PG8_SA(1, 0), cA + kstep, voffA); PG8_STAGE(PG8_SB(1, 1), cB + hstep + kstep, voffB);
        PG8_WAIT_V(6); PG8_BAR;
    }
    for (;;) {
        const bool has_next = S.next(ui + 1, nxt);
        const char* nA = has_next ? (const char*)g.A + (size_t)nxt.pm * tstep : cA; const char* nB = has_next ? (const char*)g.Bt + (size_t)nxt.pn * tstep : cB;
        for (int t = 0; t < nt; t += 2) {
            const bool last = (t == nt - 2);
            const char* a1 = cA + (size_t)(t + 1) * kstep;
            const char* a2 = last ? nA : cA + (size_t)(t + 2) * kstep; const char* b2 = last ? nB : cB + (size_t)(t + 2) * kstep;
            const char* a3 = a2 + kstep; const char* b3 = b2 + kstep;
            if (last && has_next) S.a_ready(nxt);
            if constexpr (SP2) {
            PG8_LDB(B0, 0, 0); PG8_LDB(B1, 0, 1); PG8_SCHED; PG8_LDA(At, 0, 0); PG8_STAGE(PG8_SA(1, 1), a1 + hstep, voffA);
            PG8_WAIT_V(8); PG8_WAIT_L(0); PG8_BAR; PG8_MMA(0, 0, At, B0); PG8_MMA(0, 1, At, B1); PG8_BAR; PG8_SCHED;
            PG8_LDA(At, 0, 1); PG8_STAGE(PG8_SB(0, 0), b2, voffB); PG8_STAGE(PG8_SB(0, 1), b2 + hstep, voffB); PG8_STAGE(PG8_SA(0, 0), a2, voffA);
            PG8_WAIT_V(8); PG8_WAIT_L(0); PG8_BAR; PG8_MMA(1, 0, At, B0); PG8_MMA(1, 1, At, B1); PG8_BAR; PG8_SCHED;
            PG8_LDB(B0, 1, 0); PG8_LDB(B1, 1, 1); PG8_SCHED; PG8_LDA(At, 1, 0); PG8_STAGE(PG8_SA(0, 1), a2 + hstep, voffA);
            PG8_WAIT_V(8); PG8_WAIT_L(0); PG8_BAR; PG8_MMA(0, 0, At, B0); PG8_MMA(0, 1, At, B1); PG8_BAR; PG8_SCHED;
            PG8_LDA(At, 1, 1); PG8_STAGE(PG8_SB(1, 0), b3, voffB); PG8_STAGE(PG8_SB(1, 1), b3 + hstep, voffB); PG8_STAGE(PG8_SA(1, 0), a3, voffA);
            PG8_WAIT_V(8); PG8_WAIT_L(0); PG8_BAR; PG8_MMA(1, 0, At, B0); PG8_MMA(1, 1, At, B1); PG8_BAR; PG8_SCHED;
            } else {
            PG8_LDB(B0, 0, 0); PG8_SCHED; PG8_LDA(At, 0, 0); PG8_STAGE(PG8_SA(1, 1), a1 + hstep, voffA);
            PG8_WAIT_L(8); PG8_BAR; PG8_WAIT_L(0); PG8_MMA(0, 0, At, B0); PG8_BAR; PG8_SCHED;
            PG8_LDB(B1, 0, 1); PG8_STAGE(PG8_SB(0, 0), b2, voffB);
            PG8_BAR; PG8_WAIT_L(0); PG8_MMA(0, 1, At, B1); PG8_BAR;
            PG8_LDA(At, 0, 1); PG8_STAGE(PG8_SA(0, 0), a2, voffA);
            PG8_BAR; PG8_WAIT_L(0); PG8_MMA(1, 0, At, B0); PG8_BAR; PG8_SCHED;
            PG8_STAGE(PG8_SB(0, 1), b2 + hstep, voffB);
            PG8_WAIT_V(6); PG8_BAR; PG8_MMA(1, 1, At, B1); PG8_BAR;
            PG8_LDB(B0, 1, 0); PG8_SCHED; PG8_LDA(At, 1, 0); PG8_STAGE(PG8_SA(0, 1), a2 + hstep, voffA);
            PG8_WAIT_L(8); PG8_BAR; PG8_WAIT_L(0); PG8_MMA(0, 0, At, B0); PG8_BAR; PG8_SCHED;
            PG8_LDB(B1, 1, 1); PG8_STAGE(PG8_SB(1, 0), b3, voffB);
            PG8_BAR; PG8_WAIT_L(0); PG8_MMA(0, 1, At, B1); PG8_BAR;
            PG8_LDA(At, 1, 1); PG8_STAGE(PG8_SA(1, 0), a3, voffA);
            PG8_BAR; PG8_WAIT_L(0); PG8_MMA(1, 0, At, B0); PG8_BAR; PG8_SCHED;
            PG8_STAGE(PG8_SB(1, 1), b3 + hstep, voffB);
            PG8_WAIT_V(6); PG8_BAR; PG8_MMA(1, 1, At, B1); PG8_BAR;
            }
        }
        if constexpr (ALIGN_EPI) { if (wr == 0) PG8_BAR; }
        if constexpr (!Epi::AFTER_DRAIN) { E(acc, cur, wr, wc, fr, fq); S.done(cur); }
        if (!has_next) break;
#pragma unroll
        for (int a = 0; a < 2; ++a)
#pragma unroll
            for (int b = 0; b < 2; ++b)
#pragma unroll
                for (int m = 0; m < 4; ++m)
#pragma unroll
                    for (int n = 0; n < 2; ++n) acc[a][b][m][n] = (f32x4){0.f, 0.f, 0.f, 0.f};
        cur = nxt; cA = nA; cB = nB; ++ui;
        if constexpr (ALIGN_EPI) { if (wr == 1) PG8_BAR; }
    }
    PG8_WAIT_V(0);
    if constexpr (!ALIGN_EPI) { if (wr == 0) PG8_BAR; }
    PG8_BAR;
    if constexpr (Epi::AFTER_DRAIN) { E.fused(acc, cur, wr, wc, fr, fq, lds, wid, lane); S.done(cur); }
#undef PG8_SA
#undef PG8_SB
#undef PG8_STAGE
#undef PG8_LDA
#undef PG8_LDB
#undef PG8_MMA
#undef PG8_WAIT_V
#undef PG8_WAIT_L
#undef PG8_BAR
#undef PG8_SCHED
}
}

constexpr int NWAVES = 8;
constexpr int NPHASES = 9;
#ifndef MK_N_LAUNCHES
#define MK_N_LAUNCHES 9
#endif
constexpr int N_LAUNCHES = MK_N_LAUNCHES;
static_assert(N_LAUNCHES == 1 || N_LAUNCHES == NPHASES, "MK_N_LAUNCHES is 1 or NPHASES");

constexpr int BATCH = 16, SEQ = 2048, D = 1024, M = BATCH * SEQ;
constexpr int IN_W = 2304, O_Q = 0, O_K = 512, O_V = 640, O_B = 768, O_C = 1280, O_U = 1792;
constexpr int NQH = 8, NKVH = 2, HD = 64, WIN = 128;
constexpr int NKEYS = 128, NEXP = 16384, PH = 8, TOPK = 16, DKEY = 256, DHALF = 128, QW = PH * DKEY;
constexpr int ADA_W = 6 * D, ADA_KC = 8;
constexpr float EPS = 1e-6f;

constexpr size_t MiB = 1u << 20;
constexpr size_t WS_CTL = 0, CTL_ZERO_BYTES = 1 * MiB;
constexpr size_t WS_ADAP = 1 * MiB;
constexpr size_t WS_ADA = 4 * MiB;
constexpr size_t WS_WIN = 5 * MiB;
constexpr size_t WS_WOUT = 10 * MiB;
constexpr size_t WS_WQ = 12 * MiB;
constexpr size_t WS_K1 = 16 * MiB, WS_K2 = 16 * MiB + 512 * 1024;
constexpr size_t WS_U = 17 * MiB, WS_V = 49 * MiB;
constexpr size_t WS_H = 81 * MiB;
constexpr size_t WS_PROJ = 145 * MiB;
constexpr size_t WS_MIX = 289 * MiB;
constexpr size_t WS_IDX = 353 * MiB;
constexpr size_t WS_GATE = 369 * MiB;
constexpr size_t WS_END = 385 * MiB;
constexpr int CW_BAR = 4096;

constexpr int RING_OFF = 0, RING_BYTES = 131072;
constexpr int LDSCTL_OFF = RING_BYTES, MISC_OFF = LDSCTL_OFF + 320;
constexpr int LDS_BYTES = 147456;
static_assert(MISC_OFF + 128 <= LDS_BYTES, "LDS map");

#define GAS __attribute__((address_space(1)))
#define LAS __attribute__((address_space(3)))
typedef unsigned short bf16;
typedef unsigned v4u __attribute__((ext_vector_type(4)));
typedef float f32x4 __attribute__((ext_vector_type(4)));
typedef short bf16x8 __attribute__((ext_vector_type(8)));
typedef GAS unsigned gu32;
typedef GAS unsigned long long gu64;
#define RLX_AGENT __ATOMIC_RELAXED, __HIP_MEMORY_SCOPE_AGENT
#define LDS_WAIT() asm volatile("s_waitcnt lgkmcnt(0)" ::: "memory")
#define VM_WAIT() asm volatile("s_waitcnt vmcnt(0)" ::: "memory")
__device__ __forceinline__ unsigned long long rt() { return __builtin_amdgcn_s_memrealtime(); }
__device__ __forceinline__ unsigned f2bf(float f) { unsigned u = __builtin_bit_cast(unsigned, f); return (u + 0x7fffu + ((u >> 16) & 1u)) >> 16; }
__device__ __forceinline__ unsigned pk2(float lo, float hi) { return f2bf(lo) | (f2bf(hi) << 16); }

#define XB_TMO      128
#define XB_XCNT(j)  (256  + 64 * (j))
#define XB_XSUB(j)  (1280 + 64 * (j))
#define XB_XGEN(j)  (2304 + 64 * (j))
#define XB_TOP      3328
#define XB_TOPGEN   3392
#define XCD_BAR_WORDS 3456
#define XB_SPIN_CAP (1u << 22)

__device__ __forceinline__ unsigned xb_ld(unsigned* p)              { return __hip_atomic_load(p, __ATOMIC_RELAXED, __HIP_MEMORY_SCOPE_AGENT); }
__device__ __forceinline__ unsigned xb_add(unsigned* p, unsigned v) { return __hip_atomic_fetch_add(p, v, __ATOMIC_RELAXED, __HIP_MEMORY_SCOPE_AGENT); }
__device__ __forceinline__ unsigned xb_xcc_id() { return (unsigned)__builtin_amdgcn_s_getreg((3 << 11) | 20) & 0xFu; }
#define XB_SPIN(cond, bar) do { unsigned _sp = 0; while (cond) { __builtin_amdgcn_s_sleep(1); \
    if ((++_sp & 255u) == 0u) { if (xb_ld(&(bar)[XB_TMO])) break; if (_sp > XB_SPIN_CAP) { atomicAdd(&(bar)[XB_TMO], 1u); break; } } } } while (0)

struct XcdBarrier {
    unsigned* bar; unsigned x;
    volatile LAS unsigned* st;
};

__device__ __forceinline__ XcdBarrier xcd_barrier_post(unsigned* bar, volatile LAS unsigned* st) {
    XcdBarrier b; b.bar = bar; b.x = xb_xcc_id(); b.st = st;
    if (threadIdx.x == 0) (void)xb_add(&bar[XB_XCNT(b.x)], 1u);
    return b;
}
__device__ __forceinline__ void xcd_barrier_complete(unsigned* bar, unsigned x, unsigned& nloc, unsigned& nx) {
    const unsigned G = gridDim.x * gridDim.y * gridDim.z;
    unsigned sum, cnt, mine, sp = 0u;
    for (;;) {
        sum = 0u; cnt = 0u; mine = 0u;
#pragma unroll
        for (unsigned j = 0; j < 16; ++j) { const unsigned c = xb_ld(&bar[XB_XCNT(j)]); sum += c; cnt += (c > 0u) ? 1u : 0u; mine = (j == x) ? c : mine; }
        if (sum == G) break;
        __builtin_amdgcn_s_sleep(1);
        if ((++sp & 255u) == 0u) { if (xb_ld(&bar[XB_TMO])) break; if (sp > XB_SPIN_CAP) { atomicAdd(&bar[XB_TMO], 1u); break; } }
    }
    nloc = mine > 0u ? mine : 1u; nx = cnt > 0u ? cnt : 1u;
}

__device__ __forceinline__ void xcd_barrier(const XcdBarrier& b) {
    asm volatile("s_waitcnt vmcnt(0)" ::: "memory");
    __syncthreads();
    if (threadIdx.x == 0) {
        unsigned* bar = b.bar;
        __builtin_amdgcn_s_waitcnt(0);
        unsigned nloc = b.st[0], nx = b.st[1];
        if (nloc == 0u) { xcd_barrier_complete(bar, b.x, nloc, nx); b.st[0] = nloc; b.st[1] = nx; }
        const unsigned old = xb_add(&bar[XB_XSUB(b.x)], 1u);
        const unsigned gen = old / nloc;
        if (old + 1u == (gen + 1u) * nloc) {
            __builtin_amdgcn_fence(__ATOMIC_RELEASE, "agent");
            asm volatile("s_waitcnt vmcnt(0)" ::: "memory");
            const unsigned og = xb_add(&bar[XB_TOP], 1u);
            const unsigned tg = og / nx;
            if (og + 1u == (tg + 1u) * nx) xb_add(&bar[XB_TOPGEN], 1u);
            else XB_SPIN(xb_ld(&bar[XB_TOPGEN]) == tg, bar);
            __builtin_amdgcn_fence(__ATOMIC_ACQUIRE, "agent");
            xb_add(&bar[XB_XGEN(b.x)], 1u);
            asm volatile("s_waitcnt vmcnt(0)" ::: "memory");
        } else {
            XB_SPIN(xb_ld(&bar[XB_XGEN(b.x)]) == gen, bar);
            __builtin_amdgcn_fence(__ATOMIC_ACQUIRE, "agent");
            asm volatile("s_waitcnt vmcnt(0)" ::: "memory");
        }
    }
    __syncthreads();
}

struct Frame {
    LAS unsigned char* lds;
    volatile LAS unsigned* MISC;
    gu32* ctl;
    int tid, lane, wave;
    int vcu, G;
    const float* in[20]; float* out; unsigned char* ws;
};
#define IN_X 0
#define IN_C 1
#define IN_WADA 2
#define IN_BADA 3
#define IN_G1 4
#define IN_WIN 5
#define IN_BIN 6
#define IN_SINK 7
#define IN_CONVW 8
#define IN_AOG 9
#define IN_COG 10
#define IN_WOUT 11
#define IN_BOUT 12
#define IN_G2 13
#define IN_WQ 14
#define IN_PK1 15
#define IN_PK2 16
#define IN_PU 17
#define IN_PV 18
#define IN_GF 19

typedef __bf16 bf16x2_t __attribute__((ext_vector_type(2)));
typedef unsigned v2u __attribute__((ext_vector_type(2)));
__device__ __forceinline__ float dot2(unsigned a, unsigned b, float acc) { return __builtin_amdgcn_fdot2_f32_bf16(__builtin_bit_cast(bf16x2_t, a), __builtin_bit_cast(bf16x2_t, b), acc, false); }
__device__ __forceinline__ float dot8(v4u a, v4u b, float acc) { acc = dot2(a.x, b.x, acc); acc = dot2(a.y, b.y, acc); acc = dot2(a.z, b.z, acc); acc = dot2(a.w, b.w, acc); return acc; }
__device__ __forceinline__ float bflo(unsigned w) { return __uint_as_float(w << 16); }
__device__ __forceinline__ float bfhi(unsigned w) { return __uint_as_float(w & 0xffff0000u); }
__device__ __forceinline__ float wave_sum(float v) {
#pragma unroll
    for (int o = 1; o < 64; o <<= 1) v += __shfl_xor(v, o);
    return v;
}
__device__ __forceinline__ unsigned wave_umax(unsigned v) {
#pragma unroll
    for (int o = 1; o < 64; o <<= 1) { const unsigned t = (unsigned)__shfl_xor((int)v, o); v = v > t ? v : t; }
    return v;
}
__device__ __forceinline__ unsigned f2ord(float f) { const unsigned u = __float_as_uint(f); return (u & 0x80000000u) ? ~u : (u | 0x80000000u); }
__device__ __forceinline__ float ord2f(unsigned u) { return __uint_as_float((u & 0x80000000u) ? (u & 0x7fffffffu) : ~u); }

__device__ __forceinline__ void p0_transpose_item(const float* W, int K, int N, bf16* WT, LAS float* scr, int item, int lane) {
    const int nblk = N / 32, kb = item / nblk, nb = item % nblk, k0 = 64 * kb, n0 = 32 * nb;
#pragma unroll 8
    for (int i = 0; i < 32; ++i) { const int kk = 2 * i + (lane >> 5); scr[kk * 33 + (lane & 31)] = W[(size_t)(k0 + kk) * N + n0 + (lane & 31)]; }
    LDS_WAIT(); asm volatile("" ::: "memory");
    const int c = lane & 7;
#pragma unroll
    for (int j = 0; j < 4; ++j) { const int n = (lane >> 3) + 8 * j; const LAS float* s = scr + (8 * c) * 33 + n;
        v4u o; o.x = pk2(s[0 * 33], s[1 * 33]); o.y = pk2(s[2 * 33], s[3 * 33]); o.z = pk2(s[4 * 33], s[5 * 33]); o.w = pk2(s[6 * 33], s[7 * 33]);
        *(GAS v4u*)(WT + (size_t)(n0 + n) * K + k0 + 8 * c) = o; }
    LDS_WAIT(); asm volatile("" ::: "memory");
}
__device__ __forceinline__ void p0_convert_item(const float* src, bf16* dst, size_t item, int lane) {
    const GAS f32x4* s = (const GAS f32x4*)(src + item * 2048) + lane * 2;
    GAS v4u* d = (GAS v4u*)(dst + item * 2048) + lane;
#pragma unroll
    for (int j = 0; j < 4; ++j) { const f32x4 a = s[j * 128], b = s[j * 128 + 1];
        v4u o; o.x = pk2(a.x, a.y); o.y = pk2(a.z, a.w); o.z = pk2(b.x, b.y); o.w = pk2(b.z, b.w); d[j * 64] = o; }
}
__device__ __forceinline__ void p0_ada_task(Frame& F, int task, LAS float* scr) {
    const int kc = task / (ADA_W / 64), ng = task % (ADA_W / 64), lane = F.lane;
    const float* c = F.in[IN_C];
    for (int e = lane; e < BATCH * 128; e += 64) { const int b = e >> 7, kk = e & 127; const float cv = c[b * D + kc * 128 + kk]; scr[kk * 16 + b] = cv / (1.f + expf(-cv)); }
    LDS_WAIT(); asm volatile("" ::: "memory");
    float acc[BATCH];
#pragma unroll
    for (int b = 0; b < BATCH; ++b) acc[b] = 0.f;
    const float* wp = F.in[IN_WADA] + (size_t)(kc * 128) * ADA_W + ng * 64 + lane;
#pragma unroll 4
    for (int kk = 0; kk < 128; ++kk) { const float wv = wp[(size_t)kk * ADA_W];
        const LAS f32x4* sp = (const LAS f32x4*)(scr + kk * 16);
#pragma unroll
        for (int q = 0; q < 4; ++q) { const f32x4 s = sp[q]; acc[4 * q] += s.x * wv; acc[4 * q + 1] += s.y * wv; acc[4 * q + 2] += s.z * wv; acc[4 * q + 3] += s.w * wv; } }
    float* ap = (float*)(F.ws + WS_ADAP);
#pragma unroll
    for (int b = 0; b < BATCH; ++b) ap[(size_t)(kc * BATCH + b) * ADA_W + ng * 64 + lane] = acc[b];
    LDS_WAIT(); asm volatile("" ::: "memory");
}
__device__ __forceinline__ void p0_prologue(Frame& F) {
    LAS float* scr = (LAS float*)(F.lds + RING_OFF + F.wave * 16384);
    const int gw = F.vcu * NWAVES + F.wave, NGW = F.G * NWAVES;
    constexpr int I_ADA = ADA_KC * (ADA_W / 64);
    constexpr int I_T1 = (D / 64) * (IN_W / 32), I_T2 = (D / 64) * (D / 32), I_T3 = (D / 64) * (QW / 32);
    constexpr int I_K = PH * NKEYS * DHALF / 2048;
    constexpr int I_E = (int)((size_t)NEXP * D / 2048);
    constexpr int NITEMS = I_ADA + I_T1 + I_T2 + I_T3 + 2 * I_K + 2 * I_E;
    for (int it = gw; it < NITEMS; it += NGW) {
        int r = it;
        if (r < I_ADA) { p0_ada_task(F, r, scr); continue; } r -= I_ADA;
        if (r < I_T1) { p0_transpose_item(F.in[IN_WIN], D, IN_W, (bf16*)(F.ws + WS_WIN), scr, r, F.lane); continue; } r -= I_T1;
        if (r < I_T2) { p0_transpose_item(F.in[IN_WOUT], D, D, (bf16*)(F.ws + WS_WOUT), scr, r, F.lane); continue; } r -= I_T2;
        if (r < I_T3) { p0_transpose_item(F.in[IN_WQ], D, QW, (bf16*)(F.ws + WS_WQ), scr, r, F.lane); continue; } r -= I_T3;
        if (r < I_K) { p0_convert_item(F.in[IN_PK1], (bf16*)(F.ws + WS_K1), r, F.lane); continue; } r -= I_K;
        if (r < I_K) { p0_convert_item(F.in[IN_PK2], (bf16*)(F.ws + WS_K2), r, F.lane); continue; } r -= I_K;
        if (r < I_E) { p0_convert_item(F.in[IN_PU], (bf16*)(F.ws + WS_U), r, F.lane); continue; } r -= I_E;
        p0_convert_item(F.in[IN_PV], (bf16*)(F.ws + WS_V), r, F.lane);
    }
}

__device__ __forceinline__ void mod_row(const float* xrow, bf16* orow, const LAS float* SC, const LAS float* SH, int lane) {
    const GAS f32x4* xr = (const GAS f32x4*)xrow + lane;
    f32x4 v[4]; float s = 0.f;
#pragma unroll
    for (int j = 0; j < 4; ++j) { v[j] = xr[64 * j]; s += (v[j].x * v[j].x + v[j].y * v[j].y) + (v[j].z * v[j].z + v[j].w * v[j].w); }
    const float rstd = 1.0f / sqrtf(wave_sum(s) * (1.f / D) + EPS);
    GAS unsigned long long* o8 = (GAS unsigned long long*)orow + lane;
#pragma unroll
    for (int j = 0; j < 4; ++j) { const f32x4 sc = ((const LAS f32x4*)SC)[lane + 64 * j], sh = ((const LAS f32x4*)SH)[lane + 64 * j];
        const f32x4 o = v[j] * rstd * sc + sh;
        o8[64 * j] = (unsigned long long)pk2(o.x, o.y) | ((unsigned long long)pk2(o.z, o.w) << 32); }
}
__device__ __forceinline__ void p1_hpass(Frame& F) {
    LAS float* SC = (LAS float*)(F.lds); LAS float* SH = SC + D;
    const float* adap = (const float*)(F.ws + WS_ADAP); const float* bada = F.in[IN_BADA]; const float* g1 = F.in[IN_G1];
    float* ada = (float*)(F.ws + WS_ADA);
    for (int e = blockIdx.x * 512 + F.tid; e < BATCH * ADA_W; e += F.G * 512) { const int b = e / ADA_W, n = e % ADA_W; float s = bada[n];
#pragma unroll
        for (int kc = 0; kc < ADA_KC; ++kc) s += adap[(size_t)(kc * BATCH + b) * ADA_W + n];
        ada[e] = s; }
    for (int tile = blockIdx.x; tile < M / 128; tile += F.G) {
        const int b = tile / (SEQ / 128);
        for (int d = F.tid; d < D; d += 512) { float sh = bada[d], sc = bada[D + d];
#pragma unroll
            for (int kc = 0; kc < ADA_KC; ++kc) { const float* p = adap + (size_t)(kc * BATCH + b) * ADA_W; sh += p[d]; sc += p[D + d]; }
            SC[d] = g1[d] * (1.f + sc); SH[d] = sh; }
        __syncthreads();
        for (int r = F.wave; r < 128; r += NWAVES) { const size_t row = (size_t)tile * 128 + r; mod_row(F.in[IN_X] + row * D, (bf16*)(F.ws + WS_H) + row * D, SC, SH, F.lane); }
        __syncthreads();
    }
}
__device__ __forceinline__ void p5_h2pass(Frame& F) {
    LAS float* SC = (LAS float*)(F.lds); LAS float* SH = SC + D;
    const float* ada = (const float*)(F.ws + WS_ADA); const float* g2 = F.in[IN_G2];
    for (int tile = blockIdx.x; tile < M / 128; tile += F.G) {
        const int b = tile / (SEQ / 128);
        for (int d = F.tid; d < D; d += 512) { SC[d] = g2[d] * (1.f + ada[(size_t)b * ADA_W + 4 * D + d]); SH[d] = ada[(size_t)b * ADA_W + 3 * D + d]; }
        __syncthreads();
        for (int r = F.wave; r < 128; r += NWAVES) { const size_t row = (size_t)tile * 128 + r; mod_row(F.out + row * D, (bf16*)(F.ws + WS_H) + row * D, SC, SH, F.lane); }
        __syncthreads();
    }
}

constexpr int KV_STRIDE = 144;
__device__ __forceinline__ void p3_attn_unit(Frame& F, int unit) {
    const int kh = unit & 1, nb = (unit >> 1) & 15, b = unit >> 5;
    LAS unsigned char* KL = F.lds; LAS unsigned char* VL = F.lds + 256 * KV_STRIDE;
    const bf16* proj = (const bf16*)(F.ws + WS_PROJ);
    const int tok0 = b * SEQ + nb * 128;
    for (int c = F.tid; c < 2048; c += 512) { const int j = c >> 3, ch = c & 7;
        v4u kv = (v4u){0u, 0u, 0u, 0u}, vv = (v4u){0u, 0u, 0u, 0u};
        if (nb > 0 || j >= 128) { const bf16* rowp = proj + (size_t)(tok0 - 128 + j) * IN_W; kv = *(const GAS v4u*)(rowp + O_K + kh * HD + ch * 8); vv = *(const GAS v4u*)(rowp + O_V + kh * HD + ch * 8); }
        *(LAS v4u*)(KL + j * KV_STRIDE + ch * 16) = kv; *(LAS v4u*)(VL + j * KV_STRIDE + ch * 16) = vv; }
    __syncthreads();
    const int g = F.tid >> 7, i = F.tid & 127, qh = kh * 4 + g;
    const bf16* qp = proj + (size_t)(tok0 + i) * IN_W + O_Q + qh * HD;
    v4u q[8]; float o[64];
#pragma unroll
    for (int ch = 0; ch < 8; ++ch) q[ch] = *(const GAS v4u*)(qp + ch * 8);
#pragma unroll
    for (int d = 0; d < 64; ++d) o[d] = 0.f;
    float m = F.in[IN_SINK][qh], l = 1.f;
#pragma unroll 1
    for (int s0 = 0; s0 < 128; s0 += 4) {
        float sc[4];
#pragma unroll
        for (int e = 0; e < 4; ++e) { const int j = i + 1 + s0 + e; const LAS v4u* kr = (const LAS v4u*)(KL + j * KV_STRIDE); float a = 0.f;
#pragma unroll
            for (int ch = 0; ch < 8; ++ch) a = dot8(kr[ch], q[ch], a);
            a *= 0.125f;
            sc[e] = (nb > 0 || j >= 128) ? a : -1e30f; }
        const float mx = fmaxf(fmaxf(sc[0], sc[1]), fmaxf(sc[2], sc[3])), mn = fmaxf(m, mx), corr = __expf(m - mn);
        m = mn; l *= corr;
#pragma unroll
        for (int d = 0; d < 64; ++d) o[d] *= corr;
#pragma unroll
        for (int e = 0; e < 4; ++e) { const int j = i + 1 + s0 + e; const float p = __expf(sc[e] - m); l += p; const LAS v4u* vr = (const LAS v4u*)(VL + j * KV_STRIDE);
#pragma unroll
            for (int ch = 0; ch < 8; ++ch) { const v4u w = vr[ch];
                o[ch * 8 + 0] += p * bflo(w.x); o[ch * 8 + 1] += p * bfhi(w.x); o[ch * 8 + 2] += p * bflo(w.y); o[ch * 8 + 3] += p * bfhi(w.y);
                o[ch * 8 + 4] += p * bflo(w.z); o[ch * 8 + 5] += p * bfhi(w.z); o[ch * 8 + 6] += p * bflo(w.w); o[ch * 8 + 7] += p * bfhi(w.w); } }
    }
    const float inv = 1.f / l; float ss = 0.f;
#pragma unroll
    for (int d = 0; d < 64; ++d) { o[d] *= inv; ss += o[d] * o[d]; }
    const float rs = 1.0f / sqrtf(ss * (1.f / HD) + EPS);
    const float* gp = F.in[IN_AOG] + qh * HD;
    bf16* op = (bf16*)(F.ws + WS_MIX) + (size_t)(tok0 + i) * D + qh * HD;
#pragma unroll
    for (int ch = 0; ch < 8; ++ch) { const f32x4 g0 = *(const f32x4*)(gp + ch * 8), g1 = *(const f32x4*)(gp + ch * 8 + 4);
        v4u w; w.x = pk2(o[ch * 8 + 0] * rs * g0.x, o[ch * 8 + 1] * rs * g0.y); w.y = pk2(o[ch * 8 + 2] * rs * g0.z, o[ch * 8 + 3] * rs * g0.w);
        w.z = pk2(o[ch * 8 + 4] * rs * g1.x, o[ch * 8 + 5] * rs * g1.y); w.w = pk2(o[ch * 8 + 6] * rs * g1.z, o[ch * 8 + 7] * rs * g1.w);
        *(GAS v4u*)(op + ch * 8) = w; }
    __syncthreads();
}
__device__ __forceinline__ void p3_conv(Frame& F) {
    const bf16* proj = (const bf16*)(F.ws + WS_PROJ); const int lane = F.lane, c0 = 8 * lane;
    const float* cw = F.in[IN_CONVW]; const float* cg = F.in[IN_COG];
    float w0[8], w1[8], w2[8], gg[8];
#pragma unroll
    for (int e = 0; e < 8; ++e) { w0[e] = cw[c0 + e]; w1[e] = cw[512 + c0 + e]; w2[e] = cw[1024 + c0 + e]; gg[e] = cg[c0 + e]; }
    const int gw = F.vcu * NWAVES + F.wave, NGW = F.G * NWAVES;
    for (int tok = gw; tok < M; tok += NGW) {
        const int s = tok & (SEQ - 1); const bf16* rp = proj + (size_t)tok * IN_W;
        const v4u z4 = (v4u){0u, 0u, 0u, 0u};
        const v4u Bv = *(const GAS v4u*)(rp + O_B + c0), C0 = *(const GAS v4u*)(rp + O_C + c0), U0 = *(const GAS v4u*)(rp + O_U + c0);
        v4u C1 = z4, U1 = z4, C2 = z4, U2 = z4;
        if (s >= 1) { C1 = *(const GAS v4u*)(rp - IN_W + O_C + c0); U1 = *(const GAS v4u*)(rp - IN_W + O_U + c0); }
        if (s >= 2) { C2 = *(const GAS v4u*)(rp - 2 * IN_W + O_C + c0); U2 = *(const GAS v4u*)(rp - 2 * IN_W + O_U + c0); }
        float y[8]; float ss = 0.f;
#pragma unroll
        for (int e = 0; e < 8; ++e) { const int wi = e >> 1; const bool hi = e & 1;
            const unsigned bw = Bv[wi], c0w = C0[wi], u0w = U0[wi], c1w = C1[wi], u1w = U1[wi], c2w = C2[wi], u2w = U2[wi];
            const float bb = hi ? bfhi(bw) : bflo(bw);
            const float z0 = (hi ? bfhi(c0w) : bflo(c0w)) * (hi ? bfhi(u0w) : bflo(u0w));
            const float z1 = (hi ? bfhi(c1w) : bflo(c1w)) * (hi ? bfhi(u1w) : bflo(u1w));
            const float z2 = (hi ? bfhi(c2w) : bflo(c2w)) * (hi ? bfhi(u2w) : bflo(u2w));
            y[e] = bb * (z2 * w0[e] + z1 * w1[e] + z0 * w2[e]); ss += y[e] * y[e]; }
        ss += __shfl_xor(ss, 1); ss += __shfl_xor(ss, 2); ss += __shfl_xor(ss, 4);
        const float rs = 1.0f / sqrtf(ss * (1.f / 64.f) + EPS);
        v4u w; w.x = pk2(y[0] * rs * gg[0], y[1] * rs * gg[1]); w.y = pk2(y[2] * rs * gg[2], y[3] * rs * gg[3]);
        w.z = pk2(y[4] * rs * gg[4], y[5] * rs * gg[5]); w.w = pk2(y[6] * rs * gg[6], y[7] * rs * gg[7]);
        *(GAS v4u*)((bf16*)(F.ws + WS_MIX) + (size_t)tok * D + 512 + c0) = w;
    }
}
__device__ __forceinline__ void p3_mixer(Frame& F) {
    for (int unit = blockIdx.x; unit < BATCH * 16 * NKVH; unit += F.G) p3_attn_unit(F, unit);
    p3_conv(F);
}

constexpr int KEY_STRIDE = 272;
__device__ __forceinline__ void p7_routing(Frame& F) {
    LAS unsigned char* KL1 = F.lds; LAS unsigned char* KL2 = F.lds + 128 * KEY_STRIDE; LAS unsigned char* QS = F.lds + 2 * 128 * KEY_STRIDE + F.wave * 512;
    const bf16* pq = (const bf16*)(F.ws + WS_PROJ); const bf16* k1 = (const bf16*)(F.ws + WS_K1); const bf16* k2 = (const bf16*)(F.ws + WS_K2);
    int* IDX = (int*)(F.ws + WS_IDX); float* GATE = (float*)(F.ws + WS_GATE);
    const int lane = F.lane;
    for (int tile = blockIdx.x; tile < M / 128; tile += F.G) {
        for (int h = 0; h < PH; ++h) {
            for (int c = F.tid; c < 2 * 128 * 16; c += 512) { const int which = c >> 11, r = (c >> 4) & 127, ch = c & 15;
                const v4u v = *(const GAS v4u*)((which ? k2 : k1) + (size_t)(h * NKEYS + r) * DHALF + ch * 8);
                *(LAS v4u*)((which ? KL2 : KL1) + r * KEY_STRIDE + ch * 16) = v; }
            __syncthreads();
            for (int tt = F.wave; tt < 128; tt += NWAVES) {
                const int tok = tile * 128 + tt;
                const v2u qv = *(const GAS v2u*)(pq + (size_t)tok * QW + h * DKEY + 4 * lane);
                *(LAS v2u*)(QS + 8 * lane) = qv;
                LDS_WAIT(); asm volatile("" ::: "memory");
                float s1a = 0.f, s1b = 0.f, s2a = 0.f, s2b = 0.f;
#pragma unroll
                for (int ch = 0; ch < 16; ++ch) {
                    const v4u q1 = *(const LAS v4u*)(QS + ch * 16), q2 = *(const LAS v4u*)(QS + 256 + ch * 16);
                    s1a = dot8(*(const LAS v4u*)(KL1 + lane * KEY_STRIDE + ch * 16), q1, s1a);
                    s1b = dot8(*(const LAS v4u*)(KL1 + (lane + 64) * KEY_STRIDE + ch * 16), q1, s1b);
                    s2a = dot8(*(const LAS v4u*)(KL2 + lane * KEY_STRIDE + ch * 16), q2, s2a);
                    s2b = dot8(*(const LAS v4u*)(KL2 + (lane + 64) * KEY_STRIDE + ch * 16), q2, s2b); }
                unsigned p1a = (f2ord(s1a) & ~127u) | (unsigned)(127 - lane), p1b = (f2ord(s1b) & ~127u) | (unsigned)(63 - lane);
                unsigned p2a = (f2ord(s2a) & ~127u) | (unsigned)(127 - lane), p2b = (f2ord(s2b) & ~127u) | (unsigned)(63 - lane);
                unsigned t1 = 0u, t2 = 0u;
#pragma unroll 1
                for (int it = 0; it < TOPK; ++it) {
                    const unsigned m1 = wave_umax(p1a > p1b ? p1a : p1b), m2 = wave_umax(p2a > p2b ? p2a : p2b);
                    if (lane == it) { t1 = m1; t2 = m2; }
                    if (p1a == m1) p1a = 0u; if (p1b == m1) p1b = 0u; if (p2a == m2) p2a = 0u; if (p2b == m2) p2b = 0u; }
                const float v1 = ord2f(t1 & ~127u), v2 = ord2f(t2 & ~127u);
                const int i1 = 127 - (int)(t1 & 127u), i2 = 127 - (int)(t2 & 127u);
                unsigned pc[4];
#pragma unroll
                for (int cc = 0; cc < 4; ++cc) { const int c = lane + 64 * cc; const float sm = __shfl(v1, c >> 4) + __shfl(v2, c & 15); pc[cc] = (f2ord(sm) & ~255u) | (unsigned)(255 - c); }
                unsigned tc = 0u;
#pragma unroll 1
                for (int it = 0; it < TOPK; ++it) {
                    const unsigned a = pc[0] > pc[1] ? pc[0] : pc[1], bq = pc[2] > pc[3] ? pc[2] : pc[3]; const unsigned mc = wave_umax(a > bq ? a : bq);
                    if (lane == it) tc = mc;
#pragma unroll
                    for (int cc = 0; cc < 4; ++cc) if (pc[cc] == mc) pc[cc] = 0u; }
                const int csel = 255 - (int)(tc & 255u), ci = csel >> 4, cj = csel & 15;
                const float scv = __shfl(v1, ci) + __shfl(v2, cj);
                const int e1 = __shfl(i1, ci), e2 = __shfl(i2, cj);
                const float mxs = __shfl(scv, 0);
                const float ex = lane < TOPK ? __expf(scv - mxs) : 0.f;
                const float den = wave_sum(ex);
                if (lane < TOPK) { IDX[(size_t)tok * 128 + h * TOPK + lane] = (e1 * NKEYS + e2) & (NEXP - 1); GATE[(size_t)tok * 128 + h * TOPK + lane] = ex / den; }
            }
            __syncthreads();
        }
    }
}

__device__ __forceinline__ float gelu_erf(float v) { return 0.5f * v * (1.f + erff(v * 0.70710678118654752f)); }
__device__ __forceinline__ void p8_experts(Frame& F) {
    const bf16* H2 = (const bf16*)(F.ws + WS_H); const bf16* U = (const bf16*)(F.ws + WS_U); const bf16* V = (const bf16*)(F.ws + WS_V);
    const int* IDX = (const int*)(F.ws + WS_IDX); const float* GATE = (const float*)(F.ws + WS_GATE); const float* ada = (const float*)(F.ws + WS_ADA);
    const int lane = F.lane; const int gw = F.vcu * NWAVES + F.wave, NGW = F.G * NWAVES;
    for (int tok = gw; tok < M; tok += NGW) {
        const int b = tok / SEQ;
        const v4u ha = *(const GAS v4u*)(H2 + (size_t)tok * D + 8 * lane), hb = *(const GAS v4u*)(H2 + (size_t)tok * D + 512 + 8 * lane);
        float acc[16];
#pragma unroll
        for (int e = 0; e < 16; ++e) acc[e] = 0.f;
#pragma unroll 1
        for (int bt = 0; bt < 2; ++bt) {
            const int my_idx = IDX[(size_t)tok * 128 + bt * 64 + lane]; const float my_gate = GATE[(size_t)tok * 128 + bt * 64 + lane];
            float p[64];
#pragma unroll
            for (int k = 0; k < 64; ++k) { const int e = __builtin_amdgcn_readlane(my_idx, k); const bf16* ur = U + (size_t)e * D;
                const v4u ua = *(const GAS v4u*)(ur + 8 * lane), ub = *(const GAS v4u*)(ur + 512 + 8 * lane);
                p[k] = dot8(ub, hb, dot8(ua, ha, 0.f));
                if ((k & 7) == 7) asm volatile("" ::: "memory"); }
#pragma unroll
            for (int k = 0; k < 32; ++k) { const bool up = lane & 32; const float send = up ? p[k] : p[k + 32], keep = up ? p[k + 32] : p[k]; p[k] = keep + __shfl_xor(send, 32); }
#pragma unroll
            for (int k = 0; k < 16; ++k) { const bool up = lane & 16; const float send = up ? p[k] : p[k + 16], keep = up ? p[k + 16] : p[k]; p[k] = keep + __shfl_xor(send, 16); }
#pragma unroll
            for (int k = 0; k < 8; ++k) { const bool up = lane & 8; const float send = up ? p[k] : p[k + 8], keep = up ? p[k + 8] : p[k]; p[k] = keep + __shfl_xor(send, 8); }
#pragma unroll
            for (int k = 0; k < 4; ++k) { const bool up = lane & 4; const float send = up ? p[k] : p[k + 4], keep = up ? p[k + 4] : p[k]; p[k] = keep + __shfl_xor(send, 4); }
#pragma unroll
            for (int k = 0; k < 2; ++k) { const bool up = lane & 2; const float send = up ? p[k] : p[k + 2], keep = up ? p[k + 2] : p[k]; p[k] = keep + __shfl_xor(send, 2); }
            { const bool up = lane & 1; const float send = up ? p[0] : p[1], keep = up ? p[1] : p[0]; p[0] = keep + __shfl_xor(send, 1); }
            const float wgt = my_gate * gelu_erf(p[0]);
#pragma unroll
            for (int k = 0; k < 64; ++k) { const int e = __builtin_amdgcn_readlane(my_idx, k); const float wk = __uint_as_float((unsigned)__builtin_amdgcn_readlane((int)__float_as_uint(wgt), k)); const bf16* vr = V + (size_t)e * D;
                const v4u va = *(const GAS v4u*)(vr + 8 * lane), vb = *(const GAS v4u*)(vr + 512 + 8 * lane);
                acc[0] += wk * bflo(va.x); acc[1] += wk * bfhi(va.x); acc[2] += wk * bflo(va.y); acc[3] += wk * bfhi(va.y);
                acc[4] += wk * bflo(va.z); acc[5] += wk * bfhi(va.z); acc[6] += wk * bflo(va.w); acc[7] += wk * bfhi(va.w);
                acc[8] += wk * bflo(vb.x); acc[9] += wk * bfhi(vb.x); acc[10] += wk * bflo(vb.y); acc[11] += wk * bfhi(vb.y);
                acc[12] += wk * bflo(vb.z); acc[13] += wk * bfhi(vb.z); acc[14] += wk * bflo(vb.w); acc[15] += wk * bfhi(vb.w);
                if ((k & 7) == 7) asm volatile("" ::: "memory"); }
        }
        float* orow = F.out + (size_t)tok * D; const float* g2p = ada + (size_t)b * ADA_W + 5 * D; const float* gf = F.in[IN_GF];
        float x2[16]; float ss = 0.f;
#pragma unroll
        for (int hh = 0; hh < 2; ++hh)
#pragma unroll
            for (int q4 = 0; q4 < 2; ++q4) { const int off = hh * 512 + 8 * lane + 4 * q4; const f32x4 xv = *(const GAS f32x4*)(orow + off), gv = *(const f32x4*)(g2p + off);
#pragma unroll
                for (int e = 0; e < 4; ++e) { const float t = xv[e] + gv[e] * acc[hh * 8 + q4 * 4 + e]; x2[hh * 8 + q4 * 4 + e] = t; ss += t * t; } }
        const float rstd = 1.0f / sqrtf(wave_sum(ss) * (1.f / D) + EPS);
#pragma unroll
        for (int hh = 0; hh < 2; ++hh)
#pragma unroll
            for (int q4 = 0; q4 < 2; ++q4) { const int off = hh * 512 + 8 * lane + 4 * q4; const f32x4 fv = *(const f32x4*)(gf + off); f32x4 o;
#pragma unroll
                for (int e = 0; e < 4; ++e) o[e] = x2[hh * 8 + q4 * 4 + e] * rstd * fv[e];
                *(GAS f32x4*)(orow + off) = o; }
    }
}

struct Args { const float* in[20]; float* out; unsigned char* ws; int ph_lo, ph_hi, li, pad; };
__global__ void __launch_bounds__(NWAVES * 64, 2) skel_fwd(Args args) {
    extern __shared__ __attribute__((aligned(16))) unsigned char lds[];
    Frame F;
    F.lds = (LAS unsigned char*)lds;
    F.MISC = (volatile LAS unsigned*)(F.lds + MISC_OFF);
    F.tid = threadIdx.x; F.lane = F.tid & 63; F.wave = __builtin_amdgcn_readfirstlane(F.tid >> 6);
    F.G = gridDim.x; { const int bx = blockIdx.x; F.vcu = (F.G % 8 == 0) ? (bx % 8) * (F.G / 8) + bx / 8 : bx; }
    F.ws = args.ws; F.out = args.out;
#pragma unroll
    for (int i = 0; i < 20; ++i) F.in[i] = args.in[i];
    F.ctl = (gu32*)(args.ws + WS_CTL);
    for (int u = F.tid; u < (LDS_BYTES - LDSCTL_OFF) / 4; u += NWAVES * 64) ((LAS unsigned*)(F.lds + LDSCTL_OFF))[u] = 0u;
    __syncthreads();
    XcdBarrier bar; bar.bar = (unsigned*)(F.ctl + CW_BAR); bar.x = 0; bar.st = nullptr;
    if (N_LAUNCHES == 1) bar = xcd_barrier_post((unsigned*)(F.ctl + CW_BAR), F.MISC + 8);
#define GRID_BAR() do { if (N_LAUNCHES == 1) xcd_barrier(bar); } while (0)
    const int lo = args.ph_lo, hi = args.ph_hi;
#define IN(k) (lo <= (k) && (k) < hi)
    bf16* const H = (bf16*)(args.ws + WS_H); bf16* const PROJ = (bf16*)(args.ws + WS_PROJ); bf16* const MIX = (bf16*)(args.ws + WS_MIX);

    if (IN(0)) { p0_prologue(F); GRID_BAR(); }
    if (IN(1)) { p1_hpass(F); GRID_BAR(); }
    if (IN(2)) {
        pg8::Gemm g{H, (const bf16*)(args.ws + WS_WIN), M, IN_W, D}; pg8::StaticOrder S; S.init(M, IN_W, F.G, (int)blockIdx.x);
        pg8::EpiBf16<0> E{PROJ, IN_W, F.in[IN_BIN], 0, 0, 1.f};
        pg8::gemm_phase<pg8::EpiBf16<0>, pg8::StaticOrder, true, true>(F.lds + RING_OFF, g, S, E);
        GRID_BAR();
    }
    if (IN(3)) { p3_mixer(F); GRID_BAR(); }
    if (IN(4)) {
        pg8::Gemm g{MIX, (const bf16*)(args.ws + WS_WOUT), M, D, D}; pg8::StaticOrder S; S.init(M, D, F.G, (int)blockIdx.x);
        pg8::EpiResGate E{F.in[IN_X], F.out, D, F.in[IN_BOUT], (const float*)(args.ws + WS_ADA), ADA_W, 2 * D, SEQ / 256};
        pg8::gemm_phase<pg8::EpiResGate, pg8::StaticOrder, true, true>(F.lds + RING_OFF, g, S, E);
        GRID_BAR();
    }
    if (IN(5)) { p5_h2pass(F); GRID_BAR(); }
    if (IN(6)) {
        pg8::Gemm g{H, (const bf16*)(args.ws + WS_WQ), M, QW, D}; pg8::StaticOrder S; S.init(M, QW, F.G, (int)blockIdx.x);
        pg8::EpiBf16<0> E{PROJ, QW, nullptr, 0, 0, 1.f};
        pg8::gemm_phase<pg8::EpiBf16<0>, pg8::StaticOrder, true, true>(F.lds + RING_OFF, g, S, E);
        GRID_BAR();
    }
    if (IN(7)) { p7_routing(F); GRID_BAR(); }
    if (IN(8)) { p8_experts(F); }
#undef IN
}

extern "C" void kernel_launch(void* const* d_in, const int* in_sizes, int n_in, void* d_out, int out_size, void* d_ws, size_t ws_size, hipStream_t stream) {
    static int grid = 0;
    if (grid == 0) {
        if (n_in != 20 || in_sizes[0] != M * D || out_size != M * D || ws_size < WS_END) { fprintf(stderr, "kernel_launch: unexpected shapes (n_in %d, in0 %d, out %d, ws %zu); nothing launched\n", n_in, n_in > 0 ? in_sizes[0] : -1, out_size, ws_size); grid = -1; return; }
        int dev = 0, cus = 0, per_cu = 0;
        if (hipGetDevice(&dev) != hipSuccess || hipDeviceGetAttribute(&cus, hipDeviceAttributeMultiprocessorCount, dev) != hipSuccess) { fprintf(stderr, "kernel_launch: device query failed\n"); grid = -1; return; }
        if (hipFuncSetAttribute((const void*)skel_fwd, hipFuncAttributeMaxDynamicSharedMemorySize, LDS_BYTES) != hipSuccess) { fprintf(stderr, "kernel_launch: hipFuncSetAttribute failed\n"); grid = -1; return; }
        if (hipOccupancyMaxActiveBlocksPerMultiprocessor(&per_cu, (const void*)skel_fwd, NWAVES * 64, LDS_BYTES) != hipSuccess || per_cu < 1)
            fprintf(stderr, "kernel_launch: note: occupancy query reports %d workgroups per CU\n", per_cu);
        (void)hipGetLastError();
        grid = cus;
    }
    if (grid < 0) return;
    if (hipMemsetAsync((char*)d_ws + WS_CTL, 0, CTL_ZERO_BYTES, stream) != hipSuccess) { fprintf(stderr, "kernel_launch: hipMemsetAsync failed\n"); return; }
    Args a{};
    for (int i = 0; i < 20; ++i) a.in[i] = (const float*)d_in[i];
    a.out = (float*)d_out; a.ws = (unsigned char*)d_ws;
    for (int li = 0; li < N_LAUNCHES; ++li) {
        a.ph_lo = (N_LAUNCHES == 1) ? 0 : li; a.ph_hi = (N_LAUNCHES == 1) ? NPHASES : li + 1; a.li = li;
        hipLaunchKernelGGL(skel_fwd, dim3(grid), dim3(NWAVES * 64), LDS_BYTES, stream, a);
        const hipError_t le = hipPeekAtLastError();
        if (le != hipSuccess) { fprintf(stderr, "kernel_launch: launch %d failed: %s\n", li, hipGetErrorName(le)); break; }
    }
}
```

```cpp
#include <hip/hip_runtime.h>
#include <cstdio>
#include <cstdint>
#include <cmath>
namespace pg8 {
#define PG8_LAS __attribute__((address_space(3)))
typedef unsigned short bf16_t;
typedef short bf16x8 __attribute__((ext_vector_type(8)));
typedef float f32x4 __attribute__((ext_vector_type(4)));
typedef unsigned u32x4 __attribute__((ext_vector_type(4)));
constexpr int BM = 256, BK = 64, HALF = 128, HTB = HALF * BK * 2  , STAGE_BYTES = 8 * HTB, NXCD = 8, WGM = 8;

__host__ __device__ __forceinline__ int lds_byte(int r, int c) { const int st = (r >> 4) * 2 + (c >> 5), rr = r & 15, cc = c & 31, ob = rr * 64 + cc * 2; return st * 1024 + (ob ^ (((ob >> 9) & 1) << 5)); }
__host__ __device__ __forceinline__ void stage_rc(int b, int& R, int& C) { const int st = b / 1024, sb = b % 1024, swz = sb ^ (((sb >> 9) & 1) << 5); R = (st >> 1) * 16 + swz / 64; C = (st & 1) * 32 + (swz % 64) / 2; }
__host__ __device__ __forceinline__ int perm32(int rho) { const int n = rho >> 4, i = rho & 15; return 8 * (i >> 2) + 4 * n + (i & 3); }

struct Unit { int pm, pn; };
struct Gemm { const bf16_t* A; const bf16_t* Bt; int M, N, K; };

struct StaticOrder {
    int nM, nN, nwg, G, c;
    __host__ __device__ void init(int M, int N, int G_, int c_) { nM = M / BM; nN = N / BM; nwg = nM * nN; G = G_; c = c_; }
    __host__ __device__ bool next(int i, Unit& u) const {
        const long L = (long)i * G + c; if (L >= nwg) return false;
        int wgid = (int)L; { const int q = nwg / NXCD, r = nwg % NXCD, xcd = wgid % NXCD, off = wgid / NXCD; wgid = (xcd < r ? xcd * (q + 1) : r * (q + 1) + (xcd - r) * q) + off; }
        const int nig = WGM * nN, gid = wgid / nig, fm = gid * WGM, gsz = (nM - fm) < WGM ? (nM - fm) : WGM;
        u.pm = fm + ((wgid % nig) % gsz); u.pn = (wgid % nig) / gsz; return true;
    }
    __device__ __forceinline__ void a_ready(const Unit&) const {}
    __device__ __forceinline__ void done(const Unit&) const {}
};

__device__ __forceinline__ unsigned cvt_pk_bf16(float lo, float hi) { unsigned r; asm volatile("v_cvt_pk_bf16_f32 %0, %1, %2" : "=v"(r) : "v"(lo), "v"(hi)); return r; }
typedef float f32x2 __attribute__((ext_vector_type(2)));
__device__ __forceinline__ f32x2 gelu_pk(f32x2 v) {
    const f32x2 av = __builtin_elementwise_abs(v), d = av * 0.2316418882f + 1.0f;
    f32x2 t; t.x = __builtin_amdgcn_rcpf(d.x); t.y = __builtin_amdgcn_rcpf(d.y);
    f32x2 q = t * 0.5307027145f + (-0.7265760135f); q = q * t + 0.7107068705f; q = q * t + (-0.142248368f); q = q * t + 0.127414796f; q = q * t;
    const f32x2 s = (v * v) * (-0.72134752044f);
    f32x2 e; e.x = __builtin_amdgcn_exp2f(s.x); e.y = __builtin_amdgcn_exp2f(s.y);
    const f32x2 m = v * (q * e), r = v - m;
    f32x2 o; o.x = v.x < 0.f ? m.x : r.x; o.y = v.y < 0.f ? m.y : r.y; return o;
}

template <int ACT  > struct EpiBf16 {
    static constexpr bool PERM = true, AFTER_DRAIN = false; static_assert(ACT == 0 || ACT == 1, "EpiBf16: ACT is 0 (none) or 1 (gelu_pk)");
    bf16_t* O; int ldc; const float* bias; int split_cols; size_t split_stride; float scale0;
    __device__ __forceinline__ void operator()(const f32x4 (&acc)[2][2][4][2], const Unit& u, int wr, int wc, int fr, int fq) const {
        const int row0 = u.pm * BM + wr * 64 + fr; int colt = u.pn * BM; bf16_t* base = O;
        float sc = 1.f; if (split_cols) { const int t = colt / split_cols; base += (size_t)t * split_stride; colt -= t * split_cols; if (t == 0) sc = scale0; }
        const int col0 = colt + wc * 32 + 8 * fq, bcol0 = u.pn * BM + wc * 32 + 8 * fq;
        f32x4 bv[2][2];
#pragma unroll
        for (int bj = 0; bj < 2; ++bj)
#pragma unroll
            for (int n = 0; n < 2; ++n) bv[bj][n] = bias ? *(const f32x4*)(bias + bcol0 + bj * HALF + 4 * n) : (f32x4){0.f, 0.f, 0.f, 0.f};
#pragma unroll
        for (int ai = 0; ai < 2; ++ai)
#pragma unroll
            for (int m = 0; m < 4; ++m) { bf16_t* rowp = base + (size_t)(row0 + ai * HALF + m * 16) * ldc + col0;
#pragma unroll
                for (int bj = 0; bj < 2; ++bj) { f32x4 v0 = acc[ai][bj][m][0] + bv[bj][0], v1 = acc[ai][bj][m][1] + bv[bj][1];
                    if (ACT == 1) { f32x2 a = gelu_pk((f32x2){v0[0], v0[1]}), b = gelu_pk((f32x2){v0[2], v0[3]}), c = gelu_pk((f32x2){v1[0], v1[1]}), d = gelu_pk((f32x2){v1[2], v1[3]});
                        v0 = (f32x4){a.x, a.y, b.x, b.y}; v1 = (f32x4){c.x, c.y, d.x, d.y}; }
                    v0 = v0 * sc; v1 = v1 * sc; u32x4 w; w.x = cvt_pk_bf16(v0[0], v0[1]); w.y = cvt_pk_bf16(v0[2], v0[3]); w.z = cvt_pk_bf16(v1[0], v1[1]); w.w = cvt_pk_bf16(v1[2], v1[3]);
                    *(u32x4*)(rowp + bj * HALF) = w; } }
    }
};

typedef unsigned u32x2 __attribute__((ext_vector_type(2)));
struct EpiResGate {
    static constexpr bool PERM = false, AFTER_DRAIN = false;
    const float* x; bf16_t* out; int ldc; const float* bias; const float* ada; int ada_ld, gate_off, tiles_per_batch;
    __device__ __forceinline__ void operator()(const f32x4 (&acc)[2][2][4][2], const Unit& u, int wr, int wc, int fr, int fq) const {
        const int row0 = u.pm * BM + wr * 64 + fr, col0 = u.pn * BM + wc * 32 + 4 * fq;
        const float* gp = ada + (size_t)(u.pm / tiles_per_batch) * ada_ld + gate_off;
        f32x4 bv[2][2], gv[2][2];
#pragma unroll
        for (int bj = 0; bj < 2; ++bj)
#pragma unroll
            for (int n = 0; n < 2; ++n) { bv[bj][n] = *(const f32x4*)(bias + col0 + bj * HALF + n * 16); gv[bj][n] = *(const f32x4*)(gp + col0 + bj * HALF + n * 16); }
#pragma unroll
        for (int ai = 0; ai < 2; ++ai) {
            f32x4 xv[4][2][2];
#pragma unroll
            for (int m = 0; m < 4; ++m) { const size_t off = (size_t)(row0 + ai * HALF + m * 16) * ldc + col0;
#pragma unroll
                for (int bj = 0; bj < 2; ++bj)
#pragma unroll
                    for (int n = 0; n < 2; ++n) xv[m][bj][n] = *(const f32x4*)(x + off + bj * HALF + n * 16); }
#pragma unroll
            for (int m = 0; m < 4; ++m) { const size_t off = (size_t)(row0 + ai * HALF + m * 16) * ldc + col0;
#pragma unroll
                for (int bj = 0; bj < 2; ++bj)
#pragma unroll
                    for (int n = 0; n < 2; ++n) { const f32x4 o = xv[m][bj][n] + gv[bj][n] * (acc[ai][bj][m][n] + bv[bj][n]);
                        u32x2 w; w.x = cvt_pk_bf16(o[0], o[1]); w.y = cvt_pk_bf16(o[2], o[3]); *(u32x2*)(out + off + bj * HALF + n * 16) = w; } }
            asm volatile("" ::: "memory"); }
    }
};


typedef int i32x4 __attribute__((ext_vector_type(4)));
template <bool I8> struct AccSel { typedef f32x4 type; static __device__ __forceinline__ f32x4 zero() { return (f32x4){0.f, 0.f, 0.f, 0.f}; } };
template <> struct AccSel<true> { typedef i32x4 type; static __device__ __forceinline__ i32x4 zero() { return (i32x4){0, 0, 0, 0}; } };
template <bool I8> __device__ __forceinline__ typename AccSel<I8>::type mma16(bf16x8 a, bf16x8 b, typename AccSel<I8>::type c) {
    if constexpr (I8) return __builtin_amdgcn_mfma_i32_16x16x64_i8(__builtin_bit_cast(i32x4, a), __builtin_bit_cast(i32x4, b), c, 0, 0, 0);
    else return __builtin_amdgcn_mfma_f32_16x16x32_bf16(a, b, c, 0, 0, 0);
}
struct EpiI8Bf16 {
    static constexpr bool PERM = true, AFTER_DRAIN = false;
    bf16_t* O; int ldc; const float* rowscale; float wscale; const float* bias;
    __device__ __forceinline__ void operator()(const i32x4 (&acc)[2][2][4][2], const Unit& u, int wr, int wc, int fr, int fq) const {
        const int row0 = u.pm * BM + wr * 64 + fr, col0 = u.pn * BM + wc * 32 + 8 * fq;
        f32x4 bv[2][2];
#pragma unroll
        for (int bj = 0; bj < 2; ++bj)
#pragma unroll
            for (int n = 0; n < 2; ++n) bv[bj][n] = bias ? *(const f32x4*)(bias + col0 + bj * HALF + 4 * n) : (f32x4){0.f, 0.f, 0.f, 0.f};
#pragma unroll
        for (int ai = 0; ai < 2; ++ai)
#pragma unroll
            for (int m = 0; m < 4; ++m) { const int row = row0 + ai * HALF + m * 16; const float sc = rowscale[row] * wscale; bf16_t* rowp = O + (size_t)row * ldc + col0;
#pragma unroll
                for (int bj = 0; bj < 2; ++bj) { const i32x4 a0 = acc[ai][bj][m][0], a1 = acc[ai][bj][m][1]; const f32x4 b0 = bv[bj][0], b1 = bv[bj][1];
                    u32x4 w; w.x = cvt_pk_bf16((float)a0[0] * sc + b0[0], (float)a0[1] * sc + b0[1]); w.y = cvt_pk_bf16((float)a0[2] * sc + b0[2], (float)a0[3] * sc + b0[3]);
                    w.z = cvt_pk_bf16((float)a1[0] * sc + b1[0], (float)a1[1] * sc + b1[1]); w.w = cvt_pk_bf16((float)a1[2] * sc + b1[2], (float)a1[3] * sc + b1[3]);
                    *(u32x4*)(rowp + bj * HALF) = w; } }
    }
};
template <class Epi, class Sched, bool ALIGN_EPI = false, bool SP2 = false, bool I8 = false>
__device__ __forceinline__ void gemm_phase(PG8_LAS unsigned char* lds, const Gemm g, const Sched& S, const Epi& E) {
    const int tid = threadIdx.x, wid = __builtin_amdgcn_readfirstlane(tid >> 6), lane = tid & 63, wr = wid >> 2, wc = wid & 3, fr = lane & 15, fq = lane >> 4;
    const int K = g.K, nt = K / BK;
    unsigned voffA[2], voffB[2];
#pragma unroll
    for (int i = 0; i < 2; ++i) { int R, C; stage_rc(tid * 16 + i * 8192, R, C); const int Rb = Epi::PERM ? ((R & ~31) + perm32(R & 31)) : R;
        voffA[i] = (unsigned)(R * K + C) * 2u; voffB[i] = (unsigned)(Rb * K + C) * 2u; }
    const size_t kstep = (size_t)(BK * 2);
    const size_t hstep = (size_t)HALF * K * 2;
    const size_t tstep = 2 * hstep;
    const unsigned ldsw = (unsigned)wid * 1024u;
    const int aoff = lds_byte(wr * 64 + fr, fq * 8), boff = lds_byte(wc * 32 + fr, fq * 8);
#define PG8_SA(b, h) (((b) * 2 + (h)) * HTB)
#define PG8_SB(b, h) ((4 + (b) * 2 + (h)) * HTB)
#define PG8_STAGE(bufoff, gbase, voff) do { _Pragma("unroll") for (int _i = 0; _i < 2; ++_i) \
        __builtin_amdgcn_global_load_lds((const unsigned*)((const char*)(gbase) + (voff)[_i]), (PG8_LAS unsigned*)(lds + (bufoff) + ldsw + _i * 8192), 16, 0, 0); } while (0)
#define PG8_LDA(dst, b, h) do { _Pragma("unroll") for (int m = 0; m < 4; ++m) _Pragma("unroll") for (int k = 0; k < 2; ++k) dst[m][k] = *(const PG8_LAS bf16x8*)(lds + PG8_SA(b, h) + aoff + m * 2048 + k * 1024); } while (0)
#define PG8_LDB(dst, b, h) do { _Pragma("unroll") for (int n = 0; n < 2; ++n) _Pragma("unroll") for (int k = 0; k < 2; ++k) dst[n][k] = *(const PG8_LAS bf16x8*)(lds + PG8_SB(b, h) + boff + n * 2048 + k * 1024); } while (0)
#define PG8_MMA(ai, bj, At, Bt) do { __builtin_amdgcn_s_setprio(1); _Pragma("unroll") for (int m = 0; m < 4; ++m) _Pragma("unroll") for (int n = 0; n < 2; ++n) _Pragma("unroll") for (int k = 0; k < 2; ++k) \
        acc[ai][bj][m][n] = mma16<I8>(Bt[n][k], At[m][k], acc[ai][bj][m][n]); __builtin_amdgcn_s_setprio(0); } while (0)
#define PG8_WAIT_V(n) asm volatile("s_waitcnt vmcnt(" #n ")" ::: "memory")
#define PG8_WAIT_L(n) asm volatile("s_waitcnt lgkmcnt(" #n ")" ::: "memory")
#define PG8_BAR __builtin_amdgcn_s_barrier()
#define PG8_SCHED __builtin_amdgcn_sched_barrier(0)
    Unit cur, nxt; int ui = 0;
    if (!S.next(0, cur)) return;
    typedef typename AccSel<I8>::type acc_t;
    acc_t acc[2][2][4][2];
#pragma unroll
    for (int a = 0; a < 2; ++a)
#pragma unroll
        for (int b = 0; b < 2; ++b)
#pragma unroll
            for (int m = 0; m < 4; ++m)
#pragma unroll
                for (int n = 0; n < 2; ++n) acc[a][b][m][n] = AccSel<I8>::zero();
    bf16x8 At[4][2], B0[2][2], B1[2][2];
    const char* cA = (const char*)g.A + (size_t)cur.pm * tstep; const char* cB = (const char*)g.Bt + (size_t)cur.pn * tstep;
    S.a_ready(cur);
    if constexpr (SP2) {
        PG8_STAGE(PG8_SB(0, 0), cB, voffB); PG8_STAGE(PG8_SB(0, 1), cB + hstep, voffB); PG8_STAGE(PG8_SA(0, 0), cA, voffA); PG8_STAGE(PG8_SA(0, 1), cA + hstep, voffA);
        if (wr == 1) PG8_BAR;
        PG8_WAIT_V(2); PG8_BAR;
        PG8_STAGE(PG8_SB(1, 0), cB + kstep, voffB); PG8_STAGE(PG8_SA(1, 0), cA + kstep, voffA); PG8_STAGE(PG8_SB(1, 1), cB + hstep + kstep, voffB);
        PG8_WAIT_V(6); PG8_BAR;
    } else {
        PG8_STAGE(PG8_SB(0, 0), cB, voffB); PG8_STAGE(PG8_SA(0, 0), cA, voffA); PG8_STAGE(PG8_SB(0, 1), cB + hstep, voffB); PG8_STAGE(PG8_SA(0, 1), cA + hstep, voffA);
        if (wr == 1) PG8_BAR;
        PG8_WAIT_V(4); PG8_BAR;
        PG8_STAGE(PG8_SB(1, 0), cB + kstep, voffB); PG8_STAGE(PG8_SA(1, 0), cA + kstep, voffA); PG8_STAGE(PG8_SB(1, 1), cB + hstep + kstep, voffB);
        PG8_WAIT_V(6); PG8_BAR;
    }
    for (;;) {
        const bool has_next = S.next(ui + 1, nxt);
        const char* nA = has_next ? (const char*)g.A + (size_t)nxt.pm * tstep : cA; const char* nB = has_next ? (const char*)g.Bt + (size_t)nxt.pn * tstep : cB;
        for (int t = 0; t < nt; t += 2) {
            const bool last = (t == nt - 2);
            const char* a1 = cA + (size_t)(t + 1) * kstep;
            const char* a2 = last ? nA : cA + (size_t)(t + 2) * kstep; const char* b2 = last ? nB : cB + (size_t)(t + 2) * kstep;
            const char* a3 = a2 + kstep; const char* b3 = b2 + kstep;
            if (last && has_next) S.a_ready(nxt);
            if constexpr (SP2) {
            PG8_LDB(B0, 0, 0); PG8_LDB(B1, 0, 1); PG8_SCHED; PG8_LDA(At, 0, 0); PG8_STAGE(PG8_SA(1, 1), a1 + hstep, voffA);
            PG8_WAIT_V(8); PG8_WAIT_L(0); PG8_BAR; PG8_MMA(0, 0, At, B0); PG8_MMA(0, 1, At, B1); PG8_BAR; PG8_SCHED;
            PG8_LDA(At, 0, 1); PG8_STAGE(PG8_SB(0, 0), b2, voffB); PG8_STAGE(PG8_SB(0, 1), b2 + hstep, voffB); PG8_STAGE(PG8_SA(0, 0), a2, voffA);
            PG8_WAIT_V(8); PG8_WAIT_L(0); PG8_BAR; PG8_MMA(1, 0, At, B0); PG8_MMA(1, 1, At, B1); PG8_BAR; PG8_SCHED;
            PG8_LDB(B0, 1, 0); PG8_LDB(B1, 1, 1); PG8_SCHED; PG8_LDA(At, 1, 0); PG8_STAGE(PG8_SA(0, 1), a2 + hstep, voffA);
            PG8_WAIT_V(8); PG8_WAIT_L(0); PG8_BAR; PG8_MMA(0, 0, At, B0); PG8_MMA(0, 1, At, B1); PG8_BAR; PG8_SCHED;
            PG8_LDA(At, 1, 1); PG8_STAGE(PG8_SB(1, 0), b3, voffB); PG8_STAGE(PG8_SB(1, 1), b3 + hstep, voffB); PG8_STAGE(PG8_SA(1, 0), a3, voffA);
            PG8_WAIT_V(8); PG8_WAIT_L(0); PG8_BAR; PG8_MMA(1, 0, At, B0); PG8_MMA(1, 1, At, B1); PG8_BAR; PG8_SCHED;
            } else {
            PG8_LDB(B0, 0, 0); PG8_SCHED; PG8_LDA(At, 0, 0); PG8_STAGE(PG8_SA(1, 1), a1 + hstep, voffA);
            PG8_WAIT_L(8); PG8_BAR; PG8_WAIT_L(0); PG8_MMA(0, 0, At, B0); PG8_BAR; PG8_SCHED;
            PG8_LDB(B1, 0, 1); PG8_STAGE(PG8_SB(0, 0), b2, voffB);
            PG8_BAR; PG8_WAIT_L(0); PG8_MMA(0, 1, At, B1); PG8_BAR;
            PG8_LDA(At, 0, 1); PG8_STAGE(PG8_SA(0, 0), a2, voffA);
            PG8_BAR; PG8_WAIT_L(0); PG8_MMA(1, 0, At, B0); PG8_BAR; PG8_SCHED;
            PG8_STAGE(PG8_SB(0, 1), b2 + hstep, voffB);
            PG8_WAIT_V(6); PG8_BAR; PG8_MMA(1, 1, At, B1); PG8_BAR;
            PG8_LDB(B0, 1, 0); PG8_SCHED; PG8_LDA(At, 1, 0); PG8_STAGE(PG8_SA(0, 1), a2 + hstep, voffA);
            PG8_WAIT_L(8); PG8_BAR; PG8_WAIT_L(0); PG8_MMA(0, 0, At, B0); PG8_BAR; PG8_SCHED;
            PG8_LDB(B1, 1, 1); PG8_STAGE(PG8_SB(1, 0), b3, voffB);
            PG8_BAR; PG8_WAIT_L(0); PG8_MMA(0, 1, At, B1); PG8_BAR;
            PG8_LDA(At, 1, 1); PG8_STAGE(PG8_SA(1, 0), a3, voffA);
            PG8_BAR; PG8_WAIT_L(0); PG8_MMA(1, 0, At, B0); PG8_BAR; PG8_SCHED;
            PG8_STAGE(PG8_SB(1, 1), b3 + hstep, voffB);
            PG8_WAIT_V(6); PG8_BAR; PG8_MMA(1, 1, At, B1); PG8_BAR;
            }
        }
        if constexpr (ALIGN_EPI) { if (wr == 0) PG8_BAR; }
        if constexpr (!Epi::AFTER_DRAIN) { E(acc, cur, wr, wc, fr, fq); S.done(cur); }
        if (!has_next) break;
#pragma unroll
        for (int a = 0; a < 2; ++a)
#pragma unroll
            for (int b = 0; b < 2; ++b)
#pragma unroll
                for (int m = 0; m < 4; ++m)
#pragma unroll
                    for (int n = 0; n < 2; ++n) acc[a][b][m][n] = AccSel<I8>::zero();
        cur = nxt; cA = nA; cB = nB; ++ui;
        if constexpr (ALIGN_EPI) { if (wr == 1) PG8_BAR; }
    }
    PG8_WAIT_V(0);
    if constexpr (!ALIGN_EPI) { if (wr == 0) PG8_BAR; }
    PG8_BAR;
    if constexpr (Epi::AFTER_DRAIN) { E.fused(acc, cur, wr, wc, fr, fq, lds, wid, lane); S.done(cur); }
#undef PG8_SA
#undef PG8_SB
#undef PG8_STAGE
#undef PG8_LDA
#undef PG8_LDB
#undef PG8_MMA
#undef PG8_WAIT_V
#undef PG8_WAIT_L
#undef PG8_BAR
#undef PG8_SCHED
}
}

constexpr int NWAVES = 8;
constexpr int NPHASES = 12;
#ifndef MK_N_LAUNCHES
#define MK_N_LAUNCHES 1
#endif
constexpr int N_LAUNCHES = MK_N_LAUNCHES;
static_assert(N_LAUNCHES == 1 || N_LAUNCHES == NPHASES, "MK_N_LAUNCHES is 1 or NPHASES");

constexpr int BATCH = 16, SEQ = 2048, D = 1024, M = BATCH * SEQ;
constexpr int IN_W = 2304, O_Q = 0, O_K = 512, O_V = 640, O_B = 768, O_C = 1280, O_U = 1792;
constexpr int NQH = 8, NKVH = 2, HD = 64, WIN = 128;
constexpr int NKEYS = 128, NEXP = 16384, PH = 8, TOPK = 16, DKEY = 256, DHALF = 128, QW = PH * DKEY;
constexpr int ADA_W = 6 * D, ADA_KC = 8;
constexpr float EPS = 1e-6f;

constexpr size_t MiB = 1u << 20;
constexpr size_t WS_CTL = 0, CTL_ZERO_BYTES = 64 * 1024;
constexpr size_t WS_ADAP = 1 * MiB;
constexpr size_t WS_ADA = 4 * MiB;
constexpr size_t WS_WIN = 5 * MiB;
constexpr size_t WS_WOUT = 10 * MiB;
constexpr size_t WS_WQ = 12 * MiB;
constexpr size_t WS_K1 = 16 * MiB, WS_K2 = 16 * MiB + 512 * 1024;
constexpr size_t WS_U = 17 * MiB, WS_V = 33 * MiB;
constexpr float U_SCALE = 896.f, V_SCALE = 8.f, WQ_SCALE = 896.f;
constexpr size_t WS_H = 81 * MiB;
constexpr size_t WS_PROJ = 145 * MiB;
constexpr size_t WS_MIX = 289 * MiB;
constexpr size_t WS_IDX = 353 * MiB;
constexpr size_t WS_GATE = 369 * MiB;
constexpr size_t WS_H8 = 49 * MiB;
constexpr size_t WS_HS = 393 * MiB;
constexpr size_t WS_W16 = 385 * MiB;
constexpr size_t WS_X1 = 417 * MiB;
constexpr size_t WS_END = 481 * MiB;
constexpr size_t WS_PA = WS_PROJ;
constexpr size_t WS_SS = WS_MIX;
constexpr int CW_BAR = 4096;
static_assert((CW_BAR + 3456) * 4 <= (int)CTL_ZERO_BYTES, "barrier words inside the zeroed region");

constexpr int RING_OFF = 0, RING_BYTES = 131072;
constexpr int LDSCTL_OFF = 135168, MISC_OFF = LDSCTL_OFF + 320;
constexpr int LDS_BYTES = 147456;
static_assert(MISC_OFF + 128 <= LDS_BYTES, "LDS map");

#define GAS __attribute__((address_space(1)))
#define LAS __attribute__((address_space(3)))
typedef unsigned short bf16;
typedef unsigned v4u __attribute__((ext_vector_type(4)));
typedef float f32x4 __attribute__((ext_vector_type(4)));
typedef short bf16x8 __attribute__((ext_vector_type(8)));
typedef GAS unsigned gu32;
typedef GAS unsigned long long gu64;
#define RLX_AGENT __ATOMIC_RELAXED, __HIP_MEMORY_SCOPE_AGENT
#define LDS_WAIT() asm volatile("s_waitcnt lgkmcnt(0)" ::: "memory")
#define VM_WAIT() asm volatile("s_waitcnt vmcnt(0)" ::: "memory")
__device__ __forceinline__ unsigned long long rt() { return __builtin_amdgcn_s_memrealtime(); }
__device__ __forceinline__ unsigned f2bf(float f) { unsigned u = __builtin_bit_cast(unsigned, f); return (u + 0x7fffu + ((u >> 16) & 1u)) >> 16; }
__device__ __forceinline__ unsigned pk2(float lo, float hi) { return f2bf(lo) | (f2bf(hi) << 16); }

#define XB_TMO      128
#define XB_XCNT(j)  (256  + 64 * (j))
#define XB_XSUB(j)  (1280 + 64 * (j))
#define XB_XGEN(j)  (2304 + 64 * (j))
#define XB_TOP      3328
#define XB_TOPGEN   3392
#define XCD_BAR_WORDS 3456
#define XB_SPIN_CAP (1u << 22)

__device__ __forceinline__ unsigned xb_ld(unsigned* p)              { return __hip_atomic_load(p, __ATOMIC_RELAXED, __HIP_MEMORY_SCOPE_AGENT); }
__device__ __forceinline__ unsigned xb_add(unsigned* p, unsigned v) { return __hip_atomic_fetch_add(p, v, __ATOMIC_RELAXED, __HIP_MEMORY_SCOPE_AGENT); }
__device__ __forceinline__ unsigned xb_xcc_id() { return (unsigned)__builtin_amdgcn_s_getreg((3 << 11) | 20) & 0xFu; }
#define XB_SPIN(cond, bar) do { unsigned _sp = 0; while (cond) { __builtin_amdgcn_s_sleep(1); \
    if ((++_sp & 255u) == 0u) { if (xb_ld(&(bar)[XB_TMO])) break; if (_sp > XB_SPIN_CAP) { atomicAdd(&(bar)[XB_TMO], 1u); break; } } } } while (0)

struct XcdBarrier {
    unsigned* bar; unsigned x;
    volatile LAS unsigned* st;
};

__device__ __forceinline__ XcdBarrier xcd_barrier_post(unsigned* bar, volatile LAS unsigned* st) {
    XcdBarrier b; b.bar = bar; b.x = xb_xcc_id(); b.st = st;
    if (threadIdx.x == 0) (void)xb_add(&bar[XB_XCNT(b.x)], 1u);
    return b;
}
__device__ __forceinline__ void xcd_barrier_complete(unsigned* bar, unsigned x, unsigned& nloc, unsigned& nx) {
    const unsigned G = gridDim.x * gridDim.y * gridDim.z;
    unsigned sum, cnt, mine, sp = 0u;
    for (;;) {
        sum = 0u; cnt = 0u; mine = 0u;
#pragma unroll
        for (unsigned j = 0; j < 16; ++j) { const unsigned c = xb_ld(&bar[XB_XCNT(j)]); sum += c; cnt += (c > 0u) ? 1u : 0u; mine = (j == x) ? c : mine; }
        if (sum == G) break;
        __builtin_amdgcn_s_sleep(1);
        if ((++sp & 255u) == 0u) { if (xb_ld(&bar[XB_TMO])) break; if (sp > XB_SPIN_CAP) { atomicAdd(&bar[XB_TMO], 1u); break; } }
    }
    nloc = mine > 0u ? mine : 1u; nx = cnt > 0u ? cnt : 1u;
}

__device__ __forceinline__ void xcd_barrier(const XcdBarrier& b) {
    asm volatile("s_waitcnt vmcnt(0)" ::: "memory");
    __syncthreads();
    if (threadIdx.x == 0) {
        unsigned* bar = b.bar;
        __builtin_amdgcn_s_waitcnt(0);
        unsigned nloc = b.st[0], nx = b.st[1];
        if (nloc == 0u) { xcd_barrier_complete(bar, b.x, nloc, nx); b.st[0] = nloc; b.st[1] = nx; }
        const unsigned old = xb_add(&bar[XB_XSUB(b.x)], 1u);
        const unsigned gen = old / nloc;
        if (old + 1u == (gen + 1u) * nloc) {
            __builtin_amdgcn_fence(__ATOMIC_RELEASE, "agent");
            asm volatile("s_waitcnt vmcnt(0)" ::: "memory");
            const unsigned og = xb_add(&bar[XB_TOP], 1u);
            const unsigned tg = og / nx;
            if (og + 1u == (tg + 1u) * nx) xb_add(&bar[XB_TOPGEN], 1u);
            else XB_SPIN(xb_ld(&bar[XB_TOPGEN]) == tg, bar);
            __builtin_amdgcn_fence(__ATOMIC_ACQUIRE, "agent");
            xb_add(&bar[XB_XGEN(b.x)], 1u);
            asm volatile("s_waitcnt vmcnt(0)" ::: "memory");
        } else {
            XB_SPIN(xb_ld(&bar[XB_XGEN(b.x)]) == gen, bar);
            __builtin_amdgcn_fence(__ATOMIC_ACQUIRE, "agent");
            asm volatile("s_waitcnt vmcnt(0)" ::: "memory");
        }
    }
    __syncthreads();
}

struct Frame {
    LAS unsigned char* lds;
    volatile LAS unsigned* MISC;
    gu32* ctl;
    int tid, lane, wave;
    int vcu, G;
    const float* in[20]; float* out; unsigned char* ws;
};
#define IN_X 0
#define IN_C 1
#define IN_WADA 2
#define IN_BADA 3
#define IN_G1 4
#define IN_WIN 5
#define IN_BIN 6
#define IN_SINK 7
#define IN_CONVW 8
#define IN_AOG 9
#define IN_COG 10
#define IN_WOUT 11
#define IN_BOUT 12
#define IN_G2 13
#define IN_WQ 14
#define IN_PK1 15
#define IN_PK2 16
#define IN_PU 17
#define IN_PV 18
#define IN_GF 19

typedef __bf16 bf16x2_t __attribute__((ext_vector_type(2)));
typedef unsigned v2u __attribute__((ext_vector_type(2)));
__device__ __forceinline__ float dot2(unsigned a, unsigned b, float acc) { return __builtin_amdgcn_fdot2_f32_bf16(__builtin_bit_cast(bf16x2_t, a), __builtin_bit_cast(bf16x2_t, b), acc, false); }
__device__ __forceinline__ float dot8(v4u a, v4u b, float acc) { acc = dot2(a.x, b.x, acc); acc = dot2(a.y, b.y, acc); acc = dot2(a.z, b.z, acc); acc = dot2(a.w, b.w, acc); return acc; }
__device__ __forceinline__ float bflo(unsigned w) { return __uint_as_float(w << 16); }
__device__ __forceinline__ float bfhi(unsigned w) { return __uint_as_float(w & 0xffff0000u); }
__device__ __forceinline__ float wave_sum(float v) {
#pragma unroll
    for (int o = 1; o < 64; o <<= 1) v += __shfl_xor(v, o);
    return v;
}
__device__ __forceinline__ unsigned wave_umax(unsigned v) {
#pragma unroll
    for (int o = 1; o < 64; o <<= 1) { const unsigned t = (unsigned)__shfl_xor((int)v, o); v = v > t ? v : t; }
    return v;
}
__device__ __forceinline__ unsigned f2ord(float f) { const unsigned u = __float_as_uint(f); return (u & 0x80000000u) ? ~u : (u | 0x80000000u); }
__device__ __forceinline__ float ord2f(unsigned u) { return __uint_as_float((u & 0x80000000u) ? (u & 0x7fffffffu) : ~u); }

__device__ __forceinline__ unsigned pk4_i8(f32x4 a, float sc) {
    const int q0 = max(-127, min(127, __float2int_rn(a.x * sc))), q1 = max(-127, min(127, __float2int_rn(a.y * sc))), q2 = max(-127, min(127, __float2int_rn(a.z * sc))), q3 = max(-127, min(127, __float2int_rn(a.w * sc)));
    return (unsigned)(q0 & 0xff) | ((unsigned)(q1 & 0xff) << 8) | ((unsigned)(q2 & 0xff) << 16) | ((unsigned)q3 << 24); }
__device__ __forceinline__ void p0_transpose_item(const float* W, int K, int N, bf16* WT, LAS float* scr, int item, int lane) {
    const int nblk = N / 64, kb = item / nblk, nb = item % nblk, k0 = 64 * kb, n0 = 64 * nb;
#pragma unroll 16
    for (int kk = 0; kk < 64; ++kk) scr[kk * 65 + lane] = W[(size_t)(k0 + kk) * N + n0 + lane];
    LDS_WAIT(); asm volatile("" ::: "memory");
    const int c = lane & 7;
#pragma unroll
    for (int j = 0; j < 8; ++j) { const int n = (lane >> 3) + 8 * j; const LAS float* s = scr + (8 * c) * 65 + n;
        v4u o; o.x = pk2(s[0 * 65], s[1 * 65]); o.y = pk2(s[2 * 65], s[3 * 65]); o.z = pk2(s[4 * 65], s[5 * 65]); o.w = pk2(s[6 * 65], s[7 * 65]);
        *(GAS v4u*)(WT + (size_t)(n0 + n) * K + k0 + 8 * c) = o; }
    LDS_WAIT(); asm volatile("" ::: "memory");
}
__device__ __forceinline__ void p0_transpose_item_i8(const float* W, int K, int N, unsigned char* WT, LAS float* scr, int item, int lane, float sc) {
    const int nblk = N / 64, kb = item / nblk, nb = item % nblk, k0 = 64 * kb, n0 = 64 * nb;
#pragma unroll 16
    for (int kk = 0; kk < 64; ++kk) scr[kk * 65 + lane] = W[(size_t)(k0 + kk) * N + n0 + lane];
    LDS_WAIT(); asm volatile("" ::: "memory");
    const int c = lane & 7;
#pragma unroll
    for (int j = 0; j < 8; ++j) { const int n = (lane >> 3) + 8 * j; const LAS float* s = scr + (8 * c) * 65 + n;
        v2u o; o.x = pk4_i8((f32x4){s[0 * 65], s[1 * 65], s[2 * 65], s[3 * 65]}, sc); o.y = pk4_i8((f32x4){s[4 * 65], s[5 * 65], s[6 * 65], s[7 * 65]}, sc);
        *(GAS v2u*)(WT + (size_t)(n0 + n) * K + k0 + 8 * c) = o; }
    LDS_WAIT(); asm volatile("" ::: "memory");
}
__device__ __forceinline__ void p0_convert_item(const float* src, bf16* dst, size_t item, int lane) {
    const GAS f32x4* s = (const GAS f32x4*)(src + item * 2048) + lane * 2;
    GAS v4u* d = (GAS v4u*)(dst + item * 2048) + lane;
#pragma unroll
    for (int j = 0; j < 4; ++j) { const f32x4 a = s[j * 128], b = s[j * 128 + 1];
        v4u o; o.x = pk2(a.x, a.y); o.y = pk2(a.z, a.w); o.z = pk2(b.x, b.y); o.w = pk2(b.z, b.w); d[j * 64] = o; }
}
__device__ __forceinline__ unsigned pk4_fp8(f32x4 a, float sc) { int w = __builtin_amdgcn_cvt_pk_fp8_f32(a.x * sc, a.y * sc, 0, false); w = __builtin_amdgcn_cvt_pk_fp8_f32(a.z * sc, a.w * sc, w, true); return (unsigned)w; }
__device__ __forceinline__ void p0_convert_item_i8(const float* src, unsigned char* dst, size_t item, int lane, float sc) {
    const GAS f32x4* s = (const GAS f32x4*)(src + item * 4096) + lane * 4;
#pragma unroll
    for (int j = 0; j < 4; ++j) { v4u o; o.x = pk4_i8(s[j * 256], sc); o.y = pk4_i8(s[j * 256 + 1], sc); o.z = pk4_i8(s[j * 256 + 2], sc); o.w = pk4_i8(s[j * 256 + 3], sc);
        *(GAS v4u*)(dst + (size_t)(lane >> 3) * NEXP * 128 + (item * 4 + j) * 128 + (lane & 7) * 16) = o; }
}
__device__ __forceinline__ void p0_convert_item_fp8(const float* src, unsigned char* dst, size_t item, int lane, float sc) {
    const GAS f32x4* s = (const GAS f32x4*)(src + item * 4096) + lane * 4;
#pragma unroll
    for (int j = 0; j < 4; ++j) { v4u o; o.x = pk4_fp8(s[j * 256], sc); o.y = pk4_fp8(s[j * 256 + 1], sc); o.z = pk4_fp8(s[j * 256 + 2], sc); o.w = pk4_fp8(s[j * 256 + 3], sc);
        *(GAS v4u*)(dst + (size_t)(lane >> 3) * NEXP * 128 + (item * 4 + j) * 128 + (lane & 7) * 16) = o; }
}
__device__ __forceinline__ void p0_ada_task(Frame& F, int task, LAS float* scr) {
    const int kc = task / (ADA_W / 64), ng = task % (ADA_W / 64), lane = F.lane;
    const float* c = F.in[IN_C];
    for (int e = lane; e < BATCH * 128; e += 64) { const int b = e >> 7, kk = e & 127; const float cv = c[b * D + kc * 128 + kk]; scr[kk * 16 + b] = cv / (1.f + expf(-cv)); }
    LDS_WAIT(); asm volatile("" ::: "memory");
    float acc[BATCH];
#pragma unroll
    for (int b = 0; b < BATCH; ++b) acc[b] = 0.f;
    const float* wp = F.in[IN_WADA] + (size_t)(kc * 128) * ADA_W + ng * 64 + lane;
#pragma unroll 1
    for (int k0 = 0; k0 < 128; k0 += 16) { float wv[16];
#pragma unroll
        for (int u = 0; u < 16; ++u) wv[u] = wp[(size_t)(k0 + u) * ADA_W];
#pragma unroll
        for (int u = 0; u < 16; ++u) { const LAS f32x4* sp = (const LAS f32x4*)(scr + (k0 + u) * 16);
#pragma unroll
            for (int q = 0; q < 4; ++q) { const f32x4 s = sp[q]; acc[4 * q] += s.x * wv[u]; acc[4 * q + 1] += s.y * wv[u]; acc[4 * q + 2] += s.z * wv[u]; acc[4 * q + 3] += s.w * wv[u]; } } }
    float* ap = (float*)(F.ws + WS_ADAP);
#pragma unroll
    for (int b = 0; b < BATCH; ++b) ap[(size_t)(kc * BATCH + b) * ADA_W + ng * 64 + lane] = acc[b];
    LDS_WAIT(); asm volatile("" ::: "memory");
}
__device__ __forceinline__ void p0_prologue(Frame& F) {
    LAS float* scr = (LAS float*)(F.lds + RING_OFF + F.wave * 16896);
    const int gw = F.vcu * NWAVES + F.wave, NGW = F.G * NWAVES;
    constexpr int I_ADA = ADA_KC * (ADA_W / 64);
    constexpr int I_T1 = (D / 64) * (IN_W / 64), I_T2 = (D / 64) * (D / 64), I_T3 = (D / 64) * (QW / 64);
    constexpr int I_K = PH * NKEYS * DHALF / 2048;
    constexpr int I_E = (int)((size_t)NEXP * D / 4096);
    constexpr int NITEMS = I_ADA + I_T1 + I_T2 + I_T3 + 2 * I_K + 2 * I_E;
    for (int it = gw; it < NITEMS; it += NGW) {
        int r = it;
        if (r < I_ADA) { p0_ada_task(F, r, scr); continue; } r -= I_ADA;
        if (r < I_T1) { p0_transpose_item_i8(F.in[IN_WIN], D, IN_W, F.ws + WS_WIN, scr, r, F.lane, WQ_SCALE); continue; } r -= I_T1;
        if (r < I_T2) { p0_transpose_item(F.in[IN_WOUT], D, D, (bf16*)(F.ws + WS_WOUT), scr, r, F.lane); continue; } r -= I_T2;
        if (r < I_T3) { p0_transpose_item_i8(F.in[IN_WQ], D, QW, F.ws + WS_WQ, scr, r, F.lane, WQ_SCALE); continue; } r -= I_T3;
        if (r < I_K) { p0_convert_item(F.in[IN_PK1], (bf16*)(F.ws + WS_K1), r, F.lane); continue; } r -= I_K;
        if (r < I_K) { p0_convert_item(F.in[IN_PK2], (bf16*)(F.ws + WS_K2), r, F.lane); continue; } r -= I_K;
        if (r < I_E) { p0_convert_item_i8(F.in[IN_PU], F.ws + WS_U, r, F.lane, U_SCALE); continue; } r -= I_E;
        p0_convert_item_fp8(F.in[IN_PV], F.ws + WS_V, r, F.lane, V_SCALE);
    }
}

__device__ __forceinline__ void mod_row(const float* xrow, bf16* orow, const LAS float* SC, const LAS float* SH, int lane) {
    const GAS f32x4* xr = (const GAS f32x4*)xrow + lane;
    f32x4 v[4]; float s = 0.f;
#pragma unroll
    for (int j = 0; j < 4; ++j) { v[j] = xr[64 * j]; s += (v[j].x * v[j].x + v[j].y * v[j].y) + (v[j].z * v[j].z + v[j].w * v[j].w); }
    const float rstd = 1.0f / sqrtf(wave_sum(s) * (1.f / D) + EPS);
    GAS unsigned long long* o8 = (GAS unsigned long long*)orow + lane;
#pragma unroll
    for (int j = 0; j < 4; ++j) { const f32x4 sc = ((const LAS f32x4*)SC)[lane + 64 * j], sh = ((const LAS f32x4*)SH)[lane + 64 * j];
        const f32x4 o = v[j] * rstd * sc + sh;
        o8[64 * j] = (unsigned long long)pk2(o.x, o.y) | ((unsigned long long)pk2(o.z, o.w) << 32); }
}
__device__ __forceinline__ void mod_row_bf(const bf16* xrow, bf16* orow, const LAS float* SC, const LAS float* SH, int lane) {
    const GAS v2u* xr = (const GAS v2u*)xrow + lane;
    f32x4 v[4]; float s = 0.f;
#pragma unroll
    for (int j = 0; j < 4; ++j) { const v2u w = xr[64 * j]; v[j] = (f32x4){bflo(w.x), bfhi(w.x), bflo(w.y), bfhi(w.y)}; s += (v[j].x * v[j].x + v[j].y * v[j].y) + (v[j].z * v[j].z + v[j].w * v[j].w); }
    const float rstd = 1.0f / sqrtf(wave_sum(s) * (1.f / D) + EPS);
    GAS unsigned long long* o8 = (GAS unsigned long long*)orow + lane;
#pragma unroll
    for (int j = 0; j < 4; ++j) { const f32x4 sc = ((const LAS f32x4*)SC)[lane + 64 * j], sh = ((const LAS f32x4*)SH)[lane + 64 * j];
        const f32x4 o = v[j] * rstd * sc + sh;
        o8[64 * j] = (unsigned long long)pk2(o.x, o.y) | ((unsigned long long)pk2(o.z, o.w) << 32); }
}
__device__ __forceinline__ void mod_load(const float* xrow, int lane, f32x4 (&v)[4]) { const GAS f32x4* xr = (const GAS f32x4*)xrow + lane;
#pragma unroll
    for (int j = 0; j < 4; ++j) v[j] = xr[64 * j]; }
__device__ __forceinline__ void mod_load_bf(const bf16* xrow, int lane, f32x4 (&v)[4]) { const GAS v2u* xr = (const GAS v2u*)xrow + lane;
#pragma unroll
    for (int j = 0; j < 4; ++j) { const v2u w = xr[64 * j]; v[j] = (f32x4){bflo(w.x), bfhi(w.x), bflo(w.y), bfhi(w.y)}; } }
template <bool I8> __device__ __forceinline__ void mod_finish(const f32x4 (&v)[4], bf16* orow, unsigned char* o8row, float* hs_out, const LAS float* SC, const LAS float* SH, int lane) {
    float s = 0.f;
#pragma unroll
    for (int j = 0; j < 4; ++j) s += (v[j].x * v[j].x + v[j].y * v[j].y) + (v[j].z * v[j].z + v[j].w * v[j].w);
    const float rstd = 1.0f / sqrtf(wave_sum(s) * (1.f / D) + EPS);
    f32x4 o[4]; float am = 0.f;
#pragma unroll
    for (int j = 0; j < 4; ++j) { const f32x4 sc = ((const LAS f32x4*)SC)[lane + 64 * j], sh = ((const LAS f32x4*)SH)[lane + 64 * j]; o[j] = v[j] * rstd * sc + sh;
        am = fmaxf(am, fmaxf(fmaxf(fabsf(o[j].x), fabsf(o[j].y)), fmaxf(fabsf(o[j].z), fabsf(o[j].w)))); }
    if (!I8) { GAS unsigned long long* o8 = (GAS unsigned long long*)orow + lane;
#pragma unroll
        for (int j = 0; j < 4; ++j) o8[64 * j] = (unsigned long long)pk2(o[j].x, o[j].y) | ((unsigned long long)pk2(o[j].z, o[j].w) << 32);
    } else {
#pragma unroll
        for (int off = 1; off < 64; off <<= 1) am = fmaxf(am, __shfl_xor(am, off));
        const float qs = am > 0.f ? 127.f / am : 0.f;
#pragma unroll
        for (int j = 0; j < 4; ++j) ((GAS unsigned*)o8row)[lane + 64 * j] = pk4_i8(o[j], qs);
        if (lane == 0) *hs_out = am * (1.f / 127.f); }
}
__device__ __forceinline__ void p1_hpass(Frame& F) {
    LAS float* SC = (LAS float*)(F.lds); LAS float* SH = SC + D;
    const float* adap = (const float*)(F.ws + WS_ADAP); const float* bada = F.in[IN_BADA]; const float* g1 = F.in[IN_G1];
    float* ada = (float*)(F.ws + WS_ADA);
    for (int e = blockIdx.x * 512 + F.tid; e < BATCH * ADA_W; e += F.G * 512) { const int b = e / ADA_W, n = e % ADA_W; float s = bada[n];
#pragma unroll
        for (int kc = 0; kc < ADA_KC; ++kc) s += adap[(size_t)(kc * BATCH + b) * ADA_W + n];
        ada[e] = s; }
    for (int tile = blockIdx.x; tile < M / 128; tile += F.G) {
        const int b = tile / (SEQ / 128);
        for (int d = F.tid; d < D; d += 512) { float sh = bada[d], sc = bada[D + d];
#pragma unroll
            for (int kc = 0; kc < ADA_KC; ++kc) { const float* p = adap + (size_t)(kc * BATCH + b) * ADA_W; sh += p[d]; sc += p[D + d]; }
            SC[d] = g1[d] * (1.f + sc); SH[d] = sh; }
        __syncthreads();
        { f32x4 va[4], vb[4];
          mod_load(F.in[IN_X] + ((size_t)tile * 128 + F.wave) * D, F.lane, va);
#pragma unroll 1
          for (int r = F.wave; r < 128; r += 2 * NWAVES) { const size_t row = (size_t)tile * 128 + r;
              mod_load(F.in[IN_X] + (row + NWAVES) * D, F.lane, vb);
              mod_finish<true>(va, nullptr, F.ws + WS_H8 + row * D, (float*)(F.ws + WS_HS) + row, SC, SH, F.lane);
              if (r + 2 * NWAVES < 128) mod_load(F.in[IN_X] + (row + 2 * NWAVES) * D, F.lane, va);
              mod_finish<true>(vb, nullptr, F.ws + WS_H8 + (row + NWAVES) * D, (float*)(F.ws + WS_HS) + (row + NWAVES), SC, SH, F.lane); } }
        __syncthreads();
    }
}
__device__ __forceinline__ void p5_h2pass(Frame& F) {
    LAS float* SC = (LAS float*)(F.lds); LAS float* SH = SC + D;
    const float* ada = (const float*)(F.ws + WS_ADA); const float* g2 = F.in[IN_G2];
    for (int tile = blockIdx.x; tile < M / 128; tile += F.G) {
        const int b = tile / (SEQ / 128);
        for (int d = F.tid; d < D; d += 512) { SC[d] = g2[d] * (1.f + ada[(size_t)b * ADA_W + 4 * D + d]); SH[d] = ada[(size_t)b * ADA_W + 3 * D + d]; }
        __syncthreads();
        { f32x4 va[4], vb[4]; const bf16* X1 = (const bf16*)(F.ws + WS_X1);
          mod_load_bf(X1 + ((size_t)tile * 128 + F.wave) * D, F.lane, va);
#pragma unroll 1
          for (int r = F.wave; r < 128; r += 2 * NWAVES) { const size_t row = (size_t)tile * 128 + r;
              mod_load_bf(X1 + (row + NWAVES) * D, F.lane, vb);
              mod_finish<true>(va, (bf16*)(F.ws + WS_H) + row * D, F.ws + WS_H8 + row * D, (float*)(F.ws + WS_HS) + row, SC, SH, F.lane);
              if (r + 2 * NWAVES < 128) mod_load_bf(X1 + (row + 2 * NWAVES) * D, F.lane, va);
              mod_finish<true>(vb, (bf16*)(F.ws + WS_H) + (row + NWAVES) * D, F.ws + WS_H8 + (row + NWAVES) * D, (float*)(F.ws + WS_HS) + (row + NWAVES), SC, SH, F.lane); } }
        __syncthreads();
    }
}

typedef float f32x16 __attribute__((ext_vector_type(16)));
typedef short s16x4 __attribute__((ext_vector_type(4)));
typedef __bf16 bf16x8_t __attribute__((ext_vector_type(8)));
#define MFMA32(a, b, c) __builtin_amdgcn_mfma_f32_32x32x16_bf16((a), (b), (c), 0, 0, 0)
constexpr int KS = 144, VS = 192;
__device__ __forceinline__ void p3_attn_unit(Frame& F, int unit) {
    const int kh = unit & 1, nb = (unit >> 1) & 15, b = unit >> 5;
    LAS unsigned char* KL = F.lds; LAS unsigned char* VL = F.lds + 256 * KS;
    const bf16* proj = (const bf16*)(F.ws + WS_PROJ);
    const int tok0 = b * SEQ + nb * 128;
    for (int c = F.tid; c < 2048; c += 512) { const int j = c >> 3, ch = c & 7;
        v4u kv = (v4u){0u, 0u, 0u, 0u}, vv = (v4u){0u, 0u, 0u, 0u};
        if (nb > 0 || j >= 128) { const bf16* rowp = proj + (size_t)(tok0 - 128 + j) * IN_W; kv = *(const GAS v4u*)(rowp + O_K + kh * HD + ch * 8); vv = *(const GAS v4u*)(rowp + O_V + kh * HD + ch * 8); }
        *(LAS v4u*)(KL + j * KS + ch * 16) = kv; *(LAS v4u*)(VL + j * VS + ch * 16) = vv; }
    __syncthreads();
    const int lane = F.lane, r = lane & 31, hh = lane >> 5;
#pragma unroll 1
    for (int task = F.wave; task < 16; task += NWAVES) {
        const int g = task >> 2, w = task & 3, qh = kh * 4 + g, i0 = 32 * w;
        const bf16* qp = proj + (size_t)(tok0 + i0 + r) * IN_W + O_Q + qh * HD + 8 * hh;
        bf16x8 qf[4];
#pragma unroll
        for (int s = 0; s < 4; ++s) qf[s] = *(const GAS bf16x8*)(qp + 16 * s);
        f32x16 sc[5];
#pragma unroll
        for (int t = 0; t < 5; ++t) {
#pragma unroll
            for (int e = 0; e < 16; ++e) sc[t][e] = 0.f;
#pragma unroll
            for (int s = 0; s < 4; ++s) { const bf16x8 a = *(const LAS bf16x8*)(KL + ((w + t) * 32 + r) * KS + 32 * s + 16 * hh); sc[t] = MFMA32(a, qf[s], sc[t]); } }
        const float sink = F.in[IN_SINK][qh];
        float mx = sink;
#pragma unroll
        for (int t = 0; t < 5; ++t)
#pragma unroll
            for (int e = 0; e < 16; ++e) { const int kr = (e & 3) + 8 * (e >> 2) + 4 * hh;
                bool valid = (nb > 0) || (w + t >= 4);
                if (t == 0) valid = valid && (kr > r);
                if (t == 4) valid = valid && (kr <= r);
                const float v = valid ? sc[t][e] * 0.125f : -1e30f; sc[t][e] = v; mx = fmaxf(mx, v); }
        mx = fmaxf(mx, __shfl_xor(mx, 32));
        float lsum = 0.f;
#pragma unroll
        for (int t = 0; t < 5; ++t)
#pragma unroll
            for (int e = 0; e < 16; ++e) { const float p = __expf(sc[t][e] - mx); sc[t][e] = p; lsum += p; }
        lsum += __shfl_xor(lsum, 32); lsum += __expf(sink - mx);
        f32x16 o[2];
#pragma unroll
        for (int dt = 0; dt < 2; ++dt)
#pragma unroll
            for (int e = 0; e < 16; ++e) o[dt][e] = 0.f;
        const int q4 = (r & 15) >> 2, p4 = r & 3;
#pragma unroll
        for (int t = 0; t < 5; ++t)
#pragma unroll
            for (int sp = 0; sp < 2; ++sp) {
                bf16x8_t pbv;
#pragma unroll
                for (int e = 0; e < 8; ++e) pbv[e] = (__bf16)sc[t][8 * sp + e];
                const bf16x8 pb = __builtin_bit_cast(bf16x8, pbv);
#pragma unroll
                for (int dt = 0; dt < 2; ++dt) {
                    const int kb = (w + t) * 32 + 16 * sp + 4 * hh;
                    const LAS unsigned char* ap = VL + (kb + q4) * VS + (32 * dt + 16 * (r >> 4) + 4 * p4) * 2;
                    const s16x4 lo = __builtin_amdgcn_ds_read_tr16_b64_v4i16((LAS s16x4*)ap);
                    const s16x4 hi = __builtin_amdgcn_ds_read_tr16_b64_v4i16((LAS s16x4*)(ap + 8 * VS));
                    const bf16x8 a = __builtin_shufflevector(lo, hi, 0, 1, 2, 3, 4, 5, 6, 7);
                    o[dt] = MFMA32(a, pb, o[dt]); } }
        const float inv = 1.f / lsum; float ss = 0.f;
#pragma unroll
        for (int dt = 0; dt < 2; ++dt)
#pragma unroll
            for (int e = 0; e < 16; ++e) { o[dt][e] *= inv; ss += o[dt][e] * o[dt][e]; }
        ss += __shfl_xor(ss, 32);
        const float rs = 1.0f / sqrtf(ss * (1.f / HD) + EPS);
        const float* gp = F.in[IN_AOG] + qh * HD;
        bf16* op = (bf16*)(F.ws + WS_MIX) + (size_t)(tok0 + i0 + r) * D + qh * HD;
#pragma unroll
        for (int dt = 0; dt < 2; ++dt)
#pragma unroll
            for (int g4 = 0; g4 < 4; ++g4) { const int d0 = 32 * dt + 8 * g4 + 4 * hh; const f32x4 gv = *(const f32x4*)(gp + d0);
                v2u wv; wv.x = pk2(o[dt][4 * g4 + 0] * rs * gv.x, o[dt][4 * g4 + 1] * rs * gv.y); wv.y = pk2(o[dt][4 * g4 + 2] * rs * gv.z, o[dt][4 * g4 + 3] * rs * gv.w);
                *(GAS v2u*)(op + d0) = wv; }
    }
    __syncthreads();
}
__device__ __forceinline__ void p3_conv(Frame& F) {
    const bf16* proj = (const bf16*)(F.ws + WS_PROJ); const int lane = F.lane, c0 = 8 * lane;
    const float* cw = F.in[IN_CONVW]; const float* cg = F.in[IN_COG];
    float w0[8], w1[8], w2[8], gg[8];
#pragma unroll
    for (int e = 0; e < 8; ++e) { w0[e] = cw[c0 + e]; w1[e] = cw[512 + c0 + e]; w2[e] = cw[1024 + c0 + e]; gg[e] = cg[c0 + e]; }
    const int gw = F.vcu * NWAVES + F.wave, NGW = F.G * NWAVES;
    for (int tok = gw; tok < M; tok += NGW) {
        const int s = tok & (SEQ - 1); const bf16* rp = proj + (size_t)tok * IN_W;
        const v4u z4 = (v4u){0u, 0u, 0u, 0u};
        const v4u Bv = *(const GAS v4u*)(rp + O_B + c0), C0 = *(const GAS v4u*)(rp + O_C + c0), U0 = *(const GAS v4u*)(rp + O_U + c0);
        v4u C1 = z4, U1 = z4, C2 = z4, U2 = z4;
        if (s >= 1) { C1 = *(const GAS v4u*)(rp - IN_W + O_C + c0); U1 = *(const GAS v4u*)(rp - IN_W + O_U + c0); }
        if (s >= 2) { C2 = *(const GAS v4u*)(rp - 2 * IN_W + O_C + c0); U2 = *(const GAS v4u*)(rp - 2 * IN_W + O_U + c0); }
        float y[8]; float ss = 0.f;
#pragma unroll
        for (int e = 0; e < 8; ++e) { const int wi = e >> 1; const bool hi = e & 1;
            const unsigned bw = Bv[wi], c0w = C0[wi], u0w = U0[wi], c1w = C1[wi], u1w = U1[wi], c2w = C2[wi], u2w = U2[wi];
            const float bb = hi ? bfhi(bw) : bflo(bw);
            const float z0 = (hi ? bfhi(c0w) : bflo(c0w)) * (hi ? bfhi(u0w) : bflo(u0w));
            const float z1 = (hi ? bfhi(c1w) : bflo(c1w)) * (hi ? bfhi(u1w) : bflo(u1w));
            const float z2 = (hi ? bfhi(c2w) : bflo(c2w)) * (hi ? bfhi(u2w) : bflo(u2w));
            y[e] = bb * (z2 * w0[e] + z1 * w1[e] + z0 * w2[e]); ss += y[e] * y[e]; }
        ss += __shfl_xor(ss, 1); ss += __shfl_xor(ss, 2); ss += __shfl_xor(ss, 4);
        const float rs = 1.0f / sqrtf(ss * (1.f / 64.f) + EPS);
        v4u w; w.x = pk2(y[0] * rs * gg[0], y[1] * rs * gg[1]); w.y = pk2(y[2] * rs * gg[2], y[3] * rs * gg[3]);
        w.z = pk2(y[4] * rs * gg[4], y[5] * rs * gg[5]); w.w = pk2(y[6] * rs * gg[6], y[7] * rs * gg[7]);
        *(GAS v4u*)((bf16*)(F.ws + WS_MIX) + (size_t)tok * D + 512 + c0) = w;
    }
}
__device__ __forceinline__ void p3_mixer(Frame& F) {
    for (int unit = blockIdx.x; unit < BATCH * 16 * NKVH; unit += F.G) p3_attn_unit(F, unit);
    p3_conv(F);
}

#define DI __device__ __forceinline__
#define CE_(i, j) { const unsigned x_ = a[i], y_ = a[j]; a[i] = x_ > y_ ? x_ : y_; a[j] = x_ > y_ ? y_ : x_; }
DI void sort16_desc(unsigned (&a)[16]) {
    CE_(0,13) CE_(1,12) CE_(2,15) CE_(3,14) CE_(4,8) CE_(5,6) CE_(7,11) CE_(9,10)
    CE_(0,5) CE_(1,7) CE_(2,9) CE_(3,4) CE_(6,13) CE_(8,14) CE_(10,15) CE_(11,12)
    CE_(0,1) CE_(2,3) CE_(4,5) CE_(6,8) CE_(7,9) CE_(10,11) CE_(12,13) CE_(14,15)
    CE_(0,2) CE_(1,3) CE_(4,10) CE_(5,11) CE_(6,7) CE_(8,9) CE_(12,14) CE_(13,15)
    CE_(1,2) CE_(3,12) CE_(4,6) CE_(5,7) CE_(8,10) CE_(9,11) CE_(13,14)
    CE_(1,4) CE_(2,6) CE_(5,8) CE_(7,10) CE_(9,13) CE_(11,14)
    CE_(2,4) CE_(3,6) CE_(9,12) CE_(11,13)
    CE_(3,5) CE_(6,8) CE_(7,9) CE_(10,12)
    CE_(3,4) CE_(5,6) CE_(7,8) CE_(9,10) CE_(11,12)
    CE_(6,7) CE_(8,9)
}
DI void bitonic_merge16_desc(unsigned (&a)[16]) {
#pragma unroll
    for (int js = 3; js >= 0; --js) {
#pragma unroll
        for (int i = 0; i < 16; ++i) { const int j = 1 << js, l = i ^ j;
            if (l > i) { const unsigned x = a[i], y = a[l]; a[i] = x > y ? x : y; a[l] = x > y ? y : x; } }
    }
}
DI void merge_top16(unsigned (&a)[16], const unsigned (&b)[16]) {
#pragma unroll
    for (int i = 0; i < 16; ++i) { const unsigned x = a[i], y = b[15 - i]; a[i] = x > y ? x : y; }
    bitonic_merge16_desc(a);
}
DI void top16_of_64(unsigned (&g0)[16], unsigned (&g1)[16], unsigned (&g2)[16], unsigned (&g3)[16]) {
    sort16_desc(g0); sort16_desc(g1); sort16_desc(g2); sort16_desc(g3);
    merge_top16(g0, g1); merge_top16(g2, g3); merge_top16(g0, g2);
}
#define SBIAS 8.0f
DI unsigned skey(float biased) { return __float_as_uint(fmaxf(biased, 0.f)); }
constexpr int KEY_STRIDE = 272;
DI void route_scores_top16(const LAS unsigned char* KL, const bf16* qrow, int r, int hh, unsigned (&out)[16]) {
    bf16x8 qf[8];
#pragma unroll
    for (int s = 0; s < 8; ++s) qf[s] = *(const GAS bf16x8*)(qrow + 16 * s);
    f32x16 acc[4];
#pragma unroll
    for (int t = 0; t < 4; ++t)
#pragma unroll
        for (int e = 0; e < 16; ++e) acc[t][e] = SBIAS;
#pragma unroll
    for (int t = 0; t < 4; ++t)
#pragma unroll
        for (int s = 0; s < 8; ++s) { const bf16x8 a = *(const LAS bf16x8*)(KL + (t * 32 + r) * KEY_STRIDE + 32 * s + 16 * hh); acc[t] = MFMA32(a, qf[s], acc[t]); }
    unsigned g0[16], g1[16], g2[16], g3[16];
    const unsigned pb = (unsigned)(127 - 4 * hh);
#pragma unroll
    for (int e = 0; e < 16; ++e) { const unsigned p = pb - (unsigned)((e & 3) + 8 * (e >> 2));
        g0[e] = (skey(acc[0][e]) & ~127u) | p; g1[e] = (skey(acc[1][e]) & ~127u) | (p - 32u); g2[e] = (skey(acc[2][e]) & ~127u) | (p - 64u); g3[e] = (skey(acc[3][e]) & ~127u) | (p - 96u); }
    top16_of_64(g0, g1, g2, g3);
    unsigned oth[16];
#pragma unroll
    for (int i = 0; i < 16; ++i) oth[i] = (unsigned)__shfl_xor((int)g0[i], 32);
    merge_top16(g0, oth);
#pragma unroll
    for (int i = 0; i < 16; ++i) out[i] = g0[i];
}
DI void p7_route_tile(Frame& F, int tok0, int h, const LAS unsigned char* KL1, const LAS unsigned char* KL2, LAS unsigned char* scr) {
    const int lane = F.lane, r = lane & 31, hh = lane >> 5;
    const bf16* qrow = (const bf16*)(F.ws + WS_PROJ) + (size_t)(tok0 + r) * QW + h * DKEY + 8 * hh;
    unsigned t1[16], t2[16];
    route_scores_top16(KL1, qrow, r, hh, t1);
    route_scores_top16(KL2, qrow + DHALF, r, hh, t2);
    { v4u w;
#pragma unroll
      for (int q = 0; q < 4; ++q) { unsigned x = 0u;
#pragma unroll
          for (int bq = 0; bq < 4; ++bq) { const unsigned k = hh ? t2[4 * q + bq] : t1[4 * q + bq]; x |= (127u - (k & 127u)) << (8 * bq); }
          w[q] = x; }
      *(LAS v4u*)(scr + r * 32 + hh * 16) = w; }
    float v1[16], v2[16];
#pragma unroll
    for (int i = 0; i < 16; ++i) { v1[i] = __uint_as_float(t1[i] & ~127u); v2[i] = __uint_as_float(t2[i] & ~127u) - SBIAS; }
    unsigned c0[16], c1[16];
    { const float sa = v1[0] + v2[0], sb = v1[2] + v2[1]; c0[0] = (__float_as_uint(fmaxf(hh ? sb : sa, 0.f)) & ~255u) | (hh ? 222u : 255u); }
    { const float sa = v1[0] + v2[1], sb = v1[2] + v2[2]; c0[1] = (__float_as_uint(fmaxf(hh ? sb : sa, 0.f)) & ~255u) | (hh ? 221u : 254u); }
    { const float sa = v1[0] + v2[2], sb = v1[2] + v2[3]; c0[2] = (__float_as_uint(fmaxf(hh ? sb : sa, 0.f)) & ~255u) | (hh ? 220u : 253u); }
    { const float sa = v1[0] + v2[3], sb = v1[2] + v2[4]; c0[3] = (__float_as_uint(fmaxf(hh ? sb : sa, 0.f)) & ~255u) | (hh ? 219u : 252u); }
    { const float sa = v1[0] + v2[4], sb = v1[3] + v2[0]; c0[4] = (__float_as_uint(fmaxf(hh ? sb : sa, 0.f)) & ~255u) | (hh ? 207u : 251u); }
    { const float sa = v1[0] + v2[5], sb = v1[3] + v2[1]; c0[5] = (__float_as_uint(fmaxf(hh ? sb : sa, 0.f)) & ~255u) | (hh ? 206u : 250u); }
    { const float sa = v1[0] + v2[6], sb = v1[3] + v2[2]; c0[6] = (__float_as_uint(fmaxf(hh ? sb : sa, 0.f)) & ~255u) | (hh ? 205u : 249u); }
    { const float sa = v1[0] + v2[7], sb = v1[3] + v2[3]; c0[7] = (__float_as_uint(fmaxf(hh ? sb : sa, 0.f)) & ~255u) | (hh ? 204u : 248u); }
    { const float sa = v1[0] + v2[8], sb = v1[4] + v2[0]; c0[8] = (__float_as_uint(fmaxf(hh ? sb : sa, 0.f)) & ~255u) | (hh ? 191u : 247u); }
    { const float sa = v1[0] + v2[9], sb = v1[4] + v2[1]; c0[9] = (__float_as_uint(fmaxf(hh ? sb : sa, 0.f)) & ~255u) | (hh ? 190u : 246u); }
    { const float sa = v1[0] + v2[10], sb = v1[4] + v2[2]; c0[10] = (__float_as_uint(fmaxf(hh ? sb : sa, 0.f)) & ~255u) | (hh ? 189u : 245u); }
    { const float sa = v1[0] + v2[11], sb = v1[5] + v2[0]; c0[11] = (__float_as_uint(fmaxf(hh ? sb : sa, 0.f)) & ~255u) | (hh ? 175u : 244u); }
    { const float sa = v1[0] + v2[12], sb = v1[5] + v2[1]; c0[12] = (__float_as_uint(fmaxf(hh ? sb : sa, 0.f)) & ~255u) | (hh ? 174u : 243u); }
    { const float sa = v1[0] + v2[13], sb = v1[6] + v2[0]; c0[13] = (__float_as_uint(fmaxf(hh ? sb : sa, 0.f)) & ~255u) | (hh ? 159u : 242u); }
    { const float sa = v1[0] + v2[14], sb = v1[6] + v2[1]; c0[14] = (__float_as_uint(fmaxf(hh ? sb : sa, 0.f)) & ~255u) | (hh ? 158u : 241u); }
    { const float sa = v1[0] + v2[15], sb = v1[7] + v2[0]; c0[15] = (__float_as_uint(fmaxf(hh ? sb : sa, 0.f)) & ~255u) | (hh ? 143u : 240u); }
    { const float sa = v1[1] + v2[0], sb = v1[7] + v2[1]; c1[0] = (__float_as_uint(fmaxf(hh ? sb : sa, 0.f)) & ~255u) | (hh ? 142u : 239u); }
    { const float sa = v1[1] + v2[1], sb = v1[8] + v2[0]; c1[1] = (__float_as_uint(fmaxf(hh ? sb : sa, 0.f)) & ~255u) | (hh ? 127u : 238u); }
    { const float sa = v1[1] + v2[2], sb = v1[9] + v2[0]; c1[2] = (__float_as_uint(fmaxf(hh ? sb : sa, 0.f)) & ~255u) | (hh ? 111u : 237u); }
    { const float sa = v1[1] + v2[3], sb = v1[10] + v2[0]; c1[3] = (__float_as_uint(fmaxf(hh ? sb : sa, 0.f)) & ~255u) | (hh ? 95u : 236u); }
    { const float sa = v1[1] + v2[4], sb = v1[11] + v2[0]; c1[4] = (__float_as_uint(fmaxf(hh ? sb : sa, 0.f)) & ~255u) | (hh ? 79u : 235u); }
    { const float sa = v1[1] + v2[5], sb = v1[12] + v2[0]; c1[5] = (__float_as_uint(fmaxf(hh ? sb : sa, 0.f)) & ~255u) | (hh ? 63u : 234u); }
    { const float sa = v1[1] + v2[6], sb = v1[13] + v2[0]; c1[6] = (__float_as_uint(fmaxf(hh ? sb : sa, 0.f)) & ~255u) | (hh ? 47u : 233u); }
    { const float sa = v1[1] + v2[7], sb = v1[14] + v2[0]; c1[7] = (__float_as_uint(fmaxf(hh ? sb : sa, 0.f)) & ~255u) | (hh ? 31u : 232u); }
    { const float sa = v1[2] + v2[0], sb = v1[15] + v2[0]; c1[8] = (__float_as_uint(fmaxf(hh ? sb : sa, 0.f)) & ~255u) | (hh ? 15u : 223u); }
    c1[9] = 0u;
    c1[10] = 0u;
    c1[11] = 0u;
    c1[12] = 0u;
    c1[13] = 0u;
    c1[14] = 0u;
    c1[15] = 0u;
    sort16_desc(c0); sort16_desc(c1); merge_top16(c0, c1);
    { unsigned oth[16];
#pragma unroll
      for (int i = 0; i < 16; ++i) oth[i] = (unsigned)__shfl_xor((int)c0[i], 32);
      merge_top16(c0, oth); }
    const float mx = __uint_as_float(c0[0] & ~255u);
    LDS_WAIT(); asm volatile("" ::: "memory");
    float ex[8]; int ee[8]; float part = 0.f;
#pragma unroll
    for (int k = 0; k < 8; ++k) { const unsigned key = hh ? c0[8 + k] : c0[k]; const int ci = 255 - (int)(key & 255u);
        const int e1 = *(const LAS unsigned char*)(scr + r * 32 + (ci >> 4)), e2 = *(const LAS unsigned char*)(scr + r * 32 + 16 + (ci & 15));
        ee[k] = (e1 * NKEYS + e2) & (NEXP - 1); ex[k] = __expf(__uint_as_float(key & ~255u) - mx); part += ex[k]; }
    const float inv = 1.f / (part + __shfl_xor(part, 32));
    int* ip = (int*)(F.ws + WS_IDX) + (size_t)(tok0 + r) * 128 + h * TOPK + 8 * hh; float* gp = (float*)(F.ws + WS_GATE) + (size_t)(tok0 + r) * 128 + h * TOPK + 8 * hh;
    *(GAS v4u*)ip = (v4u){(unsigned)ee[0], (unsigned)ee[1], (unsigned)ee[2], (unsigned)ee[3]}; *(GAS v4u*)(ip + 4) = (v4u){(unsigned)ee[4], (unsigned)ee[5], (unsigned)ee[6], (unsigned)ee[7]};
    *(GAS f32x4*)gp = (f32x4){ex[0] * inv, ex[1] * inv, ex[2] * inv, ex[3] * inv}; *(GAS f32x4*)(gp + 4) = (f32x4){ex[4] * inv, ex[5] * inv, ex[6] * inv, ex[7] * inv};
    asm volatile("" ::: "memory");
}
__device__ __forceinline__ void p7_routing(Frame& F) {
    LAS unsigned char* KL1 = F.lds; LAS unsigned char* KL2 = F.lds + 128 * KEY_STRIDE; LAS unsigned char* scr = F.lds + 2 * 128 * KEY_STRIDE + F.wave * 1024;
    const bf16* k1 = (const bf16*)(F.ws + WS_K1); const bf16* k2 = (const bf16*)(F.ws + WS_K2);
    int cur_h = -1;
    for (int item = blockIdx.x; item < (M / 256) * PH; item += F.G) {
        const int h = item & (PH - 1), tile = item >> 3;
        if (h != cur_h) {
            __syncthreads();
            for (int c = F.tid; c < 2 * 128 * 16; c += 512) { const int which = c >> 11, rr = (c >> 4) & 127, ch = c & 15;
                const v4u v = *(const GAS v4u*)((which ? k2 : k1) + (size_t)(h * NKEYS + rr) * DHALF + ch * 8);
                *(LAS v4u*)((which ? KL2 : KL1) + rr * KEY_STRIDE + ch * 16) = v; }
            __syncthreads();
            cur_h = h;
        }
        p7_route_tile(F, tile * 256 + F.wave * 32, h, KL1, KL2, scr);
    }
}

__device__ __forceinline__ float gelu_erf(float v) { return 0.5f * v * (1.f + erff(v * 0.70710678118654752f)); }
typedef float f32x2v __attribute__((ext_vector_type(2)));
__device__ __forceinline__ unsigned fp8x2_bf16x2(unsigned w, bool hi) { return hi ? __builtin_bit_cast(unsigned, __builtin_amdgcn_cvt_scalef32_pk_bf16_fp8((int)w, 1.0f, true)) : __builtin_bit_cast(unsigned, __builtin_amdgcn_cvt_scalef32_pk_bf16_fp8((int)w, 1.0f, false)); }
__device__ __forceinline__ float dot16_fp8(v4u u, v4u ha, v4u hb, float acc) {
    acc = dot2(fp8x2_bf16x2(u.x, false), ha.x, acc); acc = dot2(fp8x2_bf16x2(u.x, true), ha.y, acc);
    acc = dot2(fp8x2_bf16x2(u.y, false), ha.z, acc); acc = dot2(fp8x2_bf16x2(u.y, true), ha.w, acc);
    acc = dot2(fp8x2_bf16x2(u.z, false), hb.x, acc); acc = dot2(fp8x2_bf16x2(u.z, true), hb.y, acc);
    acc = dot2(fp8x2_bf16x2(u.w, false), hb.z, acc); acc = dot2(fp8x2_bf16x2(u.w, true), hb.w, acc);
    return acc;
}
struct SliceWork { int j0, nj, t0, ts; };
__device__ __forceinline__ SliceWork slice_work(const Frame& F) { SliceWork w;
    if ((F.G & 7) == 0) { w.j0 = blockIdx.x & 7; w.nj = 1; w.t0 = (blockIdx.x >> 3) * NWAVES + F.wave; w.ts = F.G; }
    else { w.j0 = 0; w.nj = 8; w.t0 = blockIdx.x * NWAVES + F.wave; w.ts = F.G * NWAVES; }
    return w; }
struct USet { v4u hq; float hs; v4u u[16]; };
struct UMeta { v2u id; v4u hh; float hs; };
__device__ __forceinline__ UMeta p8a_G(const int* IDX, const unsigned char* H8, const float* HS, int t, int j, int lane) { UMeta m;
    m.id = *(const GAS v2u*)(IDX + (size_t)t * 128 + 2 * lane); m.hh = *(const GAS v4u*)(H8 + (size_t)t * D + 128 * j + 16 * (lane & 7)); m.hs = HS[t]; return m; }
__device__ __forceinline__ void p8a_S(LAS unsigned char* mb, const UMeta& m, int lane) { *(LAS v2u*)(mb + 8 * lane) = m.id; if (lane < 8) *(LAS v4u*)(mb + 512 + 16 * lane) = m.hh; }
__device__ __forceinline__ void p8a_RT(const LAS unsigned char* mb, const unsigned char* Ub, int c, int g, float hs, USet& s) {
    v4u ix[4];
#pragma unroll
    for (int q = 0; q < 4; ++q) ix[q] = *(const LAS v4u*)(mb + 64 * g + 16 * q);
    s.hq = *(const LAS v4u*)(mb + 512 + 16 * c); s.hs = hs;
#pragma unroll
    for (int i = 0; i < 16; ++i) s.u[i] = *(const GAS v4u*)(Ub + (unsigned)((ix[i >> 2][i & 3] << 7) + 16u * (unsigned)c)); }
__device__ __forceinline__ void p8a_compute(const USet& s, bf16* pa_row, int lane, int c) {
    int p[16];
#pragma unroll
    for (int i = 0; i < 16; ++i) { int a = __builtin_amdgcn_sdot4((int)s.u[i].x, (int)s.hq.x, 0, false); a = __builtin_amdgcn_sdot4((int)s.u[i].y, (int)s.hq.y, a, false);
        a = __builtin_amdgcn_sdot4((int)s.u[i].z, (int)s.hq.z, a, false); p[i] = __builtin_amdgcn_sdot4((int)s.u[i].w, (int)s.hq.w, a, false); }
#pragma unroll
    for (int i = 0; i < 8; ++i) { const bool up = c & 4; const int send = up ? p[i] : p[i + 8], keep = up ? p[i + 8] : p[i]; p[i] = keep + __shfl_xor(send, 4); }
#pragma unroll
    for (int i = 0; i < 4; ++i) { const bool up = c & 2; const int send = up ? p[i] : p[i + 4], keep = up ? p[i + 4] : p[i]; p[i] = keep + __shfl_xor(send, 2); }
#pragma unroll
    for (int i = 0; i < 2; ++i) { const bool up = c & 1; const int send = up ? p[i] : p[i + 2], keep = up ? p[i + 2] : p[i]; p[i] = keep + __shfl_xor(send, 1); }
    const float sc = s.hs * (1.f / U_SCALE);
    ((GAS unsigned*)pa_row)[lane] = pk2((float)p[0] * sc, (float)p[1] * sc);
}
__device__ __forceinline__ void p8a_udots(Frame& F) {
    const unsigned char* H8 = F.ws + WS_H8; const float* HS = (const float*)(F.ws + WS_HS); const int* IDX = (const int*)(F.ws + WS_IDX); bf16* PA = (bf16*)(F.ws + WS_PA);
    const int lane = F.lane, c = lane & 7, g = lane >> 3; const SliceWork sw = slice_work(F);
    LAS unsigned char* mb = F.lds + F.wave * 1024;
    if (sw.t0 >= M) return;
    const int nt = (M - 1 - sw.t0) / sw.ts + 1;
#define TOK(n) (sw.t0 + ((n) < nt ? (n) : nt - 1) * sw.ts)
    for (int jj = 0; jj < sw.nj; ++jj) { const int j = sw.j0 + jj; const unsigned char* Uj = F.ws + WS_U + (size_t)j * NEXP * 128;
        USet sA, sB, sC;
        UMeta mN = p8a_G(IDX, H8, HS, TOK(0), j, lane); p8a_S(mb, mN, lane); p8a_RT(mb, Uj, c, g, mN.hs, sA);
        mN = p8a_G(IDX, H8, HS, TOK(1), j, lane); p8a_S(mb, mN, lane); p8a_RT(mb, Uj, c, g, mN.hs, sB);
        mN = p8a_G(IDX, H8, HS, TOK(2), j, lane);
#define P8A_STAGE(k, SN, SC_) do { p8a_S(mb, mN, lane); p8a_RT(mb, Uj, c, g, mN.hs, SN); mN = p8a_G(IDX, H8, HS, TOK((k) + 3), j, lane); asm volatile("" ::: "memory"); \
            if ((k) < nt) p8a_compute(SC_, PA + ((size_t)j * M + TOK(k)) * 128, lane, c); asm volatile("" ::: "memory"); } while (0)
#pragma unroll 1
        for (int n = 0; n < nt; n += 3) {
            P8A_STAGE(n, sC, sA);
            P8A_STAGE(n + 1, sA, sB);
            P8A_STAGE(n + 2, sB, sC);
        }
#undef P8A_STAGE
    }
}
typedef _Float16 h2_t __attribute__((ext_vector_type(2)));
__device__ __forceinline__ h2_t cvt_h2_lo(int w) { return __builtin_bit_cast(h2_t, __builtin_amdgcn_cvt_scalef32_pk_f16_fp8(w, 1.0f, false)); }
__device__ __forceinline__ h2_t cvt_h2_hi(int w) { return __builtin_bit_cast(h2_t, __builtin_amdgcn_cvt_scalef32_pk_f16_fp8(w, 1.0f, true)); }
__device__ __forceinline__ void p8w_weights(Frame& F) {
    const bf16* PA = (const bf16*)(F.ws + WS_PA); float* GATE = (float*)(F.ws + WS_GATE);
    for (size_t e = (size_t)blockIdx.x * 512 + F.tid; e < (size_t)M * 128 / 4; e += (size_t)F.G * 512) {
        f32x4 s = (f32x4){0.f, 0.f, 0.f, 0.f};
#pragma unroll
        for (int j = 0; j < 8; ++j) { const v2u w = *(const GAS v2u*)(PA + (size_t)j * M * 128 + 4 * e); s += (f32x4){bflo(w.x), bfhi(w.x), bflo(w.y), bfhi(w.y)}; }
        const f32x4 gt = *(const GAS f32x4*)(GATE + 4 * e); f32x4 o;
#pragma unroll
        for (int q = 0; q < 4; ++q) o[q] = gt[q] * gelu_erf(s[q]);
        const h2_t w01 = (h2_t){(_Float16)o[0], (_Float16)o[1]}, w23 = (h2_t){(_Float16)o[2], (_Float16)o[3]};
        *(GAS v2u*)((_Float16*)(F.ws + WS_W16) + 4 * e) = (v2u){__builtin_bit_cast(unsigned, w01), __builtin_bit_cast(unsigned, w23)}; }
}
struct VSet { v4u wh[2]; v4u v[16]; unsigned x1; f32x2v g2; };
struct VMeta { v2u id; unsigned w; };
__device__ __forceinline__ VMeta p8b_G(const int* IDX, const _Float16* W, int t, int lane) { VMeta m;
    m.id = *(const GAS v2u*)(IDX + (size_t)t * 128 + 2 * lane); m.w = *(const GAS unsigned*)(W + (size_t)t * 128 + 2 * lane); return m; }
__device__ __forceinline__ void p8b_S(LAS unsigned char* mb, const VMeta& m, int lane) { *(LAS v2u*)(mb + 8 * lane) = m.id; *(LAS unsigned*)(mb + 512 + 4 * lane) = m.w; }
__device__ __forceinline__ void p8b_RT(Frame& F, const LAS unsigned char* mb, const unsigned char* Vj, int t, int j, int c, int g, VSet& s) {
    { const int d = 128 * j + 16 * c + 2 * g; s.x1 = *(const GAS unsigned*)((const bf16*)(F.ws + WS_X1) + (size_t)t * D + d); s.g2 = *(const GAS f32x2v*)((const float*)(F.ws + WS_ADA) + (size_t)(t / SEQ) * ADA_W + 5 * D + d); }
    v4u ix[4];
#pragma unroll
    for (int q = 0; q < 4; ++q) ix[q] = *(const LAS v4u*)(mb + 64 * g + 16 * q);
    s.wh[0] = *(const LAS v4u*)(mb + 512 + 32 * g); s.wh[1] = *(const LAS v4u*)(mb + 512 + 32 * g + 16);
#pragma unroll
    for (int i = 0; i < 16; ++i) s.v[i] = *(const GAS v4u*)(Vj + (unsigned)((ix[i >> 2][i & 3] << 7) + 16u * (unsigned)c)); }
__device__ __forceinline__ void p8b_compute(Frame& F, const VSet& s, int t, int j, int lane, int c, int g) {
    h2_t ah[8];
#pragma unroll
    for (int m = 0; m < 8; ++m) ah[m] = (h2_t){(_Float16)0.f, (_Float16)0.f};
#pragma unroll
    for (int i = 0; i < 16; ++i) { const v4u v = s.v[i]; const unsigned wu = s.wh[i >> 3][(i >> 1) & 3]; const h2_t w2 = __builtin_bit_cast(h2_t, (i & 1) ? ((wu >> 16) | (wu & 0xffff0000u)) : ((wu & 0xffffu) | (wu << 16)));
        ah[0] = __builtin_elementwise_fma(cvt_h2_lo((int)v.x), w2, ah[0]); ah[1] = __builtin_elementwise_fma(cvt_h2_hi((int)v.x), w2, ah[1]);
        ah[2] = __builtin_elementwise_fma(cvt_h2_lo((int)v.y), w2, ah[2]); ah[3] = __builtin_elementwise_fma(cvt_h2_hi((int)v.y), w2, ah[3]);
        ah[4] = __builtin_elementwise_fma(cvt_h2_lo((int)v.z), w2, ah[4]); ah[5] = __builtin_elementwise_fma(cvt_h2_hi((int)v.z), w2, ah[5]);
        ah[6] = __builtin_elementwise_fma(cvt_h2_lo((int)v.w), w2, ah[6]); ah[7] = __builtin_elementwise_fma(cvt_h2_hi((int)v.w), w2, ah[7]); }
    f32x2v acc[8];
#pragma unroll
    for (int m = 0; m < 8; ++m) acc[m] = (f32x2v){(float)ah[m].x, (float)ah[m].y} * (1.f / V_SCALE);
#pragma unroll
    for (int m = 0; m < 4; ++m) { const bool up = lane & 32; const f32x2v send = up ? acc[m] : acc[m + 4], keep = up ? acc[m + 4] : acc[m]; acc[m] = keep + (f32x2v){__shfl_xor(send.x, 32), __shfl_xor(send.y, 32)}; }
#pragma unroll
    for (int m = 0; m < 2; ++m) { const bool up = lane & 16; const f32x2v send = up ? acc[m] : acc[m + 2], keep = up ? acc[m + 2] : acc[m]; acc[m] = keep + (f32x2v){__shfl_xor(send.x, 16), __shfl_xor(send.y, 16)}; }
    { const bool up = lane & 8; const f32x2v send = up ? acc[0] : acc[1], keep = up ? acc[1] : acc[0]; acc[0] = keep + (f32x2v){__shfl_xor(send.x, 8), __shfl_xor(send.y, 8)}; }
    const int d = 128 * j + 16 * c + 2 * g;
    const f32x2v x2 = (f32x2v){bflo(s.x1), bfhi(s.x1)} + s.g2 * acc[0];
    *(GAS unsigned*)((bf16*)(F.ws + WS_X1) + (size_t)t * D + d) = pk2(x2.x, x2.y);
    const float ss = wave_sum(x2.x * x2.x + x2.y * x2.y);
    if (lane == 0) ((float*)(F.ws + WS_SS))[(size_t)j * M + t] = ss;
}
__device__ __forceinline__ void p8b_step(Frame& F, const LAS unsigned char* mb, const unsigned char* Vj, int tn, VSet& sn, const VSet& sc, int tc, int j, int lane, int c, int g, bool do_compute) {
    { const int d = 128 * j + 16 * c + 2 * g; sn.x1 = *(const GAS unsigned*)((const bf16*)(F.ws + WS_X1) + (size_t)tn * D + d); sn.g2 = *(const GAS f32x2v*)((const float*)(F.ws + WS_ADA) + (size_t)(tn / SEQ) * ADA_W + 5 * D + d); }
    v4u ix[4];
#pragma unroll
    for (int q = 0; q < 4; ++q) ix[q] = *(const LAS v4u*)(mb + 64 * g + 16 * q);
    sn.wh[0] = *(const LAS v4u*)(mb + 512 + 32 * g); sn.wh[1] = *(const LAS v4u*)(mb + 512 + 32 * g + 16);
    h2_t ah[8];
#pragma unroll
    for (int m = 0; m < 8; ++m) ah[m] = (h2_t){(_Float16)0.f, (_Float16)0.f};
#pragma unroll
    for (int i = 0; i < 16; ++i) {
        sn.v[i] = *(const GAS v4u*)(Vj + (unsigned)((ix[i >> 2][i & 3] << 7) + 16u * (unsigned)c));
        const v4u v = sc.v[i]; const unsigned wu = sc.wh[i >> 3][(i >> 1) & 3]; const h2_t w2 = __builtin_bit_cast(h2_t, (i & 1) ? ((wu >> 16) | (wu & 0xffff0000u)) : ((wu & 0xffffu) | (wu << 16)));
        ah[0] = __builtin_elementwise_fma(cvt_h2_lo((int)v.x), w2, ah[0]); ah[1] = __builtin_elementwise_fma(cvt_h2_hi((int)v.x), w2, ah[1]);
        ah[2] = __builtin_elementwise_fma(cvt_h2_lo((int)v.y), w2, ah[2]); ah[3] = __builtin_elementwise_fma(cvt_h2_hi((int)v.y), w2, ah[3]);
        ah[4] = __builtin_elementwise_fma(cvt_h2_lo((int)v.z), w2, ah[4]); ah[5] = __builtin_elementwise_fma(cvt_h2_hi((int)v.z), w2, ah[5]);
        ah[6] = __builtin_elementwise_fma(cvt_h2_lo((int)v.w), w2, ah[6]); ah[7] = __builtin_elementwise_fma(cvt_h2_hi((int)v.w), w2, ah[7]);
        asm volatile("" ::: "memory"); }
    if (!do_compute) return;
#pragma unroll
    for (int m = 0; m < 4; ++m) { const bool up = lane & 32; const h2_t send = up ? ah[m] : ah[m + 4], keep = up ? ah[m + 4] : ah[m]; ah[m] = keep + __builtin_bit_cast(h2_t, __shfl_xor(__builtin_bit_cast(int, send), 32)); }
#pragma unroll
    for (int m = 0; m < 2; ++m) { const bool up = lane & 16; const h2_t send = up ? ah[m] : ah[m + 2], keep = up ? ah[m + 2] : ah[m]; ah[m] = keep + __builtin_bit_cast(h2_t, __shfl_xor(__builtin_bit_cast(int, send), 16)); }
    { const bool up = lane & 8; const h2_t send = up ? ah[0] : ah[1], keep = up ? ah[1] : ah[0]; ah[0] = keep + __builtin_bit_cast(h2_t, __shfl_xor(__builtin_bit_cast(int, send), 8)); }
    const f32x2v peer = (f32x2v){(float)ah[0].x, (float)ah[0].y} * (1.f / V_SCALE);
    const int d = 128 * j + 16 * c + 2 * g;
    const f32x2v x2 = (f32x2v){bflo(sc.x1), bfhi(sc.x1)} + sc.g2 * peer;
    *(GAS unsigned*)((bf16*)(F.ws + WS_X1) + (size_t)tc * D + d) = pk2(x2.x, x2.y);
    const float ss = wave_sum(x2.x * x2.x + x2.y * x2.y);
    if (lane == 0) ((float*)(F.ws + WS_SS))[(size_t)j * M + tc] = ss;
}
__device__ __forceinline__ void p8b_vsum(Frame& F) {
    const int* IDX = (const int*)(F.ws + WS_IDX); const _Float16* W = (const _Float16*)(F.ws + WS_W16);
    const int lane = F.lane, c = lane & 7, g = lane >> 3; const SliceWork sw = slice_work(F);
    LAS unsigned char* mb = F.lds + F.wave * 1024;
    if (sw.t0 >= M) return;
    const int nt = (M - 1 - sw.t0) / sw.ts + 1;
    for (int jj = 0; jj < sw.nj; ++jj) { const int j = sw.j0 + jj; const unsigned char* Vj = F.ws + WS_V + (size_t)j * NEXP * 128;
        VSet sA, sB;
        { const VMeta m0 = p8b_G(IDX, W, TOK(0), lane); p8b_S(mb, m0, lane); }
        VMeta mN = p8b_G(IDX, W, TOK(1), lane);
        p8b_RT(F, mb, Vj, TOK(0), j, c, g, sA);
#pragma unroll 1
        for (int n = 0; n < nt; n += 2) {
            p8b_S(mb, mN, lane);
            mN = p8b_G(IDX, W, TOK(n + 2), lane);
            p8b_step(F, mb, Vj, TOK(n + 1), sB, sA, TOK(n), j, lane, c, g, true);
            asm volatile("" ::: "memory");
            p8b_S(mb, mN, lane);
            mN = p8b_G(IDX, W, TOK(n + 3), lane);
            p8b_step(F, mb, Vj, TOK(n + 2), sA, sB, TOK(n + 1), j, lane, c, g, n + 1 < nt);
            asm volatile("" ::: "memory");
        } }
#undef TOK
}
__device__ __forceinline__ void p8c_final(Frame& F) {
    const float* SS = (const float*)(F.ws + WS_SS); const float* gf = F.in[IN_GF]; const int lane = F.lane;
    f32x4 gv[4];
#pragma unroll
    for (int q = 0; q < 4; ++q) gv[q] = *(const f32x4*)(gf + 4 * lane + 256 * q);
    for (int t = blockIdx.x * NWAVES + F.wave; t < M; t += F.G * NWAVES) {
        float s = 0.f;
#pragma unroll
        for (int j = 0; j < 8; ++j) s += SS[(size_t)j * M + t];
        const float rstd = 1.0f / sqrtf(s * (1.f / D) + EPS);
        const GAS v2u* xr = (const GAS v2u*)((const bf16*)(F.ws + WS_X1) + (size_t)t * D) + lane; GAS f32x4* yr = (GAS f32x4*)(F.out + (size_t)t * D) + lane;
#pragma unroll
        for (int q = 0; q < 4; ++q) { const v2u w = xr[64 * q]; yr[64 * q] = (f32x4){bflo(w.x), bfhi(w.x), bflo(w.y), bfhi(w.y)} * rstd * gv[q]; }
    }
}

struct Args { const float* in[20]; float* out; unsigned char* ws; int ph_lo, ph_hi, li, pad; };
__global__ void __launch_bounds__(NWAVES * 64, 2) skel_fwd(Args args) {
    extern __shared__ __attribute__((aligned(16))) unsigned char lds[];
    Frame F;
    F.lds = (LAS unsigned char*)lds;
    F.MISC = (volatile LAS unsigned*)(F.lds + MISC_OFF);
    F.tid = threadIdx.x; F.lane = F.tid & 63; F.wave = __builtin_amdgcn_readfirstlane(F.tid >> 6);
    F.G = gridDim.x; { const int bx = blockIdx.x; F.vcu = (F.G % 8 == 0) ? (bx % 8) * (F.G / 8) + bx / 8 : bx; }
    F.ws = args.ws; F.out = args.out;
#pragma unroll
    for (int i = 0; i < 20; ++i) F.in[i] = args.in[i];
    F.ctl = (gu32*)(args.ws + WS_CTL);
    for (int u = F.tid; u < (LDS_BYTES - LDSCTL_OFF) / 4; u += NWAVES * 64) ((LAS unsigned*)(F.lds + LDSCTL_OFF))[u] = 0u;
    __syncthreads();
    XcdBarrier bar; bar.bar = (unsigned*)(F.ctl + CW_BAR); bar.x = 0; bar.st = nullptr;
    if (N_LAUNCHES == 1) bar = xcd_barrier_post((unsigned*)(F.ctl + CW_BAR), F.MISC + 8);
#define GRID_BAR() do { if (N_LAUNCHES == 1) xcd_barrier(bar); } while (0)
    const int lo = args.ph_lo, hi = args.ph_hi;
#define IN(k) (lo <= (k) && (k) < hi)
    bf16* const H = (bf16*)(args.ws + WS_H); bf16* const PROJ = (bf16*)(args.ws + WS_PROJ); bf16* const MIX = (bf16*)(args.ws + WS_MIX);

    if (IN(0)) { p0_prologue(F); GRID_BAR(); }
    if (IN(1)) { p1_hpass(F); GRID_BAR(); }
    if (IN(2)) {
        pg8::Gemm g{(const bf16*)(args.ws + WS_H8), (const bf16*)(args.ws + WS_WIN), M, IN_W, D / 2}; pg8::StaticOrder S; S.init(M, IN_W, F.G, (int)blockIdx.x);
        pg8::EpiI8Bf16 E{PROJ, IN_W, (const float*)(args.ws + WS_HS), 1.f / WQ_SCALE, F.in[IN_BIN]};
        pg8::gemm_phase<pg8::EpiI8Bf16, pg8::StaticOrder, true, true, true>(F.lds + RING_OFF, g, S, E);
        GRID_BAR();
    }
    if (IN(3)) { p3_mixer(F); GRID_BAR(); }
    if (IN(4)) {
        pg8::Gemm g{MIX, (const bf16*)(args.ws + WS_WOUT), M, D, D}; pg8::StaticOrder S; S.init(M, D, F.G, (int)blockIdx.x);
        pg8::EpiResGate E{F.in[IN_X], (bf16*)(args.ws + WS_X1), D, F.in[IN_BOUT], (const float*)(args.ws + WS_ADA), ADA_W, 2 * D, SEQ / 256};
        pg8::gemm_phase<pg8::EpiResGate, pg8::StaticOrder, true, true>(F.lds + RING_OFF, g, S, E);
        GRID_BAR();
    }
    if (IN(5)) { p5_h2pass(F); GRID_BAR(); }
    if (IN(6)) {
        pg8::Gemm g{(const bf16*)(args.ws + WS_H8), (const bf16*)(args.ws + WS_WQ), M, QW, D / 2}; pg8::StaticOrder S; S.init(M, QW, F.G, (int)blockIdx.x);
        pg8::EpiI8Bf16 E{PROJ, QW, (const float*)(args.ws + WS_HS), 1.f / WQ_SCALE, nullptr};
        pg8::gemm_phase<pg8::EpiI8Bf16, pg8::StaticOrder, true, true, true>(F.lds + RING_OFF, g, S, E);
        GRID_BAR();
    }
    if (IN(7)) { p7_routing(F); GRID_BAR(); }
    if (IN(8)) { p8a_udots(F); GRID_BAR(); }
    if (IN(9)) { p8w_weights(F); GRID_BAR(); }
    if (IN(10)) { p8b_vsum(F); GRID_BAR(); }
    if (IN(11)) { p8c_final(F); }
#undef IN
}

extern "C" void kernel_launch(void* const* d_in, const int* in_sizes, int n_in, void* d_out, int out_size, void* d_ws, size_t ws_size, hipStream_t stream) {
    static int grid = 0;
    if (grid == 0) {
        if (n_in != 20 || in_sizes[0] != M * D || out_size != M * D || ws_size < WS_END) { fprintf(stderr, "kernel_launch: unexpected shapes (n_in %d, in0 %d, out %d, ws %zu); nothing launched\n", n_in, n_in > 0 ? in_sizes[0] : -1, out_size, ws_size); grid = -1; return; }
        int dev = 0, cus = 0, per_cu = 0;
        if (hipGetDevice(&dev) != hipSuccess || hipDeviceGetAttribute(&cus, hipDeviceAttributeMultiprocessorCount, dev) != hipSuccess) { fprintf(stderr, "kernel_launch: device query failed\n"); grid = -1; return; }
        if (hipFuncSetAttribute((const void*)skel_fwd, hipFuncAttributeMaxDynamicSharedMemorySize, LDS_BYTES) != hipSuccess) { fprintf(stderr, "kernel_launch: hipFuncSetAttribute failed\n"); grid = -1; return; }
        if (hipOccupancyMaxActiveBlocksPerMultiprocessor(&per_cu, (const void*)skel_fwd, NWAVES * 64, LDS_BYTES) != hipSuccess || per_cu < 1)
            fprintf(stderr, "kernel_launch: note: occupancy query reports %d workgroups per CU\n", per_cu);
        (void)hipGetLastError();
        grid = cus;
    }
    if (grid < 0) return;
    if (hipMemsetAsync((char*)d_ws + WS_CTL, 0, CTL_ZERO_BYTES, stream) != hipSuccess) { fprintf(stderr, "kernel_launch: hipMemsetAsync failed\n"); return; }
    Args a{};
    for (int i = 0; i < 20; ++i) a.in[i] = (const float*)d_in[i];
    a.out = (float*)d_out; a.ws = (unsigned char*)d_ws;
    for (int li = 0; li < N_LAUNCHES; ++li) {
        a.ph_lo = (N_LAUNCHES == 1) ? 0 : li; a.ph_hi = (N_LAUNCHES == 1) ? NPHASES : li + 1; a.li = li;
        hipLaunchKernelGGL(skel_fwd, dim3(grid), dim3(NWAVES * 64), LDS_BYTES, stream, a);
        const hipError_t le = hipPeekAtLastError();
        if (le != hipSuccess) { fprintf(stderr, "kernel_launch: launch %d failed: %s\n", li, hipGetErrorName(le)); break; }
    }
}
```

```cpp
#include <hip/hip_runtime.h>
#include <cstdio>
#include <cstdint>
#include <cmath>
namespace pg8 {
#define PG8_LAS __attribute__((address_space(3)))
typedef unsigned short bf16_t;
typedef short bf16x8 __attribute__((ext_vector_type(8)));
typedef float f32x4 __attribute__((ext_vector_type(4)));
typedef unsigned u32x4 __attribute__((ext_vector_type(4)));
constexpr int BM = 256, BK = 64, HALF = 128, HTB = HALF * BK * 2  , STAGE_BYTES = 8 * HTB, NXCD = 8, WGM = 8;

__host__ __device__ __forceinline__ int lds_byte(int r, int c) { const int st = (r >> 4) * 2 + (c >> 5), rr = r & 15, cc = c & 31, ob = rr * 64 + cc * 2; return st * 1024 + (ob ^ (((ob >> 9) & 1) << 5)); }
__host__ __device__ __forceinline__ void stage_rc(int b, int& R, int& C) { const int st = b / 1024, sb = b % 1024, swz = sb ^ (((sb >> 9) & 1) << 5); R = (st >> 1) * 16 + swz / 64; C = (st & 1) * 32 + (swz % 64) / 2; }
__host__ __device__ __forceinline__ int perm32(int rho) { const int n = rho >> 4, i = rho & 15; return 8 * (i >> 2) + 4 * n + (i & 3); }

struct Unit { int pm, pn; };
struct Gemm { const bf16_t* A; const bf16_t* Bt; int M, N, K; };

struct StaticOrder {
    int nM, nN, nwg, G, c;
    __host__ __device__ void init(int M, int N, int G_, int c_) { nM = M / BM; nN = N / BM; nwg = nM * nN; G = G_; c = c_; }
    __host__ __device__ bool next(int i, Unit& u) const {
        const long L = (long)i * G + c; if (L >= nwg) return false;
        int wgid = (int)L; { const int q = nwg / NXCD, r = nwg % NXCD, xcd = wgid % NXCD, off = wgid / NXCD; wgid = (xcd < r ? xcd * (q + 1) : r * (q + 1) + (xcd - r) * q) + off; }
        const int nig = WGM * nN, gid = wgid / nig, fm = gid * WGM, gsz = (nM - fm) < WGM ? (nM - fm) : WGM;
        u.pm = fm + ((wgid % nig) % gsz); u.pn = (wgid % nig) / gsz; return true;
    }
    __device__ __forceinline__ void a_ready(const Unit&) const {}
    __device__ __forceinline__ void done(const Unit&) const {}
};

__device__ __forceinline__ unsigned cvt_pk_bf16(float lo, float hi) { unsigned r; asm volatile("v_cvt_pk_bf16_f32 %0, %1, %2" : "=v"(r) : "v"(lo), "v"(hi)); return r; }
typedef float f32x2 __attribute__((ext_vector_type(2)));
__device__ __forceinline__ f32x2 gelu_pk(f32x2 v) {
    const f32x2 av = __builtin_elementwise_abs(v), d = av * 0.2316418882f + 1.0f;
    f32x2 t; t.x = __builtin_amdgcn_rcpf(d.x); t.y = __builtin_amdgcn_rcpf(d.y);
    f32x2 q = t * 0.5307027145f + (-0.7265760135f); q = q * t + 0.7107068705f; q = q * t + (-0.142248368f); q = q * t + 0.127414796f; q = q * t;
    const f32x2 s = (v * v) * (-0.72134752044f);
    f32x2 e; e.x = __builtin_amdgcn_exp2f(s.x); e.y = __builtin_amdgcn_exp2f(s.y);
    const f32x2 m = v * (q * e), r = v - m;
    f32x2 o; o.x = v.x < 0.f ? m.x : r.x; o.y = v.y < 0.f ? m.y : r.y; return o;
}

template <int ACT  > struct EpiBf16 {
    static constexpr bool PERM = true, AFTER_DRAIN = false; static_assert(ACT == 0 || ACT == 1, "EpiBf16: ACT is 0 (none) or 1 (gelu_pk)");
    bf16_t* O; int ldc; const float* bias; int split_cols; size_t split_stride; float scale0;
    __device__ __forceinline__ void operator()(const f32x4 (&acc)[2][2][4][2], const Unit& u, int wr, int wc, int fr, int fq) const {
        const int row0 = u.pm * BM + wr * 64 + fr; int colt = u.pn * BM; bf16_t* base = O;
        float sc = 1.f; if (split_cols) { const int t = colt / split_cols; base += (size_t)t * split_stride; colt -= t * split_cols; if (t == 0) sc = scale0; }
        const int col0 = colt + wc * 32 + 8 * fq, bcol0 = u.pn * BM + wc * 32 + 8 * fq;
        f32x4 bv[2][2];
#pragma unroll
        for (int bj = 0; bj < 2; ++bj)
#pragma unroll
            for (int n = 0; n < 2; ++n) bv[bj][n] = bias ? *(const f32x4*)(bias + bcol0 + bj * HALF + 4 * n) : (f32x4){0.f, 0.f, 0.f, 0.f};
#pragma unroll
        for (int ai = 0; ai < 2; ++ai)
#pragma unroll
            for (int m = 0; m < 4; ++m) { bf16_t* rowp = base + (size_t)(row0 + ai * HALF + m * 16) * ldc + col0;
#pragma unroll
                for (int bj = 0; bj < 2; ++bj) { f32x4 v0 = acc[ai][bj][m][0] + bv[bj][0], v1 = acc[ai][bj][m][1] + bv[bj][1];
                    if (ACT == 1) { f32x2 a = gelu_pk((f32x2){v0[0], v0[1]}), b = gelu_pk((f32x2){v0[2], v0[3]}), c = gelu_pk((f32x2){v1[0], v1[1]}), d = gelu_pk((f32x2){v1[2], v1[3]});
                        v0 = (f32x4){a.x, a.y, b.x, b.y}; v1 = (f32x4){c.x, c.y, d.x, d.y}; }
                    v0 = v0 * sc; v1 = v1 * sc; u32x4 w; w.x = cvt_pk_bf16(v0[0], v0[1]); w.y = cvt_pk_bf16(v0[2], v0[3]); w.z = cvt_pk_bf16(v1[0], v1[1]); w.w = cvt_pk_bf16(v1[2], v1[3]);
                    *(u32x4*)(rowp + bj * HALF) = w; } }
    }
};

typedef unsigned u32x2 __attribute__((ext_vector_type(2)));
struct EpiResGate {
    static constexpr bool PERM = false, AFTER_DRAIN = false;
    const float* x; bf16_t* out; int ldc; const float* bias; const float* ada; int ada_ld, gate_off, tiles_per_batch;
    __device__ __forceinline__ void operator()(const f32x4 (&acc)[2][2][4][2], const Unit& u, int wr, int wc, int fr, int fq) const {
        const int row0 = u.pm * BM + wr * 64 + fr, col0 = u.pn * BM + wc * 32 + 4 * fq;
        const float* gp = ada + (size_t)(u.pm / tiles_per_batch) * ada_ld + gate_off;
        f32x4 bv[2][2], gv[2][2];
#pragma unroll
        for (int bj = 0; bj < 2; ++bj)
#pragma unroll
            for (int n = 0; n < 2; ++n) { bv[bj][n] = *(const f32x4*)(bias + col0 + bj * HALF + n * 16); gv[bj][n] = *(const f32x4*)(gp + col0 + bj * HALF + n * 16); }
#pragma unroll
        for (int ai = 0; ai < 2; ++ai) {
            f32x4 xv[4][2][2];
#pragma unroll
            for (int m = 0; m < 4; ++m) { const size_t off = (size_t)(row0 + ai * HALF + m * 16) * ldc + col0;
#pragma unroll
                for (int bj = 0; bj < 2; ++bj)
#pragma unroll
                    for (int n = 0; n < 2; ++n) xv[m][bj][n] = __builtin_nontemporal_load((const f32x4*)(x + off + bj * HALF + n * 16)); }
#pragma unroll
            for (int m = 0; m < 4; ++m) { const size_t off = (size_t)(row0 + ai * HALF + m * 16) * ldc + col0;
#pragma unroll
                for (int bj = 0; bj < 2; ++bj)
#pragma unroll
                    for (int n = 0; n < 2; ++n) { const f32x4 o = xv[m][bj][n] + gv[bj][n] * (acc[ai][bj][m][n] + bv[bj][n]);
                        u32x2 w; w.x = cvt_pk_bf16(o[0], o[1]); w.y = cvt_pk_bf16(o[2], o[3]); *(u32x2*)(out + off + bj * HALF + n * 16) = w; } }
            asm volatile("" ::: "memory"); }
    }
};


typedef int i32x4 __attribute__((ext_vector_type(4)));
template <bool I8> struct AccSel { typedef f32x4 type; static __device__ __forceinline__ f32x4 zero() { return (f32x4){0.f, 0.f, 0.f, 0.f}; } };
template <> struct AccSel<true> { typedef i32x4 type; static __device__ __forceinline__ i32x4 zero() { return (i32x4){0, 0, 0, 0}; } };
template <bool I8> __device__ __forceinline__ typename AccSel<I8>::type mma16(bf16x8 a, bf16x8 b, typename AccSel<I8>::type c) {
    if constexpr (I8) return __builtin_amdgcn_mfma_i32_16x16x64_i8(__builtin_bit_cast(i32x4, a), __builtin_bit_cast(i32x4, b), c, 0, 0, 0);
    else return __builtin_amdgcn_mfma_f32_16x16x32_bf16(a, b, c, 0, 0, 0);
}
struct EpiI8Bf16 {
    static constexpr bool PERM = true, AFTER_DRAIN = false;
    bf16_t* O; int ldc; const float* rowscale; float wscale; const float* bias;
    __device__ __forceinline__ void operator()(const i32x4 (&acc)[2][2][4][2], const Unit& u, int wr, int wc, int fr, int fq) const {
        const int row0 = u.pm * BM + wr * 64 + fr, col0 = u.pn * BM + wc * 32 + 8 * fq;
        f32x4 bv[2][2];
#pragma unroll
        for (int bj = 0; bj < 2; ++bj)
#pragma unroll
            for (int n = 0; n < 2; ++n) bv[bj][n] = bias ? *(const f32x4*)(bias + col0 + bj * HALF + 4 * n) : (f32x4){0.f, 0.f, 0.f, 0.f};
#pragma unroll
        for (int ai = 0; ai < 2; ++ai)
#pragma unroll
            for (int m = 0; m < 4; ++m) { const int row = row0 + ai * HALF + m * 16; const float sc = rowscale[row] * wscale; bf16_t* rowp = O + (size_t)row * ldc + col0;
#pragma unroll
                for (int bj = 0; bj < 2; ++bj) { const i32x4 a0 = acc[ai][bj][m][0], a1 = acc[ai][bj][m][1]; const f32x4 b0 = bv[bj][0], b1 = bv[bj][1];
                    u32x4 w; w.x = cvt_pk_bf16((float)a0[0] * sc + b0[0], (float)a0[1] * sc + b0[1]); w.y = cvt_pk_bf16((float)a0[2] * sc + b0[2], (float)a0[3] * sc + b0[3]);
                    w.z = cvt_pk_bf16((float)a1[0] * sc + b1[0], (float)a1[1] * sc + b1[1]); w.w = cvt_pk_bf16((float)a1[2] * sc + b1[2], (float)a1[3] * sc + b1[3]);
                    *(u32x4*)(rowp + bj * HALF) = w; } }
    }
};
template <class Epi, class Sched, bool ALIGN_EPI = false, bool SP2 = false, bool I8 = false>
__device__ __forceinline__ void gemm_phase(PG8_LAS unsigned char* lds, const Gemm g, const Sched& S, const Epi& E) {
    const int tid = threadIdx.x, wid = __builtin_amdgcn_readfirstlane(tid >> 6), lane = tid & 63, wr = wid >> 2, wc = wid & 3, fr = lane & 15, fq = lane >> 4;
    const int K = g.K, nt = K / BK;
    unsigned voffA[2], voffB[2];
#pragma unroll
    for (int i = 0; i < 2; ++i) { int R, C; stage_rc(tid * 16 + i * 8192, R, C); const int Rb = Epi::PERM ? ((R & ~31) + perm32(R & 31)) : R;
        voffA[i] = (unsigned)(R * K + C) * 2u; voffB[i] = (unsigned)(Rb * K + C) * 2u; }
    const size_t kstep = (size_t)(BK * 2);
    const size_t hstep = (size_t)HALF * K * 2;
    const size_t tstep = 2 * hstep;
    const unsigned ldsw = (unsigned)wid * 1024u;
    const int aoff = lds_byte(wr * 64 + fr, fq * 8), boff = lds_byte(wc * 32 + fr, fq * 8);
#define PG8_SA(b, h) (((b) * 2 + (h)) * HTB)
#define PG8_SB(b, h) ((4 + (b) * 2 + (h)) * HTB)
#define PG8_STAGE(bufoff, gbase, voff) do { _Pragma("unroll") for (int _i = 0; _i < 2; ++_i) \
        __builtin_amdgcn_global_load_lds((const unsigned*)((const char*)(gbase) + (voff)[_i]), (PG8_LAS unsigned*)(lds + (bufoff) + ldsw + _i * 8192), 16, 0, 0); } while (0)
#define PG8_LDA(dst, b, h) do { _Pragma("unroll") for (int m = 0; m < 4; ++m) _Pragma("unroll") for (int k = 0; k < 2; ++k) dst[m][k] = *(const PG8_LAS bf16x8*)(lds + PG8_SA(b, h) + aoff + m * 2048 + k * 1024); } while (0)
#define PG8_LDB(dst, b, h) do { _Pragma("unroll") for (int n = 0; n < 2; ++n) _Pragma("unroll") for (int k = 0; k < 2; ++k) dst[n][k] = *(const PG8_LAS bf16x8*)(lds + PG8_SB(b, h) + boff + n * 2048 + k * 1024); } while (0)
#define PG8_MMA(ai, bj, At, Bt) do { __builtin_amdgcn_s_setprio(1); _Pragma("unroll") for (int m = 0; m < 4; ++m) _Pragma("unroll") for (int n = 0; n < 2; ++n) _Pragma("unroll") for (int k = 0; k < 2; ++k) \
        acc[ai][bj][m][n] = mma16<I8>(Bt[n][k], At[m][k], acc[ai][bj][m][n]); __builtin_amdgcn_s_setprio(0); } while (0)
#define PG8_WAIT_V(n) asm volatile("s_waitcnt vmcnt(" #n ")" ::: "memory")
#define PG8_WAIT_L(n) asm volatile("s_waitcnt lgkmcnt(" #n ")" ::: "memory")
#define PG8_BAR __builtin_amdgcn_s_barrier()
#define PG8_SCHED __builtin_amdgcn_sched_barrier(0)
    Unit cur, nxt; int ui = 0;
    if (!S.next(0, cur)) return;
    typedef typename AccSel<I8>::type acc_t;
    acc_t acc[2][2][4][2];
#pragma unroll
    for (int a = 0; a < 2; ++a)
#pragma unroll
        for (int b = 0; b < 2; ++b)
#pragma unroll
            for (int m = 0; m < 4; ++m)
#pragma unroll
                for (int n = 0; n < 2; ++n) acc[a][b][m][n] = AccSel<I8>::zero();
    bf16x8 At[4][2], B0[2][2], B1[2][2];
    const char* cA = (const char*)g.A + (size_t)cur.pm * tstep; const char* cB = (const char*)g.Bt + (size_t)cur.pn * tstep;
    S.a_ready(cur);
    if constexpr (SP2) {
        PG8_STAGE(PG8_SB(0, 0), cB, voffB); PG8_STAGE(PG8_SB(0, 1), cB + hstep, voffB); PG8_STAGE(PG8_SA(0, 0), cA, voffA); PG8_STAGE(PG8_SA(0, 1), cA + hstep, voffA);
        if (wr == 1) PG8_BAR;
        PG8_WAIT_V(2); PG8_BAR;
        PG8_STAGE(PG8_SB(1, 0), cB + kstep, voffB); PG8_STAGE(PG8_SA(1, 0), cA + kstep, voffA); PG8_STAGE(PG8_SB(1, 1), cB + hstep + kstep, voffB);
        PG8_WAIT_V(6); PG8_BAR;
    } else {
        PG8_STAGE(PG8_SB(0, 0), cB, voffB); PG8_STAGE(PG8_SA(0, 0), cA, voffA); PG8_STAGE(PG8_SB(0, 1), cB + hstep, voffB); PG8_STAGE(PG8_SA(0, 1), cA + hstep, voffA);
        if (wr == 1) PG8_BAR;
        PG8_WAIT_V(4); PG8_BAR;
        PG8_STAGE(PG8_SB(1, 0), cB + kstep, voffB); PG8_STAGE(PG8_SA(1, 0), cA + kstep, voffA); PG8_STAGE(PG8_SB(1, 1), cB + hstep + kstep, voffB);
        PG8_WAIT_V(6); PG8_BAR;
    }
    for (;;) {
        const bool has_next = S.next(ui + 1, nxt);
        const char* nA = has_next ? (const char*)g.A + (size_t)nxt.pm * tstep : cA; const char* nB = has_next ? (const char*)g.Bt + (size_t)nxt.pn * tstep : cB;
        for (int t = 0; t < nt; t += 2) {
            const bool last = (t == nt - 2);
            const char* a1 = cA + (size_t)(t + 1) * kstep;
            const char* a2 = last ? nA : cA + (size_t)(t + 2) * kstep; const char* b2 = last ? nB : cB + (size_t)(t + 2) * kstep;
            const char* a3 = a2 + kstep; const char* b3 = b2 + kstep;
            if (last && has_next) S.a_ready(nxt);
            if constexpr (SP2) {
            PG8_LDB(B0, 0, 0); PG8_LDB(B1, 0, 1); PG8_SCHED; PG8_LDA(At, 0, 0); PG8_STAGE(PG8_SA(1, 1), a1 + hstep, voffA);
            PG8_WAIT_V(8); PG8_WAIT_L(0); PG8_BAR; PG8_MMA(0, 0, At, B0); PG8_MMA(0, 1, At, B1); PG8_BAR; PG8_SCHED;
            PG8_LDA(At, 0, 1); PG8_STAGE(PG8_SB(0, 0), b2, voffB); PG8_STAGE(PG8_SB(0, 1), b2 + hstep, voffB); PG8_STAGE(PG8_SA(0, 0), a2, voffA);
            PG8_WAIT_V(8); PG8_WAIT_L(0); PG8_BAR; PG8_MMA(1, 0, At, B0); PG8_MMA(1, 1, At, B1); PG8_BAR; PG8_SCHED;
            PG8_LDB(B0, 1, 0); PG8_LDB(B1, 1, 1); PG8_SCHED; PG8_LDA(At, 1, 0); PG8_STAGE(PG8_SA(0, 1), a2 + hstep, voffA);
            PG8_WAIT_V(8); PG8_WAIT_L(0); PG8_BAR; PG8_MMA(0, 0, At, B0); PG8_MMA(0, 1, At, B1); PG8_BAR; PG8_SCHED;
            PG8_LDA(At, 1, 1); PG8_STAGE(PG8_SB(1, 0), b3, voffB); PG8_STAGE(PG8_SB(1, 1), b3 + hstep, voffB); PG8_STAGE(PG8_SA(1, 0), a3, voffA);
            PG8_WAIT_V(8); PG8_WAIT_L(0); PG8_BAR; PG8_MMA(1, 0, At, B0); PG8_MMA(1, 1, At, B1); PG8_BAR; PG8_SCHED;
            } else {
            PG8_LDB(B0, 0, 0); PG8_SCHED; PG8_LDA(At, 0, 0); PG8_STAGE(PG8_SA(1, 1), a1 + hstep, voffA);
            PG8_WAIT_L(8); PG8_BAR; PG8_WAIT_L(0); PG8_MMA(0, 0, At, B0); PG8_BAR; PG8_SCHED;
            PG8_LDB(B1, 0, 1); PG8_STAGE(PG8_SB(0, 0), b2, voffB);
            PG8_BAR; PG8_WAIT_L(0); PG8_MMA(0, 1, At, B1); PG8_BAR;
            PG8_LDA(At, 0, 1); PG8_STAGE(PG8_SA(0, 0), a2, voffA);
            PG8_BAR; PG8_WAIT_L(0); PG8_MMA(1, 0, At, B0); PG8_BAR; PG8_SCHED;
            PG8_STAGE(PG8_SB(0, 1), b2 + hstep, voffB);
            PG8_WAIT_V(6); PG8_BAR; PG8_MMA(1, 1, At, B1); PG8_BAR;
            PG8_LDB(B0, 1, 0); PG8_SCHED; PG8_LDA(At, 1, 0); PG8_STAGE(PG8_SA(0, 1), a2 + hstep, voffA);
            PG8_WAIT_L(8); PG8_BAR; PG8_WAIT_L(0); PG8_MMA(0, 0, At, B0); PG8_BAR; PG8_SCHED;
            PG8_LDB(B1, 1, 1); PG8_STAGE(PG8_SB(1, 0), b3, voffB);
            PG8_BAR; PG8_WAIT_L(0); PG8_MMA(0, 1, At, B1); PG8_BAR;
            PG8_LDA(At, 1, 1); PG8_STAGE(PG8_SA(1, 0), a3, voffA);
            PG8_BAR; PG8_WAIT_L(0); PG8_MMA(1, 0, At, B0); PG8_BAR; PG8_SCHED;
            PG8_STAGE(PG8_SB(1, 1), b3 + hstep, voffB);
            PG8_WAIT_V(6); PG8_BAR; PG8_MMA(1, 1, At, B1); PG8_BAR;
            }
        }
        if constexpr (ALIGN_EPI) { if (wr == 0) PG8_BAR; }
        if constexpr (!Epi::AFTER_DRAIN) { E(acc, cur, wr, wc, fr, fq); S.done(cur); }
        if (!has_next) break;
#pragma unroll
        for (int a = 0; a < 2; ++a)
#pragma unroll
            for (int b = 0; b < 2; ++b)
#pragma unroll
                for (int m = 0; m < 4; ++m)
#pragma unroll
                    for (int n = 0; n < 2; ++n) acc[a][b][m][n] = AccSel<I8>::zero();
        cur = nxt; cA = nA; cB = nB; ++ui;
        if constexpr (ALIGN_EPI) { if (wr == 1) PG8_BAR; }
    }
    PG8_WAIT_V(0);
    if constexpr (!ALIGN_EPI) { if (wr == 0) PG8_BAR; }
    PG8_BAR;
    if constexpr (Epi::AFTER_DRAIN) { E.fused(acc, cur, wr, wc, fr, fq, lds, wid, lane); S.done(cur); }
#undef PG8_SA
#undef PG8_SB
#undef PG8_STAGE
#undef PG8_LDA
#undef PG8_LDB
#undef PG8_MMA
#undef PG8_WAIT_V
#undef PG8_WAIT_L
#undef PG8_BAR
#undef PG8_SCHED
}
}

constexpr int NWAVES = 8;
constexpr int NPHASES = 12;
#ifndef MK_N_LAUNCHES
#define MK_N_LAUNCHES 1
#endif
constexpr int N_LAUNCHES = MK_N_LAUNCHES;
static_assert(N_LAUNCHES == 1 || N_LAUNCHES == NPHASES, "MK_N_LAUNCHES is 1 or NPHASES");

constexpr int BATCH = 16, SEQ = 2048, D = 1024, M = BATCH * SEQ;
constexpr int IN_W = 2304, O_Q = 0, O_K = 512, O_V = 640, O_B = 768, O_C = 1280, O_U = 1792;
constexpr int NQH = 8, NKVH = 2, HD = 64, WIN = 128;
constexpr int NKEYS = 128, NEXP = 16384, PH = 8, TOPK = 16, DKEY = 256, DHALF = 128, QW = PH * DKEY;
constexpr int ADA_W = 6 * D, ADA_KC = 8;
constexpr float EPS = 1e-6f;

constexpr size_t MiB = 1u << 20;
constexpr size_t WS_CTL = 0, CTL_ZERO_BYTES = 64 * 1024;
constexpr size_t WS_ADAP = 1 * MiB;
constexpr size_t WS_ADA = 4 * MiB;
constexpr size_t WS_WIN = 5 * MiB;
constexpr size_t WS_WOUT = 10 * MiB;
constexpr size_t WS_WQ = 12 * MiB;
constexpr size_t WS_K1 = 16 * MiB, WS_K2 = 16 * MiB + 512 * 1024;
constexpr size_t WS_U = 17 * MiB, WS_V = 33 * MiB;
constexpr float U_SCALE = 896.f, V_SCALE = 8.f, WQ_SCALE = 896.f;
constexpr size_t WS_H = 81 * MiB;
constexpr size_t WS_PROJ = 145 * MiB;
constexpr size_t WS_MIX = 289 * MiB;
constexpr size_t WS_IDX = 353 * MiB;
constexpr size_t WS_GATE = 369 * MiB;
constexpr size_t WS_H8 = 49 * MiB;
constexpr size_t WS_HS = 393 * MiB;
constexpr size_t WS_W16 = 385 * MiB;
constexpr size_t WS_X1 = 417 * MiB;
constexpr size_t WS_END = 481 * MiB;
constexpr size_t WS_PA = WS_PROJ;
constexpr size_t WS_SS = WS_MIX;
constexpr int CW_BAR = 4096;
static_assert((CW_BAR + 3456) * 4 <= (int)CTL_ZERO_BYTES, "barrier words inside the zeroed region");

constexpr int RING_OFF = 0, RING_BYTES = 131072;
constexpr int LDSCTL_OFF = 135168, MISC_OFF = LDSCTL_OFF + 320;
constexpr int LDS_BYTES = 147456;
static_assert(MISC_OFF + 128 <= LDS_BYTES, "LDS map");

#define GAS __attribute__((address_space(1)))
#define LAS __attribute__((address_space(3)))
typedef unsigned short bf16;
typedef unsigned v4u __attribute__((ext_vector_type(4)));
typedef float f32x4 __attribute__((ext_vector_type(4)));
typedef short bf16x8 __attribute__((ext_vector_type(8)));
typedef GAS unsigned gu32;
typedef GAS unsigned long long gu64;
#define RLX_AGENT __ATOMIC_RELAXED, __HIP_MEMORY_SCOPE_AGENT
#define LDS_WAIT() asm volatile("s_waitcnt lgkmcnt(0)" ::: "memory")
#define VM_WAIT() asm volatile("s_waitcnt vmcnt(0)" ::: "memory")
__device__ __forceinline__ unsigned long long rt() { return __builtin_amdgcn_s_memrealtime(); }
__device__ __forceinline__ unsigned f2bf(float f) { unsigned u = __builtin_bit_cast(unsigned, f); return (u + 0x7fffu + ((u >> 16) & 1u)) >> 16; }
__device__ __forceinline__ unsigned pk2(float lo, float hi) { return f2bf(lo) | (f2bf(hi) << 16); }

#define XB_TMO      128
#define XB_XCNT(j)  (256  + 64 * (j))
#define XB_XSUB(j)  (1280 + 64 * (j))
#define XB_XGEN(j)  (2304 + 64 * (j))
#define XB_TOP      3328
#define XB_TOPGEN   3392
#define XCD_BAR_WORDS 3456
#define XB_SPIN_CAP (1u << 22)

__device__ __forceinline__ unsigned xb_ld(unsigned* p)              { return __hip_atomic_load(p, __ATOMIC_RELAXED, __HIP_MEMORY_SCOPE_AGENT); }
__device__ __forceinline__ unsigned xb_add(unsigned* p, unsigned v) { return __hip_atomic_fetch_add(p, v, __ATOMIC_RELAXED, __HIP_MEMORY_SCOPE_AGENT); }
__device__ __forceinline__ unsigned xb_xcc_id() { return (unsigned)__builtin_amdgcn_s_getreg((3 << 11) | 20) & 0xFu; }
#define XB_SPIN(cond, bar) do { unsigned _sp = 0; while (cond) { __builtin_amdgcn_s_sleep(1); \
    if ((++_sp & 255u) == 0u) { if (xb_ld(&(bar)[XB_TMO])) break; if (_sp > XB_SPIN_CAP) { atomicAdd(&(bar)[XB_TMO], 1u); break; } } } } while (0)

struct XcdBarrier {
    unsigned* bar; unsigned x;
    volatile LAS unsigned* st;
};

__device__ __forceinline__ XcdBarrier xcd_barrier_post(unsigned* bar, volatile LAS unsigned* st) {
    XcdBarrier b; b.bar = bar; b.x = xb_xcc_id(); b.st = st;
    if (threadIdx.x == 0) (void)xb_add(&bar[XB_XCNT(b.x)], 1u);
    return b;
}
__device__ __forceinline__ void xcd_barrier_complete(unsigned* bar, unsigned x, unsigned& nloc, unsigned& nx) {
    const unsigned G = gridDim.x * gridDim.y * gridDim.z;
    unsigned sum, cnt, mine, sp = 0u;
    for (;;) {
        sum = 0u; cnt = 0u; mine = 0u;
#pragma unroll
        for (unsigned j = 0; j < 16; ++j) { const unsigned c = xb_ld(&bar[XB_XCNT(j)]); sum += c; cnt += (c > 0u) ? 1u : 0u; mine = (j == x) ? c : mine; }
        if (sum == G) break;
        __builtin_amdgcn_s_sleep(1);
        if ((++sp & 255u) == 0u) { if (xb_ld(&bar[XB_TMO])) break; if (sp > XB_SPIN_CAP) { atomicAdd(&bar[XB_TMO], 1u); break; } }
    }
    nloc = mine > 0u ? mine : 1u; nx = cnt > 0u ? cnt : 1u;
}

__device__ __forceinline__ void xcd_barrier(const XcdBarrier& b) {
    asm volatile("s_waitcnt vmcnt(0)" ::: "memory");
    __syncthreads();
    if (threadIdx.x == 0) {
        unsigned* bar = b.bar;
        __builtin_amdgcn_s_waitcnt(0);
        unsigned nloc = b.st[0], nx = b.st[1];
        if (nloc == 0u) { xcd_barrier_complete(bar, b.x, nloc, nx); b.st[0] = nloc; b.st[1] = nx; }
        const unsigned old = xb_add(&bar[XB_XSUB(b.x)], 1u);
        const unsigned gen = old / nloc;
        if (old + 1u == (gen + 1u) * nloc) {
            __builtin_amdgcn_fence(__ATOMIC_RELEASE, "agent");
            asm volatile("s_waitcnt vmcnt(0)" ::: "memory");
            const unsigned og = xb_add(&bar[XB_TOP], 1u);
            const unsigned tg = og / nx;
            if (og + 1u == (tg + 1u) * nx) xb_add(&bar[XB_TOPGEN], 1u);
            else XB_SPIN(xb_ld(&bar[XB_TOPGEN]) == tg, bar);
            __builtin_amdgcn_fence(__ATOMIC_ACQUIRE, "agent");
            xb_add(&bar[XB_XGEN(b.x)], 1u);
            asm volatile("s_waitcnt vmcnt(0)" ::: "memory");
        } else {
            XB_SPIN(xb_ld(&bar[XB_XGEN(b.x)]) == gen, bar);
            __builtin_amdgcn_fence(__ATOMIC_ACQUIRE, "agent");
            asm volatile("s_waitcnt vmcnt(0)" ::: "memory");
        }
    }
    __syncthreads();
}

struct Frame {
    LAS unsigned char* lds;
    volatile LAS unsigned* MISC;
    gu32* ctl;
    int tid, lane, wave;
    int vcu, G;
    const float* in[20]; float* out; unsigned char* ws;
};
#define IN_X 0
#define IN_C 1
#define IN_WADA 2
#define IN_BADA 3
#define IN_G1 4
#define IN_WIN 5
#define IN_BIN 6
#define IN_SINK 7
#define IN_CONVW 8
#define IN_AOG 9
#define IN_COG 10
#define IN_WOUT 11
#define IN_BOUT 12
#define IN_G2 13
#define IN_WQ 14
#define IN_PK1 15
#define IN_PK2 16
#define IN_PU 17
#define IN_PV 18
#define IN_GF 19

typedef __bf16 bf16x2_t __attribute__((ext_vector_type(2)));
typedef unsigned v2u __attribute__((ext_vector_type(2)));
__device__ __forceinline__ float dot2(unsigned a, unsigned b, float acc) { return __builtin_amdgcn_fdot2_f32_bf16(__builtin_bit_cast(bf16x2_t, a), __builtin_bit_cast(bf16x2_t, b), acc, false); }
__device__ __forceinline__ float dot8(v4u a, v4u b, float acc) { acc = dot2(a.x, b.x, acc); acc = dot2(a.y, b.y, acc); acc = dot2(a.z, b.z, acc); acc = dot2(a.w, b.w, acc); return acc; }
__device__ __forceinline__ float bflo(unsigned w) { return __uint_as_float(w << 16); }
__device__ __forceinline__ float bfhi(unsigned w) { return __uint_as_float(w & 0xffff0000u); }
__device__ __forceinline__ float wave_sum(float v) {
#pragma unroll
    for (int o = 1; o < 64; o <<= 1) v += __shfl_xor(v, o);
    return v;
}
__device__ __forceinline__ unsigned wave_umax(unsigned v) {
#pragma unroll
    for (int o = 1; o < 64; o <<= 1) { const unsigned t = (unsigned)__shfl_xor((int)v, o); v = v > t ? v : t; }
    return v;
}
__device__ __forceinline__ unsigned f2ord(float f) { const unsigned u = __float_as_uint(f); return (u & 0x80000000u) ? ~u : (u | 0x80000000u); }
__device__ __forceinline__ float ord2f(unsigned u) { return __uint_as_float((u & 0x80000000u) ? (u & 0x7fffffffu) : ~u); }

__device__ __forceinline__ unsigned pk4_i8(f32x4 a, float sc) {
    const int q0 = max(-127, min(127, __float2int_rn(a.x * sc))), q1 = max(-127, min(127, __float2int_rn(a.y * sc))), q2 = max(-127, min(127, __float2int_rn(a.z * sc))), q3 = max(-127, min(127, __float2int_rn(a.w * sc)));
    return (unsigned)(q0 & 0xff) | ((unsigned)(q1 & 0xff) << 8) | ((unsigned)(q2 & 0xff) << 16) | ((unsigned)q3 << 24); }
__device__ __forceinline__ void p0_transpose_item(const float* W, int K, int N, bf16* WT, LAS float* scr, int item, int lane) {
    const int nblk = N / 64, kb = item / nblk, nb = item % nblk, k0 = 64 * kb, n0 = 64 * nb;
#pragma unroll 16
    for (int kk = 0; kk < 64; ++kk) scr[kk * 65 + lane] = __builtin_nontemporal_load(W + (size_t)(k0 + kk) * N + n0 + lane);
    LDS_WAIT(); asm volatile("" ::: "memory");
    const int c = lane & 7;
#pragma unroll
    for (int j = 0; j < 8; ++j) { const int n = (lane >> 3) + 8 * j; const LAS float* s = scr + (8 * c) * 65 + n;
        v4u o; o.x = pk2(s[0 * 65], s[1 * 65]); o.y = pk2(s[2 * 65], s[3 * 65]); o.z = pk2(s[4 * 65], s[5 * 65]); o.w = pk2(s[6 * 65], s[7 * 65]);
        *(GAS v4u*)(WT + (size_t)(n0 + n) * K + k0 + 8 * c) = o; }
    LDS_WAIT(); asm volatile("" ::: "memory");
}
__device__ __forceinline__ void p0_transpose_item_i8(const float* W, int K, int N, unsigned char* WT, LAS float* scr, int item, int lane, float sc) {
    const int nblk = N / 64, kb = item / nblk, nb = item % nblk, k0 = 64 * kb, n0 = 64 * nb;
#pragma unroll 16
    for (int kk = 0; kk < 64; ++kk) scr[kk * 65 + lane] = __builtin_nontemporal_load(W + (size_t)(k0 + kk) * N + n0 + lane);
    LDS_WAIT(); asm volatile("" ::: "memory");
    const int c = lane & 7;
#pragma unroll
    for (int j = 0; j < 8; ++j) { const int n = (lane >> 3) + 8 * j; const LAS float* s = scr + (8 * c) * 65 + n;
        v2u o; o.x = pk4_i8((f32x4){s[0 * 65], s[1 * 65], s[2 * 65], s[3 * 65]}, sc); o.y = pk4_i8((f32x4){s[4 * 65], s[5 * 65], s[6 * 65], s[7 * 65]}, sc);
        *(GAS v2u*)(WT + (size_t)(n0 + n) * K + k0 + 8 * c) = o; }
    LDS_WAIT(); asm volatile("" ::: "memory");
}
__device__ __forceinline__ void p0_convert_item(const float* src, bf16* dst, size_t item, int lane) {
    const GAS f32x4* s = (const GAS f32x4*)(src + item * 2048) + lane * 2;
    GAS v4u* d = (GAS v4u*)(dst + item * 2048) + lane;
#pragma unroll
    for (int j = 0; j < 4; ++j) { const f32x4 a = s[j * 128], b = s[j * 128 + 1];
        v4u o; o.x = pk2(a.x, a.y); o.y = pk2(a.z, a.w); o.z = pk2(b.x, b.y); o.w = pk2(b.z, b.w); d[j * 64] = o; }
}
__device__ __forceinline__ unsigned pk4_fp8(f32x4 a, float sc) { int w = __builtin_amdgcn_cvt_pk_fp8_f32(a.x * sc, a.y * sc, 0, false); w = __builtin_amdgcn_cvt_pk_fp8_f32(a.z * sc, a.w * sc, w, true); return (unsigned)w; }
__device__ __forceinline__ void p0_convert_item_i8(const float* src, unsigned char* dst, size_t item, int lane, float sc) {
    const GAS f32x4* s = (const GAS f32x4*)(src + item * 4096) + lane * 4;
#pragma unroll
    for (int j = 0; j < 4; ++j) { v4u o; o.x = pk4_i8(__builtin_nontemporal_load(s + j * 256), sc); o.y = pk4_i8(__builtin_nontemporal_load(s + j * 256 + 1), sc); o.z = pk4_i8(__builtin_nontemporal_load(s + j * 256 + 2), sc); o.w = pk4_i8(__builtin_nontemporal_load(s + j * 256 + 3), sc);
        *(GAS v4u*)(dst + (size_t)(lane >> 3) * NEXP * 128 + (item * 4 + j) * 128 + (lane & 7) * 16) = o; }
}
__device__ __forceinline__ void p0_convert_item_fp8(const float* src, unsigned char* dst, size_t item, int lane, float sc) {
    const GAS f32x4* s = (const GAS f32x4*)(src + item * 4096) + lane * 4;
#pragma unroll
    for (int j = 0; j < 4; ++j) { v4u o; o.x = pk4_fp8(__builtin_nontemporal_load(s + j * 256), sc); o.y = pk4_fp8(__builtin_nontemporal_load(s + j * 256 + 1), sc); o.z = pk4_fp8(__builtin_nontemporal_load(s + j * 256 + 2), sc); o.w = pk4_fp8(__builtin_nontemporal_load(s + j * 256 + 3), sc);
        *(GAS v4u*)(dst + (size_t)(lane >> 3) * NEXP * 128 + (item * 4 + j) * 128 + (lane & 7) * 16) = o; }
}
__device__ __forceinline__ void p0_ada_task(Frame& F, int task, LAS float* scr) {
    const int kc = task / (ADA_W / 64), ng = task % (ADA_W / 64), lane = F.lane;
    const float* c = F.in[IN_C];
    for (int e = lane; e < BATCH * 128; e += 64) { const int b = e >> 7, kk = e & 127; const float cv = c[b * D + kc * 128 + kk]; scr[kk * 16 + b] = cv / (1.f + expf(-cv)); }
    LDS_WAIT(); asm volatile("" ::: "memory");
    float acc[BATCH];
#pragma unroll
    for (int b = 0; b < BATCH; ++b) acc[b] = 0.f;
    const float* wp = F.in[IN_WADA] + (size_t)(kc * 128) * ADA_W + ng * 64 + lane;
#pragma unroll 1
    for (int k0 = 0; k0 < 128; k0 += 16) { float wv[16];
#pragma unroll
        for (int u = 0; u < 16; ++u) wv[u] = __builtin_nontemporal_load(wp + (size_t)(k0 + u) * ADA_W);
#pragma unroll
        for (int u = 0; u < 16; ++u) { const LAS f32x4* sp = (const LAS f32x4*)(scr + (k0 + u) * 16);
#pragma unroll
            for (int q = 0; q < 4; ++q) { const f32x4 s = sp[q]; acc[4 * q] += s.x * wv[u]; acc[4 * q + 1] += s.y * wv[u]; acc[4 * q + 2] += s.z * wv[u]; acc[4 * q + 3] += s.w * wv[u]; } } }
    float* ap = (float*)(F.ws + WS_ADAP);
#pragma unroll
    for (int b = 0; b < BATCH; ++b) ap[(size_t)(kc * BATCH + b) * ADA_W + ng * 64 + lane] = acc[b];
    LDS_WAIT(); asm volatile("" ::: "memory");
}
__device__ __forceinline__ void p0_prologue(Frame& F) {
    LAS float* scr = (LAS float*)(F.lds + RING_OFF + F.wave * 16896);
    const int gw = F.vcu * NWAVES + F.wave, NGW = F.G * NWAVES;
    constexpr int I_ADA = ADA_KC * (ADA_W / 64);
    constexpr int I_T1 = (D / 64) * (IN_W / 64), I_T2 = (D / 64) * (D / 64), I_T3 = (D / 64) * (QW / 64);
    constexpr int I_K = PH * NKEYS * DHALF / 2048;
    constexpr int I_E = (int)((size_t)NEXP * D / 4096);
    constexpr int NITEMS = I_ADA + I_T1 + I_T2 + I_T3 + 2 * I_K + 2 * I_E;
    for (int it = gw; it < NITEMS; it += NGW) {
        int r = it;
        if (r < I_ADA) { p0_ada_task(F, r, scr); continue; } r -= I_ADA;
        if (r < I_T1) { p0_transpose_item_i8(F.in[IN_WIN], D, IN_W, F.ws + WS_WIN, scr, r, F.lane, WQ_SCALE); continue; } r -= I_T1;
        if (r < I_T2) { p0_transpose_item(F.in[IN_WOUT], D, D, (bf16*)(F.ws + WS_WOUT), scr, r, F.lane); continue; } r -= I_T2;
        if (r < I_T3) { p0_transpose_item_i8(F.in[IN_WQ], D, QW, F.ws + WS_WQ, scr, r, F.lane, WQ_SCALE); continue; } r -= I_T3;
        if (r < I_K) { p0_convert_item(F.in[IN_PK1], (bf16*)(F.ws + WS_K1), r, F.lane); continue; } r -= I_K;
        if (r < I_K) { p0_convert_item(F.in[IN_PK2], (bf16*)(F.ws + WS_K2), r, F.lane); continue; } r -= I_K;
        if (r < I_E) { p0_convert_item_i8(F.in[IN_PU], F.ws + WS_U, r, F.lane, U_SCALE); continue; } r -= I_E;
        p0_convert_item_fp8(F.in[IN_PV], F.ws + WS_V, r, F.lane, V_SCALE);
    }
}

__device__ __forceinline__ void mod_row(const float* xrow, bf16* orow, const LAS float* SC, const LAS float* SH, int lane) {
    const GAS f32x4* xr = (const GAS f32x4*)xrow + lane;
    f32x4 v[4]; float s = 0.f;
#pragma unroll
    for (int j = 0; j < 4; ++j) { v[j] = xr[64 * j]; s += (v[j].x * v[j].x + v[j].y * v[j].y) + (v[j].z * v[j].z + v[j].w * v[j].w); }
    const float rstd = 1.0f / sqrtf(wave_sum(s) * (1.f / D) + EPS);
    GAS unsigned long long* o8 = (GAS unsigned long long*)orow + lane;
#pragma unroll
    for (int j = 0; j < 4; ++j) { const f32x4 sc = ((const LAS f32x4*)SC)[lane + 64 * j], sh = ((const LAS f32x4*)SH)[lane + 64 * j];
        const f32x4 o = v[j] * rstd * sc + sh;
        o8[64 * j] = (unsigned long long)pk2(o.x, o.y) | ((unsigned long long)pk2(o.z, o.w) << 32); }
}
__device__ __forceinline__ void mod_row_bf(const bf16* xrow, bf16* orow, const LAS float* SC, const LAS float* SH, int lane) {
    const GAS v2u* xr = (const GAS v2u*)xrow + lane;
    f32x4 v[4]; float s = 0.f;
#pragma unroll
    for (int j = 0; j < 4; ++j) { const v2u w = xr[64 * j]; v[j] = (f32x4){bflo(w.x), bfhi(w.x), bflo(w.y), bfhi(w.y)}; s += (v[j].x * v[j].x + v[j].y * v[j].y) + (v[j].z * v[j].z + v[j].w * v[j].w); }
    const float rstd = 1.0f / sqrtf(wave_sum(s) * (1.f / D) + EPS);
    GAS unsigned long long* o8 = (GAS unsigned long long*)orow + lane;
#pragma unroll
    for (int j = 0; j < 4; ++j) { const f32x4 sc = ((const LAS f32x4*)SC)[lane + 64 * j], sh = ((const LAS f32x4*)SH)[lane + 64 * j];
        const f32x4 o = v[j] * rstd * sc + sh;
        o8[64 * j] = (unsigned long long)pk2(o.x, o.y) | ((unsigned long long)pk2(o.z, o.w) << 32); }
}
__device__ __forceinline__ void mod_load(const float* xrow, int lane, f32x4 (&v)[4]) { const GAS f32x4* xr = (const GAS f32x4*)xrow + lane;
#pragma unroll
    for (int j = 0; j < 4; ++j) v[j] = __builtin_nontemporal_load(xr + 64 * j); }
__device__ __forceinline__ void mod_load_bf(const bf16* xrow, int lane, f32x4 (&v)[4]) { const GAS v2u* xr = (const GAS v2u*)xrow + lane;
#pragma unroll
    for (int j = 0; j < 4; ++j) { const v2u w = xr[64 * j]; v[j] = (f32x4){bflo(w.x), bfhi(w.x), bflo(w.y), bfhi(w.y)}; } }
template <bool I8> __device__ __forceinline__ void mod_finish(const f32x4 (&v)[4], bf16* orow, unsigned char* o8row, float* hs_out, const LAS float* SC, const LAS float* SH, int lane) {
    float s = 0.f;
#pragma unroll
    for (int j = 0; j < 4; ++j) s += (v[j].x * v[j].x + v[j].y * v[j].y) + (v[j].z * v[j].z + v[j].w * v[j].w);
    const float rstd = 1.0f / sqrtf(wave_sum(s) * (1.f / D) + EPS);
    f32x4 o[4]; float am = 0.f;
#pragma unroll
    for (int j = 0; j < 4; ++j) { const f32x4 sc = ((const LAS f32x4*)SC)[lane + 64 * j], sh = ((const LAS f32x4*)SH)[lane + 64 * j]; o[j] = v[j] * rstd * sc + sh;
        am = fmaxf(am, fmaxf(fmaxf(fabsf(o[j].x), fabsf(o[j].y)), fmaxf(fabsf(o[j].z), fabsf(o[j].w)))); }
    if (!I8) { GAS unsigned long long* o8 = (GAS unsigned long long*)orow + lane;
#pragma unroll
        for (int j = 0; j < 4; ++j) o8[64 * j] = (unsigned long long)pk2(o[j].x, o[j].y) | ((unsigned long long)pk2(o[j].z, o[j].w) << 32);
    } else {
#pragma unroll
        for (int off = 1; off < 64; off <<= 1) am = fmaxf(am, __shfl_xor(am, off));
        const float qs = am > 0.f ? 127.f / am : 0.f;
#pragma unroll
        for (int j = 0; j < 4; ++j) ((GAS unsigned*)o8row)[lane + 64 * j] = pk4_i8(o[j], qs);
        if (lane == 0) *hs_out = am * (1.f / 127.f); }
}
__device__ __forceinline__ void p1_hpass(Frame& F) {
    LAS float* SC = (LAS float*)(F.lds); LAS float* SH = SC + D;
    const float* adap = (const float*)(F.ws + WS_ADAP); const float* bada = F.in[IN_BADA]; const float* g1 = F.in[IN_G1];
    float* ada = (float*)(F.ws + WS_ADA);
    for (int e = blockIdx.x * 512 + F.tid; e < BATCH * ADA_W; e += F.G * 512) { const int b = e / ADA_W, n = e % ADA_W; float s = bada[n];
#pragma unroll
        for (int kc = 0; kc < ADA_KC; ++kc) s += adap[(size_t)(kc * BATCH + b) * ADA_W + n];
        ada[e] = s; }
    for (int tile = blockIdx.x; tile < M / 128; tile += F.G) {
        const int b = tile / (SEQ / 128);
        for (int d = F.tid; d < D; d += 512) { float sh = bada[d], sc = bada[D + d];
#pragma unroll
            for (int kc = 0; kc < ADA_KC; ++kc) { const float* p = adap + (size_t)(kc * BATCH + b) * ADA_W; sh += p[d]; sc += p[D + d]; }
            SC[d] = g1[d] * (1.f + sc); SH[d] = sh; }
        __syncthreads();
        { f32x4 va[4], vb[4];
          mod_load(F.in[IN_X] + ((size_t)tile * 128 + F.wave) * D, F.lane, va);
#pragma unroll 1
          for (int r = F.wave; r < 128; r += 2 * NWAVES) { const size_t row = (size_t)tile * 128 + r;
              mod_load(F.in[IN_X] + (row + NWAVES) * D, F.lane, vb);
              mod_finish<true>(va, nullptr, F.ws + WS_H8 + row * D, (float*)(F.ws + WS_HS) + row, SC, SH, F.lane);
              if (r + 2 * NWAVES < 128) mod_load(F.in[IN_X] + (row + 2 * NWAVES) * D, F.lane, va);
              mod_finish<true>(vb, nullptr, F.ws + WS_H8 + (row + NWAVES) * D, (float*)(F.ws + WS_HS) + (row + NWAVES), SC, SH, F.lane); } }
        __syncthreads();
    }
}
__device__ __forceinline__ void p5_h2pass(Frame& F) {
    LAS float* SC = (LAS float*)(F.lds); LAS float* SH = SC + D;
    const float* ada = (const float*)(F.ws + WS_ADA); const float* g2 = F.in[IN_G2];
    for (int tile = blockIdx.x; tile < M / 128; tile += F.G) {
        const int b = tile / (SEQ / 128);
        for (int d = F.tid; d < D; d += 512) { SC[d] = g2[d] * (1.f + ada[(size_t)b * ADA_W + 4 * D + d]); SH[d] = ada[(size_t)b * ADA_W + 3 * D + d]; }
        __syncthreads();
        { f32x4 va[4], vb[4]; const bf16* X1 = (const bf16*)(F.ws + WS_X1);
          mod_load_bf(X1 + ((size_t)tile * 128 + F.wave) * D, F.lane, va);
#pragma unroll 1
          for (int r = F.wave; r < 128; r += 2 * NWAVES) { const size_t row = (size_t)tile * 128 + r;
              mod_load_bf(X1 + (row + NWAVES) * D, F.lane, vb);
              mod_finish<true>(va, (bf16*)(F.ws + WS_H) + row * D, F.ws + WS_H8 + row * D, (float*)(F.ws + WS_HS) + row, SC, SH, F.lane);
              if (r + 2 * NWAVES < 128) mod_load_bf(X1 + (row + 2 * NWAVES) * D, F.lane, va);
              mod_finish<true>(vb, (bf16*)(F.ws + WS_H) + (row + NWAVES) * D, F.ws + WS_H8 + (row + NWAVES) * D, (float*)(F.ws + WS_HS) + (row + NWAVES), SC, SH, F.lane); } }
        __syncthreads();
    }
}

typedef float f32x16 __attribute__((ext_vector_type(16)));
typedef short s16x4 __attribute__((ext_vector_type(4)));
typedef __bf16 bf16x8_t __attribute__((ext_vector_type(8)));
#define MFMA32(a, b, c) __builtin_amdgcn_mfma_f32_32x32x16_bf16((a), (b), (c), 0, 0, 0)
constexpr int KS = 144, VS = 192;
__device__ __forceinline__ void p3_attn_unit(Frame& F, int unit) {
    const int kh = unit & 1, nb = (unit >> 1) & 15, b = unit >> 5;
    LAS unsigned char* KL = F.lds; LAS unsigned char* VL = F.lds + 256 * KS;
    const bf16* proj = (const bf16*)(F.ws + WS_PROJ);
    const int tok0 = b * SEQ + nb * 128;
    for (int c = F.tid; c < 2048; c += 512) { const int j = c >> 3, ch = c & 7;
        v4u kv = (v4u){0u, 0u, 0u, 0u}, vv = (v4u){0u, 0u, 0u, 0u};
        if (nb > 0 || j >= 128) { const bf16* rowp = proj + (size_t)(tok0 - 128 + j) * IN_W; kv = *(const GAS v4u*)(rowp + O_K + kh * HD + ch * 8); vv = *(const GAS v4u*)(rowp + O_V + kh * HD + ch * 8); }
        *(LAS v4u*)(KL + j * KS + ch * 16) = kv; *(LAS v4u*)(VL + j * VS + ch * 16) = vv; }
    __syncthreads();
    const int lane = F.lane, r = lane & 31, hh = lane >> 5;
#pragma unroll 1
    for (int task = F.wave; task < 16; task += NWAVES) {
        const int g = task >> 2, w = task & 3, qh = kh * 4 + g, i0 = 32 * w;
        const bf16* qp = proj + (size_t)(tok0 + i0 + r) * IN_W + O_Q + qh * HD + 8 * hh;
        bf16x8 qf[4];
#pragma unroll
        for (int s = 0; s < 4; ++s) qf[s] = *(const GAS bf16x8*)(qp + 16 * s);
        f32x16 sc[5];
#pragma unroll
        for (int t = 0; t < 5; ++t) {
#pragma unroll
            for (int e = 0; e < 16; ++e) sc[t][e] = 0.f;
#pragma unroll
            for (int s = 0; s < 4; ++s) { const bf16x8 a = *(const LAS bf16x8*)(KL + ((w + t) * 32 + r) * KS + 32 * s + 16 * hh); sc[t] = MFMA32(a, qf[s], sc[t]); } }
        const float sink = F.in[IN_SINK][qh];
        float mx = sink;
#pragma unroll
        for (int t = 0; t < 5; ++t)
#pragma unroll
            for (int e = 0; e < 16; ++e) { const int kr = (e & 3) + 8 * (e >> 2) + 4 * hh;
                bool valid = (nb > 0) || (w + t >= 4);
                if (t == 0) valid = valid && (kr > r);
                if (t == 4) valid = valid && (kr <= r);
                const float v = valid ? sc[t][e] * 0.125f : -1e30f; sc[t][e] = v; mx = fmaxf(mx, v); }
        mx = fmaxf(mx, __shfl_xor(mx, 32));
        float lsum = 0.f;
#pragma unroll
        for (int t = 0; t < 5; ++t)
#pragma unroll
            for (int e = 0; e < 16; ++e) { const float p = __expf(sc[t][e] - mx); sc[t][e] = p; lsum += p; }
        lsum += __shfl_xor(lsum, 32); lsum += __expf(sink - mx);
        f32x16 o[2];
#pragma unroll
        for (int dt = 0; dt < 2; ++dt)
#pragma unroll
            for (int e = 0; e < 16; ++e) o[dt][e] = 0.f;
        const int q4 = (r & 15) >> 2, p4 = r & 3;
#pragma unroll
        for (int t = 0; t < 5; ++t)
#pragma unroll
            for (int sp = 0; sp < 2; ++sp) {
                bf16x8_t pbv;
#pragma unroll
                for (int e = 0; e < 8; ++e) pbv[e] = (__bf16)sc[t][8 * sp + e];
                const bf16x8 pb = __builtin_bit_cast(bf16x8, pbv);
#pragma unroll
                for (int dt = 0; dt < 2; ++dt) {
                    const int kb = (w + t) * 32 + 16 * sp + 4 * hh;
                    const LAS unsigned char* ap = VL + (kb + q4) * VS + (32 * dt + 16 * (r >> 4) + 4 * p4) * 2;
                    const s16x4 lo = __builtin_amdgcn_ds_read_tr16_b64_v4i16((LAS s16x4*)ap);
                    const s16x4 hi = __builtin_amdgcn_ds_read_tr16_b64_v4i16((LAS s16x4*)(ap + 8 * VS));
                    const bf16x8 a = __builtin_shufflevector(lo, hi, 0, 1, 2, 3, 4, 5, 6, 7);
                    o[dt] = MFMA32(a, pb, o[dt]); } }
        const float inv = 1.f / lsum; float ss = 0.f;
#pragma unroll
        for (int dt = 0; dt < 2; ++dt)
#pragma unroll
            for (int e = 0; e < 16; ++e) { o[dt][e] *= inv; ss += o[dt][e] * o[dt][e]; }
        ss += __shfl_xor(ss, 32);
        const float rs = 1.0f / sqrtf(ss * (1.f / HD) + EPS);
        const float* gp = F.in[IN_AOG] + qh * HD;
        bf16* op = (bf16*)(F.ws + WS_MIX) + (size_t)(tok0 + i0 + r) * D + qh * HD;
#pragma unroll
        for (int dt = 0; dt < 2; ++dt)
#pragma unroll
            for (int g4 = 0; g4 < 4; ++g4) { const int d0 = 32 * dt + 8 * g4 + 4 * hh; const f32x4 gv = *(const f32x4*)(gp + d0);
                v2u wv; wv.x = pk2(o[dt][4 * g4 + 0] * rs * gv.x, o[dt][4 * g4 + 1] * rs * gv.y); wv.y = pk2(o[dt][4 * g4 + 2] * rs * gv.z, o[dt][4 * g4 + 3] * rs * gv.w);
                *(GAS v2u*)(op + d0) = wv; }
    }
    __syncthreads();
}
__device__ __forceinline__ void p3_conv(Frame& F) {
    const bf16* proj = (const bf16*)(F.ws + WS_PROJ); const int lane = F.lane, c0 = 8 * lane;
    const float* cw = F.in[IN_CONVW]; const float* cg = F.in[IN_COG];
    float w0[8], w1[8], w2[8], gg[8];
#pragma unroll
    for (int e = 0; e < 8; ++e) { w0[e] = cw[c0 + e]; w1[e] = cw[512 + c0 + e]; w2[e] = cw[1024 + c0 + e]; gg[e] = cg[c0 + e]; }
    const int gw = F.vcu * NWAVES + F.wave, NGW = F.G * NWAVES;
    for (int tok = gw; tok < M; tok += NGW) {
        const int s = tok & (SEQ - 1); const bf16* rp = proj + (size_t)tok * IN_W;
        const v4u z4 = (v4u){0u, 0u, 0u, 0u};
        const v4u Bv = *(const GAS v4u*)(rp + O_B + c0), C0 = *(const GAS v4u*)(rp + O_C + c0), U0 = *(const GAS v4u*)(rp + O_U + c0);
        v4u C1 = z4, U1 = z4, C2 = z4, U2 = z4;
        if (s >= 1) { C1 = *(const GAS v4u*)(rp - IN_W + O_C + c0); U1 = *(const GAS v4u*)(rp - IN_W + O_U + c0); }
        if (s >= 2) { C2 = *(const GAS v4u*)(rp - 2 * IN_W + O_C + c0); U2 = *(const GAS v4u*)(rp - 2 * IN_W + O_U + c0); }
        float y[8]; float ss = 0.f;
#pragma unroll
        for (int e = 0; e < 8; ++e) { const int wi = e >> 1; const bool hi = e & 1;
            const unsigned bw = Bv[wi], c0w = C0[wi], u0w = U0[wi], c1w = C1[wi], u1w = U1[wi], c2w = C2[wi], u2w = U2[wi];
            const float bb = hi ? bfhi(bw) : bflo(bw);
            const float z0 = (hi ? bfhi(c0w) : bflo(c0w)) * (hi ? bfhi(u0w) : bflo(u0w));
            const float z1 = (hi ? bfhi(c1w) : bflo(c1w)) * (hi ? bfhi(u1w) : bflo(u1w));
            const float z2 = (hi ? bfhi(c2w) : bflo(c2w)) * (hi ? bfhi(u2w) : bflo(u2w));
            y[e] = bb * (z2 * w0[e] + z1 * w1[e] + z0 * w2[e]); ss += y[e] * y[e]; }
        ss += __shfl_xor(ss, 1); ss += __shfl_xor(ss, 2); ss += __shfl_xor(ss, 4);
        const float rs = 1.0f / sqrtf(ss * (1.f / 64.f) + EPS);
        v4u w; w.x = pk2(y[0] * rs * gg[0], y[1] * rs * gg[1]); w.y = pk2(y[2] * rs * gg[2], y[3] * rs * gg[3]);
        w.z = pk2(y[4] * rs * gg[4], y[5] * rs * gg[5]); w.w = pk2(y[6] * rs * gg[6], y[7] * rs * gg[7]);
        *(GAS v4u*)((bf16*)(F.ws + WS_MIX) + (size_t)tok * D + 512 + c0) = w;
    }
}
__device__ __forceinline__ void p3_mixer(Frame& F) {
    for (int unit = blockIdx.x; unit < BATCH * 16 * NKVH; unit += F.G) p3_attn_unit(F, unit);
    p3_conv(F);
}

#define DI __device__ __forceinline__
#define CE_(i, j) { const unsigned x_ = a[i], y_ = a[j]; a[i] = x_ > y_ ? x_ : y_; a[j] = x_ > y_ ? y_ : x_; }
DI void sort16_desc(unsigned (&a)[16]) {
    CE_(0,13) CE_(1,12) CE_(2,15) CE_(3,14) CE_(4,8) CE_(5,6) CE_(7,11) CE_(9,10)
    CE_(0,5) CE_(1,7) CE_(2,9) CE_(3,4) CE_(6,13) CE_(8,14) CE_(10,15) CE_(11,12)
    CE_(0,1) CE_(2,3) CE_(4,5) CE_(6,8) CE_(7,9) CE_(10,11) CE_(12,13) CE_(14,15)
    CE_(0,2) CE_(1,3) CE_(4,10) CE_(5,11) CE_(6,7) CE_(8,9) CE_(12,14) CE_(13,15)
    CE_(1,2) CE_(3,12) CE_(4,6) CE_(5,7) CE_(8,10) CE_(9,11) CE_(13,14)
    CE_(1,4) CE_(2,6) CE_(5,8) CE_(7,10) CE_(9,13) CE_(11,14)
    CE_(2,4) CE_(3,6) CE_(9,12) CE_(11,13)
    CE_(3,5) CE_(6,8) CE_(7,9) CE_(10,12)
    CE_(3,4) CE_(5,6) CE_(7,8) CE_(9,10) CE_(11,12)
    CE_(6,7) CE_(8,9)
}
DI void bitonic_merge16_desc(unsigned (&a)[16]) {
#pragma unroll
    for (int js = 3; js >= 0; --js) {
#pragma unroll
        for (int i = 0; i < 16; ++i) { const int j = 1 << js, l = i ^ j;
            if (l > i) { const unsigned x = a[i], y = a[l]; a[i] = x > y ? x : y; a[l] = x > y ? y : x; } }
    }
}
DI void merge_top16(unsigned (&a)[16], const unsigned (&b)[16]) {
#pragma unroll
    for (int i = 0; i < 16; ++i) { const unsigned x = a[i], y = b[15 - i]; a[i] = x > y ? x : y; }
    bitonic_merge16_desc(a);
}
DI void top16_of_64(unsigned (&g0)[16], unsigned (&g1)[16], unsigned (&g2)[16], unsigned (&g3)[16]) {
    sort16_desc(g0); sort16_desc(g1); sort16_desc(g2); sort16_desc(g3);
    merge_top16(g0, g1); merge_top16(g2, g3); merge_top16(g0, g2);
}
#define SBIAS 8.0f
DI unsigned skey(float biased) { return __float_as_uint(fmaxf(biased, 0.f)); }
constexpr int KEY_STRIDE = 272;
DI void route_scores_top16(const LAS unsigned char* KL, const bf16* qrow, int r, int hh, unsigned (&out)[16]) {
    bf16x8 qf[8];
#pragma unroll
    for (int s = 0; s < 8; ++s) qf[s] = *(const GAS bf16x8*)(qrow + 16 * s);
    f32x16 acc[4];
#pragma unroll
    for (int t = 0; t < 4; ++t)
#pragma unroll
        for (int e = 0; e < 16; ++e) acc[t][e] = SBIAS;
#pragma unroll
    for (int t = 0; t < 4; ++t)
#pragma unroll
        for (int s = 0; s < 8; ++s) { const bf16x8 a = *(const LAS bf16x8*)(KL + (t * 32 + r) * KEY_STRIDE + 32 * s + 16 * hh); acc[t] = MFMA32(a, qf[s], acc[t]); }
    unsigned g0[16], g1[16], g2[16], g3[16];
    const unsigned pb = (unsigned)(127 - 4 * hh);
#pragma unroll
    for (int e = 0; e < 16; ++e) { const unsigned p = pb - (unsigned)((e & 3) + 8 * (e >> 2));
        g0[e] = (skey(acc[0][e]) & ~127u) | p; g1[e] = (skey(acc[1][e]) & ~127u) | (p - 32u); g2[e] = (skey(acc[2][e]) & ~127u) | (p - 64u); g3[e] = (skey(acc[3][e]) & ~127u) | (p - 96u); }
    top16_of_64(g0, g1, g2, g3);
    unsigned oth[16];
#pragma unroll
    for (int i = 0; i < 16; ++i) oth[i] = (unsigned)__shfl_xor((int)g0[i], 32);
    merge_top16(g0, oth);
#pragma unroll
    for (int i = 0; i < 16; ++i) out[i] = g0[i];
}
DI void p7_route_tile(Frame& F, int tok0, int h, const LAS unsigned char* KL1, const LAS unsigned char* KL2, LAS unsigned char* scr) {
    const int lane = F.lane, r = lane & 31, hh = lane >> 5;
    const bf16* qrow = (const bf16*)(F.ws + WS_PROJ) + (size_t)(tok0 + r) * QW + h * DKEY + 8 * hh;
    unsigned t1[16], t2[16];
    route_scores_top16(KL1, qrow, r, hh, t1);
    route_scores_top16(KL2, qrow + DHALF, r, hh, t2);
    { v4u w;
#pragma unroll
      for (int q = 0; q < 4; ++q) { unsigned x = 0u;
#pragma unroll
          for (int bq = 0; bq < 4; ++bq) { const unsigned k = hh ? t2[4 * q + bq] : t1[4 * q + bq]; x |= (127u - (k & 127u)) << (8 * bq); }
          w[q] = x; }
      *(LAS v4u*)(scr + r * 32 + hh * 16) = w; }
    float v1[16], v2[16];
#pragma unroll
    for (int i = 0; i < 16; ++i) { v1[i] = __uint_as_float(t1[i] & ~127u); v2[i] = __uint_as_float(t2[i] & ~127u) - SBIAS; }
    unsigned c0[16], c1[16];
    { const float sa = v1[0] + v2[0], sb = v1[2] + v2[1]; c0[0] = (__float_as_uint(fmaxf(hh ? sb : sa, 0.f)) & ~255u) | (hh ? 222u : 255u); }
    { const float sa = v1[0] + v2[1], sb = v1[2] + v2[2]; c0[1] = (__float_as_uint(fmaxf(hh ? sb : sa, 0.f)) & ~255u) | (hh ? 221u : 254u); }
    { const float sa = v1[0] + v2[2], sb = v1[2] + v2[3]; c0[2] = (__float_as_uint(fmaxf(hh ? sb : sa, 0.f)) & ~255u) | (hh ? 220u : 253u); }
    { const float sa = v1[0] + v2[3], sb = v1[2] + v2[4]; c0[3] = (__float_as_uint(fmaxf(hh ? sb : sa, 0.f)) & ~255u) | (hh ? 219u : 252u); }
    { const float sa = v1[0] + v2[4], sb = v1[3] + v2[0]; c0[4] = (__float_as_uint(fmaxf(hh ? sb : sa, 0.f)) & ~255u) | (hh ? 207u : 251u); }
    { const float sa = v1[0] + v2[5], sb = v1[3] + v2[1]; c0[5] = (__float_as_uint(fmaxf(hh ? sb : sa, 0.f)) & ~255u) | (hh ? 206u : 250u); }
    { const float sa = v1[0] + v2[6], sb = v1[3] + v2[2]; c0[6] = (__float_as_uint(fmaxf(hh ? sb : sa, 0.f)) & ~255u) | (hh ? 205u : 249u); }
    { const float sa = v1[0] + v2[7], sb = v1[3] + v2[3]; c0[7] = (__float_as_uint(fmaxf(hh ? sb : sa, 0.f)) & ~255u) | (hh ? 204u : 248u); }
    { const float sa = v1[0] + v2[8], sb = v1[4] + v2[0]; c0[8] = (__float_as_uint(fmaxf(hh ? sb : sa, 0.f)) & ~255u) | (hh ? 191u : 247u); }
    { const float sa = v1[0] + v2[9], sb = v1[4] + v2[1]; c0[9] = (__float_as_uint(fmaxf(hh ? sb : sa, 0.f)) & ~255u) | (hh ? 190u : 246u); }
    { const float sa = v1[0] + v2[10], sb = v1[4] + v2[2]; c0[10] = (__float_as_uint(fmaxf(hh ? sb : sa, 0.f)) & ~255u) | (hh ? 189u : 245u); }
    { const float sa = v1[0] + v2[11], sb = v1[5] + v2[0]; c0[11] = (__float_as_uint(fmaxf(hh ? sb : sa, 0.f)) & ~255u) | (hh ? 175u : 244u); }
    { const float sa = v1[0] + v2[12], sb = v1[5] + v2[1]; c0[12] = (__float_as_uint(fmaxf(hh ? sb : sa, 0.f)) & ~255u) | (hh ? 174u : 243u); }
    { const float sa = v1[0] + v2[13], sb = v1[6] + v2[0]; c0[13] = (__float_as_uint(fmaxf(hh ? sb : sa, 0.f)) & ~255u) | (hh ? 159u : 242u); }
    { const float sa = v1[0] + v2[14], sb = v1[6] + v2[1]; c0[14] = (__float_as_uint(fmaxf(hh ? sb : sa, 0.f)) & ~255u) | (hh ? 158u : 241u); }
    { const float sa = v1[0] + v2[15], sb = v1[7] + v2[0]; c0[15] = (__float_as_uint(fmaxf(hh ? sb : sa, 0.f)) & ~255u) | (hh ? 143u : 240u); }
    { const float sa = v1[1] + v2[0], sb = v1[7] + v2[1]; c1[0] = (__float_as_uint(fmaxf(hh ? sb : sa, 0.f)) & ~255u) | (hh ? 142u : 239u); }
    { const float sa = v1[1] + v2[1], sb = v1[8] + v2[0]; c1[1] = (__float_as_uint(fmaxf(hh ? sb : sa, 0.f)) & ~255u) | (hh ? 127u : 238u); }
    { const float sa = v1[1] + v2[2], sb = v1[9] + v2[0]; c1[2] = (__float_as_uint(fmaxf(hh ? sb : sa, 0.f)) & ~255u) | (hh ? 111u : 237u); }
    { const float sa = v1[1] + v2[3], sb = v1[10] + v2[0]; c1[3] = (__float_as_uint(fmaxf(hh ? sb : sa, 0.f)) & ~255u) | (hh ? 95u : 236u); }
    { const float sa = v1[1] + v2[4], sb = v1[11] + v2[0]; c1[4] = (__float_as_uint(fmaxf(hh ? sb : sa, 0.f)) & ~255u) | (hh ? 79u : 235u); }
    { const float sa = v1[1] + v2[5], sb = v1[12] + v2[0]; c1[5] = (__float_as_uint(fmaxf(hh ? sb : sa, 0.f)) & ~255u) | (hh ? 63u : 234u); }
    { const float sa = v1[1] + v2[6], sb = v1[13] + v2[0]; c1[6] = (__float_as_uint(fmaxf(hh ? sb : sa, 0.f)) & ~255u) | (hh ? 47u : 233u); }
    { const float sa = v1[1] + v2[7], sb = v1[14] + v2[0]; c1[7] = (__float_as_uint(fmaxf(hh ? sb : sa, 0.f)) & ~255u) | (hh ? 31u : 232u); }
    { const float sa = v1[2] + v2[0], sb = v1[15] + v2[0]; c1[8] = (__float_as_uint(fmaxf(hh ? sb : sa, 0.f)) & ~255u) | (hh ? 15u : 223u); }
    c1[9] = 0u;
    c1[10] = 0u;
    c1[11] = 0u;
    c1[12] = 0u;
    c1[13] = 0u;
    c1[14] = 0u;
    c1[15] = 0u;
    sort16_desc(c0); sort16_desc(c1); merge_top16(c0, c1);
    { unsigned oth[16];
#pragma unroll
      for (int i = 0; i < 16; ++i) oth[i] = (unsigned)__shfl_xor((int)c0[i], 32);
      merge_top16(c0, oth); }
    const float mx = __uint_as_float(c0[0] & ~255u);
    LDS_WAIT(); asm volatile("" ::: "memory");
    float ex[8]; int ee[8]; float part = 0.f;
#pragma unroll
    for (int k = 0; k < 8; ++k) { const unsigned key = hh ? c0[8 + k] : c0[k]; const int ci = 255 - (int)(key & 255u);
        const int e1 = *(const LAS unsigned char*)(scr + r * 32 + (ci >> 4)), e2 = *(const LAS unsigned char*)(scr + r * 32 + 16 + (ci & 15));
        ee[k] = (e1 * NKEYS + e2) & (NEXP - 1); ex[k] = __expf(__uint_as_float(key & ~255u) - mx); part += ex[k]; }
    const float inv = 1.f / (part + __shfl_xor(part, 32));
    int* ip = (int*)(F.ws + WS_IDX) + (size_t)(tok0 + r) * 128 + h * TOPK + 8 * hh; float* gp = (float*)(F.ws + WS_GATE) + (size_t)(tok0 + r) * 128 + h * TOPK + 8 * hh;
    *(GAS v4u*)ip = (v4u){(unsigned)ee[0], (unsigned)ee[1], (unsigned)ee[2], (unsigned)ee[3]}; *(GAS v4u*)(ip + 4) = (v4u){(unsigned)ee[4], (unsigned)ee[5], (unsigned)ee[6], (unsigned)ee[7]};
    *(GAS f32x4*)gp = (f32x4){ex[0] * inv, ex[1] * inv, ex[2] * inv, ex[3] * inv}; *(GAS f32x4*)(gp + 4) = (f32x4){ex[4] * inv, ex[5] * inv, ex[6] * inv, ex[7] * inv};
    asm volatile("" ::: "memory");
}
__device__ __forceinline__ void p7_routing(Frame& F) {
    LAS unsigned char* KL1 = F.lds; LAS unsigned char* KL2 = F.lds + 128 * KEY_STRIDE; LAS unsigned char* scr = F.lds + 2 * 128 * KEY_STRIDE + F.wave * 1024;
    const bf16* k1 = (const bf16*)(F.ws + WS_K1); const bf16* k2 = (const bf16*)(F.ws + WS_K2);
    int cur_h = -1;
    for (int item = blockIdx.x; item < (M / 256) * PH; item += F.G) {
        const int h = item & (PH - 1), tile = item >> 3;
        if (h != cur_h) {
            __syncthreads();
            for (int c = F.tid; c < 2 * 128 * 16; c += 512) { const int which = c >> 11, rr = (c >> 4) & 127, ch = c & 15;
                const v4u v = *(const GAS v4u*)((which ? k2 : k1) + (size_t)(h * NKEYS + rr) * DHALF + ch * 8);
                *(LAS v4u*)((which ? KL2 : KL1) + rr * KEY_STRIDE + ch * 16) = v; }
            __syncthreads();
            cur_h = h;
        }
        p7_route_tile(F, tile * 256 + F.wave * 32, h, KL1, KL2, scr);
    }
}

__device__ __forceinline__ float gelu_erf(float v) { return 0.5f * v * (1.f + erff(v * 0.70710678118654752f)); }
typedef float f32x2v __attribute__((ext_vector_type(2)));
__device__ __forceinline__ unsigned fp8x2_bf16x2(unsigned w, bool hi) { return hi ? __builtin_bit_cast(unsigned, __builtin_amdgcn_cvt_scalef32_pk_bf16_fp8((int)w, 1.0f, true)) : __builtin_bit_cast(unsigned, __builtin_amdgcn_cvt_scalef32_pk_bf16_fp8((int)w, 1.0f, false)); }
__device__ __forceinline__ float dot16_fp8(v4u u, v4u ha, v4u hb, float acc) {
    acc = dot2(fp8x2_bf16x2(u.x, false), ha.x, acc); acc = dot2(fp8x2_bf16x2(u.x, true), ha.y, acc);
    acc = dot2(fp8x2_bf16x2(u.y, false), ha.z, acc); acc = dot2(fp8x2_bf16x2(u.y, true), ha.w, acc);
    acc = dot2(fp8x2_bf16x2(u.z, false), hb.x, acc); acc = dot2(fp8x2_bf16x2(u.z, true), hb.y, acc);
    acc = dot2(fp8x2_bf16x2(u.w, false), hb.z, acc); acc = dot2(fp8x2_bf16x2(u.w, true), hb.w, acc);
    return acc;
}
struct SliceWork { int j0, nj, t0, ts; };
__device__ __forceinline__ SliceWork slice_work(const Frame& F) { SliceWork w;
    if ((F.G & 7) == 0) { w.j0 = blockIdx.x & 7; w.nj = 1; w.t0 = (blockIdx.x >> 3) * NWAVES + F.wave; w.ts = F.G; }
    else { w.j0 = 0; w.nj = 8; w.t0 = blockIdx.x * NWAVES + F.wave; w.ts = F.G * NWAVES; }
    return w; }
struct USet { v4u hq; float hs; v4u u[16]; };
struct UMeta { v2u id; v4u hh; float hs; };
__device__ __forceinline__ UMeta p8a_G(const int* IDX, const unsigned char* H8, const float* HS, int t, int j, int lane) { UMeta m;
    m.id = *(const GAS v2u*)(IDX + (size_t)t * 128 + 2 * lane); m.hh = *(const GAS v4u*)(H8 + (size_t)t * D + 128 * j + 16 * (lane & 7)); m.hs = HS[t]; return m; }
__device__ __forceinline__ void p8a_S(LAS unsigned char* mb, const UMeta& m, int lane) { *(LAS v2u*)(mb + 8 * lane) = m.id; if (lane < 8) *(LAS v4u*)(mb + 512 + 16 * lane) = m.hh; }
__device__ __forceinline__ void p8a_RT(const LAS unsigned char* mb, const unsigned char* Ub, int c, int g, float hs, USet& s) {
    v4u ix[4];
#pragma unroll
    for (int q = 0; q < 4; ++q) ix[q] = *(const LAS v4u*)(mb + 64 * g + 16 * q);
    s.hq = *(const LAS v4u*)(mb + 512 + 16 * c); s.hs = hs;
#pragma unroll
    for (int i = 0; i < 16; ++i) s.u[i] = *(const GAS v4u*)(Ub + (unsigned)((ix[i >> 2][i & 3] << 7) + 16u * (unsigned)c)); }
__device__ __forceinline__ void p8a_compute(const USet& s, bf16* pa_row, int lane, int c) {
    int p[16];
#pragma unroll
    for (int i = 0; i < 16; ++i) { int a = __builtin_amdgcn_sdot4((int)s.u[i].x, (int)s.hq.x, 0, false); a = __builtin_amdgcn_sdot4((int)s.u[i].y, (int)s.hq.y, a, false);
        a = __builtin_amdgcn_sdot4((int)s.u[i].z, (int)s.hq.z, a, false); p[i] = __builtin_amdgcn_sdot4((int)s.u[i].w, (int)s.hq.w, a, false); }
#pragma unroll
    for (int i = 0; i < 8; ++i) { const bool up = c & 4; const int send = up ? p[i] : p[i + 8], keep = up ? p[i + 8] : p[i]; p[i] = keep + __shfl_xor(send, 4); }
#pragma unroll
    for (int i = 0; i < 4; ++i) { const bool up = c & 2; const int send = up ? p[i] : p[i + 4], keep = up ? p[i + 4] : p[i]; p[i] = keep + __shfl_xor(send, 2); }
#pragma unroll
    for (int i = 0; i < 2; ++i) { const bool up = c & 1; const int send = up ? p[i] : p[i + 2], keep = up ? p[i + 2] : p[i]; p[i] = keep + __shfl_xor(send, 1); }
    const float sc = s.hs * (1.f / U_SCALE);
    ((GAS unsigned*)pa_row)[lane] = pk2((float)p[0] * sc, (float)p[1] * sc);
}
__device__ __forceinline__ void p8a_udots(Frame& F) {
    const unsigned char* H8 = F.ws + WS_H8; const float* HS = (const float*)(F.ws + WS_HS); const int* IDX = (const int*)(F.ws + WS_IDX); bf16* PA = (bf16*)(F.ws + WS_PA);
    const int lane = F.lane, c = lane & 7, g = lane >> 3; const SliceWork sw = slice_work(F);
    LAS unsigned char* mb = F.lds + F.wave * 1024;
    if (sw.t0 >= M) return;
    const int nt = (M - 1 - sw.t0) / sw.ts + 1;
#define TOK(n) (sw.t0 + ((n) < nt ? (n) : nt - 1) * sw.ts)
    for (int jj = 0; jj < sw.nj; ++jj) { const int j = sw.j0 + jj; const unsigned char* Uj = F.ws + WS_U + (size_t)j * NEXP * 128;
        USet sA, sB, sC;
        UMeta mN = p8a_G(IDX, H8, HS, TOK(0), j, lane); p8a_S(mb, mN, lane); p8a_RT(mb, Uj, c, g, mN.hs, sA);
        mN = p8a_G(IDX, H8, HS, TOK(1), j, lane); p8a_S(mb, mN, lane); p8a_RT(mb, Uj, c, g, mN.hs, sB);
        mN = p8a_G(IDX, H8, HS, TOK(2), j, lane);
#define P8A_STAGE(k, SN, SC_) do { p8a_S(mb, mN, lane); p8a_RT(mb, Uj, c, g, mN.hs, SN); mN = p8a_G(IDX, H8, HS, TOK((k) + 3), j, lane); asm volatile("" ::: "memory"); \
            if ((k) < nt) p8a_compute(SC_, PA + ((size_t)j * M + TOK(k)) * 128, lane, c); asm volatile("" ::: "memory"); } while (0)
#pragma unroll 1
        for (int n = 0; n < nt; n += 3) {
            P8A_STAGE(n, sC, sA);
            P8A_STAGE(n + 1, sA, sB);
            P8A_STAGE(n + 2, sB, sC);
        }
#undef P8A_STAGE
    }
}
typedef _Float16 h2_t __attribute__((ext_vector_type(2)));
__device__ __forceinline__ h2_t cvt_h2_lo(int w) { return __builtin_bit_cast(h2_t, __builtin_amdgcn_cvt_scalef32_pk_f16_fp8(w, 1.0f, false)); }
__device__ __forceinline__ h2_t cvt_h2_hi(int w) { return __builtin_bit_cast(h2_t, __builtin_amdgcn_cvt_scalef32_pk_f16_fp8(w, 1.0f, true)); }
__device__ __forceinline__ void p8w_weights(Frame& F) {
    const bf16* PA = (const bf16*)(F.ws + WS_PA); float* GATE = (float*)(F.ws + WS_GATE);
    for (size_t e = (size_t)blockIdx.x * 512 + F.tid; e < (size_t)M * 128 / 4; e += (size_t)F.G * 512) {
        f32x4 s = (f32x4){0.f, 0.f, 0.f, 0.f};
#pragma unroll
        for (int j = 0; j < 8; ++j) { const v2u w = __builtin_nontemporal_load((const GAS v2u*)(PA + (size_t)j * M * 128 + 4 * e)); s += (f32x4){bflo(w.x), bfhi(w.x), bflo(w.y), bfhi(w.y)}; }
        const f32x4 gt = *(const GAS f32x4*)(GATE + 4 * e); f32x4 o;
#pragma unroll
        for (int q = 0; q < 4; ++q) o[q] = gt[q] * gelu_erf(s[q]);
        const h2_t w01 = (h2_t){(_Float16)o[0], (_Float16)o[1]}, w23 = (h2_t){(_Float16)o[2], (_Float16)o[3]};
        *(GAS v2u*)((_Float16*)(F.ws + WS_W16) + 4 * e) = (v2u){__builtin_bit_cast(unsigned, w01), __builtin_bit_cast(unsigned, w23)}; }
}
struct VSet { v4u wh[2]; v4u v[16]; unsigned x1; f32x2v g2; };
struct VMeta { v2u id; unsigned w; };
__device__ __forceinline__ VMeta p8b_G(const int* IDX, const _Float16* W, int t, int lane) { VMeta m;
    m.id = *(const GAS v2u*)(IDX + (size_t)t * 128 + 2 * lane); m.w = *(const GAS unsigned*)(W + (size_t)t * 128 + 2 * lane); return m; }
__device__ __forceinline__ void p8b_S(LAS unsigned char* mb, const VMeta& m, int lane) { *(LAS v2u*)(mb + 8 * lane) = m.id; *(LAS unsigned*)(mb + 512 + 4 * lane) = m.w; }
__device__ __forceinline__ void p8b_RT(Frame& F, const LAS unsigned char* mb, const unsigned char* Vj, int t, int j, int c, int g, VSet& s) {
    { const int d = 128 * j + 16 * c + 2 * g; s.x1 = *(const GAS unsigned*)((const bf16*)(F.ws + WS_X1) + (size_t)t * D + d); s.g2 = *(const GAS f32x2v*)((const float*)(F.ws + WS_ADA) + (size_t)(t / SEQ) * ADA_W + 5 * D + d); }
    v4u ix[4];
#pragma unroll
    for (int q = 0; q < 4; ++q) ix[q] = *(const LAS v4u*)(mb + 64 * g + 16 * q);
    s.wh[0] = *(const LAS v4u*)(mb + 512 + 32 * g); s.wh[1] = *(const LAS v4u*)(mb + 512 + 32 * g + 16);
#pragma unroll
    for (int i = 0; i < 16; ++i) s.v[i] = *(const GAS v4u*)(Vj + (unsigned)((ix[i >> 2][i & 3] << 7) + 16u * (unsigned)c)); }
__device__ __forceinline__ void p8b_compute(Frame& F, const VSet& s, int t, int j, int lane, int c, int g) {
    h2_t ah[8];
#pragma unroll
    for (int m = 0; m < 8; ++m) ah[m] = (h2_t){(_Float16)0.f, (_Float16)0.f};
#pragma unroll
    for (int i = 0; i < 16; ++i) { const v4u v = s.v[i]; const unsigned wu = s.wh[i >> 3][(i >> 1) & 3]; const h2_t w2 = __builtin_bit_cast(h2_t, (i & 1) ? ((wu >> 16) | (wu & 0xffff0000u)) : ((wu & 0xffffu) | (wu << 16)));
        ah[0] = __builtin_elementwise_fma(cvt_h2_lo((int)v.x), w2, ah[0]); ah[1] = __builtin_elementwise_fma(cvt_h2_hi((int)v.x), w2, ah[1]);
        ah[2] = __builtin_elementwise_fma(cvt_h2_lo((int)v.y), w2, ah[2]); ah[3] = __builtin_elementwise_fma(cvt_h2_hi((int)v.y), w2, ah[3]);
        ah[4] = __builtin_elementwise_fma(cvt_h2_lo((int)v.z), w2, ah[4]); ah[5] = __builtin_elementwise_fma(cvt_h2_hi((int)v.z), w2, ah[5]);
        ah[6] = __builtin_elementwise_fma(cvt_h2_lo((int)v.w), w2, ah[6]); ah[7] = __builtin_elementwise_fma(cvt_h2_hi((int)v.w), w2, ah[7]); }
    f32x2v acc[8];
#pragma unroll
    for (int m = 0; m < 8; ++m) acc[m] = (f32x2v){(float)ah[m].x, (float)ah[m].y} * (1.f / V_SCALE);
#pragma unroll
    for (int m = 0; m < 4; ++m) { const bool up = lane & 32; const f32x2v send = up ? acc[m] : acc[m + 4], keep = up ? acc[m + 4] : acc[m]; acc[m] = keep + (f32x2v){__shfl_xor(send.x, 32), __shfl_xor(send.y, 32)}; }
#pragma unroll
    for (int m = 0; m < 2; ++m) { const bool up = lane & 16; const f32x2v send = up ? acc[m] : acc[m + 2], keep = up ? acc[m + 2] : acc[m]; acc[m] = keep + (f32x2v){__shfl_xor(send.x, 16), __shfl_xor(send.y, 16)}; }
    { const bool up = lane & 8; const f32x2v send = up ? acc[0] : acc[1], keep = up ? acc[1] : acc[0]; acc[0] = keep + (f32x2v){__shfl_xor(send.x, 8), __shfl_xor(send.y, 8)}; }
    const int d = 128 * j + 16 * c + 2 * g;
    const f32x2v x2 = (f32x2v){bflo(s.x1), bfhi(s.x1)} + s.g2 * acc[0];
    *(GAS unsigned*)((bf16*)(F.ws + WS_X1) + (size_t)t * D + d) = pk2(x2.x, x2.y);
    const float ss = wave_sum(x2.x * x2.x + x2.y * x2.y);
    if (lane == 0) ((float*)(F.ws + WS_SS))[(size_t)j * M + t] = ss;
}
__device__ __forceinline__ void p8b_step(Frame& F, const LAS unsigned char* mb, const unsigned char* Vj, int tn, VSet& sn, const VSet& sc, int tc, int j, int lane, int c, int g, bool do_compute) {
    { const int d = 128 * j + 16 * c + 2 * g; sn.x1 = *(const GAS unsigned*)((const bf16*)(F.ws + WS_X1) + (size_t)tn * D + d); sn.g2 = *(const GAS f32x2v*)((const float*)(F.ws + WS_ADA) + (size_t)(tn / SEQ) * ADA_W + 5 * D + d); }
    v4u ix[4];
#pragma unroll
    for (int q = 0; q < 4; ++q) ix[q] = *(const LAS v4u*)(mb + 64 * g + 16 * q);
    sn.wh[0] = *(const LAS v4u*)(mb + 512 + 32 * g); sn.wh[1] = *(const LAS v4u*)(mb + 512 + 32 * g + 16);
    h2_t ah[8];
#pragma unroll
    for (int m = 0; m < 8; ++m) ah[m] = (h2_t){(_Float16)0.f, (_Float16)0.f};
#pragma unroll
    for (int i = 0; i < 16; ++i) {
        sn.v[i] = *(const GAS v4u*)(Vj + (unsigned)((ix[i >> 2][i & 3] << 7) + 16u * (unsigned)c));
        const v4u v = sc.v[i]; const unsigned wu = sc.wh[i >> 3][(i >> 1) & 3]; const h2_t w2 = __builtin_bit_cast(h2_t, (i & 1) ? ((wu >> 16) | (wu & 0xffff0000u)) : ((wu & 0xffffu) | (wu << 16)));
        ah[0] = __builtin_elementwise_fma(cvt_h2_lo((int)v.x), w2, ah[0]); ah[1] = __builtin_elementwise_fma(cvt_h2_hi((int)v.x), w2, ah[1]);
        ah[2] = __builtin_elementwise_fma(cvt_h2_lo((int)v.y), w2, ah[2]); ah[3] = __builtin_elementwise_fma(cvt_h2_hi((int)v.y), w2, ah[3]);
        ah[4] = __builtin_elementwise_fma(cvt_h2_lo((int)v.z), w2, ah[4]); ah[5] = __builtin_elementwise_fma(cvt_h2_hi((int)v.z), w2, ah[5]);
        ah[6] = __builtin_elementwise_fma(cvt_h2_lo((int)v.w), w2, ah[6]); ah[7] = __builtin_elementwise_fma(cvt_h2_hi((int)v.w), w2, ah[7]);
        asm volatile("" ::: "memory"); }
    if (!do_compute) return;
#pragma unroll
    for (int m = 0; m < 4; ++m) { const bool up = lane & 32; const h2_t send = up ? ah[m] : ah[m + 4], keep = up ? ah[m + 4] : ah[m]; ah[m] = keep + __builtin_bit_cast(h2_t, __shfl_xor(__builtin_bit_cast(int, send), 32)); }
#pragma unroll
    for (int m = 0; m < 2; ++m) { const bool up = lane & 16; const h2_t send = up ? ah[m] : ah[m + 2], keep = up ? ah[m + 2] : ah[m]; ah[m] = keep + __builtin_bit_cast(h2_t, __shfl_xor(__builtin_bit_cast(int, send), 16)); }
    { const bool up = lane & 8; const h2_t send = up ? ah[0] : ah[1], keep = up ? ah[1] : ah[0]; ah[0] = keep + __builtin_bit_cast(h2_t, __shfl_xor(__builtin_bit_cast(int, send), 8)); }
    const f32x2v peer = (f32x2v){(float)ah[0].x, (float)ah[0].y} * (1.f / V_SCALE);
    const int d = 128 * j + 16 * c + 2 * g;
    const f32x2v x2 = (f32x2v){bflo(sc.x1), bfhi(sc.x1)} + sc.g2 * peer;
    *(GAS unsigned*)((bf16*)(F.ws + WS_X1) + (size_t)tc * D + d) = pk2(x2.x, x2.y);
    const float ss = wave_sum(x2.x * x2.x + x2.y * x2.y);
    if (lane == 0) ((float*)(F.ws + WS_SS))[(size_t)j * M + tc] = ss;
}
__device__ __forceinline__ void p8b_vsum(Frame& F) {
    const int* IDX = (const int*)(F.ws + WS_IDX); const _Float16* W = (const _Float16*)(F.ws + WS_W16);
    const int lane = F.lane, c = lane & 7, g = lane >> 3; const SliceWork sw = slice_work(F);
    LAS unsigned char* mb = F.lds + F.wave * 1024;
    if (sw.t0 >= M) return;
    const int nt = (M - 1 - sw.t0) / sw.ts + 1;
    for (int jj = 0; jj < sw.nj; ++jj) { const int j = sw.j0 + jj; const unsigned char* Vj = F.ws + WS_V + (size_t)j * NEXP * 128;
        VSet sA, sB;
        { const VMeta m0 = p8b_G(IDX, W, TOK(0), lane); p8b_S(mb, m0, lane); }
        VMeta mN = p8b_G(IDX, W, TOK(1), lane);
        p8b_RT(F, mb, Vj, TOK(0), j, c, g, sA);
#pragma unroll 1
        for (int n = 0; n < nt; n += 2) {
            p8b_S(mb, mN, lane);
            mN = p8b_G(IDX, W, TOK(n + 2), lane);
            p8b_step(F, mb, Vj, TOK(n + 1), sB, sA, TOK(n), j, lane, c, g, true);
            asm volatile("" ::: "memory");
            p8b_S(mb, mN, lane);
            mN = p8b_G(IDX, W, TOK(n + 3), lane);
            p8b_step(F, mb, Vj, TOK(n + 2), sA, sB, TOK(n + 1), j, lane, c, g, n + 1 < nt);
            asm volatile("" ::: "memory");
        } }
#undef TOK
}
__device__ __forceinline__ void p8c_final(Frame& F) {
    const float* SS = (const float*)(F.ws + WS_SS); const float* gf = F.in[IN_GF]; const int lane = F.lane;
    f32x4 gv[4];
#pragma unroll
    for (int q = 0; q < 4; ++q) gv[q] = *(const f32x4*)(gf + 4 * lane + 256 * q);
    for (int t = blockIdx.x * NWAVES + F.wave; t < M; t += F.G * NWAVES) {
        float s = 0.f;
#pragma unroll
        for (int j = 0; j < 8; ++j) s += SS[(size_t)j * M + t];
        const float rstd = 1.0f / sqrtf(s * (1.f / D) + EPS);
        const GAS v2u* xr = (const GAS v2u*)((const bf16*)(F.ws + WS_X1) + (size_t)t * D) + lane; GAS f32x4* yr = (GAS f32x4*)(F.out + (size_t)t * D) + lane;
#pragma unroll
        for (int q = 0; q < 4; ++q) { const v2u w = __builtin_nontemporal_load(xr + 64 * q); __builtin_nontemporal_store((f32x4){bflo(w.x), bfhi(w.x), bflo(w.y), bfhi(w.y)} * rstd * gv[q], yr + 64 * q); }
    }
}

struct Args { const float* in[20]; float* out; unsigned char* ws; int ph_lo, ph_hi, li, pad; };
__global__ void __launch_bounds__(NWAVES * 64, 2) skel_fwd(Args args) {
    extern __shared__ __attribute__((aligned(16))) unsigned char lds[];
    Frame F;
    F.lds = (LAS unsigned char*)lds;
    F.MISC = (volatile LAS unsigned*)(F.lds + MISC_OFF);
    F.tid = threadIdx.x; F.lane = F.tid & 63; F.wave = __builtin_amdgcn_readfirstlane(F.tid >> 6);
    F.G = gridDim.x; { const int bx = blockIdx.x; F.vcu = (F.G % 8 == 0) ? (bx % 8) * (F.G / 8) + bx / 8 : bx; }
    F.ws = args.ws; F.out = args.out;
#pragma unroll
    for (int i = 0; i < 20; ++i) F.in[i] = args.in[i];
    F.ctl = (gu32*)(args.ws + WS_CTL);
    for (int u = F.tid; u < (LDS_BYTES - LDSCTL_OFF) / 4; u += NWAVES * 64) ((LAS unsigned*)(F.lds + LDSCTL_OFF))[u] = 0u;
    __syncthreads();
    XcdBarrier bar; bar.bar = (unsigned*)(F.ctl + CW_BAR); bar.x = 0; bar.st = nullptr;
    if (N_LAUNCHES == 1) bar = xcd_barrier_post((unsigned*)(F.ctl + CW_BAR), F.MISC + 8);
#define GRID_BAR() do { if (N_LAUNCHES == 1) xcd_barrier(bar); } while (0)
    const int lo = args.ph_lo, hi = args.ph_hi;
#define IN(k) (lo <= (k) && (k) < hi)
    bf16* const H = (bf16*)(args.ws + WS_H); bf16* const PROJ = (bf16*)(args.ws + WS_PROJ); bf16* const MIX = (bf16*)(args.ws + WS_MIX);

    if (IN(0)) { p0_prologue(F); GRID_BAR(); }
    if (IN(1)) { p1_hpass(F); GRID_BAR(); }
    if (IN(2)) {
        pg8::Gemm g{(const bf16*)(args.ws + WS_H8), (const bf16*)(args.ws + WS_WIN), M, IN_W, D / 2}; pg8::StaticOrder S; S.init(M, IN_W, F.G, (int)blockIdx.x);
        pg8::EpiI8Bf16 E{PROJ, IN_W, (const float*)(args.ws + WS_HS), 1.f / WQ_SCALE, F.in[IN_BIN]};
        pg8::gemm_phase<pg8::EpiI8Bf16, pg8::StaticOrder, true, true, true>(F.lds + RING_OFF, g, S, E);
        GRID_BAR();
    }
    if (IN(3)) { p3_mixer(F); GRID_BAR(); }
    if (IN(4)) {
        pg8::Gemm g{MIX, (const bf16*)(args.ws + WS_WOUT), M, D, D}; pg8::StaticOrder S; S.init(M, D, F.G, (int)blockIdx.x);
        pg8::EpiResGate E{F.in[IN_X], (bf16*)(args.ws + WS_X1), D, F.in[IN_BOUT], (const float*)(args.ws + WS_ADA), ADA_W, 2 * D, SEQ / 256};
        pg8::gemm_phase<pg8::EpiResGate, pg8::StaticOrder, true, true>(F.lds + RING_OFF, g, S, E);
        GRID_BAR();
    }
    if (IN(5)) { p5_h2pass(F); GRID_BAR(); }
    if (IN(6)) {
        pg8::Gemm g{(const bf16*)(args.ws + WS_H8), (const bf16*)(args.ws + WS_WQ), M, QW, D / 2}; pg8::StaticOrder S; S.init(M, QW, F.G, (int)blockIdx.x);
        pg8::EpiI8Bf16 E{PROJ, QW, (const float*)(args.ws + WS_HS), 1.f / WQ_SCALE, nullptr};
        pg8::gemm_phase<pg8::EpiI8Bf16, pg8::StaticOrder, true, true, true>(F.lds + RING_OFF, g, S, E);
        GRID_BAR();
    }
    if (IN(7)) { p7_routing(F); GRID_BAR(); }
    if (IN(8)) { p8a_udots(F); GRID_BAR(); }
    if (IN(9)) { p8w_weights(F); GRID_BAR(); }
    if (IN(10)) { p8b_vsum(F); GRID_BAR(); }
    if (IN(11)) { p8c_final(F); }
#undef IN
}

extern "C" void kernel_launch(void* const* d_in, const int* in_sizes, int n_in, void* d_out, int out_size, void* d_ws, size_t ws_size, hipStream_t stream) {
    static int grid = 0;
    if (grid == 0) {
        if (n_in != 20 || in_sizes[0] != M * D || out_size != M * D || ws_size < WS_END) { fprintf(stderr, "kernel_launch: unexpected shapes (n_in %d, in0 %d, out %d, ws %zu); nothing launched\n", n_in, n_in > 0 ? in_sizes[0] : -1, out_size, ws_size); grid = -1; return; }
        int dev = 0, cus = 0, per_cu = 0;
        if (hipGetDevice(&dev) != hipSuccess || hipDeviceGetAttribute(&cus, hipDeviceAttributeMultiprocessorCount, dev) != hipSuccess) { fprintf(stderr, "kernel_launch: device query failed\n"); grid = -1; return; }
        if (hipFuncSetAttribute((const void*)skel_fwd, hipFuncAttributeMaxDynamicSharedMemorySize, LDS_BYTES) != hipSuccess) { fprintf(stderr, "kernel_launch: hipFuncSetAttribute failed\n"); grid = -1; return; }
        if (hipOccupancyMaxActiveBlocksPerMultiprocessor(&per_cu, (const void*)skel_fwd, NWAVES * 64, LDS_BYTES) != hipSuccess || per_cu < 1)
            fprintf(stderr, "kernel_launch: note: occupancy query reports %d workgroups per CU\n", per_cu);
        (void)hipGetLastError();
        grid = cus;
    }
    if (grid < 0) return;
    if (hipMemsetAsync((char*)d_ws + WS_CTL, 0, CTL_ZERO_BYTES, stream) != hipSuccess) { fprintf(stderr, "kernel_launch: hipMemsetAsync failed\n"); return; }
    Args a{};
    for (int i = 0; i < 20; ++i) a.in[i] = (const float*)d_in[i];
    a.out = (float*)d_out; a.ws = (unsigned char*)d_ws;
    for (int li = 0; li < N_LAUNCHES; ++li) {
        a.ph_lo = (N_LAUNCHES == 1) ? 0 : li; a.ph_hi = (N_LAUNCHES == 1) ? NPHASES : li + 1; a.li = li;
        hipLaunchKernelGGL(skel_fwd, dim3(grid), dim3(NWAVES * 64), LDS_BYTES, stream, a);
        const hipError_t le = hipPeekAtLastError();
        if (le != hipSuccess) { fprintf(stderr, "kernel_launch: launch %d failed: %s\n", li, hipGetErrorName(le)); break; }
    }
}
```

```cpp
#include <hip/hip_runtime.h>
#include <cstdio>
#include <cstdint>
#include <cmath>
namespace pg8 {
#define PG8_LAS __attribute__((address_space(3)))
typedef unsigned short bf16_t;
typedef short bf16x8 __attribute__((ext_vector_type(8)));
typedef float f32x4 __attribute__((ext_vector_type(4)));
typedef unsigned u32x4 __attribute__((ext_vector_type(4)));
constexpr int BM = 256, BK = 64, HALF = 128, HTB = HALF * BK * 2  , STAGE_BYTES = 8 * HTB, NXCD = 8, WGM = 8;

__host__ __device__ __forceinline__ int lds_byte(int r, int c) { const int st = (r >> 4) * 2 + (c >> 5), rr = r & 15, cc = c & 31, ob = rr * 64 + cc * 2; return st * 1024 + (ob ^ (((ob >> 9) & 1) << 5)); }
__host__ __device__ __forceinline__ void stage_rc(int b, int& R, int& C) { const int st = b / 1024, sb = b % 1024, swz = sb ^ (((sb >> 9) & 1) << 5); R = (st >> 1) * 16 + swz / 64; C = (st & 1) * 32 + (swz % 64) / 2; }
__host__ __device__ __forceinline__ int perm32(int rho) { const int n = rho >> 4, i = rho & 15; return 8 * (i >> 2) + 4 * n + (i & 3); }

struct Unit { int pm, pn; };
struct Gemm { const bf16_t* A; const bf16_t* Bt; int M, N, K; };

struct StaticOrder {
    int nM, nN, nwg, G, c;
    __host__ __device__ void init(int M, int N, int G_, int c_) { nM = M / BM; nN = N / BM; nwg = nM * nN; G = G_; c = c_; }
    __host__ __device__ bool next(int i, Unit& u) const {
        const long L = (long)i * G + c; if (L >= nwg) return false;
        int wgid = (int)L; { const int q = nwg / NXCD, r = nwg % NXCD, xcd = wgid % NXCD, off = wgid / NXCD; wgid = (xcd < r ? xcd * (q + 1) : r * (q + 1) + (xcd - r) * q) + off; }
        const int nig = WGM * nN, gid = wgid / nig, fm = gid * WGM, gsz = (nM - fm) < WGM ? (nM - fm) : WGM;
        u.pm = fm + ((wgid % nig) % gsz); u.pn = (wgid % nig) / gsz; return true;
    }
    __device__ __forceinline__ void a_ready(const Unit&) const {}
    __device__ __forceinline__ void done(const Unit&) const {}
};

__device__ __forceinline__ unsigned cvt_pk_bf16(float lo, float hi) { unsigned r; asm volatile("v_cvt_pk_bf16_f32 %0, %1, %2" : "=v"(r) : "v"(lo), "v"(hi)); return r; }
typedef float f32x2 __attribute__((ext_vector_type(2)));
__device__ __forceinline__ f32x2 gelu_pk(f32x2 v) {
    const f32x2 av = __builtin_elementwise_abs(v), d = av * 0.2316418882f + 1.0f;
    f32x2 t; t.x = __builtin_amdgcn_rcpf(d.x); t.y = __builtin_amdgcn_rcpf(d.y);
    f32x2 q = t * 0.5307027145f + (-0.7265760135f); q = q * t + 0.7107068705f; q = q * t + (-0.142248368f); q = q * t + 0.127414796f; q = q * t;
    const f32x2 s = (v * v) * (-0.72134752044f);
    f32x2 e; e.x = __builtin_amdgcn_exp2f(s.x); e.y = __builtin_amdgcn_exp2f(s.y);
    const f32x2 m = v * (q * e), r = v - m;
    f32x2 o; o.x = v.x < 0.f ? m.x : r.x; o.y = v.y < 0.f ? m.y : r.y; return o;
}

template <int ACT  > struct EpiBf16 {
    static constexpr bool PERM = true, AFTER_DRAIN = false; static_assert(ACT == 0 || ACT == 1, "EpiBf16: ACT is 0 (none) or 1 (gelu_pk)");
    bf16_t* O; int ldc; const float* bias; int split_cols; size_t split_stride; float scale0;
    __device__ __forceinline__ void operator()(const f32x4 (&acc)[2][2][4][2], const Unit& u, int wr, int wc, int fr, int fq) const {
        const int row0 = u.pm * BM + wr * 64 + fr; int colt = u.pn * BM; bf16_t* base = O;
        float sc = 1.f; if (split_cols) { const int t = colt / split_cols; base += (size_t)t * split_stride; colt -= t * split_cols; if (t == 0) sc = scale0; }
        const int col0 = colt + wc * 32 + 8 * fq, bcol0 = u.pn * BM + wc * 32 + 8 * fq;
        f32x4 bv[2][2];
#pragma unroll
        for (int bj = 0; bj < 2; ++bj)
#pragma unroll
            for (int n = 0; n < 2; ++n) bv[bj][n] = bias ? *(const f32x4*)(bias + bcol0 + bj * HALF + 4 * n) : (f32x4){0.f, 0.f, 0.f, 0.f};
#pragma unroll
        for (int ai = 0; ai < 2; ++ai)
#pragma unroll
            for (int m = 0; m < 4; ++m) { bf16_t* rowp = base + (size_t)(row0 + ai * HALF + m * 16) * ldc + col0;
#pragma unroll
                for (int bj = 0; bj < 2; ++bj) { f32x4 v0 = acc[ai][bj][m][0] + bv[bj][0], v1 = acc[ai][bj][m][1] + bv[bj][1];
                    if (ACT == 1) { f32x2 a = gelu_pk((f32x2){v0[0], v0[1]}), b = gelu_pk((f32x2){v0[2], v0[3]}), c = gelu_pk((f32x2){v1[0], v1[1]}), d = gelu_pk((f32x2){v1[2], v1[3]});
                        v0 = (f32x4){a.x, a.y, b.x, b.y}; v1 = (f32x4){c.x, c.y, d.x, d.y}; }
                    v0 = v0 * sc; v1 = v1 * sc; u32x4 w; w.x = cvt_pk_bf16(v0[0], v0[1]); w.y = cvt_pk_bf16(v0[2], v0[3]); w.z = cvt_pk_bf16(v1[0], v1[1]); w.w = cvt_pk_bf16(v1[2], v1[3]);
                    *(u32x4*)(rowp + bj * HALF) = w; } }
    }
};

typedef unsigned u32x2 __attribute__((ext_vector_type(2)));
struct EpiResGate {
    static constexpr bool PERM = false, AFTER_DRAIN = false;
    const float* x; bf16_t* out; int ldc; const float* bias; const float* ada; int ada_ld, gate_off, tiles_per_batch;
    __device__ __forceinline__ void operator()(const f32x4 (&acc)[2][2][4][2], const Unit& u, int wr, int wc, int fr, int fq) const {
        const int row0 = u.pm * BM + wr * 64 + fr, col0 = u.pn * BM + wc * 32 + 4 * fq;
        const float* gp = ada + (size_t)(u.pm / tiles_per_batch) * ada_ld + gate_off;
        f32x4 bv[2][2], gv[2][2];
#pragma unroll
        for (int bj = 0; bj < 2; ++bj)
#pragma unroll
            for (int n = 0; n < 2; ++n) { bv[bj][n] = *(const f32x4*)(bias + col0 + bj * HALF + n * 16); gv[bj][n] = *(const f32x4*)(gp + col0 + bj * HALF + n * 16); }
#pragma unroll
        for (int ai = 0; ai < 2; ++ai) {
            f32x4 xv[4][2][2];
#pragma unroll
            for (int m = 0; m < 4; ++m) { const size_t off = (size_t)(row0 + ai * HALF + m * 16) * ldc + col0;
#pragma unroll
                for (int bj = 0; bj < 2; ++bj)
#pragma unroll
                    for (int n = 0; n < 2; ++n) xv[m][bj][n] = __builtin_nontemporal_load((const f32x4*)(x + off + bj * HALF + n * 16)); }
#pragma unroll
            for (int m = 0; m < 4; ++m) { const size_t off = (size_t)(row0 + ai * HALF + m * 16) * ldc + col0;
#pragma unroll
                for (int bj = 0; bj < 2; ++bj)
#pragma unroll
                    for (int n = 0; n < 2; ++n) { const f32x4 o = xv[m][bj][n] + gv[bj][n] * (acc[ai][bj][m][n] + bv[bj][n]);
                        u32x2 w; w.x = cvt_pk_bf16(o[0], o[1]); w.y = cvt_pk_bf16(o[2], o[3]); *(u32x2*)(out + off + bj * HALF + n * 16) = w; } }
            asm volatile("" ::: "memory"); }
    }
};


typedef int i32x4 __attribute__((ext_vector_type(4)));
template <bool I8> struct AccSel { typedef f32x4 type; static __device__ __forceinline__ f32x4 zero() { return (f32x4){0.f, 0.f, 0.f, 0.f}; } };
template <> struct AccSel<true> { typedef i32x4 type; static __device__ __forceinline__ i32x4 zero() { return (i32x4){0, 0, 0, 0}; } };
template <bool I8> __device__ __forceinline__ typename AccSel<I8>::type mma16(bf16x8 a, bf16x8 b, typename AccSel<I8>::type c) {
    if constexpr (I8) return __builtin_amdgcn_mfma_i32_16x16x64_i8(__builtin_bit_cast(i32x4, a), __builtin_bit_cast(i32x4, b), c, 0, 0, 0);
    else return __builtin_amdgcn_mfma_f32_16x16x32_bf16(a, b, c, 0, 0, 0);
}
struct EpiI8Bf16 {
    static constexpr bool PERM = true, AFTER_DRAIN = false;
    bf16_t* O; int ldc; const float* rowscale; float wscale; const float* bias;
    __device__ __forceinline__ void operator()(const i32x4 (&acc)[2][2][4][2], const Unit& u, int wr, int wc, int fr, int fq) const {
        const int row0 = u.pm * BM + wr * 64 + fr, col0 = u.pn * BM + wc * 32 + 8 * fq;
        f32x4 bv[2][2];
#pragma unroll
        for (int bj = 0; bj < 2; ++bj)
#pragma unroll
            for (int n = 0; n < 2; ++n) bv[bj][n] = bias ? *(const f32x4*)(bias + col0 + bj * HALF + 4 * n) : (f32x4){0.f, 0.f, 0.f, 0.f};
#pragma unroll
        for (int ai = 0; ai < 2; ++ai)
#pragma unroll
            for (int m = 0; m < 4; ++m) { const int row = row0 + ai * HALF + m * 16; const float sc = rowscale[row] * wscale; bf16_t* rowp = O + (size_t)row * ldc + col0;
#pragma unroll
                for (int bj = 0; bj < 2; ++bj) { const i32x4 a0 = acc[ai][bj][m][0], a1 = acc[ai][bj][m][1]; const f32x4 b0 = bv[bj][0], b1 = bv[bj][1];
                    u32x4 w; w.x = cvt_pk_bf16((float)a0[0] * sc + b0[0], (float)a0[1] * sc + b0[1]); w.y = cvt_pk_bf16((float)a0[2] * sc + b0[2], (float)a0[3] * sc + b0[3]);
                    w.z = cvt_pk_bf16((float)a1[0] * sc + b1[0], (float)a1[1] * sc + b1[1]); w.w = cvt_pk_bf16((float)a1[2] * sc + b1[2], (float)a1[3] * sc + b1[3]);
                    *(u32x4*)(rowp + bj * HALF) = w; } }
    }
};
template <class Epi, class Sched, bool ALIGN_EPI = false, bool SP2 = false, bool I8 = false>
__device__ __forceinline__ void gemm_phase(PG8_LAS unsigned char* lds, const Gemm g, const Sched& S, const Epi& E) {
    const int tid = threadIdx.x, wid = __builtin_amdgcn_readfirstlane(tid >> 6), lane = tid & 63, wr = wid >> 2, wc = wid & 3, fr = lane & 15, fq = lane >> 4;
    const int K = g.K, nt = K / BK;
    unsigned voffA[2], voffB[2];
#pragma unroll
    for (int i = 0; i < 2; ++i) { int R, C; stage_rc(tid * 16 + i * 8192, R, C); const int Rb = Epi::PERM ? ((R & ~31) + perm32(R & 31)) : R;
        voffA[i] = (unsigned)(R * K + C) * 2u; voffB[i] = (unsigned)(Rb * K + C) * 2u; }
    const size_t kstep = (size_t)(BK * 2);
    const size_t hstep = (size_t)HALF * K * 2;
    const size_t tstep = 2 * hstep;
    const unsigned ldsw = (unsigned)wid * 1024u;
    const int aoff = lds_byte(wr * 64 + fr, fq * 8), boff = lds_byte(wc * 32 + fr, fq * 8);
#define PG8_SA(b, h) (((b) * 2 + (h)) * HTB)
#define PG8_SB(b, h) ((4 + (b) * 2 + (h)) * HTB)
#define PG8_STAGE(bufoff, gbase, voff) do { _Pragma("unroll") for (int _i = 0; _i < 2; ++_i) \
        __builtin_amdgcn_global_load_lds((const unsigned*)((const char*)(gbase) + (voff)[_i]), (PG8_LAS unsigned*)(lds + (bufoff) + ldsw + _i * 8192), 16, 0, 0); } while (0)
#define PG8_LDA(dst, b, h) do { _Pragma("unroll") for (int m = 0; m < 4; ++m) _Pragma("unroll") for (int k = 0; k < 2; ++k) dst[m][k] = *(const PG8_LAS bf16x8*)(lds + PG8_SA(b, h) + aoff + m * 2048 + k * 1024); } while (0)
#define PG8_LDB(dst, b, h) do { _Pragma("unroll") for (int n = 0; n < 2; ++n) _Pragma("unroll") for (int k = 0; k < 2; ++k) dst[n][k] = *(const PG8_LAS bf16x8*)(lds + PG8_SB(b, h) + boff + n * 2048 + k * 1024); } while (0)
#define PG8_MMA(ai, bj, At, Bt) do { __builtin_amdgcn_s_setprio(1); _Pragma("unroll") for (int m = 0; m < 4; ++m) _Pragma("unroll") for (int n = 0; n < 2; ++n) _Pragma("unroll") for (int k = 0; k < 2; ++k) \
        acc[ai][bj][m][n] = mma16<I8>(Bt[n][k], At[m][k], acc[ai][bj][m][n]); __builtin_amdgcn_s_setprio(0); } while (0)
#define PG8_WAIT_V(n) asm volatile("s_waitcnt vmcnt(" #n ")" ::: "memory")
#define PG8_WAIT_L(n) asm volatile("s_waitcnt lgkmcnt(" #n ")" ::: "memory")
#define PG8_BAR __builtin_amdgcn_s_barrier()
#define PG8_SCHED __builtin_amdgcn_sched_barrier(0)
    Unit cur, nxt; int ui = 0;
    if (!S.next(0, cur)) return;
    typedef typename AccSel<I8>::type acc_t;
    acc_t acc[2][2][4][2];
#pragma unroll
    for (int a = 0; a < 2; ++a)
#pragma unroll
        for (int b = 0; b < 2; ++b)
#pragma unroll
            for (int m = 0; m < 4; ++m)
#pragma unroll
                for (int n = 0; n < 2; ++n) acc[a][b][m][n] = AccSel<I8>::zero();
    bf16x8 At[4][2], B0[2][2], B1[2][2];
    const char* cA = (const char*)g.A + (size_t)cur.pm * tstep; const char* cB = (const char*)g.Bt + (size_t)cur.pn * tstep;
    S.a_ready(cur);
    if constexpr (SP2) {
        PG8_STAGE(PG8_SB(0, 0), cB, voffB); PG8_STAGE(PG8_SB(0, 1), cB + hstep, voffB); PG8_STAGE(PG8_SA(0, 0), cA, voffA); PG8_STAGE(PG8_SA(0, 1), cA + hstep, voffA);
        if (wr == 1) PG8_BAR;
        PG8_WAIT_V(2); PG8_BAR;
        PG8_STAGE(PG8_SB(1, 0), cB + kstep, voffB); PG8_STAGE(PG8_SA(1, 0), cA + kstep, voffA); PG8_STAGE(PG8_SB(1, 1), cB + hstep + kstep, voffB);
        PG8_WAIT_V(6); PG8_BAR;
    } else {
        PG8_STAGE(PG8_SB(0, 0), cB, voffB); PG8_STAGE(PG8_SA(0, 0), cA, voffA); PG8_STAGE(PG8_SB(0, 1), cB + hstep, voffB); PG8_STAGE(PG8_SA(0, 1), cA + hstep, voffA);
        if (wr == 1) PG8_BAR;
        PG8_WAIT_V(4); PG8_BAR;
        PG8_STAGE(PG8_SB(1, 0), cB + kstep, voffB); PG8_STAGE(PG8_SA(1, 0), cA + kstep, voffA); PG8_STAGE(PG8_SB(1, 1), cB + hstep + kstep, voffB);
        PG8_WAIT_V(6); PG8_BAR;
    }
    for (;;) {
        const bool has_next = S.next(ui + 1, nxt);
        const char* nA = has_next ? (const char*)g.A + (size_t)nxt.pm * tstep : cA; const char* nB = has_next ? (const char*)g.Bt + (size_t)nxt.pn * tstep : cB;
        for (int t = 0; t < nt; t += 2) {
            const bool last = (t == nt - 2);
            const char* a1 = cA + (size_t)(t + 1) * kstep;
            const char* a2 = last ? nA : cA + (size_t)(t + 2) * kstep; const char* b2 = last ? nB : cB + (size_t)(t + 2) * kstep;
            const char* a3 = a2 + kstep; const char* b3 = b2 + kstep;
            if (last && has_next) S.a_ready(nxt);
            if constexpr (SP2) {
            PG8_LDB(B0, 0, 0); PG8_LDB(B1, 0, 1); PG8_SCHED; PG8_LDA(At, 0, 0); PG8_STAGE(PG8_SA(1, 1), a1 + hstep, voffA);
            PG8_WAIT_V(8); PG8_WAIT_L(0); PG8_BAR; PG8_MMA(0, 0, At, B0); PG8_MMA(0, 1, At, B1); PG8_BAR; PG8_SCHED;
            PG8_LDA(At, 0, 1); PG8_STAGE(PG8_SB(0, 0), b2, voffB); PG8_STAGE(PG8_SB(0, 1), b2 + hstep, voffB); PG8_STAGE(PG8_SA(0, 0), a2, voffA);
            PG8_WAIT_V(8); PG8_WAIT_L(0); PG8_BAR; PG8_MMA(1, 0, At, B0); PG8_MMA(1, 1, At, B1); PG8_BAR; PG8_SCHED;
            PG8_LDB(B0, 1, 0); PG8_LDB(B1, 1, 1); PG8_SCHED; PG8_LDA(At, 1, 0); PG8_STAGE(PG8_SA(0, 1), a2 + hstep, voffA);
            PG8_WAIT_V(8); PG8_WAIT_L(0); PG8_BAR; PG8_MMA(0, 0, At, B0); PG8_MMA(0, 1, At, B1); PG8_BAR; PG8_SCHED;
            PG8_LDA(At, 1, 1); PG8_STAGE(PG8_SB(1, 0), b3, voffB); PG8_STAGE(PG8_SB(1, 1), b3 + hstep, voffB); PG8_STAGE(PG8_SA(1, 0), a3, voffA);
            PG8_WAIT_V(8); PG8_WAIT_L(0); PG8_BAR; PG8_MMA(1, 0, At, B0); PG8_MMA(1, 1, At, B1); PG8_BAR; PG8_SCHED;
            } else {
            PG8_LDB(B0, 0, 0); PG8_SCHED; PG8_LDA(At, 0, 0); PG8_STAGE(PG8_SA(1, 1), a1 + hstep, voffA);
            PG8_WAIT_L(8); PG8_BAR; PG8_WAIT_L(0); PG8_MMA(0, 0, At, B0); PG8_BAR; PG8_SCHED;
            PG8_LDB(B1, 0, 1); PG8_STAGE(PG8_SB(0, 0), b2, voffB);
            PG8_BAR; PG8_WAIT_L(0); PG8_MMA(0, 1, At, B1); PG8_BAR;
            PG8_LDA(At, 0, 1); PG8_STAGE(PG8_SA(0, 0), a2, voffA);
            PG8_BAR; PG8_WAIT_L(0); PG8_MMA(1, 0, At, B0); PG8_BAR; PG8_SCHED;
            PG8_STAGE(PG8_SB(0, 1), b2 + hstep, voffB);
            PG8_WAIT_V(6); PG8_BAR; PG8_MMA(1, 1, At, B1); PG8_BAR;
            PG8_LDB(B0, 1, 0); PG8_SCHED; PG8_LDA(At, 1, 0); PG8_STAGE(PG8_SA(0, 1), a2 + hstep, voffA);
            PG8_WAIT_L(8); PG8_BAR; PG8_WAIT_L(0); PG8_MMA(0, 0, At, B0); PG8_BAR; PG8_SCHED;
            PG8_LDB(B1, 1, 1); PG8_STAGE(PG8_SB(1, 0), b3, voffB);
            PG8_BAR; PG8_WAIT_L(0); PG8_MMA(0, 1, At, B1); PG8_BAR;
            PG8_LDA(At, 1, 1); PG8_STAGE(PG8_SA(1, 0), a3, voffA);
            PG8_BAR; PG8_WAIT_L(0); PG8_MMA(1, 0, At, B0); PG8_BAR; PG8_SCHED;
            PG8_STAGE(PG8_SB(1, 1), b3 + hstep, voffB);
            PG8_WAIT_V(6); PG8_BAR; PG8_MMA(1, 1, At, B1); PG8_BAR;
            }
        }
        if constexpr (ALIGN_EPI) { if (wr == 0) PG8_BAR; }
        if constexpr (!Epi::AFTER_DRAIN) { E(acc, cur, wr, wc, fr, fq); S.done(cur); }
        if (!has_next) break;
#pragma unroll
        for (int a = 0; a < 2; ++a)
#pragma unroll
            for (int b = 0; b < 2; ++b)
#pragma unroll
                for (int m = 0; m < 4; ++m)
#pragma unroll
                    for (int n = 0; n < 2; ++n) acc[a][b][m][n] = AccSel<I8>::zero();
        cur = nxt; cA = nA; cB = nB; ++ui;
        if constexpr (ALIGN_EPI) { if (wr == 1) PG8_BAR; }
    }
    PG8_WAIT_V(0);
    if constexpr (!ALIGN_EPI) { if (wr == 0) PG8_BAR; }
    PG8_BAR;
    if constexpr (Epi::AFTER_DRAIN) { E.fused(acc, cur, wr, wc, fr, fq, lds, wid, lane); S.done(cur); }
#undef PG8_SA
#undef PG8_SB
#undef PG8_STAGE
#undef PG8_LDA
#undef PG8_LDB
#undef PG8_MMA
#undef PG8_WAIT_V
#undef PG8_WAIT_L
#undef PG8_BAR
#undef PG8_SCHED
}
}

constexpr int NWAVES = 8;
constexpr int NPHASES = 12;
#ifndef MK_N_LAUNCHES
#define MK_N_LAUNCHES 1
#endif
constexpr int N_LAUNCHES = MK_N_LAUNCHES;
static_assert(N_LAUNCHES == 1 || N_LAUNCHES == NPHASES, "MK_N_LAUNCHES is 1 or NPHASES");

constexpr int BATCH = 16, SEQ = 2048, D = 1024, M = BATCH * SEQ;
constexpr int IN_W = 2304, O_Q = 0, O_K = 512, O_V = 640, O_B = 768, O_C = 1280, O_U = 1792;
constexpr int NQH = 8, NKVH = 2, HD = 64, WIN = 128;
constexpr int NKEYS = 128, NEXP = 16384, PH = 8, TOPK = 16, DKEY = 256, DHALF = 128, QW = PH * DKEY;
constexpr int ADA_W = 6 * D, ADA_KC = 8;
constexpr float EPS = 1e-6f;

constexpr size_t MiB = 1u << 20;
constexpr size_t WS_CTL = 0, CTL_ZERO_BYTES = 64 * 1024;
constexpr size_t WS_ADAP = 1 * MiB;
constexpr size_t WS_ADA = 4 * MiB;
constexpr size_t WS_WIN = 5 * MiB;
constexpr size_t WS_WOUT = 10 * MiB;
constexpr size_t WS_WQ = 12 * MiB;
constexpr size_t WS_K1 = 16 * MiB, WS_K2 = 16 * MiB + 512 * 1024;
constexpr size_t WS_U = 17 * MiB, WS_V = 33 * MiB;
constexpr float U_SCALE = 896.f, V_SCALE = 8.f, WQ_SCALE = 896.f;
constexpr size_t WS_H = 81 * MiB;
constexpr size_t WS_PROJ = 145 * MiB;
constexpr size_t WS_MIX = 289 * MiB;
constexpr size_t WS_IDX = 353 * MiB;
constexpr size_t WS_GATE = 369 * MiB;
constexpr size_t WS_H8 = 49 * MiB;
constexpr size_t WS_HS = 393 * MiB;
constexpr size_t WS_W16 = 385 * MiB;
constexpr size_t WS_X1 = 417 * MiB;
constexpr size_t WS_END = 481 * MiB;
constexpr size_t WS_PA = WS_PROJ;
constexpr size_t WS_SS = WS_MIX;
constexpr int CW_BAR = 4096;
static_assert((CW_BAR + 3456) * 4 <= (int)CTL_ZERO_BYTES, "barrier words inside the zeroed region");

constexpr int RING_OFF = 0, RING_BYTES = 131072;
constexpr int LDSCTL_OFF = 135168, MISC_OFF = LDSCTL_OFF + 320;
constexpr int LDS_BYTES = 147456;
static_assert(MISC_OFF + 128 <= LDS_BYTES, "LDS map");

#define GAS __attribute__((address_space(1)))
#define LAS __attribute__((address_space(3)))
typedef unsigned short bf16;
typedef unsigned v4u __attribute__((ext_vector_type(4)));
typedef float f32x4 __attribute__((ext_vector_type(4)));
typedef short bf16x8 __attribute__((ext_vector_type(8)));
typedef GAS unsigned gu32;
typedef GAS unsigned long long gu64;
#define RLX_AGENT __ATOMIC_RELAXED, __HIP_MEMORY_SCOPE_AGENT
#define LDS_WAIT() asm volatile("s_waitcnt lgkmcnt(0)" ::: "memory")
#define VM_WAIT() asm volatile("s_waitcnt vmcnt(0)" ::: "memory")
__device__ __forceinline__ unsigned long long rt() { return __builtin_amdgcn_s_memrealtime(); }
__device__ __forceinline__ unsigned f2bf(float f) { unsigned u = __builtin_bit_cast(unsigned, f); return (u + 0x7fffu + ((u >> 16) & 1u)) >> 16; }
__device__ __forceinline__ unsigned pk2(float lo, float hi) { return f2bf(lo) | (f2bf(hi) << 16); }

#define XB_TMO      128
#define XB_XCNT(j)  (256  + 64 * (j))
#define XB_XSUB(j)  (1280 + 64 * (j))
#define XB_XGEN(j)  (2304 + 64 * (j))
#define XB_TOP      3328
#define XB_TOPGEN   3392
#define XCD_BAR_WORDS 3456
#define XB_SPIN_CAP (1u << 22)

__device__ __forceinline__ unsigned xb_ld(unsigned* p)              { return __hip_atomic_load(p, __ATOMIC_RELAXED, __HIP_MEMORY_SCOPE_AGENT); }
__device__ __forceinline__ unsigned xb_add(unsigned* p, unsigned v) { return __hip_atomic_fetch_add(p, v, __ATOMIC_RELAXED, __HIP_MEMORY_SCOPE_AGENT); }
__device__ __forceinline__ unsigned xb_xcc_id() { return (unsigned)__builtin_amdgcn_s_getreg((3 << 11) | 20) & 0xFu; }
#define XB_SPIN(cond, bar) do { unsigned _sp = 0; while (cond) { __builtin_amdgcn_s_sleep(1); \
    if ((++_sp & 255u) == 0u) { if (xb_ld(&(bar)[XB_TMO])) break; if (_sp > XB_SPIN_CAP) { atomicAdd(&(bar)[XB_TMO], 1u); break; } } } } while (0)

struct XcdBarrier {
    unsigned* bar; unsigned x;
    volatile LAS unsigned* st;
};

__device__ __forceinline__ XcdBarrier xcd_barrier_post(unsigned* bar, volatile LAS unsigned* st) {
    XcdBarrier b; b.bar = bar; b.x = xb_xcc_id(); b.st = st;
    if (threadIdx.x == 0) (void)xb_add(&bar[XB_XCNT(b.x)], 1u);
    return b;
}
__device__ __forceinline__ void xcd_barrier_complete(unsigned* bar, unsigned x, unsigned& nloc, unsigned& nx) {
    const unsigned G = gridDim.x * gridDim.y * gridDim.z;
    unsigned sum, cnt, mine, sp = 0u;
    for (;;) {
        sum = 0u; cnt = 0u; mine = 0u;
#pragma unroll
        for (unsigned j = 0; j < 16; ++j) { const unsigned c = xb_ld(&bar[XB_XCNT(j)]); sum += c; cnt += (c > 0u) ? 1u : 0u; mine = (j == x) ? c : mine; }
        if (sum == G) break;
        __builtin_amdgcn_s_sleep(1);
        if ((++sp & 255u) == 0u) { if (xb_ld(&bar[XB_TMO])) break; if (sp > XB_SPIN_CAP) { atomicAdd(&bar[XB_TMO], 1u); break; } }
    }
    nloc = mine > 0u ? mine : 1u; nx = cnt > 0u ? cnt : 1u;
}

__device__ __forceinline__ void xcd_barrier(const XcdBarrier& b) {
    asm volatile("s_waitcnt vmcnt(0)" ::: "memory");
    __syncthreads();
    if (threadIdx.x == 0) {
        unsigned* bar = b.bar;
        __builtin_amdgcn_s_waitcnt(0);
        unsigned nloc = b.st[0], nx = b.st[1];
        if (nloc == 0u) { xcd_barrier_complete(bar, b.x, nloc, nx); b.st[0] = nloc; b.st[1] = nx; }
        const unsigned old = xb_add(&bar[XB_XSUB(b.x)], 1u);
        const unsigned gen = old / nloc;
        if (old + 1u == (gen + 1u) * nloc) {
            __builtin_amdgcn_fence(__ATOMIC_RELEASE, "agent");
            asm volatile("s_waitcnt vmcnt(0)" ::: "memory");
            const unsigned og = xb_add(&bar[XB_TOP], 1u);
            const unsigned tg = og / nx;
            if (og + 1u == (tg + 1u) * nx) xb_add(&bar[XB_TOPGEN], 1u);
            else XB_SPIN(xb_ld(&bar[XB_TOPGEN]) == tg, bar);
            __builtin_amdgcn_fence(__ATOMIC_ACQUIRE, "agent");
            xb_add(&bar[XB_XGEN(b.x)], 1u);
            asm volatile("s_waitcnt vmcnt(0)" ::: "memory");
        } else {
            XB_SPIN(xb_ld(&bar[XB_XGEN(b.x)]) == gen, bar);
            __builtin_amdgcn_fence(__ATOMIC_ACQUIRE, "agent");
            asm volatile("s_waitcnt vmcnt(0)" ::: "memory");
        }
    }
    __syncthreads();
}

struct Frame {
    LAS unsigned char* lds;
    volatile LAS unsigned* MISC;
    gu32* ctl;
    int tid, lane, wave;
    int vcu, G;
    const float* in[20]; float* out; unsigned char* ws;
};
#define IN_X 0
#define IN_C 1
#define IN_WADA 2
#define IN_BADA 3
#define IN_G1 4
#define IN_WIN 5
#define IN_BIN 6
#define IN_SINK 7
#define IN_CONVW 8
#define IN_AOG 9
#define IN_COG 10
#define IN_WOUT 11
#define IN_BOUT 12
#define IN_G2 13
#define IN_WQ 14
#define IN_PK1 15
#define IN_PK2 16
#define IN_PU 17
#define IN_PV 18
#define IN_GF 19

typedef __bf16 bf16x2_t __attribute__((ext_vector_type(2)));
typedef unsigned v2u __attribute__((ext_vector_type(2)));
__device__ __forceinline__ float dot2(unsigned a, unsigned b, float acc) { return __builtin_amdgcn_fdot2_f32_bf16(__builtin_bit_cast(bf16x2_t, a), __builtin_bit_cast(bf16x2_t, b), acc, false); }
__device__ __forceinline__ float dot8(v4u a, v4u b, float acc) { acc = dot2(a.x, b.x, acc); acc = dot2(a.y, b.y, acc); acc = dot2(a.z, b.z, acc); acc = dot2(a.w, b.w, acc); return acc; }
__device__ __forceinline__ float bflo(unsigned w) { return __uint_as_float(w << 16); }
__device__ __forceinline__ float bfhi(unsigned w) { return __uint_as_float(w & 0xffff0000u); }
__device__ __forceinline__ float wave_sum(float v) {
#pragma unroll
    for (int o = 1; o < 64; o <<= 1) v += __shfl_xor(v, o);
    return v;
}
__device__ __forceinline__ unsigned wave_umax(unsigned v) {
#pragma unroll
    for (int o = 1; o < 64; o <<= 1) { const unsigned t = (unsigned)__shfl_xor((int)v, o); v = v > t ? v : t; }
    return v;
}
__device__ __forceinline__ unsigned f2ord(float f) { const unsigned u = __float_as_uint(f); return (u & 0x80000000u) ? ~u : (u | 0x80000000u); }
__device__ __forceinline__ float ord2f(unsigned u) { return __uint_as_float((u & 0x80000000u) ? (u & 0x7fffffffu) : ~u); }

__device__ __forceinline__ unsigned pk4_i8(f32x4 a, float sc) {
    const int q0 = max(-127, min(127, __float2int_rn(a.x * sc))), q1 = max(-127, min(127, __float2int_rn(a.y * sc))), q2 = max(-127, min(127, __float2int_rn(a.z * sc))), q3 = max(-127, min(127, __float2int_rn(a.w * sc)));
    return (unsigned)(q0 & 0xff) | ((unsigned)(q1 & 0xff) << 8) | ((unsigned)(q2 & 0xff) << 16) | ((unsigned)q3 << 24); }
__device__ __forceinline__ void p0_transpose_item(const float* W, int K, int N, bf16* WT, LAS float* scr, int item, int lane) {
    const int nblk = N / 64, kb = item / nblk, nb = item % nblk, k0 = 64 * kb, n0 = 64 * nb;
#pragma unroll 16
    for (int kk = 0; kk < 64; ++kk) scr[kk * 65 + lane] = __builtin_nontemporal_load(W + (size_t)(k0 + kk) * N + n0 + lane);
    LDS_WAIT(); asm volatile("" ::: "memory");
    const int c = lane & 7;
#pragma unroll
    for (int j = 0; j < 8; ++j) { const int n = (lane >> 3) + 8 * j; const LAS float* s = scr + (8 * c) * 65 + n;
        v4u o; o.x = pk2(s[0 * 65], s[1 * 65]); o.y = pk2(s[2 * 65], s[3 * 65]); o.z = pk2(s[4 * 65], s[5 * 65]); o.w = pk2(s[6 * 65], s[7 * 65]);
        *(GAS v4u*)(WT + (size_t)(n0 + n) * K + k0 + 8 * c) = o; }
    LDS_WAIT(); asm volatile("" ::: "memory");
}
__device__ __forceinline__ void p0_transpose_item_i8(const float* W, int K, int N, unsigned char* WT, LAS float* scr, int item, int lane, float sc) {
    const int nblk = N / 64, kb = item / nblk, nb = item % nblk, k0 = 64 * kb, n0 = 64 * nb;
#pragma unroll 16
    for (int kk = 0; kk < 64; ++kk) scr[kk * 65 + lane] = __builtin_nontemporal_load(W + (size_t)(k0 + kk) * N + n0 + lane);
    LDS_WAIT(); asm volatile("" ::: "memory");
    const int c = lane & 7;
#pragma unroll
    for (int j = 0; j < 8; ++j) { const int n = (lane >> 3) + 8 * j; const LAS float* s = scr + (8 * c) * 65 + n;
        v2u o; o.x = pk4_i8((f32x4){s[0 * 65], s[1 * 65], s[2 * 65], s[3 * 65]}, sc); o.y = pk4_i8((f32x4){s[4 * 65], s[5 * 65], s[6 * 65], s[7 * 65]}, sc);
        *(GAS v2u*)(WT + (size_t)(n0 + n) * K + k0 + 8 * c) = o; }
    LDS_WAIT(); asm volatile("" ::: "memory");
}
__device__ __forceinline__ void p0_convert_item(const float* src, bf16* dst, size_t item, int lane) {
    const GAS f32x4* s = (const GAS f32x4*)(src + item * 2048) + lane * 2;
    GAS v4u* d = (GAS v4u*)(dst + item * 2048) + lane;
#pragma unroll
    for (int j = 0; j < 4; ++j) { const f32x4 a = s[j * 128], b = s[j * 128 + 1];
        v4u o; o.x = pk2(a.x, a.y); o.y = pk2(a.z, a.w); o.z = pk2(b.x, b.y); o.w = pk2(b.z, b.w); d[j * 64] = o; }
}
__device__ __forceinline__ unsigned pk4_fp8(f32x4 a, float sc) { int w = __builtin_amdgcn_cvt_pk_fp8_f32(a.x * sc, a.y * sc, 0, false); w = __builtin_amdgcn_cvt_pk_fp8_f32(a.z * sc, a.w * sc, w, true); return (unsigned)w; }
__device__ __forceinline__ void p0_convert_item_i8(const float* src, unsigned char* dst, size_t item, int lane, float sc) {
    const GAS f32x4* s = (const GAS f32x4*)(src + item * 4096) + lane * 4;
#pragma unroll
    for (int j = 0; j < 4; ++j) { v4u o; o.x = pk4_i8(__builtin_nontemporal_load(s + j * 256), sc); o.y = pk4_i8(__builtin_nontemporal_load(s + j * 256 + 1), sc); o.z = pk4_i8(__builtin_nontemporal_load(s + j * 256 + 2), sc); o.w = pk4_i8(__builtin_nontemporal_load(s + j * 256 + 3), sc);
        *(GAS v4u*)(dst + (size_t)(lane >> 3) * NEXP * 128 + (item * 4 + j) * 128 + (lane & 7) * 16) = o; }
}
__device__ __forceinline__ void p0_convert_item_fp8(const float* src, unsigned char* dst, size_t item, int lane, float sc) {
    const GAS f32x4* s = (const GAS f32x4*)(src + item * 4096) + lane * 4;
#pragma unroll
    for (int j = 0; j < 4; ++j) { v4u o; o.x = pk4_fp8(__builtin_nontemporal_load(s + j * 256), sc); o.y = pk4_fp8(__builtin_nontemporal_load(s + j * 256 + 1), sc); o.z = pk4_fp8(__builtin_nontemporal_load(s + j * 256 + 2), sc); o.w = pk4_fp8(__builtin_nontemporal_load(s + j * 256 + 3), sc);
        *(GAS v4u*)(dst + (size_t)(lane >> 3) * NEXP * 128 + (item * 4 + j) * 128 + (lane & 7) * 16) = o; }
}
__device__ __forceinline__ void p0_ada_task(Frame& F, int task, LAS float* scr) {
    const int kc = task / (ADA_W / 64), ng = task % (ADA_W / 64), lane = F.lane;
    const float* c = F.in[IN_C];
    for (int e = lane; e < BATCH * 128; e += 64) { const int b = e >> 7, kk = e & 127; const float cv = c[b * D + kc * 128 + kk]; scr[kk * 16 + b] = cv / (1.f + expf(-cv)); }
    LDS_WAIT(); asm volatile("" ::: "memory");
    float acc[BATCH];
#pragma unroll
    for (int b = 0; b < BATCH; ++b) acc[b] = 0.f;
    const float* wp = F.in[IN_WADA] + (size_t)(kc * 128) * ADA_W + ng * 64 + lane;
#pragma unroll 1
    for (int k0 = 0; k0 < 128; k0 += 16) { float wv[16];
#pragma unroll
        for (int u = 0; u < 16; ++u) wv[u] = __builtin_nontemporal_load(wp + (size_t)(k0 + u) * ADA_W);
#pragma unroll
        for (int u = 0; u < 16; ++u) { const LAS f32x4* sp = (const LAS f32x4*)(scr + (k0 + u) * 16);
#pragma unroll
            for (int q = 0; q < 4; ++q) { const f32x4 s = sp[q]; acc[4 * q] += s.x * wv[u]; acc[4 * q + 1] += s.y * wv[u]; acc[4 * q + 2] += s.z * wv[u]; acc[4 * q + 3] += s.w * wv[u]; } } }
    float* ap = (float*)(F.ws + WS_ADAP);
#pragma unroll
    for (int b = 0; b < BATCH; ++b) ap[(size_t)(kc * BATCH + b) * ADA_W + ng * 64 + lane] = acc[b];
    LDS_WAIT(); asm volatile("" ::: "memory");
}
__device__ __forceinline__ void p0_prologue(Frame& F) {
    LAS float* scr = (LAS float*)(F.lds + RING_OFF + F.wave * 16896);
    const int gw = F.vcu * NWAVES + F.wave, NGW = F.G * NWAVES;
    constexpr int I_ADA = ADA_KC * (ADA_W / 64);
    constexpr int I_T1 = (D / 64) * (IN_W / 64), I_T2 = (D / 64) * (D / 64), I_T3 = (D / 64) * (QW / 64);
    constexpr int I_K = PH * NKEYS * DHALF / 2048;
    constexpr int I_E = (int)((size_t)NEXP * D / 4096);
    constexpr int NITEMS = I_ADA + I_T1 + I_T2 + I_T3 + 2 * I_K + 2 * I_E;
    for (int it = gw; it < NITEMS; it += NGW) {
        int r = it;
        if (r < I_ADA) { p0_ada_task(F, r, scr); continue; } r -= I_ADA;
        if (r < I_T1) { p0_transpose_item_i8(F.in[IN_WIN], D, IN_W, F.ws + WS_WIN, scr, r, F.lane, WQ_SCALE); continue; } r -= I_T1;
        if (r < I_T2) { p0_transpose_item(F.in[IN_WOUT], D, D, (bf16*)(F.ws + WS_WOUT), scr, r, F.lane); continue; } r -= I_T2;
        if (r < I_T3) { p0_transpose_item_i8(F.in[IN_WQ], D, QW, F.ws + WS_WQ, scr, r, F.lane, WQ_SCALE); continue; } r -= I_T3;
        if (r < I_K) { p0_convert_item(F.in[IN_PK1], (bf16*)(F.ws + WS_K1), r, F.lane); continue; } r -= I_K;
        if (r < I_K) { p0_convert_item(F.in[IN_PK2], (bf16*)(F.ws + WS_K2), r, F.lane); continue; } r -= I_K;
        if (r < I_E) { p0_convert_item_i8(F.in[IN_PU], F.ws + WS_U, r, F.lane, U_SCALE); continue; } r -= I_E;
        p0_convert_item_fp8(F.in[IN_PV], F.ws + WS_V, r, F.lane, V_SCALE);
    }
}

__device__ __forceinline__ void mod_row(const float* xrow, bf16* orow, const LAS float* SC, const LAS float* SH, int lane) {
    const GAS f32x4* xr = (const GAS f32x4*)xrow + lane;
    f32x4 v[4]; float s = 0.f;
#pragma unroll
    for (int j = 0; j < 4; ++j) { v[j] = xr[64 * j]; s += (v[j].x * v[j].x + v[j].y * v[j].y) + (v[j].z * v[j].z + v[j].w * v[j].w); }
    const float rstd = 1.0f / sqrtf(wave_sum(s) * (1.f / D) + EPS);
    GAS unsigned long long* o8 = (GAS unsigned long long*)orow + lane;
#pragma unroll
    for (int j = 0; j < 4; ++j) { const f32x4 sc = ((const LAS f32x4*)SC)[lane + 64 * j], sh = ((const LAS f32x4*)SH)[lane + 64 * j];
        const f32x4 o = v[j] * rstd * sc + sh;
        o8[64 * j] = (unsigned long long)pk2(o.x, o.y) | ((unsigned long long)pk2(o.z, o.w) << 32); }
}
__device__ __forceinline__ void mod_row_bf(const bf16* xrow, bf16* orow, const LAS float* SC, const LAS float* SH, int lane) {
    const GAS v2u* xr = (const GAS v2u*)xrow + lane;
    f32x4 v[4]; float s = 0.f;
#pragma unroll
    for (int j = 0; j < 4; ++j) { const v2u w = xr[64 * j]; v[j] = (f32x4){bflo(w.x), bfhi(w.x), bflo(w.y), bfhi(w.y)}; s += (v[j].x * v[j].x + v[j].y * v[j].y) + (v[j].z * v[j].z + v[j].w * v[j].w); }
    const float rstd = 1.0f / sqrtf(wave_sum(s) * (1.f / D) + EPS);
    GAS unsigned long long* o8 = (GAS unsigned long long*)orow + lane;
#pragma unroll
    for (int j = 0; j < 4; ++j) { const f32x4 sc = ((const LAS f32x4*)SC)[lane + 64 * j], sh = ((const LAS f32x4*)SH)[lane + 64 * j];
        const f32x4 o = v[j] * rstd * sc + sh;
        o8[64 * j] = (unsigned long long)pk2(o.x, o.y) | ((unsigned long long)pk2(o.z, o.w) << 32); }
}
__device__ __forceinline__ void mod_load(const float* xrow, int lane, f32x4 (&v)[4]) { const GAS f32x4* xr = (const GAS f32x4*)xrow + lane;
#pragma unroll
    for (int j = 0; j < 4; ++j) v[j] = __builtin_nontemporal_load(xr + 64 * j); }
__device__ __forceinline__ void mod_load_bf(const bf16* xrow, int lane, f32x4 (&v)[4]) { const GAS v2u* xr = (const GAS v2u*)xrow + lane;
#pragma unroll
    for (int j = 0; j < 4; ++j) { const v2u w = xr[64 * j]; v[j] = (f32x4){bflo(w.x), bfhi(w.x), bflo(w.y), bfhi(w.y)}; } }
template <bool I8> __device__ __forceinline__ void mod_finish(const f32x4 (&v)[4], bf16* orow, unsigned char* o8row, float* hs_out, const LAS float* SC, const LAS float* SH, int lane) {
    float s = 0.f;
#pragma unroll
    for (int j = 0; j < 4; ++j) s += (v[j].x * v[j].x + v[j].y * v[j].y) + (v[j].z * v[j].z + v[j].w * v[j].w);
    const float rstd = 1.0f / sqrtf(wave_sum(s) * (1.f / D) + EPS);
    f32x4 o[4]; float am = 0.f;
#pragma unroll
    for (int j = 0; j < 4; ++j) { const f32x4 sc = ((const LAS f32x4*)SC)[lane + 64 * j], sh = ((const LAS f32x4*)SH)[lane + 64 * j]; o[j] = v[j] * rstd * sc + sh;
        am = fmaxf(am, fmaxf(fmaxf(fabsf(o[j].x), fabsf(o[j].y)), fmaxf(fabsf(o[j].z), fabsf(o[j].w)))); }
    if (!I8) { GAS unsigned long long* o8 = (GAS unsigned long long*)orow + lane;
#pragma unroll
        for (int j = 0; j < 4; ++j) o8[64 * j] = (unsigned long long)pk2(o[j].x, o[j].y) | ((unsigned long long)pk2(o[j].z, o[j].w) << 32);
    } else {
#pragma unroll
        for (int off = 1; off < 64; off <<= 1) am = fmaxf(am, __shfl_xor(am, off));
        const float qs = am > 0.f ? 127.f / am : 0.f;
#pragma unroll
        for (int j = 0; j < 4; ++j) ((GAS unsigned*)o8row)[lane + 64 * j] = pk4_i8(o[j], qs);
        if (lane == 0) *hs_out = am * (1.f / 127.f); }
}
__device__ __forceinline__ void p1_hpass(Frame& F) {
    LAS float* SC = (LAS float*)(F.lds); LAS float* SH = SC + D;
    const float* adap = (const float*)(F.ws + WS_ADAP); const float* bada = F.in[IN_BADA]; const float* g1 = F.in[IN_G1];
    float* ada = (float*)(F.ws + WS_ADA);
    for (int e = blockIdx.x * 512 + F.tid; e < BATCH * ADA_W; e += F.G * 512) { const int b = e / ADA_W, n = e % ADA_W; float s = bada[n];
#pragma unroll
        for (int kc = 0; kc < ADA_KC; ++kc) s += adap[(size_t)(kc * BATCH + b) * ADA_W + n];
        ada[e] = s; }
    for (int tile = blockIdx.x; tile < M / 128; tile += F.G) {
        const int b = tile / (SEQ / 128);
        for (int d = F.tid; d < D; d += 512) { float sh = bada[d], sc = bada[D + d];
#pragma unroll
            for (int kc = 0; kc < ADA_KC; ++kc) { const float* p = adap + (size_t)(kc * BATCH + b) * ADA_W; sh += p[d]; sc += p[D + d]; }
            SC[d] = g1[d] * (1.f + sc); SH[d] = sh; }
        __syncthreads();
        { f32x4 va[4], vb[4];
          mod_load(F.in[IN_X] + ((size_t)tile * 128 + F.wave) * D, F.lane, va);
#pragma unroll 1
          for (int r = F.wave; r < 128; r += 2 * NWAVES) { const size_t row = (size_t)tile * 128 + r;
              mod_load(F.in[IN_X] + (row + NWAVES) * D, F.lane, vb);
              mod_finish<true>(va, nullptr, F.ws + WS_H8 + row * D, (float*)(F.ws + WS_HS) + row, SC, SH, F.lane);
              if (r + 2 * NWAVES < 128) mod_load(F.in[IN_X] + (row + 2 * NWAVES) * D, F.lane, va);
              mod_finish<true>(vb, nullptr, F.ws + WS_H8 + (row + NWAVES) * D, (float*)(F.ws + WS_HS) + (row + NWAVES), SC, SH, F.lane); } }
        __syncthreads();
    }
}
__device__ __forceinline__ void p5_h2pass(Frame& F) {
    LAS float* SC = (LAS float*)(F.lds); LAS float* SH = SC + D;
    const float* ada = (const float*)(F.ws + WS_ADA); const float* g2 = F.in[IN_G2];
    for (int tile = blockIdx.x; tile < M / 128; tile += F.G) {
        const int b = tile / (SEQ / 128);
        for (int d = F.tid; d < D; d += 512) { SC[d] = g2[d] * (1.f + ada[(size_t)b * ADA_W + 4 * D + d]); SH[d] = ada[(size_t)b * ADA_W + 3 * D + d]; }
        __syncthreads();
        { f32x4 va[4], vb[4]; const bf16* X1 = (const bf16*)(F.ws + WS_X1);
          mod_load_bf(X1 + ((size_t)tile * 128 + F.wave) * D, F.lane, va);
#pragma unroll 1
          for (int r = F.wave; r < 128; r += 2 * NWAVES) { const size_t row = (size_t)tile * 128 + r;
              mod_load_bf(X1 + (row + NWAVES) * D, F.lane, vb);
              mod_finish<true>(va, (bf16*)(F.ws + WS_H) + row * D, F.ws + WS_H8 + row * D, (float*)(F.ws + WS_HS) + row, SC, SH, F.lane);
              if (r + 2 * NWAVES < 128) mod_load_bf(X1 + (row + 2 * NWAVES) * D, F.lane, va);
              mod_finish<true>(vb, (bf16*)(F.ws + WS_H) + (row + NWAVES) * D, F.ws + WS_H8 + (row + NWAVES) * D, (float*)(F.ws + WS_HS) + (row + NWAVES), SC, SH, F.lane); } }
        __syncthreads();
    }
}

typedef float f32x16 __attribute__((ext_vector_type(16)));
typedef short s16x4 __attribute__((ext_vector_type(4)));
typedef __bf16 bf16x8_t __attribute__((ext_vector_type(8)));
#define MFMA32(a, b, c) __builtin_amdgcn_mfma_f32_32x32x16_bf16((a), (b), (c), 0, 0, 0)
constexpr int KS = 144, VS = 192;
__device__ __forceinline__ void p3_attn_unit(Frame& F, int unit) {
    const int kh = unit & 1, nb = (unit >> 1) & 15, b = unit >> 5;
    LAS unsigned char* KL = F.lds; LAS unsigned char* VL = F.lds + 256 * KS;
    const bf16* proj = (const bf16*)(F.ws + WS_PROJ);
    const int tok0 = b * SEQ + nb * 128;
    for (int c = F.tid; c < 2048; c += 512) { const int j = c >> 3, ch = c & 7;
        v4u kv = (v4u){0u, 0u, 0u, 0u}, vv = (v4u){0u, 0u, 0u, 0u};
        if (nb > 0 || j >= 128) { const bf16* rowp = proj + (size_t)(tok0 - 128 + j) * IN_W; kv = *(const GAS v4u*)(rowp + O_K + kh * HD + ch * 8); vv = *(const GAS v4u*)(rowp + O_V + kh * HD + ch * 8); }
        *(LAS v4u*)(KL + j * KS + ch * 16) = kv; *(LAS v4u*)(VL + j * VS + ch * 16) = vv; }
    __syncthreads();
    const int lane = F.lane, r = lane & 31, hh = lane >> 5;
#pragma unroll 1
    for (int task = F.wave; task < 16; task += NWAVES) {
        const int g = task >> 2, w = task & 3, qh = kh * 4 + g, i0 = 32 * w;
        const bf16* qp = proj + (size_t)(tok0 + i0 + r) * IN_W + O_Q + qh * HD + 8 * hh;
        bf16x8 qf[4];
#pragma unroll
        for (int s = 0; s < 4; ++s) qf[s] = *(const GAS bf16x8*)(qp + 16 * s);
        f32x16 sc[5];
#pragma unroll
        for (int t = 0; t < 5; ++t) {
#pragma unroll
            for (int e = 0; e < 16; ++e) sc[t][e] = 0.f;
#pragma unroll
            for (int s = 0; s < 4; ++s) { const bf16x8 a = *(const LAS bf16x8*)(KL + ((w + t) * 32 + r) * KS + 32 * s + 16 * hh); sc[t] = MFMA32(a, qf[s], sc[t]); } }
        const float sink = F.in[IN_SINK][qh];
        float mx = sink;
#pragma unroll
        for (int t = 0; t < 5; ++t)
#pragma unroll
            for (int e = 0; e < 16; ++e) { const int kr = (e & 3) + 8 * (e >> 2) + 4 * hh;
                bool valid = (nb > 0) || (w + t >= 4);
                if (t == 0) valid = valid && (kr > r);
                if (t == 4) valid = valid && (kr <= r);
                const float v = valid ? sc[t][e] * 0.125f : -1e30f; sc[t][e] = v; mx = fmaxf(mx, v); }
        mx = fmaxf(mx, __shfl_xor(mx, 32));
        float lsum = 0.f;
#pragma unroll
        for (int t = 0; t < 5; ++t)
#pragma unroll
            for (int e = 0; e < 16; ++e) { const float p = __expf(sc[t][e] - mx); sc[t][e] = p; lsum += p; }
        lsum += __shfl_xor(lsum, 32); lsum += __expf(sink - mx);
        f32x16 o[2];
#pragma unroll
        for (int dt = 0; dt < 2; ++dt)
#pragma unroll
            for (int e = 0; e < 16; ++e) o[dt][e] = 0.f;
        const int q4 = (r & 15) >> 2, p4 = r & 3;
#pragma unroll
        for (int t = 0; t < 5; ++t)
#pragma unroll
            for (int sp = 0; sp < 2; ++sp) {
                bf16x8_t pbv;
#pragma unroll
                for (int e = 0; e < 8; ++e) pbv[e] = (__bf16)sc[t][8 * sp + e];
                const bf16x8 pb = __builtin_bit_cast(bf16x8, pbv);
#pragma unroll
                for (int dt = 0; dt < 2; ++dt) {
                    const int kb = (w + t) * 32 + 16 * sp + 4 * hh;
                    const LAS unsigned char* ap = VL + (kb + q4) * VS + (32 * dt + 16 * (r >> 4) + 4 * p4) * 2;
                    const s16x4 lo = __builtin_amdgcn_ds_read_tr16_b64_v4i16((LAS s16x4*)ap);
                    const s16x4 hi = __builtin_amdgcn_ds_read_tr16_b64_v4i16((LAS s16x4*)(ap + 8 * VS));
                    const bf16x8 a = __builtin_shufflevector(lo, hi, 0, 1, 2, 3, 4, 5, 6, 7);
                    o[dt] = MFMA32(a, pb, o[dt]); } }
        const float inv = 1.f / lsum; float ss = 0.f;
#pragma unroll
        for (int dt = 0; dt < 2; ++dt)
#pragma unroll
            for (int e = 0; e < 16; ++e) { o[dt][e] *= inv; ss += o[dt][e] * o[dt][e]; }
        ss += __shfl_xor(ss, 32);
        const float rs = 1.0f / sqrtf(ss * (1.f / HD) + EPS);
        const float* gp = F.in[IN_AOG] + qh * HD;
        bf16* op = (bf16*)(F.ws + WS_MIX) + (size_t)(tok0 + i0 + r) * D + qh * HD;
#pragma unroll
        for (int dt = 0; dt < 2; ++dt)
#pragma unroll
            for (int g4 = 0; g4 < 4; ++g4) { const int d0 = 32 * dt + 8 * g4 + 4 * hh; const f32x4 gv = *(const f32x4*)(gp + d0);
                v2u wv; wv.x = pk2(o[dt][4 * g4 + 0] * rs * gv.x, o[dt][4 * g4 + 1] * rs * gv.y); wv.y = pk2(o[dt][4 * g4 + 2] * rs * gv.z, o[dt][4 * g4 + 3] * rs * gv.w);
                *(GAS v2u*)(op + d0) = wv; }
    }
    __syncthreads();
}
__device__ __forceinline__ void p3_conv(Frame& F) {
    const bf16* proj = (const bf16*)(F.ws + WS_PROJ); const int lane = F.lane, c0 = 8 * lane;
    const float* cw = F.in[IN_CONVW]; const float* cg = F.in[IN_COG];
    float w0[8], w1[8], w2[8], gg[8];
#pragma unroll
    for (int e = 0; e < 8; ++e) { w0[e] = cw[c0 + e]; w1[e] = cw[512 + c0 + e]; w2[e] = cw[1024 + c0 + e]; gg[e] = cg[c0 + e]; }
    const int gw = F.vcu * NWAVES + F.wave, NGW = F.G * NWAVES;
    for (int tok = gw; tok < M; tok += NGW) {
        const int s = tok & (SEQ - 1); const bf16* rp = proj + (size_t)tok * IN_W;
        const v4u z4 = (v4u){0u, 0u, 0u, 0u};
        const v4u Bv = *(const GAS v4u*)(rp + O_B + c0), C0 = *(const GAS v4u*)(rp + O_C + c0), U0 = *(const GAS v4u*)(rp + O_U + c0);
        v4u C1 = z4, U1 = z4, C2 = z4, U2 = z4;
        if (s >= 1) { C1 = *(const GAS v4u*)(rp - IN_W + O_C + c0); U1 = *(const GAS v4u*)(rp - IN_W + O_U + c0); }
        if (s >= 2) { C2 = *(const GAS v4u*)(rp - 2 * IN_W + O_C + c0); U2 = *(const GAS v4u*)(rp - 2 * IN_W + O_U + c0); }
        float y[8]; float ss = 0.f;
#pragma unroll
        for (int e = 0; e < 8; ++e) { const int wi = e >> 1; const bool hi = e & 1;
            const unsigned bw = Bv[wi], c0w = C0[wi], u0w = U0[wi], c1w = C1[wi], u1w = U1[wi], c2w = C2[wi], u2w = U2[wi];
            const float bb = hi ? bfhi(bw) : bflo(bw);
            const float z0 = (hi ? bfhi(c0w) : bflo(c0w)) * (hi ? bfhi(u0w) : bflo(u0w));
            const float z1 = (hi ? bfhi(c1w) : bflo(c1w)) * (hi ? bfhi(u1w) : bflo(u1w));
            const float z2 = (hi ? bfhi(c2w) : bflo(c2w)) * (hi ? bfhi(u2w) : bflo(u2w));
            y[e] = bb * (z2 * w0[e] + z1 * w1[e] + z0 * w2[e]); ss += y[e] * y[e]; }
        ss += __shfl_xor(ss, 1); ss += __shfl_xor(ss, 2); ss += __shfl_xor(ss, 4);
        const float rs = 1.0f / sqrtf(ss * (1.f / 64.f) + EPS);
        v4u w; w.x = pk2(y[0] * rs * gg[0], y[1] * rs * gg[1]); w.y = pk2(y[2] * rs * gg[2], y[3] * rs * gg[3]);
        w.z = pk2(y[4] * rs * gg[4], y[5] * rs * gg[5]); w.w = pk2(y[6] * rs * gg[6], y[7] * rs * gg[7]);
        *(GAS v4u*)((bf16*)(F.ws + WS_MIX) + (size_t)tok * D + 512 + c0) = w;
    }
}
__device__ __forceinline__ void p3_mixer(Frame& F) {
    for (int unit = blockIdx.x; unit < BATCH * 16 * NKVH; unit += F.G) p3_attn_unit(F, unit);
    p3_conv(F);
}

#define DI __device__ __forceinline__
#define CE_(i, j) { const unsigned x_ = a[i], y_ = a[j]; a[i] = x_ > y_ ? x_ : y_; a[j] = x_ > y_ ? y_ : x_; }
DI void sort16_desc(unsigned (&a)[16]) {
    CE_(0,13) CE_(1,12) CE_(2,15) CE_(3,14) CE_(4,8) CE_(5,6) CE_(7,11) CE_(9,10)
    CE_(0,5) CE_(1,7) CE_(2,9) CE_(3,4) CE_(6,13) CE_(8,14) CE_(10,15) CE_(11,12)
    CE_(0,1) CE_(2,3) CE_(4,5) CE_(6,8) CE_(7,9) CE_(10,11) CE_(12,13) CE_(14,15)
    CE_(0,2) CE_(1,3) CE_(4,10) CE_(5,11) CE_(6,7) CE_(8,9) CE_(12,14) CE_(13,15)
    CE_(1,2) CE_(3,12) CE_(4,6) CE_(5,7) CE_(8,10) CE_(9,11) CE_(13,14)
    CE_(1,4) CE_(2,6) CE_(5,8) CE_(7,10) CE_(9,13) CE_(11,14)
    CE_(2,4) CE_(3,6) CE_(9,12) CE_(11,13)
    CE_(3,5) CE_(6,8) CE_(7,9) CE_(10,12)
    CE_(3,4) CE_(5,6) CE_(7,8) CE_(9,10) CE_(11,12)
    CE_(6,7) CE_(8,9)
}
DI void bitonic_merge16_desc(unsigned (&a)[16]) {
#pragma unroll
    for (int js = 3; js >= 0; --js) {
#pragma unroll
        for (int i = 0; i < 16; ++i) { const int j = 1 << js, l = i ^ j;
            if (l > i) { const unsigned x = a[i], y = a[l]; a[i] = x > y ? x : y; a[l] = x > y ? y : x; } }
    }
}
DI void merge_top16(unsigned (&a)[16], const unsigned (&b)[16]) {
#pragma unroll
    for (int i = 0; i < 16; ++i) { const unsigned x = a[i], y = b[15 - i]; a[i] = x > y ? x : y; }
    bitonic_merge16_desc(a);
}
DI void top16_of_64(unsigned (&g0)[16], unsigned (&g1)[16], unsigned (&g2)[16], unsigned (&g3)[16]) {
    sort16_desc(g0); sort16_desc(g1); sort16_desc(g2); sort16_desc(g3);
    merge_top16(g0, g1); merge_top16(g2, g3); merge_top16(g0, g2);
}
#define SBIAS 8.0f
DI unsigned skey(float biased) { return __float_as_uint(fmaxf(biased, 0.f)); }
constexpr int KEY_STRIDE = 272;
DI void route_scores_top16(const LAS unsigned char* KL, const bf16* qrow, int r, int hh, unsigned (&out)[16]) {
    bf16x8 qf[8];
#pragma unroll
    for (int s = 0; s < 8; ++s) qf[s] = *(const GAS bf16x8*)(qrow + 16 * s);
    f32x16 acc[4];
#pragma unroll
    for (int t = 0; t < 4; ++t)
#pragma unroll
        for (int e = 0; e < 16; ++e) acc[t][e] = SBIAS;
#pragma unroll
    for (int t = 0; t < 4; ++t)
#pragma unroll
        for (int s = 0; s < 8; ++s) { const bf16x8 a = *(const LAS bf16x8*)(KL + (t * 32 + r) * KEY_STRIDE + 32 * s + 16 * hh); acc[t] = MFMA32(a, qf[s], acc[t]); }
    unsigned g0[16], g1[16], g2[16], g3[16];
    const unsigned pb = (unsigned)(127 - 4 * hh);
#pragma unroll
    for (int e = 0; e < 16; ++e) { const unsigned p = pb - (unsigned)((e & 3) + 8 * (e >> 2));
        g0[e] = (skey(acc[0][e]) & ~127u) | p; g1[e] = (skey(acc[1][e]) & ~127u) | (p - 32u); g2[e] = (skey(acc[2][e]) & ~127u) | (p - 64u); g3[e] = (skey(acc[3][e]) & ~127u) | (p - 96u); }
    top16_of_64(g0, g1, g2, g3);
    unsigned oth[16];
#pragma unroll
    for (int i = 0; i < 16; ++i) oth[i] = (unsigned)__shfl_xor((int)g0[i], 32);
    merge_top16(g0, oth);
#pragma unroll
    for (int i = 0; i < 16; ++i) out[i] = g0[i];
}
DI void p7_route_tile(Frame& F, int tok0, int h, const LAS unsigned char* KL1, const LAS unsigned char* KL2, LAS unsigned char* scr) {
    const int lane = F.lane, r = lane & 31, hh = lane >> 5;
    const bf16* qrow = (const bf16*)(F.ws + WS_PROJ) + (size_t)(tok0 + r) * QW + h * DKEY + 8 * hh;
    unsigned t1[16], t2[16];
    route_scores_top16(KL1, qrow, r, hh, t1);
    route_scores_top16(KL2, qrow + DHALF, r, hh, t2);
    { v4u w;
#pragma unroll
      for (int q = 0; q < 4; ++q) { unsigned x = 0u;
#pragma unroll
          for (int bq = 0; bq < 4; ++bq) { const unsigned k = hh ? t2[4 * q + bq] : t1[4 * q + bq]; x |= (127u - (k & 127u)) << (8 * bq); }
          w[q] = x; }
      *(LAS v4u*)(scr + r * 32 + hh * 16) = w; }
    float v1[16], v2[16];
#pragma unroll
    for (int i = 0; i < 16; ++i) { v1[i] = __uint_as_float(t1[i] & ~127u); v2[i] = __uint_as_float(t2[i] & ~127u) - SBIAS; }
    unsigned c0[16], c1[16];
    { const float sa = v1[0] + v2[0], sb = v1[2] + v2[1]; c0[0] = (__float_as_uint(fmaxf(hh ? sb : sa, 0.f)) & ~255u) | (hh ? 222u : 255u); }
    { const float sa = v1[0] + v2[1], sb = v1[2] + v2[2]; c0[1] = (__float_as_uint(fmaxf(hh ? sb : sa, 0.f)) & ~255u) | (hh ? 221u : 254u); }
    { const float sa = v1[0] + v2[2], sb = v1[2] + v2[3]; c0[2] = (__float_as_uint(fmaxf(hh ? sb : sa, 0.f)) & ~255u) | (hh ? 220u : 253u); }
    { const float sa = v1[0] + v2[3], sb = v1[2] + v2[4]; c0[3] = (__float_as_uint(fmaxf(hh ? sb : sa, 0.f)) & ~255u) | (hh ? 219u : 252u); }
    { const float sa = v1[0] + v2[4], sb = v1[3] + v2[0]; c0[4] = (__float_as_uint(fmaxf(hh ? sb : sa, 0.f)) & ~255u) | (hh ? 207u : 251u); }
    { const float sa = v1[0] + v2[5], sb = v1[3] + v2[1]; c0[5] = (__float_as_uint(fmaxf(hh ? sb : sa, 0.f)) & ~255u) | (hh ? 206u : 250u); }
    { const float sa = v1[0] + v2[6], sb = v1[3] + v2[2]; c0[6] = (__float_as_uint(fmaxf(hh ? sb : sa, 0.f)) & ~255u) | (hh ? 205u : 249u); }
    { const float sa = v1[0] + v2[7], sb = v1[3] + v2[3]; c0[7] = (__float_as_uint(fmaxf(hh ? sb : sa, 0.f)) & ~255u) | (hh ? 204u : 248u); }
    { const float sa = v1[0] + v2[8], sb = v1[4] + v2[0]; c0[8] = (__float_as_uint(fmaxf(hh ? sb : sa, 0.f)) & ~255u) | (hh ? 191u : 247u); }
    { const float sa = v1[0] + v2[9], sb = v1[4] + v2[1]; c0[9] = (__float_as_uint(fmaxf(hh ? sb : sa, 0.f)) & ~255u) | (hh ? 190u : 246u); }
    { const float sa = v1[0] + v2[10], sb = v1[4] + v2[2]; c0[10] = (__float_as_uint(fmaxf(hh ? sb : sa, 0.f)) & ~255u) | (hh ? 189u : 245u); }
    { const float sa = v1[0] + v2[11], sb = v1[5] + v2[0]; c0[11] = (__float_as_uint(fmaxf(hh ? sb : sa, 0.f)) & ~255u) | (hh ? 175u : 244u); }
    { const float sa = v1[0] + v2[12], sb = v1[5] + v2[1]; c0[12] = (__float_as_uint(fmaxf(hh ? sb : sa, 0.f)) & ~255u) | (hh ? 174u : 243u); }
    { const float sa = v1[0] + v2[13], sb = v1[6] + v2[0]; c0[13] = (__float_as_uint(fmaxf(hh ? sb : sa, 0.f)) & ~255u) | (hh ? 159u : 242u); }
    { const float sa = v1[0] + v2[14], sb = v1[6] + v2[1]; c0[14] = (__float_as_uint(fmaxf(hh ? sb : sa, 0.f)) & ~255u) | (hh ? 158u : 241u); }
    { const float sa = v1[0] + v2[15], sb = v1[7] + v2[0]; c0[15] = (__float_as_uint(fmaxf(hh ? sb : sa, 0.f)) & ~255u) | (hh ? 143u : 240u); }
    { const float sa = v1[1] + v2[0], sb = v1[7] + v2[1]; c1[0] = (__float_as_uint(fmaxf(hh ? sb : sa, 0.f)) & ~255u) | (hh ? 142u : 239u); }
    { const float sa = v1[1] + v2[1], sb = v1[8] + v2[0]; c1[1] = (__float_as_uint(fmaxf(hh ? sb : sa, 0.f)) & ~255u) | (hh ? 127u : 238u); }
    { const float sa = v1[1] + v2[2], sb = v1[9] + v2[0]; c1[2] = (__float_as_uint(fmaxf(hh ? sb : sa, 0.f)) & ~255u) | (hh ? 111u : 237u); }
    { const float sa = v1[1] + v2[3], sb = v1[10] + v2[0]; c1[3] = (__float_as_uint(fmaxf(hh ? sb : sa, 0.f)) & ~255u) | (hh ? 95u : 236u); }
    { const float sa = v1[1] + v2[4], sb = v1[11] + v2[0]; c1[4] = (__float_as_uint(fmaxf(hh ? sb : sa, 0.f)) & ~255u) | (hh ? 79u : 235u); }
    { const float sa = v1[1] + v2[5], sb = v1[12] + v2[0]; c1[5] = (__float_as_uint(fmaxf(hh ? sb : sa, 0.f)) & ~255u) | (hh ? 63u : 234u); }
    { const float sa = v1[1] + v2[6], sb = v1[13] + v2[0]; c1[6] = (__float_as_uint(fmaxf(hh ? sb : sa, 0.f)) & ~255u) | (hh ? 47u : 233u); }
    { const float sa = v1[1] + v2[7], sb = v1[14] + v2[0]; c1[7] = (__float_as_uint(fmaxf(hh ? sb : sa, 0.f)) & ~255u) | (hh ? 31u : 232u); }
    { const float sa = v1[2] + v2[0], sb = v1[15] + v2[0]; c1[8] = (__float_as_uint(fmaxf(hh ? sb : sa, 0.f)) & ~255u) | (hh ? 15u : 223u); }
    c1[9] = 0u;
    c1[10] = 0u;
    c1[11] = 0u;
    c1[12] = 0u;
    c1[13] = 0u;
    c1[14] = 0u;
    c1[15] = 0u;
    sort16_desc(c0); sort16_desc(c1); merge_top16(c0, c1);
    { unsigned oth[16];
#pragma unroll
      for (int i = 0; i < 16; ++i) oth[i] = (unsigned)__shfl_xor((int)c0[i], 32);
      merge_top16(c0, oth); }
    const float mx = __uint_as_float(c0[0] & ~255u);
    LDS_WAIT(); asm volatile("" ::: "memory");
    float ex[8]; int ee[8]; float part = 0.f;
#pragma unroll
    for (int k = 0; k < 8; ++k) { const unsigned key = hh ? c0[8 + k] : c0[k]; const int ci = 255 - (int)(key & 255u);
        const int e1 = *(const LAS unsigned char*)(scr + r * 32 + (ci >> 4)), e2 = *(const LAS unsigned char*)(scr + r * 32 + 16 + (ci & 15));
        ee[k] = (e1 * NKEYS + e2) & (NEXP - 1); ex[k] = __expf(__uint_as_float(key & ~255u) - mx); part += ex[k]; }
    const float inv = 1.f / (part + __shfl_xor(part, 32));
    int* ip = (int*)(F.ws + WS_IDX) + (size_t)(tok0 + r) * 128 + h * TOPK + 8 * hh; float* gp = (float*)(F.ws + WS_GATE) + (size_t)(tok0 + r) * 128 + h * TOPK + 8 * hh;
    *(GAS v4u*)ip = (v4u){(unsigned)ee[0], (unsigned)ee[1], (unsigned)ee[2], (unsigned)ee[3]}; *(GAS v4u*)(ip + 4) = (v4u){(unsigned)ee[4], (unsigned)ee[5], (unsigned)ee[6], (unsigned)ee[7]};
    *(GAS f32x4*)gp = (f32x4){ex[0] * inv, ex[1] * inv, ex[2] * inv, ex[3] * inv}; *(GAS f32x4*)(gp + 4) = (f32x4){ex[4] * inv, ex[5] * inv, ex[6] * inv, ex[7] * inv};
    asm volatile("" ::: "memory");
}
__device__ __forceinline__ void p7_routing(Frame& F) {
    LAS unsigned char* KL1 = F.lds; LAS unsigned char* KL2 = F.lds + 128 * KEY_STRIDE; LAS unsigned char* scr = F.lds + 2 * 128 * KEY_STRIDE + F.wave * 1024;
    const bf16* k1 = (const bf16*)(F.ws + WS_K1); const bf16* k2 = (const bf16*)(F.ws + WS_K2);
    int cur_h = -1;
    for (int item = blockIdx.x; item < (M / 256) * PH; item += F.G) {
        const int h = item & (PH - 1), tile = item >> 3;
        if (h != cur_h) {
            __syncthreads();
            for (int c = F.tid; c < 2 * 128 * 16; c += 512) { const int which = c >> 11, rr = (c >> 4) & 127, ch = c & 15;
                const v4u v = *(const GAS v4u*)((which ? k2 : k1) + (size_t)(h * NKEYS + rr) * DHALF + ch * 8);
                *(LAS v4u*)((which ? KL2 : KL1) + rr * KEY_STRIDE + ch * 16) = v; }
            __syncthreads();
            cur_h = h;
        }
        p7_route_tile(F, tile * 256 + F.wave * 32, h, KL1, KL2, scr);
    }
}

__device__ __forceinline__ float gelu_erf(float v) { return 0.5f * v * (1.f + erff(v * 0.70710678118654752f)); }
typedef float f32x2v __attribute__((ext_vector_type(2)));
__device__ __forceinline__ unsigned fp8x2_bf16x2(unsigned w, bool hi) { return hi ? __builtin_bit_cast(unsigned, __builtin_amdgcn_cvt_scalef32_pk_bf16_fp8((int)w, 1.0f, true)) : __builtin_bit_cast(unsigned, __builtin_amdgcn_cvt_scalef32_pk_bf16_fp8((int)w, 1.0f, false)); }
__device__ __forceinline__ float dot16_fp8(v4u u, v4u ha, v4u hb, float acc) {
    acc = dot2(fp8x2_bf16x2(u.x, false), ha.x, acc); acc = dot2(fp8x2_bf16x2(u.x, true), ha.y, acc);
    acc = dot2(fp8x2_bf16x2(u.y, false), ha.z, acc); acc = dot2(fp8x2_bf16x2(u.y, true), ha.w, acc);
    acc = dot2(fp8x2_bf16x2(u.z, false), hb.x, acc); acc = dot2(fp8x2_bf16x2(u.z, true), hb.y, acc);
    acc = dot2(fp8x2_bf16x2(u.w, false), hb.z, acc); acc = dot2(fp8x2_bf16x2(u.w, true), hb.w, acc);
    return acc;
}
struct SliceWork { int j0, nj, t0, ts; };
__device__ __forceinline__ SliceWork slice_work(const Frame& F) { SliceWork w;
    if ((F.G & 7) == 0) { w.j0 = blockIdx.x & 7; w.nj = 1; w.t0 = (blockIdx.x >> 3) * NWAVES + F.wave; w.ts = F.G; }
    else { w.j0 = 0; w.nj = 8; w.t0 = blockIdx.x * NWAVES + F.wave; w.ts = F.G * NWAVES; }
    return w; }
struct USet { v4u hq; float hs; v4u u[16]; };
struct UMeta { v2u id; v4u hh; float hs; };
__device__ __forceinline__ UMeta p8a_G(const int* IDX, const unsigned char* H8, const float* HS, int t, int j, int lane) { UMeta m;
    m.id = *(const GAS v2u*)(IDX + (size_t)t * 128 + 2 * lane); m.hh = *(const GAS v4u*)(H8 + (size_t)t * D + 128 * j + 16 * (lane & 7)); m.hs = HS[t]; return m; }
__device__ __forceinline__ void p8a_S(LAS unsigned char* mb, const UMeta& m, int lane) { *(LAS v2u*)(mb + 8 * lane) = m.id; if (lane < 8) *(LAS v4u*)(mb + 512 + 16 * lane) = m.hh; }
__device__ __forceinline__ void p8a_RT(const LAS unsigned char* mb, const unsigned char* Ub, int c, int g, float hs, USet& s) {
    v4u ix[4];
#pragma unroll
    for (int q = 0; q < 4; ++q) ix[q] = *(const LAS v4u*)(mb + 64 * g + 16 * q);
    s.hq = *(const LAS v4u*)(mb + 512 + 16 * c); s.hs = hs;
#pragma unroll
    for (int i = 0; i < 16; ++i) s.u[i] = *(const GAS v4u*)(Ub + (unsigned)((ix[i >> 2][i & 3] << 7) + 16u * (unsigned)c)); }
__device__ __forceinline__ void p8a_compute(const USet& s, bf16* pa_row, int lane, int c) {
    int p[16];
#pragma unroll
    for (int i = 0; i < 16; ++i) { int a = __builtin_amdgcn_sdot4((int)s.u[i].x, (int)s.hq.x, 0, false); a = __builtin_amdgcn_sdot4((int)s.u[i].y, (int)s.hq.y, a, false);
        a = __builtin_amdgcn_sdot4((int)s.u[i].z, (int)s.hq.z, a, false); p[i] = __builtin_amdgcn_sdot4((int)s.u[i].w, (int)s.hq.w, a, false); }
#pragma unroll
    for (int i = 0; i < 8; ++i) { const bool up = c & 4; const int send = up ? p[i] : p[i + 8], keep = up ? p[i + 8] : p[i]; p[i] = keep + __shfl_xor(send, 4); }
#pragma unroll
    for (int i = 0; i < 4; ++i) { const bool up = c & 2; const int send = up ? p[i] : p[i + 4], keep = up ? p[i + 4] : p[i]; p[i] = keep + __shfl_xor(send, 2); }
#pragma unroll
    for (int i = 0; i < 2; ++i) { const bool up = c & 1; const int send = up ? p[i] : p[i + 2], keep = up ? p[i + 2] : p[i]; p[i] = keep + __shfl_xor(send, 1); }
    const float sc = s.hs * (1.f / U_SCALE);
    ((GAS unsigned*)pa_row)[lane] = pk2((float)p[0] * sc, (float)p[1] * sc);
}
__device__ __forceinline__ void p8a_udots(Frame& F) {
    const unsigned char* H8 = F.ws + WS_H8; const float* HS = (const float*)(F.ws + WS_HS); const int* IDX = (const int*)(F.ws + WS_IDX); bf16* PA = (bf16*)(F.ws + WS_PA);
    const int lane = F.lane, c = lane & 7, g = lane >> 3; const SliceWork sw = slice_work(F);
    LAS unsigned char* mb = F.lds + F.wave * 1024;
    if (sw.t0 >= M) return;
    const int nt = (M - 1 - sw.t0) / sw.ts + 1;
#define TOK(n) (sw.t0 + ((n) < nt ? (n) : nt - 1) * sw.ts)
    for (int jj = 0; jj < sw.nj; ++jj) { const int j = sw.j0 + jj; const unsigned char* Uj = F.ws + WS_U + (size_t)j * NEXP * 128;
        USet sA, sB, sC;
        UMeta mN = p8a_G(IDX, H8, HS, TOK(0), j, lane); p8a_S(mb, mN, lane); p8a_RT(mb, Uj, c, g, mN.hs, sA);
        mN = p8a_G(IDX, H8, HS, TOK(1), j, lane); p8a_S(mb, mN, lane); p8a_RT(mb, Uj, c, g, mN.hs, sB);
        mN = p8a_G(IDX, H8, HS, TOK(2), j, lane);
#define P8A_STAGE(k, SN, SC_) do { p8a_S(mb, mN, lane); p8a_RT(mb, Uj, c, g, mN.hs, SN); mN = p8a_G(IDX, H8, HS, TOK((k) + 3), j, lane); asm volatile("" ::: "memory"); \
            if ((k) < nt) p8a_compute(SC_, PA + ((size_t)j * M + TOK(k)) * 128, lane, c); asm volatile("" ::: "memory"); } while (0)
#pragma unroll 1
        for (int n = 0; n < nt; n += 3) {
            P8A_STAGE(n, sC, sA);
            P8A_STAGE(n + 1, sA, sB);
            P8A_STAGE(n + 2, sB, sC);
        }
#undef P8A_STAGE
    }
}
typedef _Float16 h2_t __attribute__((ext_vector_type(2)));
__device__ __forceinline__ h2_t cvt_h2_lo(int w) { return __builtin_bit_cast(h2_t, __builtin_amdgcn_cvt_scalef32_pk_f16_fp8(w, 1.0f, false)); }
__device__ __forceinline__ h2_t cvt_h2_hi(int w) { return __builtin_bit_cast(h2_t, __builtin_amdgcn_cvt_scalef32_pk_f16_fp8(w, 1.0f, true)); }
__device__ __forceinline__ void p8w_weights(Frame& F) {
    const bf16* PA = (const bf16*)(F.ws + WS_PA); float* GATE = (float*)(F.ws + WS_GATE);
    for (size_t e = (size_t)blockIdx.x * 512 + F.tid; e < (size_t)M * 128 / 4; e += (size_t)F.G * 512) {
        f32x4 s = (f32x4){0.f, 0.f, 0.f, 0.f};
#pragma unroll
        for (int j = 0; j < 8; ++j) { const v2u w = __builtin_nontemporal_load((const GAS v2u*)(PA + (size_t)j * M * 128 + 4 * e)); s += (f32x4){bflo(w.x), bfhi(w.x), bflo(w.y), bfhi(w.y)}; }
        const f32x4 gt = *(const GAS f32x4*)(GATE + 4 * e); f32x4 o;
#pragma unroll
        for (int q = 0; q < 4; ++q) o[q] = gt[q] * gelu_erf(s[q]);
        const h2_t w01 = (h2_t){(_Float16)o[0], (_Float16)o[1]}, w23 = (h2_t){(_Float16)o[2], (_Float16)o[3]};
        *(GAS v2u*)((_Float16*)(F.ws + WS_W16) + 4 * e) = (v2u){__builtin_bit_cast(unsigned, w01), __builtin_bit_cast(unsigned, w23)}; }
}
struct VSet { v4u wh[2]; v4u v[16]; };
struct VMeta { v2u id; unsigned w; };
__device__ __forceinline__ VMeta p8b_G(const int* IDX, const _Float16* W, int t, int lane) { VMeta m;
    m.id = *(const GAS v2u*)(IDX + (size_t)t * 128 + 2 * lane); m.w = *(const GAS unsigned*)(W + (size_t)t * 128 + 2 * lane); return m; }
__device__ __forceinline__ void p8b_S(LAS unsigned char* mb, const VMeta& m, int lane) { *(LAS v2u*)(mb + 8 * lane) = m.id; *(LAS unsigned*)(mb + 512 + 4 * lane) = m.w; }
__device__ __forceinline__ void p8b_RT(Frame& F, const LAS unsigned char* mb, const unsigned char* Vj, int t, int j, int c, int g, VSet& s) {
    v4u ix[4];
#pragma unroll
    for (int q = 0; q < 4; ++q) ix[q] = *(const LAS v4u*)(mb + 64 * g + 16 * q);
    s.wh[0] = *(const LAS v4u*)(mb + 512 + 32 * g); s.wh[1] = *(const LAS v4u*)(mb + 512 + 32 * g + 16);
#pragma unroll
    for (int i = 0; i < 16; ++i) s.v[i] = *(const GAS v4u*)(Vj + (unsigned)((ix[i >> 2][i & 3] << 7) + 16u * (unsigned)c)); }
__device__ __forceinline__ void p8b_step(Frame& F, const LAS unsigned char* mb, const unsigned char* Vj, int tn, VSet& sn, const VSet& sc, int tc, int j, int lane, int c, int g, bool do_compute) {
    v4u ix[4];
#pragma unroll
    for (int q = 0; q < 4; ++q) ix[q] = *(const LAS v4u*)(mb + 64 * g + 16 * q);
    sn.wh[0] = *(const LAS v4u*)(mb + 512 + 32 * g); sn.wh[1] = *(const LAS v4u*)(mb + 512 + 32 * g + 16);
    h2_t ah[8];
#pragma unroll
    for (int m = 0; m < 8; ++m) ah[m] = (h2_t){(_Float16)0.f, (_Float16)0.f};
#pragma unroll
    for (int i = 0; i < 16; ++i) {
        sn.v[i] = *(const GAS v4u*)(Vj + (unsigned)((ix[i >> 2][i & 3] << 7) + 16u * (unsigned)c));
        const v4u v = sc.v[i]; const unsigned wu = sc.wh[i >> 3][(i >> 1) & 3]; const h2_t w2 = __builtin_bit_cast(h2_t, (i & 1) ? ((wu >> 16) | (wu & 0xffff0000u)) : ((wu & 0xffffu) | (wu << 16)));
        ah[0] = __builtin_elementwise_fma(cvt_h2_lo((int)v.x), w2, ah[0]); ah[1] = __builtin_elementwise_fma(cvt_h2_hi((int)v.x), w2, ah[1]);
        ah[2] = __builtin_elementwise_fma(cvt_h2_lo((int)v.y), w2, ah[2]); ah[3] = __builtin_elementwise_fma(cvt_h2_hi((int)v.y), w2, ah[3]);
        ah[4] = __builtin_elementwise_fma(cvt_h2_lo((int)v.z), w2, ah[4]); ah[5] = __builtin_elementwise_fma(cvt_h2_hi((int)v.z), w2, ah[5]);
        ah[6] = __builtin_elementwise_fma(cvt_h2_lo((int)v.w), w2, ah[6]); ah[7] = __builtin_elementwise_fma(cvt_h2_hi((int)v.w), w2, ah[7]);
        asm volatile("" ::: "memory"); }
    if (!do_compute) return;
#pragma unroll
    for (int m = 0; m < 4; ++m) { const bool up = lane & 32; const h2_t send = up ? ah[m] : ah[m + 4], keep = up ? ah[m + 4] : ah[m]; ah[m] = keep + __builtin_bit_cast(h2_t, __shfl_xor(__builtin_bit_cast(int, send), 32)); }
#pragma unroll
    for (int m = 0; m < 2; ++m) { const bool up = lane & 16; const h2_t send = up ? ah[m] : ah[m + 2], keep = up ? ah[m + 2] : ah[m]; ah[m] = keep + __builtin_bit_cast(h2_t, __shfl_xor(__builtin_bit_cast(int, send), 16)); }
    { const bool up = lane & 8; const h2_t send = up ? ah[0] : ah[1], keep = up ? ah[1] : ah[0]; ah[0] = keep + __builtin_bit_cast(h2_t, __shfl_xor(__builtin_bit_cast(int, send), 8)); }
    const f32x2v peer = (f32x2v){(float)ah[0].x, (float)ah[0].y} * (1.f / V_SCALE);
    *(GAS unsigned*)((bf16*)(F.ws + WS_H) + (size_t)tc * D + 128 * j + 16 * c + 2 * g) = pk2(peer.x, peer.y);
}
__device__ __forceinline__ void p8b_vsum(Frame& F) {
    const int* IDX = (const int*)(F.ws + WS_IDX); const _Float16* W = (const _Float16*)(F.ws + WS_W16);
    const int lane = F.lane, c = lane & 7, g = lane >> 3; const SliceWork sw = slice_work(F);
    LAS unsigned char* mb = F.lds + F.wave * 1024;
    if (sw.t0 >= M) return;
    const int nt = (M - 1 - sw.t0) / sw.ts + 1;
    for (int jj = 0; jj < sw.nj; ++jj) { const int j = sw.j0 + jj; const unsigned char* Vj = F.ws + WS_V + (size_t)j * NEXP * 128;
        VSet sA, sB;
        { const VMeta m0 = p8b_G(IDX, W, TOK(0), lane); p8b_S(mb, m0, lane); }
        VMeta mN = p8b_G(IDX, W, TOK(1), lane);
        p8b_RT(F, mb, Vj, TOK(0), j, c, g, sA);
#pragma unroll 1
        for (int n = 0; n < nt; n += 2) {
            p8b_S(mb, mN, lane);
            mN = p8b_G(IDX, W, TOK(n + 2), lane);
            p8b_step(F, mb, Vj, TOK(n + 1), sB, sA, TOK(n), j, lane, c, g, true);
            asm volatile("" ::: "memory");
            p8b_S(mb, mN, lane);
            mN = p8b_G(IDX, W, TOK(n + 3), lane);
            p8b_step(F, mb, Vj, TOK(n + 2), sA, sB, TOK(n + 1), j, lane, c, g, n + 1 < nt);
            asm volatile("" ::: "memory");
        } }
#undef TOK
}
__device__ __forceinline__ void p8c_final(Frame& F) {
    const float* gf = F.in[IN_GF]; const float* ada = (const float*)(F.ws + WS_ADA); const int lane = F.lane;
    f32x4 gv[4];
#pragma unroll
    for (int q = 0; q < 4; ++q) gv[q] = *(const f32x4*)(gf + 4 * lane + 256 * q);
    const bf16* X1 = (const bf16*)(F.ws + WS_X1); const bf16* PE = (const bf16*)(F.ws + WS_H);
    for (int t = blockIdx.x * NWAVES + F.wave; t < M; t += F.G * NWAVES) {
        const GAS v2u* xr = (const GAS v2u*)(X1 + (size_t)t * D) + lane; const GAS v2u* pr = (const GAS v2u*)(PE + (size_t)t * D) + lane;
        const float* g2 = ada + (size_t)(t / SEQ) * ADA_W + 5 * D + 4 * lane;
        f32x4 x2[4]; float s = 0.f;
#pragma unroll
        for (int q = 0; q < 4; ++q) { const v2u a = __builtin_nontemporal_load(xr + 64 * q), p = __builtin_nontemporal_load(pr + 64 * q); const f32x4 gg = *(const f32x4*)(g2 + 256 * q);
            x2[q] = (f32x4){bflo(a.x), bfhi(a.x), bflo(a.y), bfhi(a.y)} + gg * (f32x4){bflo(p.x), bfhi(p.x), bflo(p.y), bfhi(p.y)};
            s += (x2[q].x * x2[q].x + x2[q].y * x2[q].y) + (x2[q].z * x2[q].z + x2[q].w * x2[q].w); }
        const float rstd = 1.0f / sqrtf(wave_sum(s) * (1.f / D) + EPS);
        GAS f32x4* yr = (GAS f32x4*)(F.out + (size_t)t * D) + lane;
#pragma unroll
        for (int q = 0; q < 4; ++q) __builtin_nontemporal_store(x2[q] * rstd * gv[q], yr + 64 * q);
    }
}

struct Args { const float* in[20]; float* out; unsigned char* ws; int ph_lo, ph_hi, li, pad; };
__global__ void __launch_bounds__(NWAVES * 64, 2) skel_fwd(Args args) {
    extern __shared__ __attribute__((aligned(16))) unsigned char lds[];
    Frame F;
    F.lds = (LAS unsigned char*)lds;
    F.MISC = (volatile LAS unsigned*)(F.lds + MISC_OFF);
    F.tid = threadIdx.x; F.lane = F.tid & 63; F.wave = __builtin_amdgcn_readfirstlane(F.tid >> 6);
    F.G = gridDim.x; { const int bx = blockIdx.x; F.vcu = (F.G % 8 == 0) ? (bx % 8) * (F.G / 8) + bx / 8 : bx; }
    F.ws = args.ws; F.out = args.out;
#pragma unroll
    for (int i = 0; i < 20; ++i) F.in[i] = args.in[i];
    F.ctl = (gu32*)(args.ws + WS_CTL);
    for (int u = F.tid; u < (LDS_BYTES - LDSCTL_OFF) / 4; u += NWAVES * 64) ((LAS unsigned*)(F.lds + LDSCTL_OFF))[u] = 0u;
    __syncthreads();
    XcdBarrier bar; bar.bar = (unsigned*)(F.ctl + CW_BAR); bar.x = 0; bar.st = nullptr;
    if (N_LAUNCHES == 1) bar = xcd_barrier_post((unsigned*)(F.ctl + CW_BAR), F.MISC + 8);
#define GRID_BAR() do { if (N_LAUNCHES == 1) xcd_barrier(bar); } while (0)
    const int lo = args.ph_lo, hi = args.ph_hi;
#define IN(k) (lo <= (k) && (k) < hi)
    bf16* const H = (bf16*)(args.ws + WS_H); bf16* const PROJ = (bf16*)(args.ws + WS_PROJ); bf16* const MIX = (bf16*)(args.ws + WS_MIX);

    if (IN(0)) { p0_prologue(F); GRID_BAR(); }
    if (IN(1)) { p1_hpass(F); GRID_BAR(); }
    if (IN(2)) {
        pg8::Gemm g{(const bf16*)(args.ws + WS_H8), (const bf16*)(args.ws + WS_WIN), M, IN_W, D / 2}; pg8::StaticOrder S; S.init(M, IN_W, F.G, (int)blockIdx.x);
        pg8::EpiI8Bf16 E{PROJ, IN_W, (const float*)(args.ws + WS_HS), 1.f / WQ_SCALE, F.in[IN_BIN]};
        pg8::gemm_phase<pg8::EpiI8Bf16, pg8::StaticOrder, true, true, true>(F.lds + RING_OFF, g, S, E);
        GRID_BAR();
    }
    if (IN(3)) { p3_mixer(F); GRID_BAR(); }
    if (IN(4)) {
        pg8::Gemm g{MIX, (const bf16*)(args.ws + WS_WOUT), M, D, D}; pg8::StaticOrder S; S.init(M, D, F.G, (int)blockIdx.x);
        pg8::EpiResGate E{F.in[IN_X], (bf16*)(args.ws + WS_X1), D, F.in[IN_BOUT], (const float*)(args.ws + WS_ADA), ADA_W, 2 * D, SEQ / 256};
        pg8::gemm_phase<pg8::EpiResGate, pg8::StaticOrder, true, true>(F.lds + RING_OFF, g, S, E);
        GRID_BAR();
    }
    if (IN(5)) { p5_h2pass(F); GRID_BAR(); }
    if (IN(6)) {
        pg8::Gemm g{(const bf16*)(args.ws + WS_H8), (const bf16*)(args.ws + WS_WQ), M, QW, D / 2}; pg8::StaticOrder S; S.init(M, QW, F.G, (int)blockIdx.x);
        pg8::EpiI8Bf16 E{PROJ, QW, (const float*)(args.ws + WS_HS), 1.f / WQ_SCALE, nullptr};
        pg8::gemm_phase<pg8::EpiI8Bf16, pg8::StaticOrder, true, true, true>(F.lds + RING_OFF, g, S, E);
        GRID_BAR();
    }
    if (IN(7)) { p7_routing(F); GRID_BAR(); }
    if (IN(8)) { p8a_udots(F); GRID_BAR(); }
    if (IN(9)) { p8w_weights(F); GRID_BAR(); }
    if (IN(10)) { p8b_vsum(F); GRID_BAR(); }
    if (IN(11)) { p8c_final(F); }
#undef IN
}

extern "C" void kernel_launch(void* const* d_in, const int* in_sizes, int n_in, void* d_out, int out_size, void* d_ws, size_t ws_size, hipStream_t stream) {
    static int grid = 0;
    if (grid == 0) {
        if (n_in != 20 || in_sizes[0] != M * D || out_size != M * D || ws_size < WS_END) { fprintf(stderr, "kernel_launch: unexpected shapes (n_in %d, in0 %d, out %d, ws %zu); nothing launched\n", n_in, n_in > 0 ? in_sizes[0] : -1, out_size, ws_size); grid = -1; return; }
        int dev = 0, cus = 0, per_cu = 0;
        if (hipGetDevice(&dev) != hipSuccess || hipDeviceGetAttribute(&cus, hipDeviceAttributeMultiprocessorCount, dev) != hipSuccess) { fprintf(stderr, "kernel_launch: device query failed\n"); grid = -1; return; }
        if (hipFuncSetAttribute((const void*)skel_fwd, hipFuncAttributeMaxDynamicSharedMemorySize, LDS_BYTES) != hipSuccess) { fprintf(stderr, "kernel_launch: hipFuncSetAttribute failed\n"); grid = -1; return; }
        if (hipOccupancyMaxActiveBlocksPerMultiprocessor(&per_cu, (const void*)skel_fwd, NWAVES * 64, LDS_BYTES) != hipSuccess || per_cu < 1)
            fprintf(stderr, "kernel_launch: note: occupancy query reports %d workgroups per CU\n", per_cu);
        (void)hipGetLastError();
        grid = cus;
    }
    if (grid < 0) return;
    if (hipMemsetAsync((char*)d_ws + WS_CTL, 0, CTL_ZERO_BYTES, stream) != hipSuccess) { fprintf(stderr, "kernel_launch: hipMemsetAsync failed\n"); return; }
    Args a{};
    for (int i = 0; i < 20; ++i) a.in[i] = (const float*)d_in[i];
    a.out = (float*)d_out; a.ws = (unsigned char*)d_ws;
    for (int li = 0; li < N_LAUNCHES; ++li) {
        a.ph_lo = (N_LAUNCHES == 1) ? 0 : li; a.ph_hi = (N_LAUNCHES == 1) ? NPHASES : li + 1; a.li = li;
        hipLaunchKernelGGL(skel_fwd, dim3(grid), dim3(NWAVES * 64), LDS_BYTES, stream, a);
        const hipError_t le = hipPeekAtLastError();
        if (le != hipSuccess) { fprintf(stderr, "kernel_launch: launch %d failed: %s\n", li, hipGetErrorName(le)); break; }
    }
}
```

```cpp
#include <hip/hip_runtime.h>
#include <cstdio>
#include <cstdint>
#include <cmath>
namespace pg8 {
#define PG8_LAS __attribute__((address_space(3)))
typedef unsigned short bf16_t;
typedef short bf16x8 __attribute__((ext_vector_type(8)));
typedef float f32x4 __attribute__((ext_vector_type(4)));
typedef unsigned u32x4 __attribute__((ext_vector_type(4)));
constexpr int BM = 256, BK = 64, HALF = 128, HTB = HALF * BK * 2  , STAGE_BYTES = 8 * HTB, NXCD = 8, WGM = 8;

__host__ __device__ __forceinline__ int lds_byte(int r, int c) { const int st = (r >> 4) * 2 + (c >> 5), rr = r & 15, cc = c & 31, ob = rr * 64 + cc * 2; return st * 1024 + (ob ^ (((ob >> 9) & 1) << 5)); }
__host__ __device__ __forceinline__ void stage_rc(int b, int& R, int& C) { const int st = b / 1024, sb = b % 1024, swz = sb ^ (((sb >> 9) & 1) << 5); R = (st >> 1) * 16 + swz / 64; C = (st & 1) * 32 + (swz % 64) / 2; }
__host__ __device__ __forceinline__ int perm32(int rho) { const int n = rho >> 4, i = rho & 15; return 8 * (i >> 2) + 4 * n + (i & 3); }

struct Unit { int pm, pn; };
struct Gemm { const bf16_t* A; const bf16_t* Bt; int M, N, K; };

struct StaticOrder {
    int nM, nN, nwg, G, c;
    __host__ __device__ void init(int M, int N, int G_, int c_) { nM = M / BM; nN = N / BM; nwg = nM * nN; G = G_; c = c_; }
    __host__ __device__ bool next(int i, Unit& u) const {
        const long L = (long)i * G + c; if (L >= nwg) return false;
        int wgid = (int)L; { const int q = nwg / NXCD, r = nwg % NXCD, xcd = wgid % NXCD, off = wgid / NXCD; wgid = (xcd < r ? xcd * (q + 1) : r * (q + 1) + (xcd - r) * q) + off; }
        const int nig = WGM * nN, gid = wgid / nig, fm = gid * WGM, gsz = (nM - fm) < WGM ? (nM - fm) : WGM;
        u.pm = fm + ((wgid % nig) % gsz); u.pn = (wgid % nig) / gsz; return true;
    }
    __device__ __forceinline__ void a_ready(const Unit&) const {}
    __device__ __forceinline__ void done(const Unit&) const {}
};

__device__ __forceinline__ unsigned cvt_pk_bf16(float lo, float hi) { unsigned r; asm volatile("v_cvt_pk_bf16_f32 %0, %1, %2" : "=v"(r) : "v"(lo), "v"(hi)); return r; }
typedef float f32x2 __attribute__((ext_vector_type(2)));
__device__ __forceinline__ f32x2 gelu_pk(f32x2 v) {
    const f32x2 av = __builtin_elementwise_abs(v), d = av * 0.2316418882f + 1.0f;
    f32x2 t; t.x = __builtin_amdgcn_rcpf(d.x); t.y = __builtin_amdgcn_rcpf(d.y);
    f32x2 q = t * 0.5307027145f + (-0.7265760135f); q = q * t + 0.7107068705f; q = q * t + (-0.142248368f); q = q * t + 0.127414796f; q = q * t;
    const f32x2 s = (v * v) * (-0.72134752044f);
    f32x2 e; e.x = __builtin_amdgcn_exp2f(s.x); e.y = __builtin_amdgcn_exp2f(s.y);
    const f32x2 m = v * (q * e), r = v - m;
    f32x2 o; o.x = v.x < 0.f ? m.x : r.x; o.y = v.y < 0.f ? m.y : r.y; return o;
}

template <int ACT  > struct EpiBf16 {
    static constexpr bool PERM = true, AFTER_DRAIN = false; static_assert(ACT == 0 || ACT == 1, "EpiBf16: ACT is 0 (none) or 1 (gelu_pk)");
    bf16_t* O; int ldc; const float* bias; int split_cols; size_t split_stride; float scale0;
    __device__ __forceinline__ void operator()(const f32x4 (&acc)[2][2][4][2], const Unit& u, int wr, int wc, int fr, int fq) const {
        const int row0 = u.pm * BM + wr * 64 + fr; int colt = u.pn * BM; bf16_t* base = O;
        float sc = 1.f; if (split_cols) { const int t = colt / split_cols; base += (size_t)t * split_stride; colt -= t * split_cols; if (t == 0) sc = scale0; }
        const int col0 = colt + wc * 32 + 8 * fq, bcol0 = u.pn * BM + wc * 32 + 8 * fq;
        f32x4 bv[2][2];
#pragma unroll
        for (int bj = 0; bj < 2; ++bj)
#pragma unroll
            for (int n = 0; n < 2; ++n) bv[bj][n] = bias ? *(const f32x4*)(bias + bcol0 + bj * HALF + 4 * n) : (f32x4){0.f, 0.f, 0.f, 0.f};
#pragma unroll
        for (int ai = 0; ai < 2; ++ai)
#pragma unroll
            for (int m = 0; m < 4; ++m) { bf16_t* rowp = base + (size_t)(row0 + ai * HALF + m * 16) * ldc + col0;
#pragma unroll
                for (int bj = 0; bj < 2; ++bj) { f32x4 v0 = acc[ai][bj][m][0] + bv[bj][0], v1 = acc[ai][bj][m][1] + bv[bj][1];
                    if (ACT == 1) { f32x2 a = gelu_pk((f32x2){v0[0], v0[1]}), b = gelu_pk((f32x2){v0[2], v0[3]}), c = gelu_pk((f32x2){v1[0], v1[1]}), d = gelu_pk((f32x2){v1[2], v1[3]});
                        v0 = (f32x4){a.x, a.y, b.x, b.y}; v1 = (f32x4){c.x, c.y, d.x, d.y}; }
                    v0 = v0 * sc; v1 = v1 * sc; u32x4 w; w.x = cvt_pk_bf16(v0[0], v0[1]); w.y = cvt_pk_bf16(v0[2], v0[3]); w.z = cvt_pk_bf16(v1[0], v1[1]); w.w = cvt_pk_bf16(v1[2], v1[3]);
                    *(u32x4*)(rowp + bj * HALF) = w; } }
    }
};

typedef unsigned u32x2 __attribute__((ext_vector_type(2)));
struct EpiResGate {
    static constexpr bool PERM = false, AFTER_DRAIN = false;
    const float* x; bf16_t* out; int ldc; const float* bias; const float* ada; int ada_ld, gate_off, tiles_per_batch;
    __device__ __forceinline__ void operator()(const f32x4 (&acc)[2][2][4][2], const Unit& u, int wr, int wc, int fr, int fq) const {
        const int row0 = u.pm * BM + wr * 64 + fr, col0 = u.pn * BM + wc * 32 + 4 * fq;
        const float* gp = ada + (size_t)(u.pm / tiles_per_batch) * ada_ld + gate_off;
        f32x4 bv[2][2], gv[2][2];
#pragma unroll
        for (int bj = 0; bj < 2; ++bj)
#pragma unroll
            for (int n = 0; n < 2; ++n) { bv[bj][n] = *(const f32x4*)(bias + col0 + bj * HALF + n * 16); gv[bj][n] = *(const f32x4*)(gp + col0 + bj * HALF + n * 16); }
#pragma unroll
        for (int ai = 0; ai < 2; ++ai) {
            f32x4 xv[4][2][2];
#pragma unroll
            for (int m = 0; m < 4; ++m) { const size_t off = (size_t)(row0 + ai * HALF + m * 16) * ldc + col0;
#pragma unroll
                for (int bj = 0; bj < 2; ++bj)
#pragma unroll
                    for (int n = 0; n < 2; ++n) xv[m][bj][n] = __builtin_nontemporal_load((const f32x4*)(x + off + bj * HALF + n * 16)); }
#pragma unroll
            for (int m = 0; m < 4; ++m) { const size_t off = (size_t)(row0 + ai * HALF + m * 16) * ldc + col0;
#pragma unroll
                for (int bj = 0; bj < 2; ++bj)
#pragma unroll
                    for (int n = 0; n < 2; ++n) { const f32x4 o = xv[m][bj][n] + gv[bj][n] * (acc[ai][bj][m][n] + bv[bj][n]);
                        u32x2 w; w.x = cvt_pk_bf16(o[0], o[1]); w.y = cvt_pk_bf16(o[2], o[3]); *(u32x2*)(out + off + bj * HALF + n * 16) = w; } }
            asm volatile("" ::: "memory"); }
    }
};


typedef int i32x4 __attribute__((ext_vector_type(4)));
template <bool I8> struct AccSel { typedef f32x4 type; static __device__ __forceinline__ f32x4 zero() { return (f32x4){0.f, 0.f, 0.f, 0.f}; } };
template <> struct AccSel<true> { typedef i32x4 type; static __device__ __forceinline__ i32x4 zero() { return (i32x4){0, 0, 0, 0}; } };
template <bool I8> __device__ __forceinline__ typename AccSel<I8>::type mma16(bf16x8 a, bf16x8 b, typename AccSel<I8>::type c) {
    if constexpr (I8) return __builtin_amdgcn_mfma_i32_16x16x64_i8(__builtin_bit_cast(i32x4, a), __builtin_bit_cast(i32x4, b), c, 0, 0, 0);
    else return __builtin_amdgcn_mfma_f32_16x16x32_bf16(a, b, c, 0, 0, 0);
}
struct EpiI8Bf16 {
    static constexpr bool PERM = true, AFTER_DRAIN = false;
    bf16_t* O; int ldc; const float* rowscale; float wscale; const float* bias;
    __device__ __forceinline__ void operator()(const i32x4 (&acc)[2][2][4][2], const Unit& u, int wr, int wc, int fr, int fq) const {
        const int row0 = u.pm * BM + wr * 64 + fr, col0 = u.pn * BM + wc * 32 + 8 * fq;
        f32x4 bv[2][2];
#pragma unroll
        for (int bj = 0; bj < 2; ++bj)
#pragma unroll
            for (int n = 0; n < 2; ++n) bv[bj][n] = bias ? *(const f32x4*)(bias + col0 + bj * HALF + 4 * n) : (f32x4){0.f, 0.f, 0.f, 0.f};
#pragma unroll
        for (int ai = 0; ai < 2; ++ai)
#pragma unroll
            for (int m = 0; m < 4; ++m) { const int row = row0 + ai * HALF + m * 16; const float sc = rowscale[row] * wscale; bf16_t* rowp = O + (size_t)row * ldc + col0;
#pragma unroll
                for (int bj = 0; bj < 2; ++bj) { const i32x4 a0 = acc[ai][bj][m][0], a1 = acc[ai][bj][m][1]; const f32x4 b0 = bv[bj][0], b1 = bv[bj][1];
                    u32x4 w; w.x = cvt_pk_bf16((float)a0[0] * sc + b0[0], (float)a0[1] * sc + b0[1]); w.y = cvt_pk_bf16((float)a0[2] * sc + b0[2], (float)a0[3] * sc + b0[3]);
                    w.z = cvt_pk_bf16((float)a1[0] * sc + b1[0], (float)a1[1] * sc + b1[1]); w.w = cvt_pk_bf16((float)a1[2] * sc + b1[2], (float)a1[3] * sc + b1[3]);
                    *(u32x4*)(rowp + bj * HALF) = w; } }
    }
};
template <class Epi, class Sched, bool ALIGN_EPI = false, bool SP2 = false, bool I8 = false>
__device__ __forceinline__ void gemm_phase(PG8_LAS unsigned char* lds, const Gemm g, const Sched& S, const Epi& E) {
    const int tid = threadIdx.x, wid = __builtin_amdgcn_readfirstlane(tid >> 6), lane = tid & 63, wr = wid >> 2, wc = wid & 3, fr = lane & 15, fq = lane >> 4;
    const int K = g.K, nt = K / BK;
    unsigned voffA[2], voffB[2];
#pragma unroll
    for (int i = 0; i < 2; ++i) { int R, C; stage_rc(tid * 16 + i * 8192, R, C); const int Rb = Epi::PERM ? ((R & ~31) + perm32(R & 31)) : R;
        voffA[i] = (unsigned)(R * K + C) * 2u; voffB[i] = (unsigned)(Rb * K + C) * 2u; }
    const size_t kstep = (size_t)(BK * 2);
    const size_t hstep = (size_t)HALF * K * 2;
    const size_t tstep = 2 * hstep;
    const unsigned ldsw = (unsigned)wid * 1024u;
    const int aoff = lds_byte(wr * 64 + fr, fq * 8), boff = lds_byte(wc * 32 + fr, fq * 8);
#define PG8_SA(b, h) (((b) * 2 + (h)) * HTB)
#define PG8_SB(b, h) ((4 + (b) * 2 + (h)) * HTB)
#define PG8_STAGE(bufoff, gbase, voff) do { _Pragma("unroll") for (int _i = 0; _i < 2; ++_i) \
        __builtin_amdgcn_global_load_lds((const unsigned*)((const char*)(gbase) + (voff)[_i]), (PG8_LAS unsigned*)(lds + (bufoff) + ldsw + _i * 8192), 16, 0, 0); } while (0)
#define PG8_LDA(dst, b, h) do { _Pragma("unroll") for (int m = 0; m < 4; ++m) _Pragma("unroll") for (int k = 0; k < 2; ++k) dst[m][k] = *(const PG8_LAS bf16x8*)(lds + PG8_SA(b, h) + aoff + m * 2048 + k * 1024); } while (0)
#define PG8_LDB(dst, b, h) do { _Pragma("unroll") for (int n = 0; n < 2; ++n) _Pragma("unroll") for (int k = 0; k < 2; ++k) dst[n][k] = *(const PG8_LAS bf16x8*)(lds + PG8_SB(b, h) + boff + n * 2048 + k * 1024); } while (0)
#define PG8_MMA(ai, bj, At, Bt) do { __builtin_amdgcn_s_setprio(1); _Pragma("unroll") for (int m = 0; m < 4; ++m) _Pragma("unroll") for (int n = 0; n < 2; ++n) _Pragma("unroll") for (int k = 0; k < 2; ++k) \
        acc[ai][bj][m][n] = mma16<I8>(Bt[n][k], At[m][k], acc[ai][bj][m][n]); __builtin_amdgcn_s_setprio(0); } while (0)
#define PG8_WAIT_V(n) asm volatile("s_waitcnt vmcnt(" #n ")" ::: "memory")
#define PG8_WAIT_L(n) asm volatile("s_waitcnt lgkmcnt(" #n ")" ::: "memory")
#define PG8_BAR __builtin_amdgcn_s_barrier()
#define PG8_SCHED __builtin_amdgcn_sched_barrier(0)
    Unit cur, nxt; int ui = 0;
    if (!S.next(0, cur)) return;
    typedef typename AccSel<I8>::type acc_t;
    acc_t acc[2][2][4][2];
#pragma unroll
    for (int a = 0; a < 2; ++a)
#pragma unroll
        for (int b = 0; b < 2; ++b)
#pragma unroll
            for (int m = 0; m < 4; ++m)
#pragma unroll
                for (int n = 0; n < 2; ++n) acc[a][b][m][n] = AccSel<I8>::zero();
    bf16x8 At[4][2], B0[2][2], B1[2][2];
    const char* cA = (const char*)g.A + (size_t)cur.pm * tstep; const char* cB = (const char*)g.Bt + (size_t)cur.pn * tstep;
    S.a_ready(cur);
    if constexpr (SP2) {
        PG8_STAGE(PG8_SB(0, 0), cB, voffB); PG8_STAGE(PG8_SB(0, 1), cB + hstep, voffB); PG8_STAGE(PG8_SA(0, 0), cA, voffA); PG8_STAGE(PG8_SA(0, 1), cA + hstep, voffA);
        if (wr == 1) PG8_BAR;
        PG8_WAIT_V(2); PG8_BAR;
        PG8_STAGE(PG8_SB(1, 0), cB + kstep, voffB); PG8_STAGE(PG8_SA(1, 0), cA + kstep, voffA); PG8_STAGE(PG8_SB(1, 1), cB + hstep + kstep, voffB);
        PG8_WAIT_V(6); PG8_BAR;
    } else {
        PG8_STAGE(PG8_SB(0, 0), cB, voffB); PG8_STAGE(PG8_SA(0, 0), cA, voffA); PG8_STAGE(PG8_SB(0, 1), cB + hstep, voffB); PG8_STAGE(PG8_SA(0, 1), cA + hstep, voffA);
        if (wr == 1) PG8_BAR;
        PG8_WAIT_V(4); PG8_BAR;
        PG8_STAGE(PG8_SB(1, 0), cB + kstep, voffB); PG8_STAGE(PG8_SA(1, 0), cA + kstep, voffA); PG8_STAGE(PG8_SB(1, 1), cB + hstep + kstep, voffB);
        PG8_WAIT_V(6); PG8_BAR;
    }
    for (;;) {
        const bool has_next = S.next(ui + 1, nxt);
        const char* nA = has_next ? (const char*)g.A + (size_t)nxt.pm * tstep : cA; const char* nB = has_next ? (const char*)g.Bt + (size_t)nxt.pn * tstep : cB;
        for (int t = 0; t < nt; t += 2) {
            const bool last = (t == nt - 2);
            const char* a1 = cA + (size_t)(t + 1) * kstep;
            const char* a2 = last ? nA : cA + (size_t)(t + 2) * kstep; const char* b2 = last ? nB : cB + (size_t)(t + 2) * kstep;
            const char* a3 = a2 + kstep; const char* b3 = b2 + kstep;
            if (last && has_next) S.a_ready(nxt);
            if constexpr (SP2) {
            PG8_LDB(B0, 0, 0); PG8_LDB(B1, 0, 1); PG8_SCHED; PG8_LDA(At, 0, 0); PG8_STAGE(PG8_SA(1, 1), a1 + hstep, voffA);
            PG8_WAIT_V(8); PG8_WAIT_L(0); PG8_BAR; PG8_MMA(0, 0, At, B0); PG8_MMA(0, 1, At, B1); PG8_BAR; PG8_SCHED;
            PG8_LDA(At, 0, 1); PG8_STAGE(PG8_SB(0, 0), b2, voffB); PG8_STAGE(PG8_SB(0, 1), b2 + hstep, voffB); PG8_STAGE(PG8_SA(0, 0), a2, voffA);
            PG8_WAIT_V(8); PG8_WAIT_L(0); PG8_BAR; PG8_MMA(1, 0, At, B0); PG8_MMA(1, 1, At, B1); PG8_BAR; PG8_SCHED;
            PG8_LDB(B0, 1, 0); PG8_LDB(B1, 1, 1); PG8_SCHED; PG8_LDA(At, 1, 0); PG8_STAGE(PG8_SA(0, 1), a2 + hstep, voffA);
            PG8_WAIT_V(8); PG8_WAIT_L(0); PG8_BAR; PG8_MMA(0, 0, At, B0); PG8_MMA(0, 1, At, B1); PG8_BAR; PG8_SCHED;
            PG8_LDA(At, 1, 1); PG8_STAGE(PG8_SB(1, 0), b3, voffB); PG8_STAGE(PG8_SB(1, 1), b3 + hstep, voffB); PG8_STAGE(PG8_SA(1, 0), a3, voffA);
            PG8_WAIT_V(8); PG8_WAIT_L(0); PG8_BAR; PG8_MMA(1, 0, At, B0); PG8_MMA(1, 1, At, B1); PG8_BAR; PG8_SCHED;
            } else {
            PG8_LDB(B0, 0, 0); PG8_SCHED; PG8_LDA(At, 0, 0); PG8_STAGE(PG8_SA(1, 1), a1 + hstep, voffA);
            PG8_WAIT_L(8); PG8_BAR; PG8_WAIT_L(0); PG8_MMA(0, 0, At, B0); PG8_BAR; PG8_SCHED;
            PG8_LDB(B1, 0, 1); PG8_STAGE(PG8_SB(0, 0), b2, voffB);
            PG8_BAR; PG8_WAIT_L(0); PG8_MMA(0, 1, At, B1); PG8_BAR;
            PG8_LDA(At, 0, 1); PG8_STAGE(PG8_SA(0, 0), a2, voffA);
            PG8_BAR; PG8_WAIT_L(0); PG8_MMA(1, 0, At, B0); PG8_BAR; PG8_SCHED;
            PG8_STAGE(PG8_SB(0, 1), b2 + hstep, voffB);
            PG8_WAIT_V(6); PG8_BAR; PG8_MMA(1, 1, At, B1); PG8_BAR;
            PG8_LDB(B0, 1, 0); PG8_SCHED; PG8_LDA(At, 1, 0); PG8_STAGE(PG8_SA(0, 1), a2 + hstep, voffA);
            PG8_WAIT_L(8); PG8_BAR; PG8_WAIT_L(0); PG8_MMA(0, 0, At, B0); PG8_BAR; PG8_SCHED;
            PG8_LDB(B1, 1, 1); PG8_STAGE(PG8_SB(1, 0), b3, voffB);
            PG8_BAR; PG8_WAIT_L(0); PG8_MMA(0, 1, At, B1); PG8_BAR;
            PG8_LDA(At, 1, 1); PG8_STAGE(PG8_SA(1, 0), a3, voffA);
            PG8_BAR; PG8_WAIT_L(0); PG8_MMA(1, 0, At, B0); PG8_BAR; PG8_SCHED;
            PG8_STAGE(PG8_SB(1, 1), b3 + hstep, voffB);
            PG8_WAIT_V(6); PG8_BAR; PG8_MMA(1, 1, At, B1); PG8_BAR;
            }
        }
        if constexpr (ALIGN_EPI) { if (wr == 0) PG8_BAR; }
        if constexpr (!Epi::AFTER_DRAIN) { E(acc, cur, wr, wc, fr, fq); S.done(cur); }
        if (!has_next) break;
#pragma unroll
        for (int a = 0; a < 2; ++a)
#pragma unroll
            for (int b = 0; b < 2; ++b)
#pragma unroll
                for (int m = 0; m < 4; ++m)
#pragma unroll
                    for (int n = 0; n < 2; ++n) acc[a][b][m][n] = AccSel<I8>::zero();
        cur = nxt; cA = nA; cB = nB; ++ui;
        if constexpr (ALIGN_EPI) { if (wr == 1) PG8_BAR; }
    }
    PG8_WAIT_V(0);
    if constexpr (!ALIGN_EPI) { if (wr == 0) PG8_BAR; }
    PG8_BAR;
    if constexpr (Epi::AFTER_DRAIN) { E.fused(acc, cur, wr, wc, fr, fq, lds, wid, lane); S.done(cur); }
#undef PG8_SA
#undef PG8_SB
#undef PG8_STAGE
#undef PG8_LDA
#undef PG8_LDB
#undef PG8_MMA
#undef PG8_WAIT_V
#undef PG8_WAIT_L
#undef PG8_BAR
#undef PG8_SCHED
}
}

constexpr int NWAVES = 8;
constexpr int NPHASES = 12;
#ifndef MK_N_LAUNCHES
#define MK_N_LAUNCHES 1
#endif
constexpr int N_LAUNCHES = MK_N_LAUNCHES;
static_assert(N_LAUNCHES == 1 || N_LAUNCHES == NPHASES, "MK_N_LAUNCHES is 1 or NPHASES");

constexpr int BATCH = 16, SEQ = 2048, D = 1024, M = BATCH * SEQ;
constexpr int IN_W = 2304, O_Q = 0, O_K = 512, O_V = 640, O_B = 768, O_C = 1280, O_U = 1792;
constexpr int NQH = 8, NKVH = 2, HD = 64, WIN = 128;
constexpr int NKEYS = 128, NEXP = 16384, PH = 8, TOPK = 16, DKEY = 256, DHALF = 128, QW = PH * DKEY;
constexpr int ADA_W = 6 * D, ADA_KC = 8;
constexpr float EPS = 1e-6f;

constexpr size_t MiB = 1u << 20;
constexpr size_t WS_CTL = 0, CTL_ZERO_BYTES = 64 * 1024;
constexpr size_t WS_ADAP = 1 * MiB;
constexpr size_t WS_ADA = 4 * MiB;
constexpr size_t WS_WIN = 5 * MiB;
constexpr size_t WS_WOUT = 10 * MiB;
constexpr size_t WS_WQ = 12 * MiB;
constexpr size_t WS_K1 = 16 * MiB, WS_K2 = 16 * MiB + 512 * 1024;
constexpr size_t WS_U = 17 * MiB, WS_V = 33 * MiB;
constexpr float U_SCALE = 896.f, V_SCALE = 8.f, WQ_SCALE = 896.f;
constexpr size_t WS_H = 81 * MiB;
constexpr size_t WS_PROJ = 145 * MiB;
constexpr size_t WS_MIX = 289 * MiB;
constexpr size_t WS_IDX = 353 * MiB;
constexpr size_t WS_GATE = 369 * MiB;
constexpr size_t WS_H8 = 49 * MiB;
constexpr size_t WS_HS = 393 * MiB;
constexpr size_t WS_W16 = 385 * MiB;
constexpr size_t WS_X1 = 417 * MiB;
constexpr size_t WS_END = 481 * MiB;
constexpr size_t WS_PA = WS_PROJ;
constexpr size_t WS_SS = WS_MIX;
constexpr int CW_BAR = 4096;
static_assert((CW_BAR + 3456) * 4 <= (int)CTL_ZERO_BYTES, "barrier words inside the zeroed region");

constexpr int RING_OFF = 0, RING_BYTES = 131072;
constexpr int LDSCTL_OFF = 135168, MISC_OFF = LDSCTL_OFF + 320;
constexpr int LDS_BYTES = 147456;
static_assert(MISC_OFF + 128 <= LDS_BYTES, "LDS map");

#define GAS __attribute__((address_space(1)))
#define LAS __attribute__((address_space(3)))
typedef unsigned short bf16;
typedef unsigned v4u __attribute__((ext_vector_type(4)));
typedef float f32x4 __attribute__((ext_vector_type(4)));
typedef short bf16x8 __attribute__((ext_vector_type(8)));
typedef GAS unsigned gu32;
typedef GAS unsigned long long gu64;
#define RLX_AGENT __ATOMIC_RELAXED, __HIP_MEMORY_SCOPE_AGENT
#define LDS_WAIT() asm volatile("s_waitcnt lgkmcnt(0)" ::: "memory")
#define VM_WAIT() asm volatile("s_waitcnt vmcnt(0)" ::: "memory")
__device__ __forceinline__ unsigned long long rt() { return __builtin_amdgcn_s_memrealtime(); }
__device__ __forceinline__ unsigned f2bf(float f) { unsigned u = __builtin_bit_cast(unsigned, f); return (u + 0x7fffu + ((u >> 16) & 1u)) >> 16; }
__device__ __forceinline__ unsigned pk2(float lo, float hi) { return f2bf(lo) | (f2bf(hi) << 16); }

#define XB_TMO      128
#define XB_XCNT(j)  (256  + 64 * (j))
#define XB_XSUB(j)  (1280 + 64 * (j))
#define XB_XGEN(j)  (2304 + 64 * (j))
#define XB_TOP      3328
#define XB_TOPGEN   3392
#define XCD_BAR_WORDS 3456
#define XB_SPIN_CAP (1u << 22)

__device__ __forceinline__ unsigned xb_ld(unsigned* p)              { return __hip_atomic_load(p, __ATOMIC_RELAXED, __HIP_MEMORY_SCOPE_AGENT); }
__device__ __forceinline__ unsigned xb_add(unsigned* p, unsigned v) { return __hip_atomic_fetch_add(p, v, __ATOMIC_RELAXED, __HIP_MEMORY_SCOPE_AGENT); }
__device__ __forceinline__ unsigned xb_xcc_id() { return (unsigned)__builtin_amdgcn_s_getreg((3 << 11) | 20) & 0xFu; }
#define XB_SPIN(cond, bar) do { unsigned _sp = 0; while (cond) { __builtin_amdgcn_s_sleep(1); \
    if ((++_sp & 255u) == 0u) { if (xb_ld(&(bar)[XB_TMO])) break; if (_sp > XB_SPIN_CAP) { atomicAdd(&(bar)[XB_TMO], 1u); break; } } } } while (0)

struct XcdBarrier {
    unsigned* bar; unsigned x;
    volatile LAS unsigned* st;
};

__device__ __forceinline__ XcdBarrier xcd_barrier_post(unsigned* bar, volatile LAS unsigned* st) {
    XcdBarrier b; b.bar = bar; b.x = xb_xcc_id(); b.st = st;
    if (threadIdx.x == 0) (void)xb_add(&bar[XB_XCNT(b.x)], 1u);
    return b;
}
__device__ __forceinline__ void xcd_barrier_complete(unsigned* bar, unsigned x, unsigned& nloc, unsigned& nx) {
    const unsigned G = gridDim.x * gridDim.y * gridDim.z;
    unsigned sum, cnt, mine, sp = 0u;
    for (;;) {
        sum = 0u; cnt = 0u; mine = 0u;
#pragma unroll
        for (unsigned j = 0; j < 16; ++j) { const unsigned c = xb_ld(&bar[XB_XCNT(j)]); sum += c; cnt += (c > 0u) ? 1u : 0u; mine = (j == x) ? c : mine; }
        if (sum == G) break;
        __builtin_amdgcn_s_sleep(1);
        if ((++sp & 255u) == 0u) { if (xb_ld(&bar[XB_TMO])) break; if (sp > XB_SPIN_CAP) { atomicAdd(&bar[XB_TMO], 1u); break; } }
    }
    nloc = mine > 0u ? mine : 1u; nx = cnt > 0u ? cnt : 1u;
}

__device__ __forceinline__ void xcd_barrier(const XcdBarrier& b) {
    asm volatile("s_waitcnt vmcnt(0)" ::: "memory");
    __syncthreads();
    if (threadIdx.x == 0) {
        unsigned* bar = b.bar;
        __builtin_amdgcn_s_waitcnt(0);
        unsigned nloc = b.st[0], nx = b.st[1];
        if (nloc == 0u) { xcd_barrier_complete(bar, b.x, nloc, nx); b.st[0] = nloc; b.st[1] = nx; }
        const unsigned old = xb_add(&bar[XB_XSUB(b.x)], 1u);
        const unsigned gen = old / nloc;
        if (old + 1u == (gen + 1u) * nloc) {
            __builtin_amdgcn_fence(__ATOMIC_RELEASE, "agent");
            asm volatile("s_waitcnt vmcnt(0)" ::: "memory");
            const unsigned og = xb_add(&bar[XB_TOP], 1u);
            const unsigned tg = og / nx;
            if (og + 1u == (tg + 1u) * nx) xb_add(&bar[XB_TOPGEN], 1u);
            else XB_SPIN(xb_ld(&bar[XB_TOPGEN]) == tg, bar);
            __builtin_amdgcn_fence(__ATOMIC_ACQUIRE, "agent");
            xb_add(&bar[XB_XGEN(b.x)], 1u);
            asm volatile("s_waitcnt vmcnt(0)" ::: "memory");
        } else {
            XB_SPIN(xb_ld(&bar[XB_XGEN(b.x)]) == gen, bar);
            __builtin_amdgcn_fence(__ATOMIC_ACQUIRE, "agent");
            asm volatile("s_waitcnt vmcnt(0)" ::: "memory");
        }
    }
    __syncthreads();
}

struct Frame {
    LAS unsigned char* lds;
    volatile LAS unsigned* MISC;
    gu32* ctl;
    int tid, lane, wave;
    int vcu, G;
    const float* in[20]; float* out; unsigned char* ws;
};
#define IN_X 0
#define IN_C 1
#define IN_WADA 2
#define IN_BADA 3
#define IN_G1 4
#define IN_WIN 5
#define IN_BIN 6
#define IN_SINK 7
#define IN_CONVW 8
#define IN_AOG 9
#define IN_COG 10
#define IN_WOUT 11
#define IN_BOUT 12
#define IN_G2 13
#define IN_WQ 14
#define IN_PK1 15
#define IN_PK2 16
#define IN_PU 17
#define IN_PV 18
#define IN_GF 19

typedef __bf16 bf16x2_t __attribute__((ext_vector_type(2)));
typedef unsigned v2u __attribute__((ext_vector_type(2)));
__device__ __forceinline__ float dot2(unsigned a, unsigned b, float acc) { return __builtin_amdgcn_fdot2_f32_bf16(__builtin_bit_cast(bf16x2_t, a), __builtin_bit_cast(bf16x2_t, b), acc, false); }
__device__ __forceinline__ float dot8(v4u a, v4u b, float acc) { acc = dot2(a.x, b.x, acc); acc = dot2(a.y, b.y, acc); acc = dot2(a.z, b.z, acc); acc = dot2(a.w, b.w, acc); return acc; }
__device__ __forceinline__ float bflo(unsigned w) { return __uint_as_float(w << 16); }
__device__ __forceinline__ float bfhi(unsigned w) { return __uint_as_float(w & 0xffff0000u); }
__device__ __forceinline__ float wave_sum(float v) {
#pragma unroll
    for (int o = 1; o < 64; o <<= 1) v += __shfl_xor(v, o);
    return v;
}
__device__ __forceinline__ unsigned wave_umax(unsigned v) {
#pragma unroll
    for (int o = 1; o < 64; o <<= 1) { const unsigned t = (unsigned)__shfl_xor((int)v, o); v = v > t ? v : t; }
    return v;
}
__device__ __forceinline__ unsigned f2ord(float f) { const unsigned u = __float_as_uint(f); return (u & 0x80000000u) ? ~u : (u | 0x80000000u); }
__device__ __forceinline__ float ord2f(unsigned u) { return __uint_as_float((u & 0x80000000u) ? (u & 0x7fffffffu) : ~u); }

__device__ __forceinline__ unsigned pk4_i8(f32x4 a, float sc) {
    const int q0 = max(-127, min(127, __float2int_rn(a.x * sc))), q1 = max(-127, min(127, __float2int_rn(a.y * sc))), q2 = max(-127, min(127, __float2int_rn(a.z * sc))), q3 = max(-127, min(127, __float2int_rn(a.w * sc)));
    return (unsigned)(q0 & 0xff) | ((unsigned)(q1 & 0xff) << 8) | ((unsigned)(q2 & 0xff) << 16) | ((unsigned)q3 << 24); }
__device__ __forceinline__ void p0_transpose_item(const float* W, int K, int N, bf16* WT, LAS float* scr, int item, int lane) {
    const int nblk = N / 64, kb = item / nblk, nb = item % nblk, k0 = 64 * kb, n0 = 64 * nb;
#pragma unroll 16
    for (int kk = 0; kk < 64; ++kk) scr[kk * 65 + lane] = __builtin_nontemporal_load(W + (size_t)(k0 + kk) * N + n0 + lane);
    LDS_WAIT(); asm volatile("" ::: "memory");
    const int c = lane & 7;
#pragma unroll
    for (int j = 0; j < 8; ++j) { const int n = (lane >> 3) + 8 * j; const LAS float* s = scr + (8 * c) * 65 + n;
        v4u o; o.x = pk2(s[0 * 65], s[1 * 65]); o.y = pk2(s[2 * 65], s[3 * 65]); o.z = pk2(s[4 * 65], s[5 * 65]); o.w = pk2(s[6 * 65], s[7 * 65]);
        *(GAS v4u*)(WT + (size_t)(n0 + n) * K + k0 + 8 * c) = o; }
    LDS_WAIT(); asm volatile("" ::: "memory");
}
__device__ __forceinline__ void p0_transpose_item_i8(const float* W, int K, int N, unsigned char* WT, LAS float* scr, int item, int lane, float sc) {
    const int nblk = N / 64, kb = item / nblk, nb = item % nblk, k0 = 64 * kb, n0 = 64 * nb;
#pragma unroll 16
    for (int kk = 0; kk < 64; ++kk) scr[kk * 65 + lane] = __builtin_nontemporal_load(W + (size_t)(k0 + kk) * N + n0 + lane);
    LDS_WAIT(); asm volatile("" ::: "memory");
    const int c = lane & 7;
#pragma unroll
    for (int j = 0; j < 8; ++j) { const int n = (lane >> 3) + 8 * j; const LAS float* s = scr + (8 * c) * 65 + n;
        v2u o; o.x = pk4_i8((f32x4){s[0 * 65], s[1 * 65], s[2 * 65], s[3 * 65]}, sc); o.y = pk4_i8((f32x4){s[4 * 65], s[5 * 65], s[6 * 65], s[7 * 65]}, sc);
        *(GAS v2u*)(WT + (size_t)(n0 + n) * K + k0 + 8 * c) = o; }
    LDS_WAIT(); asm volatile("" ::: "memory");
}
__device__ __forceinline__ void p0_convert_item(const float* src, bf16* dst, size_t item, int lane) {
    const GAS f32x4* s = (const GAS f32x4*)(src + item * 2048) + lane * 2;
    GAS v4u* d = (GAS v4u*)(dst + item * 2048) + lane;
#pragma unroll
    for (int j = 0; j < 4; ++j) { const f32x4 a = s[j * 128], b = s[j * 128 + 1];
        v4u o; o.x = pk2(a.x, a.y); o.y = pk2(a.z, a.w); o.z = pk2(b.x, b.y); o.w = pk2(b.z, b.w); d[j * 64] = o; }
}
__device__ __forceinline__ unsigned pk4_fp8(f32x4 a, float sc) { int w = __builtin_amdgcn_cvt_pk_fp8_f32(a.x * sc, a.y * sc, 0, false); w = __builtin_amdgcn_cvt_pk_fp8_f32(a.z * sc, a.w * sc, w, true); return (unsigned)w; }
__device__ __forceinline__ void p0_convert_item_i8(const float* src, unsigned char* dst, size_t item, int lane, float sc) {
    const GAS f32x4* s = (const GAS f32x4*)(src + item * 4096) + lane * 4;
#pragma unroll
    for (int j = 0; j < 4; ++j) { v4u o; o.x = pk4_i8(__builtin_nontemporal_load(s + j * 256), sc); o.y = pk4_i8(__builtin_nontemporal_load(s + j * 256 + 1), sc); o.z = pk4_i8(__builtin_nontemporal_load(s + j * 256 + 2), sc); o.w = pk4_i8(__builtin_nontemporal_load(s + j * 256 + 3), sc);
        *(GAS v4u*)(dst + (size_t)(lane >> 3) * NEXP * 128 + (item * 4 + j) * 128 + (lane & 7) * 16) = o; }
}
__device__ __forceinline__ void p0_convert_item_fp8(const float* src, unsigned char* dst, size_t item, int lane, float sc) {
    const GAS f32x4* s = (const GAS f32x4*)(src + item * 4096) + lane * 4;
#pragma unroll
    for (int j = 0; j < 4; ++j) { v4u o; o.x = pk4_fp8(__builtin_nontemporal_load(s + j * 256), sc); o.y = pk4_fp8(__builtin_nontemporal_load(s + j * 256 + 1), sc); o.z = pk4_fp8(__builtin_nontemporal_load(s + j * 256 + 2), sc); o.w = pk4_fp8(__builtin_nontemporal_load(s + j * 256 + 3), sc);
        *(GAS v4u*)(dst + (size_t)(lane >> 3) * NEXP * 128 + (item * 4 + j) * 128 + (lane & 7) * 16) = o; }
}
__device__ __forceinline__ void p0_ada_task(Frame& F, int task, LAS float* scr) {
    const int kc = task / (ADA_W / 64), ng = task % (ADA_W / 64), lane = F.lane;
    const float* c = F.in[IN_C];
    for (int e = lane; e < BATCH * 128; e += 64) { const int b = e >> 7, kk = e & 127; const float cv = c[b * D + kc * 128 + kk]; scr[kk * 16 + b] = cv / (1.f + expf(-cv)); }
    LDS_WAIT(); asm volatile("" ::: "memory");
    float acc[BATCH];
#pragma unroll
    for (int b = 0; b < BATCH; ++b) acc[b] = 0.f;
    const float* wp = F.in[IN_WADA] + (size_t)(kc * 128) * ADA_W + ng * 64 + lane;
#pragma unroll 1
    for (int k0 = 0; k0 < 128; k0 += 16) { float wv[16];
#pragma unroll
        for (int u = 0; u < 16; ++u) wv[u] = __builtin_nontemporal_load(wp + (size_t)(k0 + u) * ADA_W);
#pragma unroll
        for (int u = 0; u < 16; ++u) { const LAS f32x4* sp = (const LAS f32x4*)(scr + (k0 + u) * 16);
#pragma unroll
            for (int q = 0; q < 4; ++q) { const f32x4 s = sp[q]; acc[4 * q] += s.x * wv[u]; acc[4 * q + 1] += s.y * wv[u]; acc[4 * q + 2] += s.z * wv[u]; acc[4 * q + 3] += s.w * wv[u]; } } }
    float* ap = (float*)(F.ws + WS_ADAP);
#pragma unroll
    for (int b = 0; b < BATCH; ++b) ap[(size_t)(kc * BATCH + b) * ADA_W + ng * 64 + lane] = acc[b];
    LDS_WAIT(); asm volatile("" ::: "memory");
}
__device__ __forceinline__ void p0_prologue(Frame& F) {
    LAS float* scr = (LAS float*)(F.lds + RING_OFF + F.wave * 16896);
    const int gw = F.vcu * NWAVES + F.wave, NGW = F.G * NWAVES;
    constexpr int I_ADA = ADA_KC * (ADA_W / 64);
    constexpr int I_T1 = (D / 64) * (IN_W / 64), I_T2 = (D / 64) * (D / 64), I_T3 = (D / 64) * (QW / 64);
    constexpr int I_K = PH * NKEYS * DHALF / 2048;
    constexpr int I_E = (int)((size_t)NEXP * D / 4096);
    constexpr int NITEMS = I_ADA + I_T1 + I_T2 + I_T3 + 2 * I_K + 2 * I_E;
    for (int it = gw; it < NITEMS; it += NGW) {
        int r = it;
        if (r < I_ADA) { p0_ada_task(F, r, scr); continue; } r -= I_ADA;
        if (r < I_T1) { p0_transpose_item_i8(F.in[IN_WIN], D, IN_W, F.ws + WS_WIN, scr, r, F.lane, WQ_SCALE); continue; } r -= I_T1;
        if (r < I_T2) { p0_transpose_item(F.in[IN_WOUT], D, D, (bf16*)(F.ws + WS_WOUT), scr, r, F.lane); continue; } r -= I_T2;
        if (r < I_T3) { p0_transpose_item_i8(F.in[IN_WQ], D, QW, F.ws + WS_WQ, scr, r, F.lane, WQ_SCALE); continue; } r -= I_T3;
        if (r < I_K) { p0_convert_item(F.in[IN_PK1], (bf16*)(F.ws + WS_K1), r, F.lane); continue; } r -= I_K;
        if (r < I_K) { p0_convert_item(F.in[IN_PK2], (bf16*)(F.ws + WS_K2), r, F.lane); continue; } r -= I_K;
        if (r < I_E) { p0_convert_item_i8(F.in[IN_PU], F.ws + WS_U, r, F.lane, U_SCALE); continue; } r -= I_E;
        p0_convert_item_fp8(F.in[IN_PV], F.ws + WS_V, r, F.lane, V_SCALE);
    }
}

__device__ __forceinline__ void mod_row(const float* xrow, bf16* orow, const LAS float* SC, const LAS float* SH, int lane) {
    const GAS f32x4* xr = (const GAS f32x4*)xrow + lane;
    f32x4 v[4]; float s = 0.f;
#pragma unroll
    for (int j = 0; j < 4; ++j) { v[j] = xr[64 * j]; s += (v[j].x * v[j].x + v[j].y * v[j].y) + (v[j].z * v[j].z + v[j].w * v[j].w); }
    const float rstd = 1.0f / sqrtf(wave_sum(s) * (1.f / D) + EPS);
    GAS unsigned long long* o8 = (GAS unsigned long long*)orow + lane;
#pragma unroll
    for (int j = 0; j < 4; ++j) { const f32x4 sc = ((const LAS f32x4*)SC)[lane + 64 * j], sh = ((const LAS f32x4*)SH)[lane + 64 * j];
        const f32x4 o = v[j] * rstd * sc + sh;
        o8[64 * j] = (unsigned long long)pk2(o.x, o.y) | ((unsigned long long)pk2(o.z, o.w) << 32); }
}
__device__ __forceinline__ void mod_row_bf(const bf16* xrow, bf16* orow, const LAS float* SC, const LAS float* SH, int lane) {
    const GAS v2u* xr = (const GAS v2u*)xrow + lane;
    f32x4 v[4]; float s = 0.f;
#pragma unroll
    for (int j = 0; j < 4; ++j) { const v2u w = xr[64 * j]; v[j] = (f32x4){bflo(w.x), bfhi(w.x), bflo(w.y), bfhi(w.y)}; s += (v[j].x * v[j].x + v[j].y * v[j].y) + (v[j].z * v[j].z + v[j].w * v[j].w); }
    const float rstd = 1.0f / sqrtf(wave_sum(s) * (1.f / D) + EPS);
    GAS unsigned long long* o8 = (GAS unsigned long long*)orow + lane;
#pragma unroll
    for (int j = 0; j < 4; ++j) { const f32x4 sc = ((const LAS f32x4*)SC)[lane + 64 * j], sh = ((const LAS f32x4*)SH)[lane + 64 * j];
        const f32x4 o = v[j] * rstd * sc + sh;
        o8[64 * j] = (unsigned long long)pk2(o.x, o.y) | ((unsigned long long)pk2(o.z, o.w) << 32); }
}
__device__ __forceinline__ void mod_load(const float* xrow, int lane, f32x4 (&v)[4]) { const GAS f32x4* xr = (const GAS f32x4*)xrow + lane;
#pragma unroll
    for (int j = 0; j < 4; ++j) v[j] = __builtin_nontemporal_load(xr + 64 * j); }
__device__ __forceinline__ void mod_load_bf(const bf16* xrow, int lane, f32x4 (&v)[4]) { const GAS v2u* xr = (const GAS v2u*)xrow + lane;
#pragma unroll
    for (int j = 0; j < 4; ++j) { const v2u w = xr[64 * j]; v[j] = (f32x4){bflo(w.x), bfhi(w.x), bflo(w.y), bfhi(w.y)}; } }
template <bool I8> __device__ __forceinline__ void mod_finish(const f32x4 (&v)[4], bf16* orow, unsigned char* o8row, float* hs_out, const LAS float* SC, const LAS float* SH, int lane) {
    float s = 0.f;
#pragma unroll
    for (int j = 0; j < 4; ++j) s += (v[j].x * v[j].x + v[j].y * v[j].y) + (v[j].z * v[j].z + v[j].w * v[j].w);
    const float rstd = 1.0f / sqrtf(wave_sum(s) * (1.f / D) + EPS);
    f32x4 o[4]; float am = 0.f;
#pragma unroll
    for (int j = 0; j < 4; ++j) { const f32x4 sc = ((const LAS f32x4*)SC)[lane + 64 * j], sh = ((const LAS f32x4*)SH)[lane + 64 * j]; o[j] = v[j] * rstd * sc + sh;
        am = fmaxf(am, fmaxf(fmaxf(fabsf(o[j].x), fabsf(o[j].y)), fmaxf(fabsf(o[j].z), fabsf(o[j].w)))); }
    if (!I8) { GAS unsigned long long* o8 = (GAS unsigned long long*)orow + lane;
#pragma unroll
        for (int j = 0; j < 4; ++j) o8[64 * j] = (unsigned long long)pk2(o[j].x, o[j].y) | ((unsigned long long)pk2(o[j].z, o[j].w) << 32);
    } else {
#pragma unroll
        for (int off = 1; off < 64; off <<= 1) am = fmaxf(am, __shfl_xor(am, off));
        const float qs = am > 0.f ? 127.f / am : 0.f;
#pragma unroll
        for (int j = 0; j < 4; ++j) ((GAS unsigned*)o8row)[lane + 64 * j] = pk4_i8(o[j], qs);
        if (lane == 0) *hs_out = am * (1.f / 127.f); }
}
__device__ __forceinline__ void p1_hpass(Frame& F) {
    LAS float* SC = (LAS float*)(F.lds); LAS float* SH = SC + D;
    const float* adap = (const float*)(F.ws + WS_ADAP); const float* bada = F.in[IN_BADA]; const float* g1 = F.in[IN_G1];
    float* ada = (float*)(F.ws + WS_ADA);
    for (int e = blockIdx.x * 512 + F.tid; e < BATCH * ADA_W; e += F.G * 512) { const int b = e / ADA_W, n = e % ADA_W; float s = bada[n];
#pragma unroll
        for (int kc = 0; kc < ADA_KC; ++kc) s += adap[(size_t)(kc * BATCH + b) * ADA_W + n];
        ada[e] = s; }
    for (int tile = blockIdx.x; tile < M / 128; tile += F.G) {
        const int b = tile / (SEQ / 128);
        for (int d = F.tid; d < D; d += 512) { float sh = bada[d], sc = bada[D + d];
#pragma unroll
            for (int kc = 0; kc < ADA_KC; ++kc) { const float* p = adap + (size_t)(kc * BATCH + b) * ADA_W; sh += p[d]; sc += p[D + d]; }
            SC[d] = g1[d] * (1.f + sc); SH[d] = sh; }
        __syncthreads();
        { f32x4 va[4], vb[4];
          mod_load(F.in[IN_X] + ((size_t)tile * 128 + F.wave) * D, F.lane, va);
#pragma unroll 1
          for (int r = F.wave; r < 128; r += 2 * NWAVES) { const size_t row = (size_t)tile * 128 + r;
              mod_load(F.in[IN_X] + (row + NWAVES) * D, F.lane, vb);
              mod_finish<true>(va, nullptr, F.ws + WS_H8 + row * D, (float*)(F.ws + WS_HS) + row, SC, SH, F.lane);
              if (r + 2 * NWAVES < 128) mod_load(F.in[IN_X] + (row + 2 * NWAVES) * D, F.lane, va);
              mod_finish<true>(vb, nullptr, F.ws + WS_H8 + (row + NWAVES) * D, (float*)(F.ws + WS_HS) + (row + NWAVES), SC, SH, F.lane); } }
        __syncthreads();
    }
}
__device__ __forceinline__ void p5_h2pass(Frame& F) {
    LAS float* SC = (LAS float*)(F.lds); LAS float* SH = SC + D;
    const float* ada = (const float*)(F.ws + WS_ADA); const float* g2 = F.in[IN_G2];
    for (int tile = blockIdx.x; tile < M / 128; tile += F.G) {
        const int b = tile / (SEQ / 128);
        for (int d = F.tid; d < D; d += 512) { SC[d] = g2[d] * (1.f + ada[(size_t)b * ADA_W + 4 * D + d]); SH[d] = ada[(size_t)b * ADA_W + 3 * D + d]; }
        __syncthreads();
        { f32x4 va[4], vb[4]; const bf16* X1 = (const bf16*)(F.ws + WS_X1);
          mod_load_bf(X1 + ((size_t)tile * 128 + F.wave) * D, F.lane, va);
#pragma unroll 1
          for (int r = F.wave; r < 128; r += 2 * NWAVES) { const size_t row = (size_t)tile * 128 + r;
              mod_load_bf(X1 + (row + NWAVES) * D, F.lane, vb);
              mod_finish<true>(va, (bf16*)(F.ws + WS_H) + row * D, F.ws + WS_H8 + row * D, (float*)(F.ws + WS_HS) + row, SC, SH, F.lane);
              if (r + 2 * NWAVES < 128) mod_load_bf(X1 + (row + 2 * NWAVES) * D, F.lane, va);
              mod_finish<true>(vb, (bf16*)(F.ws + WS_H) + (row + NWAVES) * D, F.ws + WS_H8 + (row + NWAVES) * D, (float*)(F.ws + WS_HS) + (row + NWAVES), SC, SH, F.lane); } }
        __syncthreads();
    }
}

typedef float f32x16 __attribute__((ext_vector_type(16)));
typedef short s16x4 __attribute__((ext_vector_type(4)));
typedef __bf16 bf16x8_t __attribute__((ext_vector_type(8)));
#define MFMA32(a, b, c) __builtin_amdgcn_mfma_f32_32x32x16_bf16((a), (b), (c), 0, 0, 0)
constexpr int KS = 144, VS = 192;
__device__ __forceinline__ void p3_attn_unit(Frame& F, int unit) {
    const int kh = unit & 1, nb = (unit >> 1) & 15, b = unit >> 5;
    LAS unsigned char* KL = F.lds; LAS unsigned char* VL = F.lds + 256 * KS;
    const bf16* proj = (const bf16*)(F.ws + WS_PROJ);
    const int tok0 = b * SEQ + nb * 128;
    for (int c = F.tid; c < 2048; c += 512) { const int j = c >> 3, ch = c & 7;
        v4u kv = (v4u){0u, 0u, 0u, 0u}, vv = (v4u){0u, 0u, 0u, 0u};
        if (nb > 0 || j >= 128) { const bf16* rowp = proj + (size_t)(tok0 - 128 + j) * IN_W; kv = *(const GAS v4u*)(rowp + O_K + kh * HD + ch * 8); vv = *(const GAS v4u*)(rowp + O_V + kh * HD + ch * 8); }
        *(LAS v4u*)(KL + j * KS + ch * 16) = kv; *(LAS v4u*)(VL + j * VS + ch * 16) = vv; }
    __syncthreads();
    const int lane = F.lane, r = lane & 31, hh = lane >> 5;
#pragma unroll 1
    for (int task = F.wave; task < 16; task += NWAVES) {
        const int g = task >> 2, w = task & 3, qh = kh * 4 + g, i0 = 32 * w;
        const bf16* qp = proj + (size_t)(tok0 + i0 + r) * IN_W + O_Q + qh * HD + 8 * hh;
        bf16x8 qf[4];
#pragma unroll
        for (int s = 0; s < 4; ++s) qf[s] = *(const GAS bf16x8*)(qp + 16 * s);
        f32x16 sc[5];
#pragma unroll
        for (int t = 0; t < 5; ++t) {
#pragma unroll
            for (int e = 0; e < 16; ++e) sc[t][e] = 0.f;
#pragma unroll
            for (int s = 0; s < 4; ++s) { const bf16x8 a = *(const LAS bf16x8*)(KL + ((w + t) * 32 + r) * KS + 32 * s + 16 * hh); sc[t] = MFMA32(a, qf[s], sc[t]); } }
        const float sink = F.in[IN_SINK][qh];
        float mx = sink;
#pragma unroll
        for (int t = 0; t < 5; ++t)
#pragma unroll
            for (int e = 0; e < 16; ++e) { const int kr = (e & 3) + 8 * (e >> 2) + 4 * hh;
                bool valid = (nb > 0) || (w + t >= 4);
                if (t == 0) valid = valid && (kr > r);
                if (t == 4) valid = valid && (kr <= r);
                const float v = valid ? sc[t][e] * 0.125f : -1e30f; sc[t][e] = v; mx = fmaxf(mx, v); }
        mx = fmaxf(mx, __shfl_xor(mx, 32));
        float lsum = 0.f;
#pragma unroll
        for (int t = 0; t < 5; ++t)
#pragma unroll
            for (int e = 0; e < 16; ++e) { const float p = __expf(sc[t][e] - mx); sc[t][e] = p; lsum += p; }
        lsum += __shfl_xor(lsum, 32); lsum += __expf(sink - mx);
        f32x16 o[2];
#pragma unroll
        for (int dt = 0; dt < 2; ++dt)
#pragma unroll
            for (int e = 0; e < 16; ++e) o[dt][e] = 0.f;
        const int q4 = (r & 15) >> 2, p4 = r & 3;
#pragma unroll
        for (int t = 0; t < 5; ++t)
#pragma unroll
            for (int sp = 0; sp < 2; ++sp) {
                bf16x8_t pbv;
#pragma unroll
                for (int e = 0; e < 8; ++e) pbv[e] = (__bf16)sc[t][8 * sp + e];
                const bf16x8 pb = __builtin_bit_cast(bf16x8, pbv);
#pragma unroll
                for (int dt = 0; dt < 2; ++dt) {
                    const int kb = (w + t) * 32 + 16 * sp + 4 * hh;
                    const LAS unsigned char* ap = VL + (kb + q4) * VS + (32 * dt + 16 * (r >> 4) + 4 * p4) * 2;
                    const s16x4 lo = __builtin_amdgcn_ds_read_tr16_b64_v4i16((LAS s16x4*)ap);
                    const s16x4 hi = __builtin_amdgcn_ds_read_tr16_b64_v4i16((LAS s16x4*)(ap + 8 * VS));
                    const bf16x8 a = __builtin_shufflevector(lo, hi, 0, 1, 2, 3, 4, 5, 6, 7);
                    o[dt] = MFMA32(a, pb, o[dt]); } }
        const float inv = 1.f / lsum; float ss = 0.f;
#pragma unroll
        for (int dt = 0; dt < 2; ++dt)
#pragma unroll
            for (int e = 0; e < 16; ++e) { o[dt][e] *= inv; ss += o[dt][e] * o[dt][e]; }
        ss += __shfl_xor(ss, 32);
        const float rs = 1.0f / sqrtf(ss * (1.f / HD) + EPS);
        const float* gp = F.in[IN_AOG] + qh * HD;
        bf16* op = (bf16*)(F.ws + WS_MIX) + (size_t)(tok0 + i0 + r) * D + qh * HD;
#pragma unroll
        for (int dt = 0; dt < 2; ++dt)
#pragma unroll
            for (int g4 = 0; g4 < 4; ++g4) { const int d0 = 32 * dt + 8 * g4 + 4 * hh; const f32x4 gv = *(const f32x4*)(gp + d0);
                v2u wv; wv.x = pk2(o[dt][4 * g4 + 0] * rs * gv.x, o[dt][4 * g4 + 1] * rs * gv.y); wv.y = pk2(o[dt][4 * g4 + 2] * rs * gv.z, o[dt][4 * g4 + 3] * rs * gv.w);
                *(GAS v2u*)(op + d0) = wv; }
    }
    __syncthreads();
}
__device__ __forceinline__ void p3_conv(Frame& F) {
    const bf16* proj = (const bf16*)(F.ws + WS_PROJ); const int lane = F.lane, c0 = 8 * lane;
    const float* cw = F.in[IN_CONVW]; const float* cg = F.in[IN_COG];
    float w0[8], w1[8], w2[8], gg[8];
#pragma unroll
    for (int e = 0; e < 8; ++e) { w0[e] = cw[c0 + e]; w1[e] = cw[512 + c0 + e]; w2[e] = cw[1024 + c0 + e]; gg[e] = cg[c0 + e]; }
    const int gw = F.vcu * NWAVES + F.wave, NGW = F.G * NWAVES;
    for (int tok = gw; tok < M; tok += NGW) {
        const int s = tok & (SEQ - 1); const bf16* rp = proj + (size_t)tok * IN_W;
        const v4u z4 = (v4u){0u, 0u, 0u, 0u};
        const v4u Bv = *(const GAS v4u*)(rp + O_B + c0), C0 = *(const GAS v4u*)(rp + O_C + c0), U0 = *(const GAS v4u*)(rp + O_U + c0);
        v4u C1 = z4, U1 = z4, C2 = z4, U2 = z4;
        if (s >= 1) { C1 = *(const GAS v4u*)(rp - IN_W + O_C + c0); U1 = *(const GAS v4u*)(rp - IN_W + O_U + c0); }
        if (s >= 2) { C2 = *(const GAS v4u*)(rp - 2 * IN_W + O_C + c0); U2 = *(const GAS v4u*)(rp - 2 * IN_W + O_U + c0); }
        float y[8]; float ss = 0.f;
#pragma unroll
        for (int e = 0; e < 8; ++e) { const int wi = e >> 1; const bool hi = e & 1;
            const unsigned bw = Bv[wi], c0w = C0[wi], u0w = U0[wi], c1w = C1[wi], u1w = U1[wi], c2w = C2[wi], u2w = U2[wi];
            const float bb = hi ? bfhi(bw) : bflo(bw);
            const float z0 = (hi ? bfhi(c0w) : bflo(c0w)) * (hi ? bfhi(u0w) : bflo(u0w));
            const float z1 = (hi ? bfhi(c1w) : bflo(c1w)) * (hi ? bfhi(u1w) : bflo(u1w));
            const float z2 = (hi ? bfhi(c2w) : bflo(c2w)) * (hi ? bfhi(u2w) : bflo(u2w));
            y[e] = bb * (z2 * w0[e] + z1 * w1[e] + z0 * w2[e]); ss += y[e] * y[e]; }
        ss += __shfl_xor(ss, 1); ss += __shfl_xor(ss, 2); ss += __shfl_xor(ss, 4);
        const float rs = 1.0f / sqrtf(ss * (1.f / 64.f) + EPS);
        v4u w; w.x = pk2(y[0] * rs * gg[0], y[1] * rs * gg[1]); w.y = pk2(y[2] * rs * gg[2], y[3] * rs * gg[3]);
        w.z = pk2(y[4] * rs * gg[4], y[5] * rs * gg[5]); w.w = pk2(y[6] * rs * gg[6], y[7] * rs * gg[7]);
        *(GAS v4u*)((bf16*)(F.ws + WS_MIX) + (size_t)tok * D + 512 + c0) = w;
    }
}
__device__ __forceinline__ void p3_mixer(Frame& F) {
    for (int unit = blockIdx.x; unit < BATCH * 16 * NKVH; unit += F.G) p3_attn_unit(F, unit);
    p3_conv(F);
}

#define DI __device__ __forceinline__
#define CE_(i, j) { const unsigned x_ = a[i], y_ = a[j]; a[i] = x_ > y_ ? x_ : y_; a[j] = x_ > y_ ? y_ : x_; }
DI void sort16_desc(unsigned (&a)[16]) {
    CE_(0,13) CE_(1,12) CE_(2,15) CE_(3,14) CE_(4,8) CE_(5,6) CE_(7,11) CE_(9,10)
    CE_(0,5) CE_(1,7) CE_(2,9) CE_(3,4) CE_(6,13) CE_(8,14) CE_(10,15) CE_(11,12)
    CE_(0,1) CE_(2,3) CE_(4,5) CE_(6,8) CE_(7,9) CE_(10,11) CE_(12,13) CE_(14,15)
    CE_(0,2) CE_(1,3) CE_(4,10) CE_(5,11) CE_(6,7) CE_(8,9) CE_(12,14) CE_(13,15)
    CE_(1,2) CE_(3,12) CE_(4,6) CE_(5,7) CE_(8,10) CE_(9,11) CE_(13,14)
    CE_(1,4) CE_(2,6) CE_(5,8) CE_(7,10) CE_(9,13) CE_(11,14)
    CE_(2,4) CE_(3,6) CE_(9,12) CE_(11,13)
    CE_(3,5) CE_(6,8) CE_(7,9) CE_(10,12)
    CE_(3,4) CE_(5,6) CE_(7,8) CE_(9,10) CE_(11,12)
    CE_(6,7) CE_(8,9)
}
DI void bitonic_merge16_desc(unsigned (&a)[16]) {
#pragma unroll
    for (int js = 3; js >= 0; --js) {
#pragma unroll
        for (int i = 0; i < 16; ++i) { const int j = 1 << js, l = i ^ j;
            if (l > i) { const unsigned x = a[i], y = a[l]; a[i] = x > y ? x : y; a[l] = x > y ? y : x; } }
    }
}
DI void merge_top16(unsigned (&a)[16], const unsigned (&b)[16]) {
#pragma unroll
    for (int i = 0; i < 16; ++i) { const unsigned x = a[i], y = b[15 - i]; a[i] = x > y ? x : y; }
    bitonic_merge16_desc(a);
}
DI void top16_of_64(unsigned (&g0)[16], unsigned (&g1)[16], unsigned (&g2)[16], unsigned (&g3)[16]) {
    sort16_desc(g0); sort16_desc(g1); sort16_desc(g2); sort16_desc(g3);
    merge_top16(g0, g1); merge_top16(g2, g3); merge_top16(g0, g2);
}
#define SBIAS 8.0f
DI unsigned skey(float biased) { return __float_as_uint(fmaxf(biased, 0.f)); }
constexpr int KEY_STRIDE = 272;
DI void route_scores_top16(const LAS unsigned char* KL, const bf16* qrow, int r, int hh, unsigned (&out)[16]) {
    bf16x8 qf[8];
#pragma unroll
    for (int s = 0; s < 8; ++s) qf[s] = *(const GAS bf16x8*)(qrow + 16 * s);
    f32x16 acc[4];
#pragma unroll
    for (int t = 0; t < 4; ++t)
#pragma unroll
        for (int e = 0; e < 16; ++e) acc[t][e] = SBIAS;
#pragma unroll
    for (int t = 0; t < 4; ++t)
#pragma unroll
        for (int s = 0; s < 8; ++s) { const bf16x8 a = *(const LAS bf16x8*)(KL + (t * 32 + r) * KEY_STRIDE + 32 * s + 16 * hh); acc[t] = MFMA32(a, qf[s], acc[t]); }
    unsigned g0[16], g1[16], g2[16], g3[16];
    const unsigned pb = (unsigned)(127 - 4 * hh);
#pragma unroll
    for (int e = 0; e < 16; ++e) { const unsigned p = pb - (unsigned)((e & 3) + 8 * (e >> 2));
        g0[e] = (skey(acc[0][e]) & ~127u) | p; g1[e] = (skey(acc[1][e]) & ~127u) | (p - 32u); g2[e] = (skey(acc[2][e]) & ~127u) | (p - 64u); g3[e] = (skey(acc[3][e]) & ~127u) | (p - 96u); }
    top16_of_64(g0, g1, g2, g3);
    unsigned oth[16];
#pragma unroll
    for (int i = 0; i < 16; ++i) oth[i] = (unsigned)__shfl_xor((int)g0[i], 32);
    merge_top16(g0, oth);
#pragma unroll
    for (int i = 0; i < 16; ++i) out[i] = g0[i];
}
DI void p7_route_tile(Frame& F, int tok0, int h, const LAS unsigned char* KL1, const LAS unsigned char* KL2, LAS unsigned char* scr) {
    const int lane = F.lane, r = lane & 31, hh = lane >> 5;
    const bf16* qrow = (const bf16*)(F.ws + WS_PROJ) + (size_t)(tok0 + r) * QW + h * DKEY + 8 * hh;
    unsigned t1[16], t2[16];
    route_scores_top16(KL1, qrow, r, hh, t1);
    route_scores_top16(KL2, qrow + DHALF, r, hh, t2);
    { v4u w;
#pragma unroll
      for (int q = 0; q < 4; ++q) { unsigned x = 0u;
#pragma unroll
          for (int bq = 0; bq < 4; ++bq) { const unsigned k = hh ? t2[4 * q + bq] : t1[4 * q + bq]; x |= (127u - (k & 127u)) << (8 * bq); }
          w[q] = x; }
      *(LAS v4u*)(scr + r * 32 + hh * 16) = w; }
    float v1[16], v2[16];
#pragma unroll
    for (int i = 0; i < 16; ++i) { v1[i] = __uint_as_float(t1[i] & ~127u); v2[i] = __uint_as_float(t2[i] & ~127u) - SBIAS; }
    unsigned c0[16], c1[16];
    { const float sa = v1[0] + v2[0], sb = v1[2] + v2[1]; c0[0] = (__float_as_uint(fmaxf(hh ? sb : sa, 0.f)) & ~255u) | (hh ? 222u : 255u); }
    { const float sa = v1[0] + v2[1], sb = v1[2] + v2[2]; c0[1] = (__float_as_uint(fmaxf(hh ? sb : sa, 0.f)) & ~255u) | (hh ? 221u : 254u); }
    { const float sa = v1[0] + v2[2], sb = v1[2] + v2[3]; c0[2] = (__float_as_uint(fmaxf(hh ? sb : sa, 0.f)) & ~255u) | (hh ? 220u : 253u); }
    { const float sa = v1[0] + v2[3], sb = v1[2] + v2[4]; c0[3] = (__float_as_uint(fmaxf(hh ? sb : sa, 0.f)) & ~255u) | (hh ? 219u : 252u); }
    { const float sa = v1[0] + v2[4], sb = v1[3] + v2[0]; c0[4] = (__float_as_uint(fmaxf(hh ? sb : sa, 0.f)) & ~255u) | (hh ? 207u : 251u); }
    { const float sa = v1[0] + v2[5], sb = v1[3] + v2[1]; c0[5] = (__float_as_uint(fmaxf(hh ? sb : sa, 0.f)) & ~255u) | (hh ? 206u : 250u); }
    { const float sa = v1[0] + v2[6], sb = v1[3] + v2[2]; c0[6] = (__float_as_uint(fmaxf(hh ? sb : sa, 0.f)) & ~255u) | (hh ? 205u : 249u); }
    { const float sa = v1[0] + v2[7], sb = v1[3] + v2[3]; c0[7] = (__float_as_uint(fmaxf(hh ? sb : sa, 0.f)) & ~255u) | (hh ? 204u : 248u); }
    { const float sa = v1[0] + v2[8], sb = v1[4] + v2[0]; c0[8] = (__float_as_uint(fmaxf(hh ? sb : sa, 0.f)) & ~255u) | (hh ? 191u : 247u); }
    { const float sa = v1[0] + v2[9], sb = v1[4] + v2[1]; c0[9] = (__float_as_uint(fmaxf(hh ? sb : sa, 0.f)) & ~255u) | (hh ? 190u : 246u); }
    { const float sa = v1[0] + v2[10], sb = v1[4] + v2[2]; c0[10] = (__float_as_uint(fmaxf(hh ? sb : sa, 0.f)) & ~255u) | (hh ? 189u : 245u); }
    { const float sa = v1[0] + v2[11], sb = v1[5] + v2[0]; c0[11] = (__float_as_uint(fmaxf(hh ? sb : sa, 0.f)) & ~255u) | (hh ? 175u : 244u); }
    { const float sa = v1[0] + v2[12], sb = v1[5] + v2[1]; c0[12] = (__float_as_uint(fmaxf(hh ? sb : sa, 0.f)) & ~255u) | (hh ? 174u : 243u); }
    { const float sa = v1[0] + v2[13], sb = v1[6] + v2[0]; c0[13] = (__float_as_uint(fmaxf(hh ? sb : sa, 0.f)) & ~255u) | (hh ? 159u : 242u); }
    { const float sa = v1[0] + v2[14], sb = v1[6] + v2[1]; c0[14] = (__float_as_uint(fmaxf(hh ? sb : sa, 0.f)) & ~255u) | (hh ? 158u : 241u); }
    { const float sa = v1[0] + v2[15], sb = v1[7] + v2[0]; c0[15] = (__float_as_uint(fmaxf(hh ? sb : sa, 0.f)) & ~255u) | (hh ? 143u : 240u); }
    { const float sa = v1[1] + v2[0], sb = v1[7] + v2[1]; c1[0] = (__float_as_uint(fmaxf(hh ? sb : sa, 0.f)) & ~255u) | (hh ? 142u : 239u); }
    { const float sa = v1[1] + v2[1], sb = v1[8] + v2[0]; c1[1] = (__float_as_uint(fmaxf(hh ? sb : sa, 0.f)) & ~255u) | (hh ? 127u : 238u); }
    { const float sa = v1[1] + v2[2], sb = v1[9] + v2[0]; c1[2] = (__float_as_uint(fmaxf(hh ? sb : sa, 0.f)) & ~255u) | (hh ? 111u : 237u); }
    { const float sa = v1[1] + v2[3], sb = v1[10] + v2[0]; c1[3] = (__float_as_uint(fmaxf(hh ? sb : sa, 0.f)) & ~255u) | (hh ? 95u : 236u); }
    { const float sa = v1[1] + v2[4], sb = v1[11] + v2[0]; c1[4] = (__float_as_uint(fmaxf(hh ? sb : sa, 0.f)) & ~255u) | (hh ? 79u : 235u); }
    { const float sa = v1[1] + v2[5], sb = v1[12] + v2[0]; c1[5] = (__float_as_uint(fmaxf(hh ? sb : sa, 0.f)) & ~255u) | (hh ? 63u : 234u); }
    { const float sa = v1[1] + v2[6], sb = v1[13] + v2[0]; c1[6] = (__float_as_uint(fmaxf(hh ? sb : sa, 0.f)) & ~255u) | (hh ? 47u : 233u); }
    { const float sa = v1[1] + v2[7], sb = v1[14] + v2[0]; c1[7] = (__float_as_uint(fmaxf(hh ? sb : sa, 0.f)) & ~255u) | (hh ? 31u : 232u); }
    { const float sa = v1[2] + v2[0], sb = v1[15] + v2[0]; c1[8] = (__float_as_uint(fmaxf(hh ? sb : sa, 0.f)) & ~255u) | (hh ? 15u : 223u); }
    c1[9] = 0u;
    c1[10] = 0u;
    c1[11] = 0u;
    c1[12] = 0u;
    c1[13] = 0u;
    c1[14] = 0u;
    c1[15] = 0u;
    sort16_desc(c0); sort16_desc(c1); merge_top16(c0, c1);
    { unsigned oth[16];
#pragma unroll
      for (int i = 0; i < 16; ++i) oth[i] = (unsigned)__shfl_xor((int)c0[i], 32);
      merge_top16(c0, oth); }
    const float mx = __uint_as_float(c0[0] & ~255u);
    LDS_WAIT(); asm volatile("" ::: "memory");
    float ex[8]; int ee[8]; float part = 0.f;
#pragma unroll
    for (int k = 0; k < 8; ++k) { const unsigned key = hh ? c0[8 + k] : c0[k]; const int ci = 255 - (int)(key & 255u);
        const int e1 = *(const LAS unsigned char*)(scr + r * 32 + (ci >> 4)), e2 = *(const LAS unsigned char*)(scr + r * 32 + 16 + (ci & 15));
        ee[k] = (e1 * NKEYS + e2) & (NEXP - 1); ex[k] = __expf(__uint_as_float(key & ~255u) - mx); part += ex[k]; }
    const float inv = 1.f / (part + __shfl_xor(part, 32));
    int* ip = (int*)(F.ws + WS_IDX) + (size_t)(tok0 + r) * 128 + h * TOPK + 8 * hh; float* gp = (float*)(F.ws + WS_GATE) + (size_t)(tok0 + r) * 128 + h * TOPK + 8 * hh;
    *(GAS v4u*)ip = (v4u){(unsigned)ee[0], (unsigned)ee[1], (unsigned)ee[2], (unsigned)ee[3]}; *(GAS v4u*)(ip + 4) = (v4u){(unsigned)ee[4], (unsigned)ee[5], (unsigned)ee[6], (unsigned)ee[7]};
    *(GAS f32x4*)gp = (f32x4){ex[0] * inv, ex[1] * inv, ex[2] * inv, ex[3] * inv}; *(GAS f32x4*)(gp + 4) = (f32x4){ex[4] * inv, ex[5] * inv, ex[6] * inv, ex[7] * inv};
    asm volatile("" ::: "memory");
}
__device__ __forceinline__ void p7_routing(Frame& F) {
    LAS unsigned char* KL1 = F.lds; LAS unsigned char* KL2 = F.lds + 128 * KEY_STRIDE; LAS unsigned char* scr = F.lds + 2 * 128 * KEY_STRIDE + F.wave * 1024;
    const bf16* k1 = (const bf16*)(F.ws + WS_K1); const bf16* k2 = (const bf16*)(F.ws + WS_K2);
    int cur_h = -1;
    for (int item = blockIdx.x; item < (M / 256) * PH; item += F.G) {
        const int h = item & (PH - 1), tile = item >> 3;
        if (h != cur_h) {
            __syncthreads();
            for (int c = F.tid; c < 2 * 128 * 16; c += 512) { const int which = c >> 11, rr = (c >> 4) & 127, ch = c & 15;
                const v4u v = *(const GAS v4u*)((which ? k2 : k1) + (size_t)(h * NKEYS + rr) * DHALF + ch * 8);
                *(LAS v4u*)((which ? KL2 : KL1) + rr * KEY_STRIDE + ch * 16) = v; }
            __syncthreads();
            cur_h = h;
        }
        p7_route_tile(F, tile * 256 + F.wave * 32, h, KL1, KL2, scr);
    }
}

__device__ __forceinline__ float gelu_erf(float v) { return 0.5f * v * (1.f + erff(v * 0.70710678118654752f)); }
typedef float f32x2v __attribute__((ext_vector_type(2)));
__device__ __forceinline__ unsigned fp8x2_bf16x2(unsigned w, bool hi) { return hi ? __builtin_bit_cast(unsigned, __builtin_amdgcn_cvt_scalef32_pk_bf16_fp8((int)w, 1.0f, true)) : __builtin_bit_cast(unsigned, __builtin_amdgcn_cvt_scalef32_pk_bf16_fp8((int)w, 1.0f, false)); }
__device__ __forceinline__ float dot16_fp8(v4u u, v4u ha, v4u hb, float acc) {
    acc = dot2(fp8x2_bf16x2(u.x, false), ha.x, acc); acc = dot2(fp8x2_bf16x2(u.x, true), ha.y, acc);
    acc = dot2(fp8x2_bf16x2(u.y, false), ha.z, acc); acc = dot2(fp8x2_bf16x2(u.y, true), ha.w, acc);
    acc = dot2(fp8x2_bf16x2(u.z, false), hb.x, acc); acc = dot2(fp8x2_bf16x2(u.z, true), hb.y, acc);
    acc = dot2(fp8x2_bf16x2(u.w, false), hb.z, acc); acc = dot2(fp8x2_bf16x2(u.w, true), hb.w, acc);
    return acc;
}
struct SliceWork { int j0, nj, t0, ts; };
__device__ __forceinline__ SliceWork slice_work(const Frame& F) { SliceWork w;
    if ((F.G & 7) == 0) { w.j0 = blockIdx.x & 7; w.nj = 1; w.t0 = (blockIdx.x >> 3) * NWAVES + F.wave; w.ts = F.G; }
    else { w.j0 = 0; w.nj = 8; w.t0 = blockIdx.x * NWAVES + F.wave; w.ts = F.G * NWAVES; }
    return w; }
struct USet { v4u hq; float hs; v4u u[16]; };
struct UMeta { v2u id; v4u hh; float hs; };
__device__ __forceinline__ UMeta p8a_G(const int* IDX, const unsigned char* H8, const float* HS, int t, int j, int lane) { UMeta m;
    m.id = *(const GAS v2u*)(IDX + (size_t)t * 128 + 2 * lane); m.hh = *(const GAS v4u*)(H8 + (size_t)t * D + 128 * j + 16 * (lane & 7)); m.hs = HS[t]; return m; }
__device__ __forceinline__ void p8a_S(LAS unsigned char* mb, const UMeta& m, int lane) { *(LAS v2u*)(mb + 8 * lane) = m.id; if (lane < 8) *(LAS v4u*)(mb + 512 + 16 * lane) = m.hh; }
__device__ __forceinline__ void p8a_RT(const LAS unsigned char* mb, const unsigned char* Ub, int c, int g, float hs, USet& s) {
    v4u ix[4];
#pragma unroll
    for (int q = 0; q < 4; ++q) ix[q] = *(const LAS v4u*)(mb + 64 * g + 16 * q);
    s.hq = *(const LAS v4u*)(mb + 512 + 16 * c); s.hs = hs;
#pragma unroll
    for (int i = 0; i < 16; ++i) s.u[i] = *(const GAS v4u*)(Ub + (unsigned)((ix[i >> 2][i & 3] << 7) + 16u * (unsigned)c)); }
__device__ __forceinline__ void p8a_compute(const USet& s, bf16* pa_row, int lane, int c) {
    int p[16];
#pragma unroll
    for (int i = 0; i < 16; ++i) { int a = __builtin_amdgcn_sdot4((int)s.u[i].x, (int)s.hq.x, 0, false); a = __builtin_amdgcn_sdot4((int)s.u[i].y, (int)s.hq.y, a, false);
        a = __builtin_amdgcn_sdot4((int)s.u[i].z, (int)s.hq.z, a, false); p[i] = __builtin_amdgcn_sdot4((int)s.u[i].w, (int)s.hq.w, a, false); }
#pragma unroll
    for (int i = 0; i < 8; ++i) { const bool up = c & 4; const int send = up ? p[i] : p[i + 8], keep = up ? p[i + 8] : p[i]; p[i] = keep + __builtin_amdgcn_update_dpp(0, send, 0x141, 0xf, 0xf, true); }
#pragma unroll
    for (int i = 0; i < 4; ++i) { const bool up = c & 2; const int send = up ? p[i] : p[i + 4], keep = up ? p[i + 4] : p[i]; p[i] = keep + __builtin_amdgcn_update_dpp(0, send, 0x4E, 0xf, 0xf, true); }
#pragma unroll
    for (int i = 0; i < 2; ++i) { const bool up = c & 1; const int send = up ? p[i] : p[i + 2], keep = up ? p[i + 2] : p[i]; p[i] = keep + __builtin_amdgcn_update_dpp(0, send, 0xB1, 0xf, 0xf, true); }
    const float sc = s.hs * (1.f / U_SCALE);
    ((GAS unsigned*)pa_row)[lane] = pk2((float)p[0] * sc, (float)p[1] * sc);
}
__device__ __forceinline__ void p8a_udots(Frame& F) {
    const unsigned char* H8 = F.ws + WS_H8; const float* HS = (const float*)(F.ws + WS_HS); const int* IDX = (const int*)(F.ws + WS_IDX); bf16* PA = (bf16*)(F.ws + WS_PA);
    const int lane = F.lane, c = lane & 7, g = lane >> 3; const SliceWork sw = slice_work(F);
    LAS unsigned char* mb = F.lds + F.wave * 1024;
    if (sw.t0 >= M) return;
    const int nt = (M - 1 - sw.t0) / sw.ts + 1;
#define TOK(n) (sw.t0 + ((n) < nt ? (n) : nt - 1) * sw.ts)
    for (int jj = 0; jj < sw.nj; ++jj) { const int j = sw.j0 + jj; const unsigned char* Uj = F.ws + WS_U + (size_t)j * NEXP * 128;
        USet sA, sB, sC;
        UMeta mN = p8a_G(IDX, H8, HS, TOK(0), j, lane); p8a_S(mb, mN, lane); p8a_RT(mb, Uj, c, g, mN.hs, sA);
        mN = p8a_G(IDX, H8, HS, TOK(1), j, lane); p8a_S(mb, mN, lane); p8a_RT(mb, Uj, c, g, mN.hs, sB);
        mN = p8a_G(IDX, H8, HS, TOK(2), j, lane);
#define P8A_STAGE(k, SN, SC_) do { p8a_S(mb, mN, lane); p8a_RT(mb, Uj, c, g, mN.hs, SN); mN = p8a_G(IDX, H8, HS, TOK((k) + 3), j, lane); asm volatile("" ::: "memory"); \
            if ((k) < nt) p8a_compute(SC_, PA + ((size_t)j * M + TOK(k)) * 128, lane, c); asm volatile("" ::: "memory"); } while (0)
#pragma unroll 1
        for (int n = 0; n < nt; n += 3) {
            P8A_STAGE(n, sC, sA);
            P8A_STAGE(n + 1, sA, sB);
            P8A_STAGE(n + 2, sB, sC);
        }
#undef P8A_STAGE
    }
}
typedef _Float16 h2_t __attribute__((ext_vector_type(2)));
__device__ __forceinline__ h2_t cvt_h2_lo(int w) { return __builtin_bit_cast(h2_t, __builtin_amdgcn_cvt_scalef32_pk_f16_fp8(w, 1.0f, false)); }
__device__ __forceinline__ h2_t cvt_h2_hi(int w) { return __builtin_bit_cast(h2_t, __builtin_amdgcn_cvt_scalef32_pk_f16_fp8(w, 1.0f, true)); }
__device__ __forceinline__ void p8w_weights(Frame& F) {
    const bf16* PA = (const bf16*)(F.ws + WS_PA); float* GATE = (float*)(F.ws + WS_GATE);
    for (size_t e = (size_t)blockIdx.x * 512 + F.tid; e < (size_t)M * 128 / 4; e += (size_t)F.G * 512) {
        f32x4 s = (f32x4){0.f, 0.f, 0.f, 0.f};
#pragma unroll
        for (int j = 0; j < 8; ++j) { const v2u w = __builtin_nontemporal_load((const GAS v2u*)(PA + (size_t)j * M * 128 + 4 * e)); s += (f32x4){bflo(w.x), bfhi(w.x), bflo(w.y), bfhi(w.y)}; }
        const f32x4 gt = *(const GAS f32x4*)(GATE + 4 * e); f32x4 o;
#pragma unroll
        for (int q = 0; q < 4; ++q) o[q] = gt[q] * gelu_erf(s[q]);
        const h2_t w01 = (h2_t){(_Float16)o[0], (_Float16)o[1]}, w23 = (h2_t){(_Float16)o[2], (_Float16)o[3]};
        *(GAS v2u*)((_Float16*)(F.ws + WS_W16) + 4 * e) = (v2u){__builtin_bit_cast(unsigned, w01), __builtin_bit_cast(unsigned, w23)}; }
}
struct VSet { v4u v[16]; };
struct VMeta { v2u id; unsigned w; };
__device__ __forceinline__ VMeta p8b_G(const int* IDX, const _Float16* W, int t, int lane) { VMeta m;
    m.id = *(const GAS v2u*)(IDX + (size_t)t * 128 + 2 * lane); m.w = *(const GAS unsigned*)(W + (size_t)t * 128 + 2 * lane); return m; }
__device__ __forceinline__ void p8b_S(LAS unsigned char* mb, const VMeta& m, int lane) { *(LAS v2u*)(mb + 8 * lane) = m.id; *(LAS unsigned*)(mb + 512 + 4 * lane) = m.w; }
__device__ __forceinline__ void p8b_RT(Frame& F, const LAS unsigned char* mb, const unsigned char* Vj, int t, int j, int c, int g, VSet& s) {
    v4u ix[4];
#pragma unroll
    for (int q = 0; q < 4; ++q) ix[q] = *(const LAS v4u*)(mb + 64 * g + 16 * q);
#pragma unroll
    for (int i = 0; i < 16; ++i) s.v[i] = *(const GAS v4u*)(Vj + (unsigned)((ix[i >> 2][i & 3] << 7) + 16u * (unsigned)c)); }
__device__ __forceinline__ void p8b_step(Frame& F, const LAS unsigned char* mb, const LAS unsigned char* mbc, const unsigned char* Vj, int tn, VSet& sn, const VSet& sc, int tc, int j, int lane, int c, int g, bool do_compute) {
    v4u ix[4];
#pragma unroll
    for (int q = 0; q < 4; ++q) ix[q] = *(const LAS v4u*)(mb + 64 * g + 16 * q);
    const v4u wh0 = *(const LAS v4u*)(mbc + 512 + 32 * g), wh1 = *(const LAS v4u*)(mbc + 512 + 32 * g + 16);
    h2_t ah[8];
#pragma unroll
    for (int m = 0; m < 8; ++m) ah[m] = (h2_t){(_Float16)0.f, (_Float16)0.f};
#pragma unroll
    for (int i = 0; i < 16; ++i) {
        sn.v[i] = *(const GAS v4u*)(Vj + (unsigned)((ix[i >> 2][i & 3] << 7) + 16u * (unsigned)c));
        const v4u v = sc.v[i]; const unsigned wu = (i >> 3) ? wh1[(i >> 1) & 3] : wh0[(i >> 1) & 3]; const h2_t w2 = __builtin_bit_cast(h2_t, (i & 1) ? ((wu >> 16) | (wu & 0xffff0000u)) : ((wu & 0xffffu) | (wu << 16)));
        ah[0] = __builtin_elementwise_fma(cvt_h2_lo((int)v.x), w2, ah[0]); ah[1] = __builtin_elementwise_fma(cvt_h2_hi((int)v.x), w2, ah[1]);
        ah[2] = __builtin_elementwise_fma(cvt_h2_lo((int)v.y), w2, ah[2]); ah[3] = __builtin_elementwise_fma(cvt_h2_hi((int)v.y), w2, ah[3]);
        ah[4] = __builtin_elementwise_fma(cvt_h2_lo((int)v.z), w2, ah[4]); ah[5] = __builtin_elementwise_fma(cvt_h2_hi((int)v.z), w2, ah[5]);
        ah[6] = __builtin_elementwise_fma(cvt_h2_lo((int)v.w), w2, ah[6]); ah[7] = __builtin_elementwise_fma(cvt_h2_hi((int)v.w), w2, ah[7]);
        asm volatile("" ::: "memory"); }
    if (!do_compute) return;
#pragma unroll
    for (int m = 0; m < 4; ++m) { const auto r = __builtin_amdgcn_permlane32_swap(__builtin_bit_cast(unsigned, ah[m]), __builtin_bit_cast(unsigned, ah[m + 4]), false, false);
        ah[m] = __builtin_bit_cast(h2_t, (unsigned)r[0]) + __builtin_bit_cast(h2_t, (unsigned)r[1]); }
#pragma unroll
    for (int m = 0; m < 2; ++m) { const auto r = __builtin_amdgcn_permlane16_swap(__builtin_bit_cast(unsigned, ah[m]), __builtin_bit_cast(unsigned, ah[m + 2]), false, false);
        ah[m] = __builtin_bit_cast(h2_t, (unsigned)r[0]) + __builtin_bit_cast(h2_t, (unsigned)r[1]); }
    { const bool up = lane & 8;
      const h2_t s0 = ah[0] + __builtin_bit_cast(h2_t, __builtin_amdgcn_update_dpp(0, __builtin_bit_cast(int, ah[0]), 0x128, 0xf, 0xf, true));
      const h2_t s1 = ah[1] + __builtin_bit_cast(h2_t, __builtin_amdgcn_update_dpp(0, __builtin_bit_cast(int, ah[1]), 0x128, 0xf, 0xf, true));
      ah[0] = up ? s1 : s0; }
    const f32x2v peer = (f32x2v){(float)ah[0].x, (float)ah[0].y} * (1.f / V_SCALE);
    *(GAS unsigned*)((bf16*)(F.ws + WS_H) + (size_t)tc * D + 128 * j + 16 * c + 2 * g) = pk2(peer.x, peer.y);
}
__device__ __forceinline__ void p8b_vsum(Frame& F) {
    const int* IDX = (const int*)(F.ws + WS_IDX); const _Float16* W = (const _Float16*)(F.ws + WS_W16);
    const int lane = F.lane, c = lane & 7, g = lane >> 3; const SliceWork sw = slice_work(F);
    LAS unsigned char* mb = F.lds + F.wave * 1024;
    if (sw.t0 >= M) return;
    const int nt = (M - 1 - sw.t0) / sw.ts + 1;
    for (int jj = 0; jj < sw.nj; ++jj) { const int j = sw.j0 + jj; const unsigned char* Vj = F.ws + WS_V + (size_t)j * NEXP * 128;
        VSet sA, sB, sC;
        LAS unsigned char* const pg0 = mb, * const pg1 = mb + 8192, * const pg2 = mb + 16384;
        VMeta mN = p8b_G(IDX, W, TOK(0), lane); p8b_S(pg0, mN, lane); p8b_RT(F, pg0, Vj, TOK(0), j, c, g, sA);
        mN = p8b_G(IDX, W, TOK(1), lane); p8b_S(pg1, mN, lane); p8b_RT(F, pg1, Vj, TOK(1), j, c, g, sB);
        mN = p8b_G(IDX, W, TOK(2), lane);
#define P8B_STAGE(k, SN, SC_, PN, PC) do { p8b_S(PN, mN, lane); mN = p8b_G(IDX, W, TOK((k) + 3), lane); \
            p8b_step(F, PN, PC, Vj, TOK((k) + 2), SN, SC_, TOK(k), j, lane, c, g, (k) < nt); asm volatile("" ::: "memory"); } while (0)
#pragma unroll 1
        for (int n = 0; n < nt; n += 3) {
            P8B_STAGE(n, sC, sA, pg2, pg0);
            P8B_STAGE(n + 1, sA, sB, pg0, pg1);
            P8B_STAGE(n + 2, sB, sC, pg1, pg2);
        }
#undef P8B_STAGE
    }
#undef TOK
}
__device__ __forceinline__ void p8c_final(Frame& F) {
    const float* gf = F.in[IN_GF]; const float* ada = (const float*)(F.ws + WS_ADA); const int lane = F.lane;
    f32x4 gv[4];
#pragma unroll
    for (int q = 0; q < 4; ++q) gv[q] = *(const f32x4*)(gf + 4 * lane + 256 * q);
    const bf16* X1 = (const bf16*)(F.ws + WS_X1); const bf16* PE = (const bf16*)(F.ws + WS_H);
    for (int t = blockIdx.x * NWAVES + F.wave; t < M; t += F.G * NWAVES) {
        const GAS v2u* xr = (const GAS v2u*)(X1 + (size_t)t * D) + lane; const GAS v2u* pr = (const GAS v2u*)(PE + (size_t)t * D) + lane;
        const float* g2 = ada + (size_t)(t / SEQ) * ADA_W + 5 * D + 4 * lane;
        f32x4 x2[4]; float s = 0.f;
#pragma unroll
        for (int q = 0; q < 4; ++q) { const v2u a = __builtin_nontemporal_load(xr + 64 * q), p = __builtin_nontemporal_load(pr + 64 * q); const f32x4 gg = *(const f32x4*)(g2 + 256 * q);
            x2[q] = (f32x4){bflo(a.x), bfhi(a.x), bflo(a.y), bfhi(a.y)} + gg * (f32x4){bflo(p.x), bfhi(p.x), bflo(p.y), bfhi(p.y)};
            s += (x2[q].x * x2[q].x + x2[q].y * x2[q].y) + (x2[q].z * x2[q].z + x2[q].w * x2[q].w); }
        const float rstd = 1.0f / sqrtf(wave_sum(s) * (1.f / D) + EPS);
        GAS f32x4* yr = (GAS f32x4*)(F.out + (size_t)t * D) + lane;
#pragma unroll
        for (int q = 0; q < 4; ++q) __builtin_nontemporal_store(x2[q] * rstd * gv[q], yr + 64 * q);
    }
}

struct Args { const float* in[20]; float* out; unsigned char* ws; int ph_lo, ph_hi, li, pad; };
__global__ void __launch_bounds__(NWAVES * 64, 2) skel_fwd(Args args) {
    extern __shared__ __attribute__((aligned(16))) unsigned char lds[];
    Frame F;
    F.lds = (LAS unsigned char*)lds;
    F.MISC = (volatile LAS unsigned*)(F.lds + MISC_OFF);
    F.tid = threadIdx.x; F.lane = F.tid & 63; F.wave = __builtin_amdgcn_readfirstlane(F.tid >> 6);
    F.G = gridDim.x; { const int bx = blockIdx.x; F.vcu = (F.G % 8 == 0) ? (bx % 8) * (F.G / 8) + bx / 8 : bx; }
    F.ws = args.ws; F.out = args.out;
#pragma unroll
    for (int i = 0; i < 20; ++i) F.in[i] = args.in[i];
    F.ctl = (gu32*)(args.ws + WS_CTL);
    for (int u = F.tid; u < (LDS_BYTES - LDSCTL_OFF) / 4; u += NWAVES * 64) ((LAS unsigned*)(F.lds + LDSCTL_OFF))[u] = 0u;
    __syncthreads();
    XcdBarrier bar; bar.bar = (unsigned*)(F.ctl + CW_BAR); bar.x = 0; bar.st = nullptr;
    if (N_LAUNCHES == 1) bar = xcd_barrier_post((unsigned*)(F.ctl + CW_BAR), F.MISC + 8);
#define GRID_BAR() do { if (N_LAUNCHES == 1) xcd_barrier(bar); } while (0)
    const int lo = args.ph_lo, hi = args.ph_hi;
#define IN(k) (lo <= (k) && (k) < hi)
    bf16* const H = (bf16*)(args.ws + WS_H); bf16* const PROJ = (bf16*)(args.ws + WS_PROJ); bf16* const MIX = (bf16*)(args.ws + WS_MIX);

    if (IN(0)) { p0_prologue(F); GRID_BAR(); }
    if (IN(1)) { p1_hpass(F); GRID_BAR(); }
    if (IN(2)) {
        pg8::Gemm g{(const bf16*)(args.ws + WS_H8), (const bf16*)(args.ws + WS_WIN), M, IN_W, D / 2}; pg8::StaticOrder S; S.init(M, IN_W, F.G, (int)blockIdx.x);
        pg8::EpiI8Bf16 E{PROJ, IN_W, (const float*)(args.ws + WS_HS), 1.f / WQ_SCALE, F.in[IN_BIN]};
        pg8::gemm_phase<pg8::EpiI8Bf16, pg8::StaticOrder, true, true, true>(F.lds + RING_OFF, g, S, E);
        GRID_BAR();
    }
    if (IN(3)) { p3_mixer(F); GRID_BAR(); }
    if (IN(4)) {
        pg8::Gemm g{MIX, (const bf16*)(args.ws + WS_WOUT), M, D, D}; pg8::StaticOrder S; S.init(M, D, F.G, (int)blockIdx.x);
        pg8::EpiResGate E{F.in[IN_X], (bf16*)(args.ws + WS_X1), D, F.in[IN_BOUT], (const float*)(args.ws + WS_ADA), ADA_W, 2 * D, SEQ / 256};
        pg8::gemm_phase<pg8::EpiResGate, pg8::StaticOrder, true, true>(F.lds + RING_OFF, g, S, E);
        GRID_BAR();
    }
    if (IN(5)) { p5_h2pass(F); GRID_BAR(); }
    if (IN(6)) {
        pg8::Gemm g{(const bf16*)(args.ws + WS_H8), (const bf16*)(args.ws + WS_WQ), M, QW, D / 2}; pg8::StaticOrder S; S.init(M, QW, F.G, (int)blockIdx.x);
        pg8::EpiI8Bf16 E{PROJ, QW, (const float*)(args.ws + WS_HS), 1.f / WQ_SCALE, nullptr};
        pg8::gemm_phase<pg8::EpiI8Bf16, pg8::StaticOrder, true, true, true>(F.lds + RING_OFF, g, S, E);
        GRID_BAR();
    }
    if (IN(7)) { p7_routing(F); GRID_BAR(); }
    if (IN(8)) { p8a_udots(F); GRID_BAR(); }
    if (IN(9)) { p8w_weights(F); GRID_BAR(); }
    if (IN(10)) { p8b_vsum(F); GRID_BAR(); }
    if (IN(11)) { p8c_final(F); }
#undef IN
}

extern "C" void kernel_launch(void* const* d_in, const int* in_sizes, int n_in, void* d_out, int out_size, void* d_ws, size_t ws_size, hipStream_t stream) {
    static int grid = 0;
    if (grid == 0) {
        if (n_in != 20 || in_sizes[0] != M * D || out_size != M * D || ws_size < WS_END) { fprintf(stderr, "kernel_launch: unexpected shapes (n_in %d, in0 %d, out %d, ws %zu); nothing launched\n", n_in, n_in > 0 ? in_sizes[0] : -1, out_size, ws_size); grid = -1; return; }
        int dev = 0, cus = 0, per_cu = 0;
        if (hipGetDevice(&dev) != hipSuccess || hipDeviceGetAttribute(&cus, hipDeviceAttributeMultiprocessorCount, dev) != hipSuccess) { fprintf(stderr, "kernel_launch: device query failed\n"); grid = -1; return; }
        if (hipFuncSetAttribute((const void*)skel_fwd, hipFuncAttributeMaxDynamicSharedMemorySize, LDS_BYTES) != hipSuccess) { fprintf(stderr, "kernel_launch: hipFuncSetAttribute failed\n"); grid = -1; return; }
        if (hipOccupancyMaxActiveBlocksPerMultiprocessor(&per_cu, (const void*)skel_fwd, NWAVES * 64, LDS_BYTES) != hipSuccess || per_cu < 1)
            fprintf(stderr, "kernel_launch: note: occupancy query reports %d workgroups per CU\n", per_cu);
        (void)hipGetLastError();
        grid = cus;
    }
    if (grid < 0) return;
    if (hipMemsetAsync((char*)d_ws + WS_CTL, 0, CTL_ZERO_BYTES, stream) != hipSuccess) { fprintf(stderr, "kernel_launch: hipMemsetAsync failed\n"); return; }
    Args a{};
    for (int i = 0; i < 20; ++i) a.in[i] = (const float*)d_in[i];
    a.out = (float*)d_out; a.ws = (unsigned char*)d_ws;
    for (int li = 0; li < N_LAUNCHES; ++li) {
        a.ph_lo = (N_LAUNCHES == 1) ? 0 : li; a.ph_hi = (N_LAUNCHES == 1) ? NPHASES : li + 1; a.li = li;
        hipLaunchKernelGGL(skel_fwd, dim3(grid), dim3(NWAVES * 64), LDS_BYTES, stream, a);
        const hipError_t le = hipPeekAtLastError();
        if (le != hipSuccess) { fprintf(stderr, "kernel_launch: launch %d failed: %s\n", li, hipGetErrorName(le)); break; }
    }
}
```

```cpp
#include <hip/hip_runtime.h>
#include <cstdio>
#include <cstdint>
#include <cmath>
namespace pg8 {
#define PG8_LAS __attribute__((address_space(3)))
typedef unsigned short bf16_t;
typedef short bf16x8 __attribute__((ext_vector_type(8)));
typedef float f32x4 __attribute__((ext_vector_type(4)));
typedef unsigned u32x4 __attribute__((ext_vector_type(4)));
constexpr int BM = 256, BK = 64, HALF = 128, HTB = HALF * BK * 2  , STAGE_BYTES = 8 * HTB, NXCD = 8, WGM = 8;

__host__ __device__ __forceinline__ int lds_byte(int r, int c) { const int st = (r >> 4) * 2 + (c >> 5), rr = r & 15, cc = c & 31, ob = rr * 64 + cc * 2; return st * 1024 + (ob ^ (((ob >> 9) & 1) << 5)); }
__host__ __device__ __forceinline__ void stage_rc(int b, int& R, int& C) { const int st = b / 1024, sb = b % 1024, swz = sb ^ (((sb >> 9) & 1) << 5); R = (st >> 1) * 16 + swz / 64; C = (st & 1) * 32 + (swz % 64) / 2; }
__host__ __device__ __forceinline__ int perm32(int rho) { const int n = rho >> 4, i = rho & 15; return 8 * (i >> 2) + 4 * n + (i & 3); }

__device__ __forceinline__ __amdgpu_buffer_rsrc_t wt_rsrc(const void* base, size_t bytes) { return __builtin_amdgcn_make_buffer_rsrc((void*)base, 0, (int)bytes, 0x00020000); }
__device__ __forceinline__ void store16_wt(__amdgpu_buffer_rsrc_t r, unsigned off, u32x4 v) { __builtin_amdgcn_raw_buffer_store_b128(v, r, (int)off, 0, 16); }
struct Unit { int pm, pn; };
struct Gemm { const bf16_t* A; const bf16_t* Bt; int M, N, K; };

struct StaticOrder {
    int nM, nN, nwg, G, c;
    __host__ __device__ void init(int M, int N, int G_, int c_) { nM = M / BM; nN = N / BM; nwg = nM * nN; G = G_; c = c_; }
    __host__ __device__ __forceinline__ bool next(int i, Unit& u) const { return at((long)i * G + c, u); }
    __host__ __device__ __forceinline__ bool at(long L, Unit& u) const {
        if (L >= nwg) return false;
        int wgid = (int)L; { const int q = nwg / NXCD, r = nwg % NXCD, xcd = wgid % NXCD, off = wgid / NXCD; wgid = (xcd < r ? xcd * (q + 1) : r * (q + 1) + (xcd - r) * q) + off; }
        const int nig = WGM * nN, gid = wgid / nig, fm = gid * WGM, gsz = (nM - fm) < WGM ? (nM - fm) : WGM;
        u.pm = fm + ((wgid % nig) % gsz); u.pn = (wgid % nig) / gsz; return true;
    }
    __host__ __device__ __forceinline__ int part(int) const { return 0; }
    __device__ __forceinline__ void a_ready(const Unit&) const {}
    __device__ __forceinline__ void done(const Unit&) const {}
};

struct StagOrder {
    StaticOrder base; int R, E, grpB, pair; bool on;
    __host__ __device__ void init(int M, int N, int G_, int c_) { base.init(M, N, G_, c_); R = base.nwg / G_; E = base.nwg - R * G_; on = (G_ % 16 == 0) && R >= 1 && (E == 0 || E == G_ / 2);
        const int slot = c_ >> 3; grpB = slot & 1; pair = (slot >> 1) * 8 + (c_ & 7); }
    __host__ __device__ __forceinline__ bool next(int i, Unit& u) const {
        if (!on) return base.next(i, u);
        if (E) {
            if (!grpB) return i < R ? base.next(i, u) : (i == R ? base.at((long)R * base.G + pair, u) : false);
            return i == 0 ? base.at((long)R * base.G + pair, u) : (i <= R ? base.next(i - 1, u) : false);
        }
        if (!grpB || i < R) return base.next(i, u);
        return i == R ? base.next(0, u) : false;
    }
    __host__ __device__ __forceinline__ int part(int i) const {
        if (!on) return 0;
        if (E) return grpB ? (i == 0 ? 2 : 0) : (i == R ? 1 : 0);
        return grpB ? (i == 0 ? 1 : (i == R ? 2 : 0)) : 0;
    }
    __device__ __forceinline__ void a_ready(const Unit&) const {}
    __device__ __forceinline__ void done(const Unit&) const {}
};

__device__ __forceinline__ unsigned cvt_pk_bf16(float lo, float hi) { unsigned r; asm volatile("v_cvt_pk_bf16_f32 %0, %1, %2" : "=v"(r) : "v"(lo), "v"(hi)); return r; }
typedef float f32x2 __attribute__((ext_vector_type(2)));
__device__ __forceinline__ f32x2 gelu_pk(f32x2 v) {
    const f32x2 av = __builtin_elementwise_abs(v), d = av * 0.2316418882f + 1.0f;
    f32x2 t; t.x = __builtin_amdgcn_rcpf(d.x); t.y = __builtin_amdgcn_rcpf(d.y);
    f32x2 q = t * 0.5307027145f + (-0.7265760135f); q = q * t + 0.7107068705f; q = q * t + (-0.142248368f); q = q * t + 0.127414796f; q = q * t;
    const f32x2 s = (v * v) * (-0.72134752044f);
    f32x2 e; e.x = __builtin_amdgcn_exp2f(s.x); e.y = __builtin_amdgcn_exp2f(s.y);
    const f32x2 m = v * (q * e), r = v - m;
    f32x2 o; o.x = v.x < 0.f ? m.x : r.x; o.y = v.y < 0.f ? m.y : r.y; return o;
}

template <int ACT  > struct EpiBf16 {
    static constexpr bool PERM = true, AFTER_DRAIN = false; static_assert(ACT == 0 || ACT == 1, "EpiBf16: ACT is 0 (none) or 1 (gelu_pk)");
    bf16_t* O; int ldc; const float* bias; int split_cols; size_t split_stride; float scale0;
    __device__ __forceinline__ void operator()(const f32x4 (&acc)[2][2][4][2], const Unit& u, int wr, int wc, int fr, int fq) const {
        const int row0 = u.pm * BM + wr * 64 + fr; int colt = u.pn * BM; bf16_t* base = O;
        float sc = 1.f; if (split_cols) { const int t = colt / split_cols; base += (size_t)t * split_stride; colt -= t * split_cols; if (t == 0) sc = scale0; }
        const int col0 = colt + wc * 32 + 8 * fq, bcol0 = u.pn * BM + wc * 32 + 8 * fq;
        f32x4 bv[2][2];
#pragma unroll
        for (int bj = 0; bj < 2; ++bj)
#pragma unroll
            for (int n = 0; n < 2; ++n) bv[bj][n] = bias ? *(const f32x4*)(bias + bcol0 + bj * HALF + 4 * n) : (f32x4){0.f, 0.f, 0.f, 0.f};
#pragma unroll
        for (int ai = 0; ai < 2; ++ai)
#pragma unroll
            for (int m = 0; m < 4; ++m) { bf16_t* rowp = base + (size_t)(row0 + ai * HALF + m * 16) * ldc + col0;
#pragma unroll
                for (int bj = 0; bj < 2; ++bj) { f32x4 v0 = acc[ai][bj][m][0] + bv[bj][0], v1 = acc[ai][bj][m][1] + bv[bj][1];
                    if (ACT == 1) { f32x2 a = gelu_pk((f32x2){v0[0], v0[1]}), b = gelu_pk((f32x2){v0[2], v0[3]}), c = gelu_pk((f32x2){v1[0], v1[1]}), d = gelu_pk((f32x2){v1[2], v1[3]});
                        v0 = (f32x4){a.x, a.y, b.x, b.y}; v1 = (f32x4){c.x, c.y, d.x, d.y}; }
                    v0 = v0 * sc; v1 = v1 * sc; u32x4 w; w.x = cvt_pk_bf16(v0[0], v0[1]); w.y = cvt_pk_bf16(v0[2], v0[3]); w.z = cvt_pk_bf16(v1[0], v1[1]); w.w = cvt_pk_bf16(v1[2], v1[3]);
                    *(u32x4*)(rowp + bj * HALF) = w; } }
    }
};

typedef unsigned u32x2 __attribute__((ext_vector_type(2)));
struct EpiResGate {
    static constexpr bool PERM = true, AFTER_DRAIN = false;
    const float* x; bf16_t* out; int ldc; const float* bias; const float* ada; int ada_ld, gate_off, tiles_per_batch;
    __device__ __forceinline__ void operator()(const f32x4 (&acc)[2][2][4][2], const Unit& u, int wr, int wc, int fr, int fq, int part) const {
        const int row0 = u.pm * BM + wr * 64 + fr, col0 = u.pn * BM + wc * 32 + 8 * fq;
        const float* gp = ada + (size_t)(u.pm / tiles_per_batch) * ada_ld + gate_off;
        f32x4 bv[2][2], gv[2][2];
#pragma unroll
        for (int bj = 0; bj < 2; ++bj)
#pragma unroll
            for (int n = 0; n < 2; ++n) { bv[bj][n] = *(const f32x4*)(bias + col0 + bj * HALF + 4 * n); gv[bj][n] = *(const f32x4*)(gp + col0 + bj * HALF + 4 * n); }
        const __amdgpu_buffer_rsrc_t orsrc = wt_rsrc(out, (size_t)32768 * ldc * 2);
#pragma unroll
        for (int ai = 0; ai < 2; ++ai) {
            if (part == (ai ? 1 : 2)) continue;
#pragma unroll
            for (int mh = 0; mh < 2; ++mh) {
            f32x4 xv[2][2][2];
#pragma unroll
            for (int m = 0; m < 2; ++m) { const size_t off = (size_t)(row0 + ai * HALF + (2 * mh + m) * 16) * ldc + col0;
#pragma unroll
                for (int bj = 0; bj < 2; ++bj)
#pragma unroll
                    for (int n = 0; n < 2; ++n) xv[m][bj][n] = __builtin_nontemporal_load((const f32x4*)(x + off + bj * HALF + 4 * n)); }
#pragma unroll
            for (int m = 0; m < 2; ++m) { const size_t off = (size_t)(row0 + ai * HALF + (2 * mh + m) * 16) * ldc + col0;
#pragma unroll
                for (int bj = 0; bj < 2; ++bj) { const f32x4 o0 = xv[m][bj][0] + gv[bj][0] * (acc[ai][bj][2 * mh + m][0] + bv[bj][0]), o1 = xv[m][bj][1] + gv[bj][1] * (acc[ai][bj][2 * mh + m][1] + bv[bj][1]);
                    u32x4 w; w.x = cvt_pk_bf16(o0[0], o0[1]); w.y = cvt_pk_bf16(o0[2], o0[3]); w.z = cvt_pk_bf16(o1[0], o1[1]); w.w = cvt_pk_bf16(o1[2], o1[3]);
                    store16_wt(orsrc, (unsigned)((off + bj * HALF) * 2), w); } }
            asm volatile("" ::: "memory"); }
            asm volatile("" ::: "memory"); }
    }
};


typedef int i32x4 __attribute__((ext_vector_type(4)));
template <bool I8> struct AccSel { typedef f32x4 type; static __device__ __forceinline__ f32x4 zero() { return (f32x4){0.f, 0.f, 0.f, 0.f}; } };
template <> struct AccSel<true> { typedef i32x4 type; static __device__ __forceinline__ i32x4 zero() { return (i32x4){0, 0, 0, 0}; } };
template <bool I8> __device__ __forceinline__ typename AccSel<I8>::type mma16(bf16x8 a, bf16x8 b, typename AccSel<I8>::type c) {
    if constexpr (I8) return __builtin_amdgcn_mfma_i32_16x16x64_i8(__builtin_bit_cast(i32x4, a), __builtin_bit_cast(i32x4, b), c, 0, 0, 0);
    else return __builtin_amdgcn_mfma_f32_16x16x32_bf16(a, b, c, 0, 0, 0);
}
struct EpiI8Bf16 {
    static constexpr bool PERM = true, AFTER_DRAIN = false;
    bf16_t* O; int ldc; const float* rowscale; float wscale; const float* bias;
    __device__ __forceinline__ void operator()(const i32x4 (&acc)[2][2][4][2], const Unit& u, int wr, int wc, int fr, int fq, int part) const {
        const int row0 = u.pm * BM + wr * 64 + fr, col0 = u.pn * BM + wc * 32 + 8 * fq;
        f32x4 bv[2][2];
#pragma unroll
        for (int bj = 0; bj < 2; ++bj)
#pragma unroll
            for (int n = 0; n < 2; ++n) bv[bj][n] = bias ? *(const f32x4*)(bias + col0 + bj * HALF + 4 * n) : (f32x4){0.f, 0.f, 0.f, 0.f};
        const __amdgpu_buffer_rsrc_t orsrc = wt_rsrc(O, (size_t)32768 * ldc * 2);
#pragma unroll
        for (int ai = 0; ai < 2; ++ai) { if (part == (ai ? 1 : 2)) continue;
#pragma unroll
            for (int m = 0; m < 4; ++m) { const int row = row0 + ai * HALF + m * 16; const float sc = rowscale[row] * wscale; const unsigned rowoff = (unsigned)(((size_t)row * ldc + col0) * 2);
#pragma unroll
                for (int bj = 0; bj < 2; ++bj) { const i32x4 a0 = acc[ai][bj][m][0], a1 = acc[ai][bj][m][1]; const f32x4 b0 = bv[bj][0], b1 = bv[bj][1];
                    u32x4 w; w.x = cvt_pk_bf16((float)a0[0] * sc + b0[0], (float)a0[1] * sc + b0[1]); w.y = cvt_pk_bf16((float)a0[2] * sc + b0[2], (float)a0[3] * sc + b0[3]);
                    w.z = cvt_pk_bf16((float)a1[0] * sc + b1[0], (float)a1[1] * sc + b1[1]); w.w = cvt_pk_bf16((float)a1[2] * sc + b1[2], (float)a1[3] * sc + b1[3]);
                    store16_wt(orsrc, rowoff + bj * HALF * 2, w); } } }
    }
};
template <class Epi, class Sched, bool ALIGN_EPI = false, bool SP2 = false, bool I8 = false>
__device__ __forceinline__ void gemm_phase(PG8_LAS unsigned char* lds, const Gemm g, const Sched& S, const Epi& E) {
    const int tid = threadIdx.x, wid = __builtin_amdgcn_readfirstlane(tid >> 6), lane = tid & 63, wr = wid >> 2, wc = wid & 3, fr = lane & 15, fq = lane >> 4;
    const int K = g.K, nt = K / BK;
    unsigned voffA[2], voffB[2];
#pragma unroll
    for (int i = 0; i < 2; ++i) { int R, C; stage_rc(tid * 16 + i * 8192, R, C); const int Rb = Epi::PERM ? ((R & ~31) + perm32(R & 31)) : R;
        voffA[i] = (unsigned)(R * K + C) * 2u; voffB[i] = (unsigned)(Rb * K + C) * 2u; }
    const size_t kstep = (size_t)(BK * 2);
    const size_t hstep = (size_t)HALF * K * 2;
    const size_t tstep = 2 * hstep;
    const unsigned ldsw = (unsigned)wid * 1024u;
    const int aoff = lds_byte(wr * 64 + fr, fq * 8), boff = lds_byte(wc * 32 + fr, fq * 8);
#define PG8_SA(b, h) (((b) * 2 + (h)) * HTB)
#define PG8_SB(b, h) ((4 + (b) * 2 + (h)) * HTB)
#define PG8_STAGE(bufoff, gbase, voff) do { _Pragma("unroll") for (int _i = 0; _i < 2; ++_i) \
        __builtin_amdgcn_global_load_lds((const unsigned*)((const char*)(gbase) + (voff)[_i]), (PG8_LAS unsigned*)(lds + (bufoff) + ldsw + _i * 8192), 16, 0, 0); } while (0)
#define PG8_LDA(dst, b, h) do { _Pragma("unroll") for (int m = 0; m < 4; ++m) _Pragma("unroll") for (int k = 0; k < 2; ++k) dst[m][k] = *(const PG8_LAS bf16x8*)(lds + PG8_SA(b, h) + aoff + m * 2048 + k * 1024); } while (0)
#define PG8_LDB(dst, b, h) do { _Pragma("unroll") for (int n = 0; n < 2; ++n) _Pragma("unroll") for (int k = 0; k < 2; ++k) dst[n][k] = *(const PG8_LAS bf16x8*)(lds + PG8_SB(b, h) + boff + n * 2048 + k * 1024); } while (0)
#define PG8_MMA(ai, bj, At, Bt) do { __builtin_amdgcn_s_setprio(1); _Pragma("unroll") for (int m = 0; m < 4; ++m) _Pragma("unroll") for (int n = 0; n < 2; ++n) _Pragma("unroll") for (int k = 0; k < 2; ++k) \
        acc[ai][bj][m][n] = mma16<I8>(Bt[n][k], At[m][k], acc[ai][bj][m][n]); __builtin_amdgcn_s_setprio(0); } while (0)
#define PG8_WAIT_V(n) asm volatile("s_waitcnt vmcnt(" #n ")" ::: "memory")
#define PG8_WAIT_L(n) asm volatile("s_waitcnt lgkmcnt(" #n ")" ::: "memory")
#define PG8_BAR __builtin_amdgcn_s_barrier()
#define PG8_SCHED __builtin_amdgcn_sched_barrier(0)
    Unit cur, nxt; int ui = 0;
    if (!S.next(0, cur)) return;
    typedef typename AccSel<I8>::type acc_t;
    acc_t acc[2][2][4][2];
#pragma unroll
    for (int a = 0; a < 2; ++a)
#pragma unroll
        for (int b = 0; b < 2; ++b)
#pragma unroll
            for (int m = 0; m < 4; ++m)
#pragma unroll
                for (int n = 0; n < 2; ++n) acc[a][b][m][n] = AccSel<I8>::zero();
    bf16x8 At[4][2], B0[2][2], B1[2][2];
    const char* cA = (const char*)g.A + (size_t)cur.pm * tstep; const char* cB = (const char*)g.Bt + (size_t)cur.pn * tstep;
    S.a_ready(cur);
    if constexpr (SP2) {
        PG8_STAGE(PG8_SB(0, 0), cB, voffB); PG8_STAGE(PG8_SB(0, 1), cB + hstep, voffB); PG8_STAGE(PG8_SA(0, 0), cA, voffA); PG8_STAGE(PG8_SA(0, 1), cA + hstep, voffA);
        if (wr == 1) PG8_BAR;
        PG8_WAIT_V(2); PG8_BAR;
        PG8_STAGE(PG8_SB(1, 0), cB + kstep, voffB); PG8_STAGE(PG8_SA(1, 0), cA + kstep, voffA); PG8_STAGE(PG8_SB(1, 1), cB + hstep + kstep, voffB);
        PG8_WAIT_V(6); PG8_BAR;
    } else {
        PG8_STAGE(PG8_SB(0, 0), cB, voffB); PG8_STAGE(PG8_SA(0, 0), cA, voffA); PG8_STAGE(PG8_SB(0, 1), cB + hstep, voffB); PG8_STAGE(PG8_SA(0, 1), cA + hstep, voffA);
        if (wr == 1) PG8_BAR;
        PG8_WAIT_V(4); PG8_BAR;
        PG8_STAGE(PG8_SB(1, 0), cB + kstep, voffB); PG8_STAGE(PG8_SA(1, 0), cA + kstep, voffA); PG8_STAGE(PG8_SB(1, 1), cB + hstep + kstep, voffB);
        PG8_WAIT_V(6); PG8_BAR;
    }
    for (;;) {
        const bool has_next = S.next(ui + 1, nxt);
        const char* nA = has_next ? (const char*)g.A + (size_t)nxt.pm * tstep : cA; const char* nB = has_next ? (const char*)g.Bt + (size_t)nxt.pn * tstep : cB;
        const int cpart = S.part(ui); const bool d0 = cpart != 2, d1 = cpart != 1;
        for (int t = 0; t < nt; t += 2) {
            const bool last = (t == nt - 2);
            const char* a1 = cA + (size_t)(t + 1) * kstep;
            const char* a2 = last ? nA : cA + (size_t)(t + 2) * kstep; const char* b2 = last ? nB : cB + (size_t)(t + 2) * kstep;
            const char* a3 = a2 + kstep; const char* b3 = b2 + kstep;
            if (last && has_next) S.a_ready(nxt);
            if constexpr (SP2) {
            PG8_LDB(B0, 0, 0); PG8_LDB(B1, 0, 1); PG8_SCHED; PG8_LDA(At, 0, 0); PG8_STAGE(PG8_SA(1, 1), a1 + hstep, voffA);
            PG8_WAIT_V(8); PG8_WAIT_L(0); PG8_BAR; if (d0) { PG8_MMA(0, 0, At, B0); PG8_MMA(0, 1, At, B1); } PG8_BAR; PG8_SCHED;
            PG8_LDA(At, 0, 1); PG8_STAGE(PG8_SB(0, 0), b2, voffB); PG8_STAGE(PG8_SB(0, 1), b2 + hstep, voffB); PG8_STAGE(PG8_SA(0, 0), a2, voffA);
            PG8_WAIT_V(8); PG8_WAIT_L(0); PG8_BAR; if (d1) { PG8_MMA(1, 0, At, B0); PG8_MMA(1, 1, At, B1); } PG8_BAR; PG8_SCHED;
            PG8_LDB(B0, 1, 0); PG8_LDB(B1, 1, 1); PG8_SCHED; PG8_LDA(At, 1, 0); PG8_STAGE(PG8_SA(0, 1), a2 + hstep, voffA);
            PG8_WAIT_V(8); PG8_WAIT_L(0); PG8_BAR; if (d0) { PG8_MMA(0, 0, At, B0); PG8_MMA(0, 1, At, B1); } PG8_BAR; PG8_SCHED;
            PG8_LDA(At, 1, 1); PG8_STAGE(PG8_SB(1, 0), b3, voffB); PG8_STAGE(PG8_SB(1, 1), b3 + hstep, voffB); PG8_STAGE(PG8_SA(1, 0), a3, voffA);
            PG8_WAIT_V(8); PG8_WAIT_L(0); PG8_BAR; if (d1) { PG8_MMA(1, 0, At, B0); PG8_MMA(1, 1, At, B1); } PG8_BAR; PG8_SCHED;
            } else {
            PG8_LDB(B0, 0, 0); PG8_SCHED; PG8_LDA(At, 0, 0); PG8_STAGE(PG8_SA(1, 1), a1 + hstep, voffA);
            PG8_WAIT_L(8); PG8_BAR; PG8_WAIT_L(0); PG8_MMA(0, 0, At, B0); PG8_BAR; PG8_SCHED;
            PG8_LDB(B1, 0, 1); PG8_STAGE(PG8_SB(0, 0), b2, voffB);
            PG8_BAR; PG8_WAIT_L(0); PG8_MMA(0, 1, At, B1); PG8_BAR;
            PG8_LDA(At, 0, 1); PG8_STAGE(PG8_SA(0, 0), a2, voffA);
            PG8_BAR; PG8_WAIT_L(0); PG8_MMA(1, 0, At, B0); PG8_BAR; PG8_SCHED;
            PG8_STAGE(PG8_SB(0, 1), b2 + hstep, voffB);
            PG8_WAIT_V(6); PG8_BAR; PG8_MMA(1, 1, At, B1); PG8_BAR;
            PG8_LDB(B0, 1, 0); PG8_SCHED; PG8_LDA(At, 1, 0); PG8_STAGE(PG8_SA(0, 1), a2 + hstep, voffA);
            PG8_WAIT_L(8); PG8_BAR; PG8_WAIT_L(0); PG8_MMA(0, 0, At, B0); PG8_BAR; PG8_SCHED;
            PG8_LDB(B1, 1, 1); PG8_STAGE(PG8_SB(1, 0), b3, voffB);
            PG8_BAR; PG8_WAIT_L(0); PG8_MMA(0, 1, At, B1); PG8_BAR;
            PG8_LDA(At, 1, 1); PG8_STAGE(PG8_SA(1, 0), a3, voffA);
            PG8_BAR; PG8_WAIT_L(0); PG8_MMA(1, 0, At, B0); PG8_BAR; PG8_SCHED;
            PG8_STAGE(PG8_SB(1, 1), b3 + hstep, voffB);
            PG8_WAIT_V(6); PG8_BAR; PG8_MMA(1, 1, At, B1); PG8_BAR;
            }
        }
        if constexpr (ALIGN_EPI) { if (wr == 0) PG8_BAR; }
        if constexpr (!Epi::AFTER_DRAIN) { E(acc, cur, wr, wc, fr, fq, cpart); S.done(cur); }
        if (!has_next) break;
#pragma unroll
        for (int a = 0; a < 2; ++a)
#pragma unroll
            for (int b = 0; b < 2; ++b)
#pragma unroll
                for (int m = 0; m < 4; ++m)
#pragma unroll
                    for (int n = 0; n < 2; ++n) acc[a][b][m][n] = AccSel<I8>::zero();
        cur = nxt; cA = nA; cB = nB; ++ui;
        if constexpr (ALIGN_EPI) { if (wr == 1) PG8_BAR; }
    }
    PG8_WAIT_V(0);
    if constexpr (!ALIGN_EPI) { if (wr == 0) PG8_BAR; }
    PG8_BAR;
    if constexpr (Epi::AFTER_DRAIN) { E.fused(acc, cur, wr, wc, fr, fq, lds, wid, lane); S.done(cur); }
#undef PG8_SA
#undef PG8_SB
#undef PG8_STAGE
#undef PG8_LDA
#undef PG8_LDB
#undef PG8_MMA
#undef PG8_WAIT_V
#undef PG8_WAIT_L
#undef PG8_BAR
#undef PG8_SCHED
}
}

constexpr int NWAVES = 8;
constexpr int NPHASES = 12;
#ifndef MK_N_LAUNCHES
#define MK_N_LAUNCHES 1
#endif
constexpr int N_LAUNCHES = MK_N_LAUNCHES;
static_assert(N_LAUNCHES == 1 || N_LAUNCHES == NPHASES, "MK_N_LAUNCHES is 1 or NPHASES");

constexpr int BATCH = 16, SEQ = 2048, D = 1024, M = BATCH * SEQ;
constexpr int IN_W = 2304, O_Q = 0, O_K = 512, O_V = 640, O_B = 768, O_C = 1280, O_U = 1792;
constexpr int NQH = 8, NKVH = 2, HD = 64, WIN = 128;
constexpr int NKEYS = 128, NEXP = 16384, PH = 8, TOPK = 16, DKEY = 256, DHALF = 128, QW = PH * DKEY;
constexpr int ADA_W = 6 * D, ADA_KC = 8;
constexpr float EPS = 1e-6f;

constexpr size_t MiB = 1u << 20;
constexpr size_t WS_CTL = 0, CTL_ZERO_BYTES = 64 * 1024;
constexpr size_t WS_ADAP = 1 * MiB;
constexpr size_t WS_ADA = 4 * MiB;
constexpr size_t WS_WIN = 5 * MiB;
constexpr size_t WS_WOUT = 10 * MiB;
constexpr size_t WS_WQ = 12 * MiB;
constexpr size_t WS_K1 = 16 * MiB, WS_K2 = 16 * MiB + 512 * 1024;
constexpr size_t WS_U = 17 * MiB, WS_V = 33 * MiB;
constexpr float U_SCALE = 896.f, V_SCALE = 8.f, WQ_SCALE = 896.f;
constexpr size_t WS_H = 81 * MiB;
constexpr size_t WS_PROJ = 145 * MiB;
constexpr size_t WS_MIX = 289 * MiB;
constexpr size_t WS_IDX = 353 * MiB;
constexpr size_t WS_GATE = 369 * MiB;
constexpr size_t WS_H8 = 49 * MiB;
constexpr size_t WS_HS = 393 * MiB;
constexpr size_t WS_W16 = 385 * MiB;
constexpr size_t WS_X1 = 417 * MiB;
constexpr size_t WS_END = 481 * MiB;
constexpr size_t WS_PA = WS_PROJ;
constexpr size_t WS_SS = WS_MIX;
constexpr int CW_BAR = 4096;
static_assert((CW_BAR + 3456) * 4 <= (int)CTL_ZERO_BYTES, "barrier words inside the zeroed region");

constexpr int RING_OFF = 0, RING_BYTES = 131072;
constexpr int LDSCTL_OFF = 135168, MISC_OFF = LDSCTL_OFF + 320;
constexpr int LDS_BYTES = 147456;
static_assert(MISC_OFF + 128 <= LDS_BYTES, "LDS map");

#define GAS __attribute__((address_space(1)))
#define LAS __attribute__((address_space(3)))
typedef unsigned short bf16;
typedef unsigned v4u __attribute__((ext_vector_type(4)));
typedef float f32x4 __attribute__((ext_vector_type(4)));
typedef short bf16x8 __attribute__((ext_vector_type(8)));
typedef GAS unsigned gu32;
typedef GAS unsigned long long gu64;
#define RLX_AGENT __ATOMIC_RELAXED, __HIP_MEMORY_SCOPE_AGENT
#define LDS_WAIT() asm volatile("s_waitcnt lgkmcnt(0)" ::: "memory")
#define VM_WAIT() asm volatile("s_waitcnt vmcnt(0)" ::: "memory")
__device__ __forceinline__ unsigned long long rt() { return __builtin_amdgcn_s_memrealtime(); }
__device__ __forceinline__ unsigned f2bf(float f) { unsigned u = __builtin_bit_cast(unsigned, f); return (u + 0x7fffu + ((u >> 16) & 1u)) >> 16; }
__device__ __forceinline__ unsigned pk2(float lo, float hi) { return f2bf(lo) | (f2bf(hi) << 16); }

#define XB_TMO      128
#define XB_XCNT(j)  (256  + 64 * (j))
#define XB_XSUB(j)  (1280 + 64 * (j))
#define XB_XGEN(j)  (2304 + 64 * (j))
#define XB_TOP      3328
#define XB_TOPGEN   3392
#define XCD_BAR_WORDS 3456
#define XB_SPIN_CAP (1u << 22)

__device__ __forceinline__ unsigned xb_ld(unsigned* p)              { return __hip_atomic_load(p, __ATOMIC_RELAXED, __HIP_MEMORY_SCOPE_AGENT); }
__device__ __forceinline__ unsigned xb_add(unsigned* p, unsigned v) { return __hip_atomic_fetch_add(p, v, __ATOMIC_RELAXED, __HIP_MEMORY_SCOPE_AGENT); }
__device__ __forceinline__ unsigned xb_xcc_id() { return (unsigned)__builtin_amdgcn_s_getreg((3 << 11) | 20) & 0xFu; }
#define XB_SPIN(cond, bar) do { unsigned _sp = 0; while (cond) { __builtin_amdgcn_s_sleep(1); \
    if ((++_sp & 255u) == 0u) { if (xb_ld(&(bar)[XB_TMO])) break; if (_sp > XB_SPIN_CAP) { atomicAdd(&(bar)[XB_TMO], 1u); break; } } } } while (0)

struct XcdBarrier {
    unsigned* bar; unsigned x;
    volatile LAS unsigned* st;
};

__device__ __forceinline__ XcdBarrier xcd_barrier_post(unsigned* bar, volatile LAS unsigned* st) {
    XcdBarrier b; b.bar = bar; b.x = xb_xcc_id(); b.st = st;
    if (threadIdx.x == 0) (void)xb_add(&bar[XB_XCNT(b.x)], 1u);
    return b;
}
__device__ __forceinline__ void xcd_barrier_complete(unsigned* bar, unsigned x, unsigned& nloc, unsigned& nx) {
    const unsigned G = gridDim.x * gridDim.y * gridDim.z;
    unsigned sum, cnt, mine, sp = 0u;
    for (;;) {
        sum = 0u; cnt = 0u; mine = 0u;
#pragma unroll
        for (unsigned j = 0; j < 16; ++j) { const unsigned c = xb_ld(&bar[XB_XCNT(j)]); sum += c; cnt += (c > 0u) ? 1u : 0u; mine = (j == x) ? c : mine; }
        if (sum == G) break;
        __builtin_amdgcn_s_sleep(1);
        if ((++sp & 255u) == 0u) { if (xb_ld(&bar[XB_TMO])) break; if (sp > XB_SPIN_CAP) { atomicAdd(&bar[XB_TMO], 1u); break; } }
    }
    nloc = mine > 0u ? mine : 1u; nx = cnt > 0u ? cnt : 1u;
}

__device__ __forceinline__ void xcd_barrier(const XcdBarrier& b) {
    asm volatile("s_waitcnt vmcnt(0)" ::: "memory");
    __syncthreads();
    if (threadIdx.x == 0) {
        unsigned* bar = b.bar;
        __builtin_amdgcn_s_waitcnt(0);
        unsigned nloc = b.st[0], nx = b.st[1];
        if (nloc == 0u) { xcd_barrier_complete(bar, b.x, nloc, nx); b.st[0] = nloc; b.st[1] = nx; }
        const unsigned old = xb_add(&bar[XB_XSUB(b.x)], 1u);
        const unsigned gen = old / nloc;
        if (old + 1u == (gen + 1u) * nloc) {
            __builtin_amdgcn_fence(__ATOMIC_RELEASE, "agent");
            asm volatile("s_waitcnt vmcnt(0)" ::: "memory");
            const unsigned og = xb_add(&bar[XB_TOP], 1u);
            const unsigned tg = og / nx;
            if (og + 1u == (tg + 1u) * nx) xb_add(&bar[XB_TOPGEN], 1u);
            else XB_SPIN(xb_ld(&bar[XB_TOPGEN]) == tg, bar);
            __builtin_amdgcn_fence(__ATOMIC_ACQUIRE, "agent");
            xb_add(&bar[XB_XGEN(b.x)], 1u);
            asm volatile("s_waitcnt vmcnt(0)" ::: "memory");
        } else {
            XB_SPIN(xb_ld(&bar[XB_XGEN(b.x)]) == gen, bar);
            __builtin_amdgcn_fence(__ATOMIC_ACQUIRE, "agent");
            asm volatile("s_waitcnt vmcnt(0)" ::: "memory");
        }
    }
    __syncthreads();
}

struct Frame {
    LAS unsigned char* lds;
    volatile LAS unsigned* MISC;
    gu32* ctl;
    int tid, lane, wave;
    int vcu, G;
    const float* in[20]; float* out; unsigned char* ws;
};
#define IN_X 0
#define IN_C 1
#define IN_WADA 2
#define IN_BADA 3
#define IN_G1 4
#define IN_WIN 5
#define IN_BIN 6
#define IN_SINK 7
#define IN_CONVW 8
#define IN_AOG 9
#define IN_COG 10
#define IN_WOUT 11
#define IN_BOUT 12
#define IN_G2 13
#define IN_WQ 14
#define IN_PK1 15
#define IN_PK2 16
#define IN_PU 17
#define IN_PV 18
#define IN_GF 19

typedef __bf16 bf16x2_t __attribute__((ext_vector_type(2)));
typedef unsigned v2u __attribute__((ext_vector_type(2)));
__device__ __forceinline__ float dot2(unsigned a, unsigned b, float acc) { return __builtin_amdgcn_fdot2_f32_bf16(__builtin_bit_cast(bf16x2_t, a), __builtin_bit_cast(bf16x2_t, b), acc, false); }
__device__ __forceinline__ float dot8(v4u a, v4u b, float acc) { acc = dot2(a.x, b.x, acc); acc = dot2(a.y, b.y, acc); acc = dot2(a.z, b.z, acc); acc = dot2(a.w, b.w, acc); return acc; }
__device__ __forceinline__ float bflo(unsigned w) { return __uint_as_float(w << 16); }
__device__ __forceinline__ float bfhi(unsigned w) { return __uint_as_float(w & 0xffff0000u); }
__device__ __forceinline__ float wave_sum(float v) {
#pragma unroll
    for (int o = 1; o < 64; o <<= 1) v += __shfl_xor(v, o);
    return v;
}
__device__ __forceinline__ unsigned wave_umax(unsigned v) {
#pragma unroll
    for (int o = 1; o < 64; o <<= 1) { const unsigned t = (unsigned)__shfl_xor((int)v, o); v = v > t ? v : t; }
    return v;
}
__device__ __forceinline__ unsigned f2ord(float f) { const unsigned u = __float_as_uint(f); return (u & 0x80000000u) ? ~u : (u | 0x80000000u); }
__device__ __forceinline__ float ord2f(unsigned u) { return __uint_as_float((u & 0x80000000u) ? (u & 0x7fffffffu) : ~u); }

__device__ __forceinline__ unsigned pk4_i8(f32x4 a, float sc) {
    const int q0 = max(-127, min(127, __float2int_rn(a.x * sc))), q1 = max(-127, min(127, __float2int_rn(a.y * sc))), q2 = max(-127, min(127, __float2int_rn(a.z * sc))), q3 = max(-127, min(127, __float2int_rn(a.w * sc)));
    return (unsigned)(q0 & 0xff) | ((unsigned)(q1 & 0xff) << 8) | ((unsigned)(q2 & 0xff) << 16) | ((unsigned)q3 << 24); }
__device__ __forceinline__ void p0_transpose_item(const float* W, int K, int N, bf16* WT, LAS float* scr, int item, int lane) {
    const int nblk = N / 64, kb = item / nblk, nb = item % nblk, k0 = 64 * kb, n0 = 64 * nb;
#pragma unroll 16
    for (int kk = 0; kk < 64; ++kk) scr[kk * 65 + lane] = __builtin_nontemporal_load(W + (size_t)(k0 + kk) * N + n0 + lane);
    LDS_WAIT(); asm volatile("" ::: "memory");
    const int c = lane & 7;
#pragma unroll
    for (int j = 0; j < 8; ++j) { const int n = (lane >> 3) + 8 * j; const LAS float* s = scr + (8 * c) * 65 + n;
        v4u o; o.x = pk2(s[0 * 65], s[1 * 65]); o.y = pk2(s[2 * 65], s[3 * 65]); o.z = pk2(s[4 * 65], s[5 * 65]); o.w = pk2(s[6 * 65], s[7 * 65]);
        *(GAS v4u*)(WT + (size_t)(n0 + n) * K + k0 + 8 * c) = o; }
    LDS_WAIT(); asm volatile("" ::: "memory");
}
__device__ __forceinline__ void p0_transpose_item_i8(const float* W, int K, int N, unsigned char* WT, LAS float* scr, int item, int lane, float sc) {
    const int nblk = N / 64, kb = item / nblk, nb = item % nblk, k0 = 64 * kb, n0 = 64 * nb;
#pragma unroll 16
    for (int kk = 0; kk < 64; ++kk) scr[kk * 65 + lane] = __builtin_nontemporal_load(W + (size_t)(k0 + kk) * N + n0 + lane);
    LDS_WAIT(); asm volatile("" ::: "memory");
    const int c = lane & 7;
#pragma unroll
    for (int j = 0; j < 8; ++j) { const int n = (lane >> 3) + 8 * j; const LAS float* s = scr + (8 * c) * 65 + n;
        v2u o; o.x = pk4_i8((f32x4){s[0 * 65], s[1 * 65], s[2 * 65], s[3 * 65]}, sc); o.y = pk4_i8((f32x4){s[4 * 65], s[5 * 65], s[6 * 65], s[7 * 65]}, sc);
        *(GAS v2u*)(WT + (size_t)(n0 + n) * K + k0 + 8 * c) = o; }
    LDS_WAIT(); asm volatile("" ::: "memory");
}
__device__ __forceinline__ void p0_convert_item(const float* src, bf16* dst, size_t item, int lane) {
    const GAS f32x4* s = (const GAS f32x4*)(src + item * 2048) + lane * 2;
    GAS v4u* d = (GAS v4u*)(dst + item * 2048) + lane;
#pragma unroll
    for (int j = 0; j < 4; ++j) { const f32x4 a = s[j * 128], b = s[j * 128 + 1];
        v4u o; o.x = pk2(a.x, a.y); o.y = pk2(a.z, a.w); o.z = pk2(b.x, b.y); o.w = pk2(b.z, b.w); d[j * 64] = o; }
}
__device__ __forceinline__ unsigned pk4_fp8(f32x4 a, float sc) { int w = __builtin_amdgcn_cvt_pk_fp8_f32(a.x * sc, a.y * sc, 0, false); w = __builtin_amdgcn_cvt_pk_fp8_f32(a.z * sc, a.w * sc, w, true); return (unsigned)w; }
__device__ __forceinline__ void p0_convert_item_i8(const float* src, unsigned char* dst, size_t item, int lane, float sc) {
    const GAS f32x4* s = (const GAS f32x4*)(src + item * 4096) + lane * 4;
#pragma unroll
    for (int j = 0; j < 4; ++j) { v4u o; o.x = pk4_i8(__builtin_nontemporal_load(s + j * 256), sc); o.y = pk4_i8(__builtin_nontemporal_load(s + j * 256 + 1), sc); o.z = pk4_i8(__builtin_nontemporal_load(s + j * 256 + 2), sc); o.w = pk4_i8(__builtin_nontemporal_load(s + j * 256 + 3), sc);
        pg8::store16_wt(pg8::wt_rsrc(dst, (size_t)NEXP * D), (unsigned)((size_t)(lane >> 3) * NEXP * 128 + (item * 4 + j) * 128 + (lane & 7) * 16), o); }
}
__device__ __forceinline__ void p0_convert_item_fp8(const float* src, unsigned char* dst, size_t item, int lane, float sc) {
    const GAS f32x4* s = (const GAS f32x4*)(src + item * 4096) + lane * 4;
#pragma unroll
    for (int j = 0; j < 4; ++j) { v4u o; o.x = pk4_fp8(__builtin_nontemporal_load(s + j * 256), sc); o.y = pk4_fp8(__builtin_nontemporal_load(s + j * 256 + 1), sc); o.z = pk4_fp8(__builtin_nontemporal_load(s + j * 256 + 2), sc); o.w = pk4_fp8(__builtin_nontemporal_load(s + j * 256 + 3), sc);
        pg8::store16_wt(pg8::wt_rsrc(dst, (size_t)NEXP * D), (unsigned)((size_t)(lane >> 3) * NEXP * 128 + (item * 4 + j) * 128 + (lane & 7) * 16), o); }
}
__device__ __forceinline__ void p0_ada_task(Frame& F, int task, LAS float* scr) {
    const int kc = task / (ADA_W / 64), ng = task % (ADA_W / 64), lane = F.lane;
    const float* c = F.in[IN_C];
    for (int e = lane; e < BATCH * 128; e += 64) { const int b = e >> 7, kk = e & 127; const float cv = c[b * D + kc * 128 + kk]; scr[kk * 16 + b] = cv / (1.f + expf(-cv)); }
    LDS_WAIT(); asm volatile("" ::: "memory");
    float acc[BATCH];
#pragma unroll
    for (int b = 0; b < BATCH; ++b) acc[b] = 0.f;
    const float* wp = F.in[IN_WADA] + (size_t)(kc * 128) * ADA_W + ng * 64 + lane;
#pragma unroll 1
    for (int k0 = 0; k0 < 128; k0 += 16) { float wv[16];
#pragma unroll
        for (int u = 0; u < 16; ++u) wv[u] = __builtin_nontemporal_load(wp + (size_t)(k0 + u) * ADA_W);
#pragma unroll
        for (int u = 0; u < 16; ++u) { const LAS f32x4* sp = (const LAS f32x4*)(scr + (k0 + u) * 16);
#pragma unroll
            for (int q = 0; q < 4; ++q) { const f32x4 s = sp[q]; acc[4 * q] += s.x * wv[u]; acc[4 * q + 1] += s.y * wv[u]; acc[4 * q + 2] += s.z * wv[u]; acc[4 * q + 3] += s.w * wv[u]; } } }
    float* ap = (float*)(F.ws + WS_ADAP);
#pragma unroll
    for (int b = 0; b < BATCH; ++b) ap[(size_t)(kc * BATCH + b) * ADA_W + ng * 64 + lane] = acc[b];
    LDS_WAIT(); asm volatile("" ::: "memory");
}
__device__ __forceinline__ void p0_prologue(Frame& F) {
    LAS float* scr = (LAS float*)(F.lds + RING_OFF + F.wave * 16896);
    const int gw = F.vcu * NWAVES + F.wave, NGW = F.G * NWAVES;
    constexpr int I_ADA = ADA_KC * (ADA_W / 64);
    constexpr int I_T1 = (D / 64) * (IN_W / 64), I_T2 = (D / 64) * (D / 64), I_T3 = (D / 64) * (QW / 64);
    constexpr int I_K = PH * NKEYS * DHALF / 2048;
    constexpr int I_E = (int)((size_t)NEXP * D / 4096);
    constexpr int NITEMS = I_ADA + I_T1 + I_T2 + I_T3 + 2 * I_K + 2 * I_E;
    for (int it = gw; it < NITEMS; it += NGW) {
        int r = it;
        if (r < I_ADA) { p0_ada_task(F, r, scr); continue; } r -= I_ADA;
        if (r < I_T1) { p0_transpose_item_i8(F.in[IN_WIN], D, IN_W, F.ws + WS_WIN, scr, r, F.lane, WQ_SCALE); continue; } r -= I_T1;
        if (r < I_T2) { p0_transpose_item(F.in[IN_WOUT], D, D, (bf16*)(F.ws + WS_WOUT), scr, r, F.lane); continue; } r -= I_T2;
        if (r < I_T3) { p0_transpose_item_i8(F.in[IN_WQ], D, QW, F.ws + WS_WQ, scr, r, F.lane, WQ_SCALE); continue; } r -= I_T3;
        if (r < I_K) { p0_convert_item(F.in[IN_PK1], (bf16*)(F.ws + WS_K1), r, F.lane); continue; } r -= I_K;
        if (r < I_K) { p0_convert_item(F.in[IN_PK2], (bf16*)(F.ws + WS_K2), r, F.lane); continue; } r -= I_K;
        if (r < I_E) { p0_convert_item_i8(F.in[IN_PU], F.ws + WS_U, r, F.lane, U_SCALE); continue; } r -= I_E;
        p0_convert_item_fp8(F.in[IN_PV], F.ws + WS_V, r, F.lane, V_SCALE);
    }
}

__device__ __forceinline__ void mod_row(const float* xrow, bf16* orow, const LAS float* SC, const LAS float* SH, int lane) {
    const GAS f32x4* xr = (const GAS f32x4*)xrow + lane;
    f32x4 v[4]; float s = 0.f;
#pragma unroll
    for (int j = 0; j < 4; ++j) { v[j] = xr[64 * j]; s += (v[j].x * v[j].x + v[j].y * v[j].y) + (v[j].z * v[j].z + v[j].w * v[j].w); }
    const float rstd = 1.0f / sqrtf(wave_sum(s) * (1.f / D) + EPS);
    GAS unsigned long long* o8 = (GAS unsigned long long*)orow + lane;
#pragma unroll
    for (int j = 0; j < 4; ++j) { const f32x4 sc = ((const LAS f32x4*)SC)[lane + 64 * j], sh = ((const LAS f32x4*)SH)[lane + 64 * j];
        const f32x4 o = v[j] * rstd * sc + sh;
        o8[64 * j] = (unsigned long long)pk2(o.x, o.y) | ((unsigned long long)pk2(o.z, o.w) << 32); }
}
__device__ __forceinline__ void mod_row_bf(const bf16* xrow, bf16* orow, const LAS float* SC, const LAS float* SH, int lane) {
    const GAS v2u* xr = (const GAS v2u*)xrow + lane;
    f32x4 v[4]; float s = 0.f;
#pragma unroll
    for (int j = 0; j < 4; ++j) { const v2u w = xr[64 * j]; v[j] = (f32x4){bflo(w.x), bfhi(w.x), bflo(w.y), bfhi(w.y)}; s += (v[j].x * v[j].x + v[j].y * v[j].y) + (v[j].z * v[j].z + v[j].w * v[j].w); }
    const float rstd = 1.0f / sqrtf(wave_sum(s) * (1.f / D) + EPS);
    GAS unsigned long long* o8 = (GAS unsigned long long*)orow + lane;
#pragma unroll
    for (int j = 0; j < 4; ++j) { const f32x4 sc = ((const LAS f32x4*)SC)[lane + 64 * j], sh = ((const LAS f32x4*)SH)[lane + 64 * j];
        const f32x4 o = v[j] * rstd * sc + sh;
        o8[64 * j] = (unsigned long long)pk2(o.x, o.y) | ((unsigned long long)pk2(o.z, o.w) << 32); }
}
__device__ __forceinline__ void mod_load(const float* xrow, int lane, f32x4 (&v)[4]) { const GAS f32x4* xr = (const GAS f32x4*)xrow + lane;
#pragma unroll
    for (int j = 0; j < 4; ++j) v[j] = __builtin_nontemporal_load(xr + 64 * j); }
__device__ __forceinline__ void mod_load_bf(const bf16* xrow, int lane, f32x4 (&v)[4]) { const GAS v2u* xr = (const GAS v2u*)xrow + lane;
#pragma unroll
    for (int j = 0; j < 4; ++j) { const v2u w = xr[64 * j]; v[j] = (f32x4){bflo(w.x), bfhi(w.x), bflo(w.y), bfhi(w.y)}; } }
template <bool I8> __device__ __forceinline__ void mod_finish(const f32x4 (&v)[4], bf16* orow, unsigned char* o8row, float* hs_out, const LAS float* SC, const LAS float* SH, int lane) {
    float s = 0.f;
#pragma unroll
    for (int j = 0; j < 4; ++j) s += (v[j].x * v[j].x + v[j].y * v[j].y) + (v[j].z * v[j].z + v[j].w * v[j].w);
    const float rstd = 1.0f / sqrtf(wave_sum(s) * (1.f / D) + EPS);
    f32x4 o[4]; float am = 0.f;
#pragma unroll
    for (int j = 0; j < 4; ++j) { const f32x4 sc = ((const LAS f32x4*)SC)[lane + 64 * j], sh = ((const LAS f32x4*)SH)[lane + 64 * j]; o[j] = v[j] * rstd * sc + sh;
        am = fmaxf(am, fmaxf(fmaxf(fabsf(o[j].x), fabsf(o[j].y)), fmaxf(fabsf(o[j].z), fabsf(o[j].w)))); }
    if (!I8) { GAS unsigned long long* o8 = (GAS unsigned long long*)orow + lane;
#pragma unroll
        for (int j = 0; j < 4; ++j) o8[64 * j] = (unsigned long long)pk2(o[j].x, o[j].y) | ((unsigned long long)pk2(o[j].z, o[j].w) << 32);
    } else {
#pragma unroll
        for (int off = 1; off < 64; off <<= 1) am = fmaxf(am, __shfl_xor(am, off));
        const float qs = am > 0.f ? 127.f / am : 0.f;
#pragma unroll
        for (int j = 0; j < 4; ++j) ((GAS unsigned*)o8row)[lane + 64 * j] = pk4_i8(o[j], qs);
        if (lane == 0) *hs_out = am * (1.f / 127.f); }
}
__device__ __forceinline__ void p1_hpass(Frame& F) {
    LAS float* SC = (LAS float*)(F.lds); LAS float* SH = SC + D;
    const float* adap = (const float*)(F.ws + WS_ADAP); const float* bada = F.in[IN_BADA]; const float* g1 = F.in[IN_G1];
    float* ada = (float*)(F.ws + WS_ADA);
    for (int e = blockIdx.x * 512 + F.tid; e < BATCH * ADA_W; e += F.G * 512) { const int b = e / ADA_W, n = e % ADA_W; float s = bada[n];
#pragma unroll
        for (int kc = 0; kc < ADA_KC; ++kc) s += adap[(size_t)(kc * BATCH + b) * ADA_W + n];
        ada[e] = s; }
    for (int tile = blockIdx.x; tile < M / 128; tile += F.G) {
        const int b = tile / (SEQ / 128);
        for (int d = F.tid; d < D; d += 512) { float sh = bada[d], sc = bada[D + d];
#pragma unroll
            for (int kc = 0; kc < ADA_KC; ++kc) { const float* p = adap + (size_t)(kc * BATCH + b) * ADA_W; sh += p[d]; sc += p[D + d]; }
            SC[d] = g1[d] * (1.f + sc); SH[d] = sh; }
        __syncthreads();
        { f32x4 va[4], vb[4];
          mod_load(F.in[IN_X] + ((size_t)tile * 128 + F.wave) * D, F.lane, va);
#pragma unroll 1
          for (int r = F.wave; r < 128; r += 2 * NWAVES) { const size_t row = (size_t)tile * 128 + r;
              mod_load(F.in[IN_X] + (row + NWAVES) * D, F.lane, vb);
              mod_finish<true>(va, nullptr, F.ws + WS_H8 + row * D, (float*)(F.ws + WS_HS) + row, SC, SH, F.lane);
              if (r + 2 * NWAVES < 128) mod_load(F.in[IN_X] + (row + 2 * NWAVES) * D, F.lane, va);
              mod_finish<true>(vb, nullptr, F.ws + WS_H8 + (row + NWAVES) * D, (float*)(F.ws + WS_HS) + (row + NWAVES), SC, SH, F.lane); } }
        __syncthreads();
    }
}
__device__ __forceinline__ void p5_h2pass(Frame& F) {
    LAS float* SC = (LAS float*)(F.lds); LAS float* SH = SC + D;
    const float* ada = (const float*)(F.ws + WS_ADA); const float* g2 = F.in[IN_G2];
    for (int tile = blockIdx.x; tile < M / 128; tile += F.G) {
        const int b = tile / (SEQ / 128);
        for (int d = F.tid; d < D; d += 512) { SC[d] = g2[d] * (1.f + ada[(size_t)b * ADA_W + 4 * D + d]); SH[d] = ada[(size_t)b * ADA_W + 3 * D + d]; }
        __syncthreads();
        { f32x4 va[4], vb[4]; const bf16* X1 = (const bf16*)(F.ws + WS_X1);
          mod_load_bf(X1 + ((size_t)tile * 128 + F.wave) * D, F.lane, va);
#pragma unroll 1
          for (int r = F.wave; r < 128; r += 2 * NWAVES) { const size_t row = (size_t)tile * 128 + r;
              mod_load_bf(X1 + (row + NWAVES) * D, F.lane, vb);
              mod_finish<true>(va, (bf16*)(F.ws + WS_H) + row * D, F.ws + WS_H8 + row * D, (float*)(F.ws + WS_HS) + row, SC, SH, F.lane);
              if (r + 2 * NWAVES < 128) mod_load_bf(X1 + (row + 2 * NWAVES) * D, F.lane, va);
              mod_finish<true>(vb, (bf16*)(F.ws + WS_H) + (row + NWAVES) * D, F.ws + WS_H8 + (row + NWAVES) * D, (float*)(F.ws + WS_HS) + (row + NWAVES), SC, SH, F.lane); } }
        __syncthreads();
    }
}

typedef float f32x16 __attribute__((ext_vector_type(16)));
typedef short s16x4 __attribute__((ext_vector_type(4)));
typedef __bf16 bf16x8_t __attribute__((ext_vector_type(8)));
#define MFMA32(a, b, c) __builtin_amdgcn_mfma_f32_32x32x16_bf16((a), (b), (c), 0, 0, 0)
constexpr int KS = 144, VS = 192;
__device__ __forceinline__ void p3_attn_unit(Frame& F, int unit) {
    const int kh = unit & 1, nb = (unit >> 1) & 15, b = unit >> 5;
    LAS unsigned char* KL = F.lds; LAS unsigned char* VL = F.lds + 256 * KS;
    const bf16* proj = (const bf16*)(F.ws + WS_PROJ);
    const int tok0 = b * SEQ + nb * 128;
    for (int c = F.tid; c < 2048; c += 512) { const int j = c >> 3, ch = c & 7;
        v4u kv = (v4u){0u, 0u, 0u, 0u}, vv = (v4u){0u, 0u, 0u, 0u};
        if (nb > 0 || j >= 128) { const bf16* rowp = proj + (size_t)(tok0 - 128 + j) * IN_W; kv = *(const GAS v4u*)(rowp + O_K + kh * HD + ch * 8); vv = *(const GAS v4u*)(rowp + O_V + kh * HD + ch * 8); }
        *(LAS v4u*)(KL + j * KS + ch * 16) = kv; *(LAS v4u*)(VL + j * VS + ch * 16) = vv; }
    __syncthreads();
    const int lane = F.lane, r = lane & 31, hh = lane >> 5;
#pragma unroll 1
    for (int task = F.wave; task < 16; task += NWAVES) {
        const int g = task >> 2, w = task & 3, qh = kh * 4 + g, i0 = 32 * w;
        const bf16* qp = proj + (size_t)(tok0 + i0 + r) * IN_W + O_Q + qh * HD + 8 * hh;
        bf16x8 qf[4];
#pragma unroll
        for (int s = 0; s < 4; ++s) qf[s] = *(const GAS bf16x8*)(qp + 16 * s);
        f32x16 sc[5];
#pragma unroll
        for (int t = 0; t < 5; ++t) {
#pragma unroll
            for (int e = 0; e < 16; ++e) sc[t][e] = 0.f;
#pragma unroll
            for (int s = 0; s < 4; ++s) { const bf16x8 a = *(const LAS bf16x8*)(KL + ((w + t) * 32 + r) * KS + 32 * s + 16 * hh); sc[t] = MFMA32(a, qf[s], sc[t]); } }
        const float sink = F.in[IN_SINK][qh];
        float mx = sink;
#pragma unroll
        for (int t = 0; t < 5; ++t)
#pragma unroll
            for (int e = 0; e < 16; ++e) { const int kr = (e & 3) + 8 * (e >> 2) + 4 * hh;
                bool valid = (nb > 0) || (w + t >= 4);
                if (t == 0) valid = valid && (kr > r);
                if (t == 4) valid = valid && (kr <= r);
                const float v = valid ? sc[t][e] * 0.125f : -1e30f; sc[t][e] = v; mx = fmaxf(mx, v); }
        mx = fmaxf(mx, __shfl_xor(mx, 32));
        float lsum = 0.f;
#pragma unroll
        for (int t = 0; t < 5; ++t)
#pragma unroll
            for (int e = 0; e < 16; ++e) { const float p = __expf(sc[t][e] - mx); sc[t][e] = p; lsum += p; }
        lsum += __shfl_xor(lsum, 32); lsum += __expf(sink - mx);
        f32x16 o[2];
#pragma unroll
        for (int dt = 0; dt < 2; ++dt)
#pragma unroll
            for (int e = 0; e < 16; ++e) o[dt][e] = 0.f;
        const int q4 = (r & 15) >> 2, p4 = r & 3;
#pragma unroll
        for (int t = 0; t < 5; ++t)
#pragma unroll
            for (int sp = 0; sp < 2; ++sp) {
                bf16x8_t pbv;
#pragma unroll
                for (int e = 0; e < 8; ++e) pbv[e] = (__bf16)sc[t][8 * sp + e];
                const bf16x8 pb = __builtin_bit_cast(bf16x8, pbv);
#pragma unroll
                for (int dt = 0; dt < 2; ++dt) {
                    const int kb = (w + t) * 32 + 16 * sp + 4 * hh;
                    const LAS unsigned char* ap = VL + (kb + q4) * VS + (32 * dt + 16 * (r >> 4) + 4 * p4) * 2;
                    const s16x4 lo = __builtin_amdgcn_ds_read_tr16_b64_v4i16((LAS s16x4*)ap);
                    const s16x4 hi = __builtin_amdgcn_ds_read_tr16_b64_v4i16((LAS s16x4*)(ap + 8 * VS));
                    const bf16x8 a = __builtin_shufflevector(lo, hi, 0, 1, 2, 3, 4, 5, 6, 7);
                    o[dt] = MFMA32(a, pb, o[dt]); } }
        const float inv = 1.f / lsum; float ss = 0.f;
#pragma unroll
        for (int dt = 0; dt < 2; ++dt)
#pragma unroll
            for (int e = 0; e < 16; ++e) { o[dt][e] *= inv; ss += o[dt][e] * o[dt][e]; }
        ss += __shfl_xor(ss, 32);
        const float rs = 1.0f / sqrtf(ss * (1.f / HD) + EPS);
        const float* gp = F.in[IN_AOG] + qh * HD;
        bf16* op = (bf16*)(F.ws + WS_MIX) + (size_t)(tok0 + i0 + r) * D + qh * HD;
#pragma unroll
        for (int dt = 0; dt < 2; ++dt)
#pragma unroll
            for (int g4 = 0; g4 < 4; ++g4) { const int d0 = 32 * dt + 8 * g4 + 4 * hh; const f32x4 gv = *(const f32x4*)(gp + d0);
                v2u wv; wv.x = pk2(o[dt][4 * g4 + 0] * rs * gv.x, o[dt][4 * g4 + 1] * rs * gv.y); wv.y = pk2(o[dt][4 * g4 + 2] * rs * gv.z, o[dt][4 * g4 + 3] * rs * gv.w);
                *(GAS v2u*)(op + d0) = wv; }
    }
    __syncthreads();
}
__device__ __forceinline__ void p3_conv(Frame& F) {
    const bf16* proj = (const bf16*)(F.ws + WS_PROJ); const int lane = F.lane, c0 = 8 * lane;
    const float* cw = F.in[IN_CONVW]; const float* cg = F.in[IN_COG];
    float w0[8], w1[8], w2[8], gg[8];
#pragma unroll
    for (int e = 0; e < 8; ++e) { w0[e] = cw[c0 + e]; w1[e] = cw[512 + c0 + e]; w2[e] = cw[1024 + c0 + e]; gg[e] = cg[c0 + e]; }
    const int gw = F.vcu * NWAVES + F.wave, NGW = F.G * NWAVES;
    for (int tok = gw; tok < M; tok += NGW) {
        const int s = tok & (SEQ - 1); const bf16* rp = proj + (size_t)tok * IN_W;
        const v4u z4 = (v4u){0u, 0u, 0u, 0u};
        const v4u Bv = *(const GAS v4u*)(rp + O_B + c0), C0 = *(const GAS v4u*)(rp + O_C + c0), U0 = *(const GAS v4u*)(rp + O_U + c0);
        v4u C1 = z4, U1 = z4, C2 = z4, U2 = z4;
        if (s >= 1) { C1 = *(const GAS v4u*)(rp - IN_W + O_C + c0); U1 = *(const GAS v4u*)(rp - IN_W + O_U + c0); }
        if (s >= 2) { C2 = *(const GAS v4u*)(rp - 2 * IN_W + O_C + c0); U2 = *(const GAS v4u*)(rp - 2 * IN_W + O_U + c0); }
        float y[8]; float ss = 0.f;
#pragma unroll
        for (int e = 0; e < 8; ++e) { const int wi = e >> 1; const bool hi = e & 1;
            const unsigned bw = Bv[wi], c0w = C0[wi], u0w = U0[wi], c1w = C1[wi], u1w = U1[wi], c2w = C2[wi], u2w = U2[wi];
            const float bb = hi ? bfhi(bw) : bflo(bw);
            const float z0 = (hi ? bfhi(c0w) : bflo(c0w)) * (hi ? bfhi(u0w) : bflo(u0w));
            const float z1 = (hi ? bfhi(c1w) : bflo(c1w)) * (hi ? bfhi(u1w) : bflo(u1w));
            const float z2 = (hi ? bfhi(c2w) : bflo(c2w)) * (hi ? bfhi(u2w) : bflo(u2w));
            y[e] = bb * (z2 * w0[e] + z1 * w1[e] + z0 * w2[e]); ss += y[e] * y[e]; }
        ss += __shfl_xor(ss, 1); ss += __shfl_xor(ss, 2); ss += __shfl_xor(ss, 4);
        const float rs = 1.0f / sqrtf(ss * (1.f / 64.f) + EPS);
        v4u w; w.x = pk2(y[0] * rs * gg[0], y[1] * rs * gg[1]); w.y = pk2(y[2] * rs * gg[2], y[3] * rs * gg[3]);
        w.z = pk2(y[4] * rs * gg[4], y[5] * rs * gg[5]); w.w = pk2(y[6] * rs * gg[6], y[7] * rs * gg[7]);
        pg8::store16_wt(pg8::wt_rsrc(F.ws + WS_MIX, (size_t)M * D * 2), (unsigned)(((size_t)tok * D + 512 + c0) * 2), w);
    }
}
__device__ __forceinline__ void p3_mixer(Frame& F) {
    for (int unit = blockIdx.x; unit < BATCH * 16 * NKVH; unit += F.G) p3_attn_unit(F, unit);
    p3_conv(F);
}

#define DI __device__ __forceinline__
#define CE_(i, j) { const unsigned x_ = a[i], y_ = a[j]; a[i] = x_ > y_ ? x_ : y_; a[j] = x_ > y_ ? y_ : x_; }
DI void sort16_desc(unsigned (&a)[16]) {
    CE_(0,13) CE_(1,12) CE_(2,15) CE_(3,14) CE_(4,8) CE_(5,6) CE_(7,11) CE_(9,10)
    CE_(0,5) CE_(1,7) CE_(2,9) CE_(3,4) CE_(6,13) CE_(8,14) CE_(10,15) CE_(11,12)
    CE_(0,1) CE_(2,3) CE_(4,5) CE_(6,8) CE_(7,9) CE_(10,11) CE_(12,13) CE_(14,15)
    CE_(0,2) CE_(1,3) CE_(4,10) CE_(5,11) CE_(6,7) CE_(8,9) CE_(12,14) CE_(13,15)
    CE_(1,2) CE_(3,12) CE_(4,6) CE_(5,7) CE_(8,10) CE_(9,11) CE_(13,14)
    CE_(1,4) CE_(2,6) CE_(5,8) CE_(7,10) CE_(9,13) CE_(11,14)
    CE_(2,4) CE_(3,6) CE_(9,12) CE_(11,13)
    CE_(3,5) CE_(6,8) CE_(7,9) CE_(10,12)
    CE_(3,4) CE_(5,6) CE_(7,8) CE_(9,10) CE_(11,12)
    CE_(6,7) CE_(8,9)
}
DI void bitonic_merge16_desc(unsigned (&a)[16]) {
#pragma unroll
    for (int js = 3; js >= 0; --js) {
#pragma unroll
        for (int i = 0; i < 16; ++i) { const int j = 1 << js, l = i ^ j;
            if (l > i) { const unsigned x = a[i], y = a[l]; a[i] = x > y ? x : y; a[l] = x > y ? y : x; } }
    }
}
DI void merge_top16(unsigned (&a)[16], const unsigned (&b)[16]) {
#pragma unroll
    for (int i = 0; i < 16; ++i) { const unsigned x = a[i], y = b[15 - i]; a[i] = x > y ? x : y; }
    bitonic_merge16_desc(a);
}
DI void top16_of_64(unsigned (&g0)[16], unsigned (&g1)[16], unsigned (&g2)[16], unsigned (&g3)[16]) {
    sort16_desc(g0); sort16_desc(g1); sort16_desc(g2); sort16_desc(g3);
    merge_top16(g0, g1); merge_top16(g2, g3); merge_top16(g0, g2);
}
#define SBIAS 8.0f
DI unsigned skey(float biased) { return __float_as_uint(fmaxf(biased, 0.f)); }
constexpr int KEY_STRIDE = 272;
DI void route_scores_top16(const LAS unsigned char* KL, const bf16* qrow, int r, int hh, unsigned (&out)[16]) {
    bf16x8 qf[8];
#pragma unroll
    for (int s = 0; s < 8; ++s) qf[s] = *(const GAS bf16x8*)(qrow + 16 * s);
    f32x16 acc[4];
#pragma unroll
    for (int t = 0; t < 4; ++t)
#pragma unroll
        for (int e = 0; e < 16; ++e) acc[t][e] = SBIAS;
#pragma unroll
    for (int t = 0; t < 4; ++t)
#pragma unroll
        for (int s = 0; s < 8; ++s) { const bf16x8 a = *(const LAS bf16x8*)(KL + (t * 32 + r) * KEY_STRIDE + 32 * s + 16 * hh); acc[t] = MFMA32(a, qf[s], acc[t]); }
    unsigned g0[16], g1[16], g2[16], g3[16];
    const unsigned pb = (unsigned)(127 - 4 * hh);
#pragma unroll
    for (int e = 0; e < 16; ++e) { const unsigned p = pb - (unsigned)((e & 3) + 8 * (e >> 2));
        g0[e] = (skey(acc[0][e]) & ~127u) | p; g1[e] = (skey(acc[1][e]) & ~127u) | (p - 32u); g2[e] = (skey(acc[2][e]) & ~127u) | (p - 64u); g3[e] = (skey(acc[3][e]) & ~127u) | (p - 96u); }
    top16_of_64(g0, g1, g2, g3);
    unsigned oth[16];
#pragma unroll
    for (int i = 0; i < 16; ++i) oth[i] = (unsigned)__shfl_xor((int)g0[i], 32);
    merge_top16(g0, oth);
#pragma unroll
    for (int i = 0; i < 16; ++i) out[i] = g0[i];
}
DI void p7_route_tile(Frame& F, int tok0, int h, const LAS unsigned char* KL1, const LAS unsigned char* KL2, LAS unsigned char* scr) {
    const int lane = F.lane, r = lane & 31, hh = lane >> 5;
    const bf16* qrow = (const bf16*)(F.ws + WS_PROJ) + (size_t)(tok0 + r) * QW + h * DKEY + 8 * hh;
    unsigned t1[16], t2[16];
    route_scores_top16(KL1, qrow, r, hh, t1);
    route_scores_top16(KL2, qrow + DHALF, r, hh, t2);
    { v4u w;
#pragma unroll
      for (int q = 0; q < 4; ++q) { unsigned x = 0u;
#pragma unroll
          for (int bq = 0; bq < 4; ++bq) { const unsigned k = hh ? t2[4 * q + bq] : t1[4 * q + bq]; x |= (127u - (k & 127u)) << (8 * bq); }
          w[q] = x; }
      *(LAS v4u*)(scr + r * 32 + hh * 16) = w; }
    float v1[16], v2[16];
#pragma unroll
    for (int i = 0; i < 16; ++i) { v1[i] = __uint_as_float(t1[i] & ~127u); v2[i] = __uint_as_float(t2[i] & ~127u) - SBIAS; }
    unsigned c0[16], c1[16];
    { const float sa = v1[0] + v2[0], sb = v1[2] + v2[1]; c0[0] = (__float_as_uint(fmaxf(hh ? sb : sa, 0.f)) & ~255u) | (hh ? 222u : 255u); }
    { const float sa = v1[0] + v2[1], sb = v1[2] + v2[2]; c0[1] = (__float_as_uint(fmaxf(hh ? sb : sa, 0.f)) & ~255u) | (hh ? 221u : 254u); }
    { const float sa = v1[0] + v2[2], sb = v1[2] + v2[3]; c0[2] = (__float_as_uint(fmaxf(hh ? sb : sa, 0.f)) & ~255u) | (hh ? 220u : 253u); }
    { const float sa = v1[0] + v2[3], sb = v1[2] + v2[4]; c0[3] = (__float_as_uint(fmaxf(hh ? sb : sa, 0.f)) & ~255u) | (hh ? 219u : 252u); }
    { const float sa = v1[0] + v2[4], sb = v1[3] + v2[0]; c0[4] = (__float_as_uint(fmaxf(hh ? sb : sa, 0.f)) & ~255u) | (hh ? 207u : 251u); }
    { const float sa = v1[0] + v2[5], sb = v1[3] + v2[1]; c0[5] = (__float_as_uint(fmaxf(hh ? sb : sa, 0.f)) & ~255u) | (hh ? 206u : 250u); }
    { const float sa = v1[0] + v2[6], sb = v1[3] + v2[2]; c0[6] = (__float_as_uint(fmaxf(hh ? sb : sa, 0.f)) & ~255u) | (hh ? 205u : 249u); }
    { const float sa = v1[0] + v2[7], sb = v1[3] + v2[3]; c0[7] = (__float_as_uint(fmaxf(hh ? sb : sa, 0.f)) & ~255u) | (hh ? 204u : 248u); }
    { const float sa = v1[0] + v2[8], sb = v1[4] + v2[0]; c0[8] = (__float_as_uint(fmaxf(hh ? sb : sa, 0.f)) & ~255u) | (hh ? 191u : 247u); }
    { const float sa = v1[0] + v2[9], sb = v1[4] + v2[1]; c0[9] = (__float_as_uint(fmaxf(hh ? sb : sa, 0.f)) & ~255u) | (hh ? 190u : 246u); }
    { const float sa = v1[0] + v2[10], sb = v1[4] + v2[2]; c0[10] = (__float_as_uint(fmaxf(hh ? sb : sa, 0.f)) & ~255u) | (hh ? 189u : 245u); }
    { const float sa = v1[0] + v2[11], sb = v1[5] + v2[0]; c0[11] = (__float_as_uint(fmaxf(hh ? sb : sa, 0.f)) & ~255u) | (hh ? 175u : 244u); }
    { const float sa = v1[0] + v2[12], sb = v1[5] + v2[1]; c0[12] = (__float_as_uint(fmaxf(hh ? sb : sa, 0.f)) & ~255u) | (hh ? 174u : 243u); }
    { const float sa = v1[0] + v2[13], sb = v1[6] + v2[0]; c0[13] = (__float_as_uint(fmaxf(hh ? sb : sa, 0.f)) & ~255u) | (hh ? 159u : 242u); }
    { const float sa = v1[0] + v2[14], sb = v1[6] + v2[1]; c0[14] = (__float_as_uint(fmaxf(hh ? sb : sa, 0.f)) & ~255u) | (hh ? 158u : 241u); }
    { const float sa = v1[0] + v2[15], sb = v1[7] + v2[0]; c0[15] = (__float_as_uint(fmaxf(hh ? sb : sa, 0.f)) & ~255u) | (hh ? 143u : 240u); }
    { const float sa = v1[1] + v2[0], sb = v1[7] + v2[1]; c1[0] = (__float_as_uint(fmaxf(hh ? sb : sa, 0.f)) & ~255u) | (hh ? 142u : 239u); }
    { const float sa = v1[1] + v2[1], sb = v1[8] + v2[0]; c1[1] = (__float_as_uint(fmaxf(hh ? sb : sa, 0.f)) & ~255u) | (hh ? 127u : 238u); }
    { const float sa = v1[1] + v2[2], sb = v1[9] + v2[0]; c1[2] = (__float_as_uint(fmaxf(hh ? sb : sa, 0.f)) & ~255u) | (hh ? 111u : 237u); }
    { const float sa = v1[1] + v2[3], sb = v1[10] + v2[0]; c1[3] = (__float_as_uint(fmaxf(hh ? sb : sa, 0.f)) & ~255u) | (hh ? 95u : 236u); }
    { const float sa = v1[1] + v2[4], sb = v1[11] + v2[0]; c1[4] = (__float_as_uint(fmaxf(hh ? sb : sa, 0.f)) & ~255u) | (hh ? 79u : 235u); }
    { const float sa = v1[1] + v2[5], sb = v1[12] + v2[0]; c1[5] = (__float_as_uint(fmaxf(hh ? sb : sa, 0.f)) & ~255u) | (hh ? 63u : 234u); }
    { const float sa = v1[1] + v2[6], sb = v1[13] + v2[0]; c1[6] = (__float_as_uint(fmaxf(hh ? sb : sa, 0.f)) & ~255u) | (hh ? 47u : 233u); }
    { const float sa = v1[1] + v2[7], sb = v1[14] + v2[0]; c1[7] = (__float_as_uint(fmaxf(hh ? sb : sa, 0.f)) & ~255u) | (hh ? 31u : 232u); }
    { const float sa = v1[2] + v2[0], sb = v1[15] + v2[0]; c1[8] = (__float_as_uint(fmaxf(hh ? sb : sa, 0.f)) & ~255u) | (hh ? 15u : 223u); }
    c1[9] = 0u;
    c1[10] = 0u;
    c1[11] = 0u;
    c1[12] = 0u;
    c1[13] = 0u;
    c1[14] = 0u;
    c1[15] = 0u;
    sort16_desc(c0); sort16_desc(c1); merge_top16(c0, c1);
    { unsigned oth[16];
#pragma unroll
      for (int i = 0; i < 16; ++i) oth[i] = (unsigned)__shfl_xor((int)c0[i], 32);
      merge_top16(c0, oth); }
    const float mx = __uint_as_float(c0[0] & ~255u);
    LDS_WAIT(); asm volatile("" ::: "memory");
    float ex[8]; int ee[8]; float part = 0.f;
#pragma unroll
    for (int k = 0; k < 8; ++k) { const unsigned key = hh ? c0[8 + k] : c0[k]; const int ci = 255 - (int)(key & 255u);
        const int e1 = *(const LAS unsigned char*)(scr + r * 32 + (ci >> 4)), e2 = *(const LAS unsigned char*)(scr + r * 32 + 16 + (ci & 15));
        ee[k] = (e1 * NKEYS + e2) & (NEXP - 1); ex[k] = __expf(__uint_as_float(key & ~255u) - mx); part += ex[k]; }
    const float inv = 1.f / (part + __shfl_xor(part, 32));
    { const unsigned oo = (unsigned)(((size_t)(tok0 + r) * 128 + h * TOPK + 8 * hh) * 4);
      const __amdgpu_buffer_rsrc_t ir = pg8::wt_rsrc(F.ws + WS_IDX, (size_t)M * 128 * 4), gr = pg8::wt_rsrc(F.ws + WS_GATE, (size_t)M * 128 * 4);
      pg8::store16_wt(ir, oo, (v4u){(unsigned)ee[0], (unsigned)ee[1], (unsigned)ee[2], (unsigned)ee[3]}); pg8::store16_wt(ir, oo + 16, (v4u){(unsigned)ee[4], (unsigned)ee[5], (unsigned)ee[6], (unsigned)ee[7]});
      pg8::store16_wt(gr, oo, (v4u){__float_as_uint(ex[0] * inv), __float_as_uint(ex[1] * inv), __float_as_uint(ex[2] * inv), __float_as_uint(ex[3] * inv)});
      pg8::store16_wt(gr, oo + 16, (v4u){__float_as_uint(ex[4] * inv), __float_as_uint(ex[5] * inv), __float_as_uint(ex[6] * inv), __float_as_uint(ex[7] * inv)}); }
    asm volatile("" ::: "memory");
}
__device__ __forceinline__ void p7_routing(Frame& F) {
    LAS unsigned char* KL1 = F.lds; LAS unsigned char* KL2 = F.lds + 128 * KEY_STRIDE; LAS unsigned char* scr = F.lds + 2 * 128 * KEY_STRIDE + F.wave * 1024;
    const bf16* k1 = (const bf16*)(F.ws + WS_K1); const bf16* k2 = (const bf16*)(F.ws + WS_K2);
    int cur_h = -1;
    for (int item = blockIdx.x; item < (M / 256) * PH; item += F.G) {
        const int h = item & (PH - 1), tile = item >> 3;
        if (h != cur_h) {
            __syncthreads();
            for (int c = F.tid; c < 2 * 128 * 16; c += 512) { const int which = c >> 11, rr = (c >> 4) & 127, ch = c & 15;
                const v4u v = *(const GAS v4u*)((which ? k2 : k1) + (size_t)(h * NKEYS + rr) * DHALF + ch * 8);
                *(LAS v4u*)((which ? KL2 : KL1) + rr * KEY_STRIDE + ch * 16) = v; }
            __syncthreads();
            cur_h = h;
        }
        p7_route_tile(F, tile * 256 + F.wave * 32, h, KL1, KL2, scr);
    }
}

__device__ __forceinline__ float gelu_erf(float v) { return 0.5f * v * (1.f + erff(v * 0.70710678118654752f)); }
typedef float f32x2v __attribute__((ext_vector_type(2)));
__device__ __forceinline__ unsigned fp8x2_bf16x2(unsigned w, bool hi) { return hi ? __builtin_bit_cast(unsigned, __builtin_amdgcn_cvt_scalef32_pk_bf16_fp8((int)w, 1.0f, true)) : __builtin_bit_cast(unsigned, __builtin_amdgcn_cvt_scalef32_pk_bf16_fp8((int)w, 1.0f, false)); }
__device__ __forceinline__ float dot16_fp8(v4u u, v4u ha, v4u hb, float acc) {
    acc = dot2(fp8x2_bf16x2(u.x, false), ha.x, acc); acc = dot2(fp8x2_bf16x2(u.x, true), ha.y, acc);
    acc = dot2(fp8x2_bf16x2(u.y, false), ha.z, acc); acc = dot2(fp8x2_bf16x2(u.y, true), ha.w, acc);
    acc = dot2(fp8x2_bf16x2(u.z, false), hb.x, acc); acc = dot2(fp8x2_bf16x2(u.z, true), hb.y, acc);
    acc = dot2(fp8x2_bf16x2(u.w, false), hb.z, acc); acc = dot2(fp8x2_bf16x2(u.w, true), hb.w, acc);
    return acc;
}
struct SliceWork { int j0, nj, t0, ts; };
__device__ __forceinline__ SliceWork slice_work(const Frame& F) { SliceWork w;
    if ((F.G & 7) == 0) { w.j0 = blockIdx.x & 7; w.nj = 1; w.t0 = (blockIdx.x >> 3) * NWAVES + F.wave; w.ts = F.G; }
    else { w.j0 = 0; w.nj = 8; w.t0 = blockIdx.x * NWAVES + F.wave; w.ts = F.G * NWAVES; }
    return w; }
struct USet { v4u hq; float hs; v4u u[16]; };
struct UMeta { v2u id; v4u hh; float hs; };
__device__ __forceinline__ UMeta p8a_G(const int* IDX, const unsigned char* H8, const float* HS, int t, int j, int lane) { UMeta m;
    m.id = *(const GAS v2u*)(IDX + (size_t)t * 128 + 2 * lane); m.hh = *(const GAS v4u*)(H8 + (size_t)t * D + 128 * j + 16 * (lane & 7)); m.hs = HS[t]; return m; }
__device__ __forceinline__ void p8a_S(LAS unsigned char* mb, const UMeta& m, int lane) { *(LAS v2u*)(mb + 8 * lane) = m.id; if (lane < 8) *(LAS v4u*)(mb + 512 + 16 * lane) = m.hh; }
__device__ __forceinline__ void p8a_RT(const LAS unsigned char* mb, const unsigned char* Ub, int c, int g, float hs, USet& s) {
    v4u ix[4];
#pragma unroll
    for (int q = 0; q < 4; ++q) ix[q] = *(const LAS v4u*)(mb + 64 * g + 16 * q);
    s.hq = *(const LAS v4u*)(mb + 512 + 16 * c); s.hs = hs;
#pragma unroll
    for (int i = 0; i < 16; ++i) s.u[i] = *(const GAS v4u*)(Ub + (unsigned)((ix[i >> 2][i & 3] << 7) + 16u * (unsigned)c)); }
__device__ __forceinline__ void p8a_compute(const USet& s, bf16* pa_row, int lane, int c) {
    int p[16];
#pragma unroll
    for (int i = 0; i < 16; ++i) { int a = __builtin_amdgcn_sdot4((int)s.u[i].x, (int)s.hq.x, 0, false); a = __builtin_amdgcn_sdot4((int)s.u[i].y, (int)s.hq.y, a, false);
        a = __builtin_amdgcn_sdot4((int)s.u[i].z, (int)s.hq.z, a, false); p[i] = __builtin_amdgcn_sdot4((int)s.u[i].w, (int)s.hq.w, a, false); }
#pragma unroll
    for (int i = 0; i < 8; ++i) { const bool up = c & 4; const int send = up ? p[i] : p[i + 8], keep = up ? p[i + 8] : p[i]; p[i] = keep + __builtin_amdgcn_update_dpp(0, send, 0x141, 0xf, 0xf, true); }
#pragma unroll
    for (int i = 0; i < 4; ++i) { const bool up = c & 2; const int send = up ? p[i] : p[i + 4], keep = up ? p[i + 4] : p[i]; p[i] = keep + __builtin_amdgcn_update_dpp(0, send, 0x4E, 0xf, 0xf, true); }
#pragma unroll
    for (int i = 0; i < 2; ++i) { const bool up = c & 1; const int send = up ? p[i] : p[i + 2], keep = up ? p[i + 2] : p[i]; p[i] = keep + __builtin_amdgcn_update_dpp(0, send, 0xB1, 0xf, 0xf, true); }
    const float sc = s.hs * (1.f / U_SCALE);
    ((GAS unsigned*)pa_row)[lane] = pk2((float)p[0] * sc, (float)p[1] * sc);
}
__device__ __forceinline__ void p8a_udots(Frame& F) {
    const unsigned char* H8 = F.ws + WS_H8; const float* HS = (const float*)(F.ws + WS_HS); const int* IDX = (const int*)(F.ws + WS_IDX); bf16* PA = (bf16*)(F.ws + WS_PA);
    const int lane = F.lane, c = lane & 7, g = lane >> 3; const SliceWork sw = slice_work(F);
    LAS unsigned char* mb = F.lds + F.wave * 1024;
    if (sw.t0 >= M) return;
    const int nt = (M - 1 - sw.t0) / sw.ts + 1;
#define TOK(n) (sw.t0 + ((n) < nt ? (n) : nt - 1) * sw.ts)
    for (int jj = 0; jj < sw.nj; ++jj) { const int j = sw.j0 + jj; const unsigned char* Uj = F.ws + WS_U + (size_t)j * NEXP * 128;
        USet sA, sB, sC;
        UMeta mN = p8a_G(IDX, H8, HS, TOK(0), j, lane); p8a_S(mb, mN, lane); p8a_RT(mb, Uj, c, g, mN.hs, sA);
        mN = p8a_G(IDX, H8, HS, TOK(1), j, lane); p8a_S(mb, mN, lane); p8a_RT(mb, Uj, c, g, mN.hs, sB);
        mN = p8a_G(IDX, H8, HS, TOK(2), j, lane);
#define P8A_STAGE(k, SN, SC_) do { p8a_S(mb, mN, lane); p8a_RT(mb, Uj, c, g, mN.hs, SN); mN = p8a_G(IDX, H8, HS, TOK((k) + 3), j, lane); asm volatile("" ::: "memory"); \
            if ((k) < nt) p8a_compute(SC_, PA + ((size_t)j * M + TOK(k)) * 128, lane, c); asm volatile("" ::: "memory"); } while (0)
#pragma unroll 1
        for (int n = 0; n < nt; n += 3) {
            P8A_STAGE(n, sC, sA);
            P8A_STAGE(n + 1, sA, sB);
            P8A_STAGE(n + 2, sB, sC);
        }
#undef P8A_STAGE
    }
}
typedef _Float16 h2_t __attribute__((ext_vector_type(2)));
__device__ __forceinline__ h2_t cvt_h2_lo(int w) { return __builtin_bit_cast(h2_t, __builtin_amdgcn_cvt_scalef32_pk_f16_fp8(w, 1.0f, false)); }
__device__ __forceinline__ h2_t cvt_h2_hi(int w) { return __builtin_bit_cast(h2_t, __builtin_amdgcn_cvt_scalef32_pk_f16_fp8(w, 1.0f, true)); }
__device__ __forceinline__ void p8w_weights(Frame& F) {
    const bf16* PA = (const bf16*)(F.ws + WS_PA); float* GATE = (float*)(F.ws + WS_GATE);
    for (size_t e = (size_t)blockIdx.x * 512 + F.tid; e < (size_t)M * 128 / 4; e += (size_t)F.G * 512) {
        f32x4 s = (f32x4){0.f, 0.f, 0.f, 0.f};
#pragma unroll
        for (int j = 0; j < 8; ++j) { const v2u w = __builtin_nontemporal_load((const GAS v2u*)(PA + (size_t)j * M * 128 + 4 * e)); s += (f32x4){bflo(w.x), bfhi(w.x), bflo(w.y), bfhi(w.y)}; }
        const f32x4 gt = *(const GAS f32x4*)(GATE + 4 * e); f32x4 o;
#pragma unroll
        for (int q = 0; q < 4; ++q) o[q] = gt[q] * gelu_erf(s[q]);
        const h2_t w01 = (h2_t){(_Float16)o[0], (_Float16)o[1]}, w23 = (h2_t){(_Float16)o[2], (_Float16)o[3]};
        *(GAS v2u*)((_Float16*)(F.ws + WS_W16) + 4 * e) = (v2u){__builtin_bit_cast(unsigned, w01), __builtin_bit_cast(unsigned, w23)}; }
}
struct VSet { v4u v[16]; };
struct VMeta { v2u id; unsigned w; };
__device__ __forceinline__ VMeta p8b_G(const int* IDX, const _Float16* W, int t, int lane) { VMeta m;
    m.id = *(const GAS v2u*)(IDX + (size_t)t * 128 + 2 * lane); m.w = *(const GAS unsigned*)(W + (size_t)t * 128 + 2 * lane); return m; }
__device__ __forceinline__ void p8b_S(LAS unsigned char* mb, const VMeta& m, int lane) { *(LAS v2u*)(mb + 8 * lane) = m.id; *(LAS unsigned*)(mb + 512 + 4 * lane) = m.w; }
__device__ __forceinline__ void p8b_RT(Frame& F, const LAS unsigned char* mb, const unsigned char* Vj, int t, int j, int c, int g, VSet& s) {
    v4u ix[4];
#pragma unroll
    for (int q = 0; q < 4; ++q) ix[q] = *(const LAS v4u*)(mb + 64 * g + 16 * q);
#pragma unroll
    for (int i = 0; i < 16; ++i) s.v[i] = *(const GAS v4u*)(Vj + (unsigned)((ix[i >> 2][i & 3] << 7) + 16u * (unsigned)c)); }
__device__ __forceinline__ void p8b_step(Frame& F, const LAS unsigned char* mb, const LAS unsigned char* mbc, const unsigned char* Vj, int tn, VSet& sn, const VSet& sc, int tc, int j, int lane, int c, int g, bool do_compute) {
    v4u ix[4];
#pragma unroll
    for (int q = 0; q < 4; ++q) ix[q] = *(const LAS v4u*)(mb + 64 * g + 16 * q);
    const v4u wh0 = *(const LAS v4u*)(mbc + 512 + 32 * g), wh1 = *(const LAS v4u*)(mbc + 512 + 32 * g + 16);
    h2_t ah[8];
#pragma unroll
    for (int m = 0; m < 8; ++m) ah[m] = (h2_t){(_Float16)0.f, (_Float16)0.f};
#pragma unroll
    for (int i = 0; i < 16; ++i) {
        sn.v[i] = *(const GAS v4u*)(Vj + (unsigned)((ix[i >> 2][i & 3] << 7) + 16u * (unsigned)c));
        const v4u v = sc.v[i]; const unsigned wu = (i >> 3) ? wh1[(i >> 1) & 3] : wh0[(i >> 1) & 3]; const h2_t w2 = __builtin_bit_cast(h2_t, (i & 1) ? ((wu >> 16) | (wu & 0xffff0000u)) : ((wu & 0xffffu) | (wu << 16)));
        ah[0] = __builtin_elementwise_fma(cvt_h2_lo((int)v.x), w2, ah[0]); ah[1] = __builtin_elementwise_fma(cvt_h2_hi((int)v.x), w2, ah[1]);
        ah[2] = __builtin_elementwise_fma(cvt_h2_lo((int)v.y), w2, ah[2]); ah[3] = __builtin_elementwise_fma(cvt_h2_hi((int)v.y), w2, ah[3]);
        ah[4] = __builtin_elementwise_fma(cvt_h2_lo((int)v.z), w2, ah[4]); ah[5] = __builtin_elementwise_fma(cvt_h2_hi((int)v.z), w2, ah[5]);
        ah[6] = __builtin_elementwise_fma(cvt_h2_lo((int)v.w), w2, ah[6]); ah[7] = __builtin_elementwise_fma(cvt_h2_hi((int)v.w), w2, ah[7]);
        asm volatile("" ::: "memory"); }
    if (!do_compute) return;
#pragma unroll
    for (int m = 0; m < 4; ++m) { const auto r = __builtin_amdgcn_permlane32_swap(__builtin_bit_cast(unsigned, ah[m]), __builtin_bit_cast(unsigned, ah[m + 4]), false, false);
        ah[m] = __builtin_bit_cast(h2_t, (unsigned)r[0]) + __builtin_bit_cast(h2_t, (unsigned)r[1]); }
#pragma unroll
    for (int m = 0; m < 2; ++m) { const auto r = __builtin_amdgcn_permlane16_swap(__builtin_bit_cast(unsigned, ah[m]), __builtin_bit_cast(unsigned, ah[m + 2]), false, false);
        ah[m] = __builtin_bit_cast(h2_t, (unsigned)r[0]) + __builtin_bit_cast(h2_t, (unsigned)r[1]); }
    { const bool up = lane & 8;
      const h2_t s0 = ah[0] + __builtin_bit_cast(h2_t, __builtin_amdgcn_update_dpp(0, __builtin_bit_cast(int, ah[0]), 0x128, 0xf, 0xf, true));
      const h2_t s1 = ah[1] + __builtin_bit_cast(h2_t, __builtin_amdgcn_update_dpp(0, __builtin_bit_cast(int, ah[1]), 0x128, 0xf, 0xf, true));
      ah[0] = up ? s1 : s0; }
    const f32x2v peer = (f32x2v){(float)ah[0].x, (float)ah[0].y} * (1.f / V_SCALE);
    *(GAS unsigned*)((bf16*)(F.ws + WS_H) + (size_t)tc * D + 128 * j + 16 * c + 2 * g) = pk2(peer.x, peer.y);
}
__device__ __forceinline__ void p8b_vsum(Frame& F) {
    const int* IDX = (const int*)(F.ws + WS_IDX); const _Float16* W = (const _Float16*)(F.ws + WS_W16);
    const int lane = F.lane, c = lane & 7, g = lane >> 3; const SliceWork sw = slice_work(F);
    LAS unsigned char* mb = F.lds + F.wave * 1024;
    if (sw.t0 >= M) return;
    const int nt = (M - 1 - sw.t0) / sw.ts + 1;
    for (int jj = 0; jj < sw.nj; ++jj) { const int j = sw.j0 + jj; const unsigned char* Vj = F.ws + WS_V + (size_t)j * NEXP * 128;
        VSet sA, sB, sC;
        LAS unsigned char* const pg0 = mb, * const pg1 = mb + 8192, * const pg2 = mb + 16384;
        VMeta mN = p8b_G(IDX, W, TOK(0), lane); p8b_S(pg0, mN, lane); p8b_RT(F, pg0, Vj, TOK(0), j, c, g, sA);
        mN = p8b_G(IDX, W, TOK(1), lane); p8b_S(pg1, mN, lane); p8b_RT(F, pg1, Vj, TOK(1), j, c, g, sB);
        mN = p8b_G(IDX, W, TOK(2), lane);
#define P8B_STAGE(k, SN, SC_, PN, PC) do { p8b_S(PN, mN, lane); mN = p8b_G(IDX, W, TOK((k) + 3), lane); \
            p8b_step(F, PN, PC, Vj, TOK((k) + 2), SN, SC_, TOK(k), j, lane, c, g, (k) < nt); asm volatile("" ::: "memory"); } while (0)
#pragma unroll 1
        for (int n = 0; n < nt; n += 3) {
            P8B_STAGE(n, sC, sA, pg2, pg0);
            P8B_STAGE(n + 1, sA, sB, pg0, pg1);
            P8B_STAGE(n + 2, sB, sC, pg1, pg2);
        }
#undef P8B_STAGE
    }
#undef TOK
}
__device__ __forceinline__ void p8c_final(Frame& F) {
    const float* gf = F.in[IN_GF]; const float* ada = (const float*)(F.ws + WS_ADA); const int lane = F.lane;
    f32x4 gv[4];
#pragma unroll
    for (int q = 0; q < 4; ++q) gv[q] = *(const f32x4*)(gf + 4 * lane + 256 * q);
    const bf16* X1 = (const bf16*)(F.ws + WS_X1); const bf16* PE = (const bf16*)(F.ws + WS_H);
    for (int t = blockIdx.x * NWAVES + F.wave; t < M; t += F.G * NWAVES) {
        const GAS v2u* xr = (const GAS v2u*)(X1 + (size_t)t * D) + lane; const GAS v2u* pr = (const GAS v2u*)(PE + (size_t)t * D) + lane;
        const float* g2 = ada + (size_t)(t / SEQ) * ADA_W + 5 * D + 4 * lane;
        f32x4 x2[4]; float s = 0.f;
#pragma unroll
        for (int q = 0; q < 4; ++q) { const v2u a = __builtin_nontemporal_load(xr + 64 * q), p = __builtin_nontemporal_load(pr + 64 * q); const f32x4 gg = *(const f32x4*)(g2 + 256 * q);
            x2[q] = (f32x4){bflo(a.x), bfhi(a.x), bflo(a.y), bfhi(a.y)} + gg * (f32x4){bflo(p.x), bfhi(p.x), bflo(p.y), bfhi(p.y)};
            s += (x2[q].x * x2[q].x + x2[q].y * x2[q].y) + (x2[q].z * x2[q].z + x2[q].w * x2[q].w); }
        const float rstd = 1.0f / sqrtf(wave_sum(s) * (1.f / D) + EPS);
        GAS f32x4* yr = (GAS f32x4*)(F.out + (size_t)t * D) + lane;
#pragma unroll
        for (int q = 0; q < 4; ++q) __builtin_nontemporal_store(x2[q] * rstd * gv[q], yr + 64 * q);
    }
}

struct Args { const float* in[20]; float* out; unsigned char* ws; int ph_lo, ph_hi, li, pad; };
__global__ void __launch_bounds__(NWAVES * 64, 2) skel_fwd(Args args) {
    extern __shared__ __attribute__((aligned(16))) unsigned char lds[];
    Frame F;
    F.lds = (LAS unsigned char*)lds;
    F.MISC = (volatile LAS unsigned*)(F.lds + MISC_OFF);
    F.tid = threadIdx.x; F.lane = F.tid & 63; F.wave = __builtin_amdgcn_readfirstlane(F.tid >> 6);
    F.G = gridDim.x; { const int bx = blockIdx.x; F.vcu = (F.G % 8 == 0) ? (bx % 8) * (F.G / 8) + bx / 8 : bx; }
    F.ws = args.ws; F.out = args.out;
#pragma unroll
    for (int i = 0; i < 20; ++i) F.in[i] = args.in[i];
    F.ctl = (gu32*)(args.ws + WS_CTL);
    for (int u = F.tid; u < (LDS_BYTES - LDSCTL_OFF) / 4; u += NWAVES * 64) ((LAS unsigned*)(F.lds + LDSCTL_OFF))[u] = 0u;
    __syncthreads();
    XcdBarrier bar; bar.bar = (unsigned*)(F.ctl + CW_BAR); bar.x = 0; bar.st = nullptr;
    if (N_LAUNCHES == 1) bar = xcd_barrier_post((unsigned*)(F.ctl + CW_BAR), F.MISC + 8);
#define GRID_BAR() do { if (N_LAUNCHES == 1) xcd_barrier(bar); } while (0)
    const int lo = args.ph_lo, hi = args.ph_hi;
#define IN(k) (lo <= (k) && (k) < hi)
    bf16* const H = (bf16*)(args.ws + WS_H); bf16* const PROJ = (bf16*)(args.ws + WS_PROJ); bf16* const MIX = (bf16*)(args.ws + WS_MIX);

    if (IN(0)) { p0_prologue(F); GRID_BAR(); }
    if (IN(1)) { p1_hpass(F); GRID_BAR(); }
    if (IN(2)) {
        pg8::Gemm g{(const bf16*)(args.ws + WS_H8), (const bf16*)(args.ws + WS_WIN), M, IN_W, D / 2}; pg8::StaticOrder S; S.init(M, IN_W, F.G, (int)blockIdx.x);
        pg8::EpiI8Bf16 E{PROJ, IN_W, (const float*)(args.ws + WS_HS), 1.f / WQ_SCALE, F.in[IN_BIN]};
        if ((int)blockIdx.x >= 128) { __builtin_amdgcn_s_sleep(127); __builtin_amdgcn_s_sleep(127); }
        pg8::gemm_phase<pg8::EpiI8Bf16, pg8::StaticOrder, true, true, true>(F.lds + RING_OFF, g, S, E);
        GRID_BAR();
    }
    if (IN(3)) { p3_mixer(F); GRID_BAR(); }
    if (IN(4)) {
        pg8::Gemm g{MIX, (const bf16*)(args.ws + WS_WOUT), M, D, D}; pg8::StaticOrder S; S.init(M, D, F.G, (int)blockIdx.x);
        pg8::EpiResGate E{F.in[IN_X], (bf16*)(args.ws + WS_X1), D, F.in[IN_BOUT], (const float*)(args.ws + WS_ADA), ADA_W, 2 * D, SEQ / 256};
        pg8::gemm_phase<pg8::EpiResGate, pg8::StaticOrder, true, true>(F.lds + RING_OFF, g, S, E);
        GRID_BAR();
    }
    if (IN(5)) { p5_h2pass(F); GRID_BAR(); }
    if (IN(6)) {
        pg8::Gemm g{(const bf16*)(args.ws + WS_H8), (const bf16*)(args.ws + WS_WQ), M, QW, D / 2}; pg8::StaticOrder S; S.init(M, QW, F.G, (int)blockIdx.x);
        pg8::EpiI8Bf16 E{PROJ, QW, (const float*)(args.ws + WS_HS), 1.f / WQ_SCALE, nullptr};
        pg8::gemm_phase<pg8::EpiI8Bf16, pg8::StaticOrder, true, true, true>(F.lds + RING_OFF, g, S, E);
        GRID_BAR();
    }
    if (IN(7)) { p7_routing(F); GRID_BAR(); }
    if (IN(8)) { p8a_udots(F); GRID_BAR(); }
    if (IN(9)) { p8w_weights(F); GRID_BAR(); }
    if (IN(10)) { p8b_vsum(F); GRID_BAR(); }
    if (IN(11)) { p8c_final(F); }
#undef IN
}

extern "C" void kernel_launch(void* const* d_in, const int* in_sizes, int n_in, void* d_out, int out_size, void* d_ws, size_t ws_size, hipStream_t stream) {
    static int grid = 0;
    if (grid == 0) {
        if (n_in != 20 || in_sizes[0] != M * D || out_size != M * D || ws_size < WS_END) { fprintf(stderr, "kernel_launch: unexpected shapes (n_in %d, in0 %d, out %d, ws %zu); nothing launched\n", n_in, n_in > 0 ? in_sizes[0] : -1, out_size, ws_size); grid = -1; return; }
        int dev = 0, cus = 0, per_cu = 0;
        if (hipGetDevice(&dev) != hipSuccess || hipDeviceGetAttribute(&cus, hipDeviceAttributeMultiprocessorCount, dev) != hipSuccess) { fprintf(stderr, "kernel_launch: device query failed\n"); grid = -1; return; }
        if (hipFuncSetAttribute((const void*)skel_fwd, hipFuncAttributeMaxDynamicSharedMemorySize, LDS_BYTES) != hipSuccess) { fprintf(stderr, "kernel_launch: hipFuncSetAttribute failed\n"); grid = -1; return; }
        if (hipOccupancyMaxActiveBlocksPerMultiprocessor(&per_cu, (const void*)skel_fwd, NWAVES * 64, LDS_BYTES) != hipSuccess || per_cu < 1)
            fprintf(stderr, "kernel_launch: note: occupancy query reports %d workgroups per CU\n", per_cu);
        (void)hipGetLastError();
        grid = cus;
    }
    if (grid < 0) return;
    if (hipMemsetAsync((char*)d_ws + WS_CTL, 0, CTL_ZERO_BYTES, stream) != hipSuccess) { fprintf(stderr, "kernel_launch: hipMemsetAsync failed\n"); return; }
    Args a{};
    for (int i = 0; i < 20; ++i) a.in[i] = (const float*)d_in[i];
    a.out = (float*)d_out; a.ws = (unsigned char*)d_ws;
    for (int li = 0; li < N_LAUNCHES; ++li) {
        a.ph_lo = (N_LAUNCHES == 1) ? 0 : li; a.ph_hi = (N_LAUNCHES == 1) ? NPHASES : li + 1; a.li = li;
        hipLaunchKernelGGL(skel_fwd, dim3(grid), dim3(NWAVES * 64), LDS_BYTES, stream, a);
        const hipError_t le = hipPeekAtLastError();
        if (le != hipSuccess) { fprintf(stderr, "kernel_launch: launch %d failed: %s\n", li, hipGetErrorName(le)); break; }
    }
}
```

```cpp
#include <hip/hip_runtime.h>
#include <cstdio>
#include <cstdint>
#include <cmath>
namespace pg8 {
#define PG8_LAS __attribute__((address_space(3)))
typedef unsigned short bf16_t;
typedef short bf16x8 __attribute__((ext_vector_type(8)));
typedef float f32x4 __attribute__((ext_vector_type(4)));
typedef unsigned u32x4 __attribute__((ext_vector_type(4)));
constexpr int BM = 256, BK = 64, HALF = 128, HTB = HALF * BK * 2  , STAGE_BYTES = 8 * HTB, NXCD = 8, WGM = 8;

__host__ __device__ __forceinline__ int lds_byte(int r, int c) { const int st = (r >> 4) * 2 + (c >> 5), rr = r & 15, cc = c & 31, ob = rr * 64 + cc * 2; return st * 1024 + (ob ^ (((ob >> 9) & 1) << 5)); }
__host__ __device__ __forceinline__ void stage_rc(int b, int& R, int& C) { const int st = b / 1024, sb = b % 1024, swz = sb ^ (((sb >> 9) & 1) << 5); R = (st >> 1) * 16 + swz / 64; C = (st & 1) * 32 + (swz % 64) / 2; }
__host__ __device__ __forceinline__ int perm32(int rho) { const int n = rho >> 4, i = rho & 15; return 8 * (i >> 2) + 4 * n + (i & 3); }

__device__ __forceinline__ __amdgpu_buffer_rsrc_t wt_rsrc(const void* base, size_t bytes) { return __builtin_amdgcn_make_buffer_rsrc((void*)base, 0, (int)bytes, 0x00020000); }
__device__ __forceinline__ void store16_wt(__amdgpu_buffer_rsrc_t r, unsigned off, u32x4 v) { __builtin_amdgcn_raw_buffer_store_b128(v, r, (int)off, 0, 16); }
struct Unit { int pm, pn; };
struct Gemm { const bf16_t* A; const bf16_t* Bt; int M, N, K; };

struct StaticOrder {
    int nM, nN, nwg, G, c;
    __host__ __device__ void init(int M, int N, int G_, int c_) { nM = M / BM; nN = N / BM; nwg = nM * nN; G = G_; c = c_; }
    __host__ __device__ __forceinline__ bool next(int i, Unit& u) const { return at((long)i * G + c, u); }
    __host__ __device__ __forceinline__ bool at(long L, Unit& u) const {
        if (L >= nwg) return false;
        int wgid = (int)L; { const int q = nwg / NXCD, r = nwg % NXCD, xcd = wgid % NXCD, off = wgid / NXCD; wgid = (xcd < r ? xcd * (q + 1) : r * (q + 1) + (xcd - r) * q) + off; }
        const int nig = WGM * nN, gid = wgid / nig, fm = gid * WGM, gsz = (nM - fm) < WGM ? (nM - fm) : WGM;
        u.pm = fm + ((wgid % nig) % gsz); u.pn = (wgid % nig) / gsz; return true;
    }
    __host__ __device__ __forceinline__ int part(int) const { return 0; }
    __device__ __forceinline__ void a_ready(const Unit&) const {}
    __device__ __forceinline__ void done(const Unit&) const {}
};

struct StagOrder {
    StaticOrder base; int R, E, grpB, pair; bool on;
    __host__ __device__ void init(int M, int N, int G_, int c_) { base.init(M, N, G_, c_); R = base.nwg / G_; E = base.nwg - R * G_; on = (G_ % 16 == 0) && R >= 1 && (E == 0 || E == G_ / 2);
        const int slot = c_ >> 3; grpB = slot & 1; pair = (slot >> 1) * 8 + (c_ & 7); }
    __host__ __device__ __forceinline__ bool next(int i, Unit& u) const {
        if (!on) return base.next(i, u);
        if (E) {
            if (!grpB) return i < R ? base.next(i, u) : (i == R ? base.at((long)R * base.G + pair, u) : false);
            return i == 0 ? base.at((long)R * base.G + pair, u) : (i <= R ? base.next(i - 1, u) : false);
        }
        if (!grpB || i < R) return base.next(i, u);
        return i == R ? base.next(0, u) : false;
    }
    __host__ __device__ __forceinline__ int part(int i) const {
        if (!on) return 0;
        if (E) return grpB ? (i == 0 ? 2 : 0) : (i == R ? 1 : 0);
        return grpB ? (i == 0 ? 1 : (i == R ? 2 : 0)) : 0;
    }
    __device__ __forceinline__ void a_ready(const Unit&) const {}
    __device__ __forceinline__ void done(const Unit&) const {}
};

__device__ __forceinline__ unsigned cvt_pk_bf16(float lo, float hi) { unsigned r; asm volatile("v_cvt_pk_bf16_f32 %0, %1, %2" : "=v"(r) : "v"(lo), "v"(hi)); return r; }
typedef float f32x2 __attribute__((ext_vector_type(2)));
__device__ __forceinline__ f32x2 gelu_pk(f32x2 v) {
    const f32x2 av = __builtin_elementwise_abs(v), d = av * 0.2316418882f + 1.0f;
    f32x2 t; t.x = __builtin_amdgcn_rcpf(d.x); t.y = __builtin_amdgcn_rcpf(d.y);
    f32x2 q = t * 0.5307027145f + (-0.7265760135f); q = q * t + 0.7107068705f; q = q * t + (-0.142248368f); q = q * t + 0.127414796f; q = q * t;
    const f32x2 s = (v * v) * (-0.72134752044f);
    f32x2 e; e.x = __builtin_amdgcn_exp2f(s.x); e.y = __builtin_amdgcn_exp2f(s.y);
    const f32x2 m = v * (q * e), r = v - m;
    f32x2 o; o.x = v.x < 0.f ? m.x : r.x; o.y = v.y < 0.f ? m.y : r.y; return o;
}

template <int ACT  > struct EpiBf16 {
    static constexpr bool PERM = true, AFTER_DRAIN = false; static_assert(ACT == 0 || ACT == 1, "EpiBf16: ACT is 0 (none) or 1 (gelu_pk)");
    bf16_t* O; int ldc; const float* bias; int split_cols; size_t split_stride; float scale0;
    __device__ __forceinline__ void operator()(const f32x4 (&acc)[2][2][4][2], const Unit& u, int wr, int wc, int fr, int fq) const {
        const int row0 = u.pm * BM + wr * 64 + fr; int colt = u.pn * BM; bf16_t* base = O;
        float sc = 1.f; if (split_cols) { const int t = colt / split_cols; base += (size_t)t * split_stride; colt -= t * split_cols; if (t == 0) sc = scale0; }
        const int col0 = colt + wc * 32 + 8 * fq, bcol0 = u.pn * BM + wc * 32 + 8 * fq;
        f32x4 bv[2][2];
#pragma unroll
        for (int bj = 0; bj < 2; ++bj)
#pragma unroll
            for (int n = 0; n < 2; ++n) bv[bj][n] = bias ? *(const f32x4*)(bias + bcol0 + bj * HALF + 4 * n) : (f32x4){0.f, 0.f, 0.f, 0.f};
#pragma unroll
        for (int ai = 0; ai < 2; ++ai)
#pragma unroll
            for (int m = 0; m < 4; ++m) { bf16_t* rowp = base + (size_t)(row0 + ai * HALF + m * 16) * ldc + col0;
#pragma unroll
                for (int bj = 0; bj < 2; ++bj) { f32x4 v0 = acc[ai][bj][m][0] + bv[bj][0], v1 = acc[ai][bj][m][1] + bv[bj][1];
                    if (ACT == 1) { f32x2 a = gelu_pk((f32x2){v0[0], v0[1]}), b = gelu_pk((f32x2){v0[2], v0[3]}), c = gelu_pk((f32x2){v1[0], v1[1]}), d = gelu_pk((f32x2){v1[2], v1[3]});
                        v0 = (f32x4){a.x, a.y, b.x, b.y}; v1 = (f32x4){c.x, c.y, d.x, d.y}; }
                    v0 = v0 * sc; v1 = v1 * sc; u32x4 w; w.x = cvt_pk_bf16(v0[0], v0[1]); w.y = cvt_pk_bf16(v0[2], v0[3]); w.z = cvt_pk_bf16(v1[0], v1[1]); w.w = cvt_pk_bf16(v1[2], v1[3]);
                    *(u32x4*)(rowp + bj * HALF) = w; } }
    }
};

typedef unsigned u32x2 __attribute__((ext_vector_type(2)));
struct EpiResGate {
    static constexpr bool PERM = true, AFTER_DRAIN = false;
    const float* x; bf16_t* out; int ldc; const float* bias; const float* ada; int ada_ld, gate_off, tiles_per_batch;
    __device__ __forceinline__ void operator()(const f32x4 (&acc)[2][2][4][2], const Unit& u, int wr, int wc, int fr, int fq, int part) const {
        const int row0 = u.pm * BM + wr * 64 + fr, col0 = u.pn * BM + wc * 32 + 8 * fq;
        const float* gp = ada + (size_t)(u.pm / tiles_per_batch) * ada_ld + gate_off;
        f32x4 bv[2][2], gv[2][2];
#pragma unroll
        for (int bj = 0; bj < 2; ++bj)
#pragma unroll
            for (int n = 0; n < 2; ++n) { bv[bj][n] = *(const f32x4*)(bias + col0 + bj * HALF + 4 * n); gv[bj][n] = *(const f32x4*)(gp + col0 + bj * HALF + 4 * n); }
        const __amdgpu_buffer_rsrc_t orsrc = wt_rsrc(out, (size_t)32768 * ldc * 2);
#pragma unroll
        for (int ai = 0; ai < 2; ++ai) {
            if (part == (ai ? 1 : 2)) continue;
#pragma unroll
            for (int mh = 0; mh < 2; ++mh) {
            f32x4 xv[2][2][2];
#pragma unroll
            for (int m = 0; m < 2; ++m) { const size_t off = (size_t)(row0 + ai * HALF + (2 * mh + m) * 16) * ldc + col0;
#pragma unroll
                for (int bj = 0; bj < 2; ++bj)
#pragma unroll
                    for (int n = 0; n < 2; ++n) xv[m][bj][n] = __builtin_nontemporal_load((const f32x4*)(x + off + bj * HALF + 4 * n)); }
#pragma unroll
            for (int m = 0; m < 2; ++m) { const size_t off = (size_t)(row0 + ai * HALF + (2 * mh + m) * 16) * ldc + col0;
#pragma unroll
                for (int bj = 0; bj < 2; ++bj) { const f32x4 o0 = xv[m][bj][0] + gv[bj][0] * (acc[ai][bj][2 * mh + m][0] + bv[bj][0]), o1 = xv[m][bj][1] + gv[bj][1] * (acc[ai][bj][2 * mh + m][1] + bv[bj][1]);
                    u32x4 w; w.x = cvt_pk_bf16(o0[0], o0[1]); w.y = cvt_pk_bf16(o0[2], o0[3]); w.z = cvt_pk_bf16(o1[0], o1[1]); w.w = cvt_pk_bf16(o1[2], o1[3]);
                    store16_wt(orsrc, (unsigned)((off + bj * HALF) * 2), w); } }
            asm volatile("" ::: "memory"); }
            asm volatile("" ::: "memory"); }
    }
};


typedef int i32x4 __attribute__((ext_vector_type(4)));
template <bool I8> struct AccSel { typedef f32x4 type; static __device__ __forceinline__ f32x4 zero() { return (f32x4){0.f, 0.f, 0.f, 0.f}; } };
template <> struct AccSel<true> { typedef i32x4 type; static __device__ __forceinline__ i32x4 zero() { return (i32x4){0, 0, 0, 0}; } };
template <bool I8> __device__ __forceinline__ typename AccSel<I8>::type mma16(bf16x8 a, bf16x8 b, typename AccSel<I8>::type c) {
    if constexpr (I8) return __builtin_amdgcn_mfma_i32_16x16x64_i8(__builtin_bit_cast(i32x4, a), __builtin_bit_cast(i32x4, b), c, 0, 0, 0);
    else return __builtin_amdgcn_mfma_f32_16x16x32_bf16(a, b, c, 0, 0, 0);
}
struct EpiI8Bf16 {
    static constexpr bool PERM = true, AFTER_DRAIN = false;
    bf16_t* O; int ldc; const float* rowscale; float wscale; const float* bias;
    __device__ __forceinline__ void operator()(const i32x4 (&acc)[2][2][4][2], const Unit& u, int wr, int wc, int fr, int fq, int part) const {
        const int row0 = u.pm * BM + wr * 64 + fr, col0 = u.pn * BM + wc * 32 + 8 * fq;
        f32x4 bv[2][2];
#pragma unroll
        for (int bj = 0; bj < 2; ++bj)
#pragma unroll
            for (int n = 0; n < 2; ++n) bv[bj][n] = bias ? *(const f32x4*)(bias + col0 + bj * HALF + 4 * n) : (f32x4){0.f, 0.f, 0.f, 0.f};
        const __amdgpu_buffer_rsrc_t orsrc = wt_rsrc(O, (size_t)32768 * ldc * 2);
#pragma unroll
        for (int ai = 0; ai < 2; ++ai) { if (part == (ai ? 1 : 2)) continue;
#pragma unroll
            for (int m = 0; m < 4; ++m) { const int row = row0 + ai * HALF + m * 16; const float sc = rowscale[row] * wscale; const unsigned rowoff = (unsigned)(((size_t)row * ldc + col0) * 2);
#pragma unroll
                for (int bj = 0; bj < 2; ++bj) { const i32x4 a0 = acc[ai][bj][m][0], a1 = acc[ai][bj][m][1]; const f32x4 b0 = bv[bj][0], b1 = bv[bj][1];
                    u32x4 w; w.x = cvt_pk_bf16((float)a0[0] * sc + b0[0], (float)a0[1] * sc + b0[1]); w.y = cvt_pk_bf16((float)a0[2] * sc + b0[2], (float)a0[3] * sc + b0[3]);
                    w.z = cvt_pk_bf16((float)a1[0] * sc + b1[0], (float)a1[1] * sc + b1[1]); w.w = cvt_pk_bf16((float)a1[2] * sc + b1[2], (float)a1[3] * sc + b1[3]);
                    store16_wt(orsrc, rowoff + bj * HALF * 2, w); } } }
    }
};
template <class Epi, class Sched, bool ALIGN_EPI = false, bool SP2 = false, bool I8 = false>
__device__ __forceinline__ void gemm_phase(PG8_LAS unsigned char* lds, const Gemm g, const Sched& S, const Epi& E) {
    const int tid = threadIdx.x, wid = __builtin_amdgcn_readfirstlane(tid >> 6), lane = tid & 63, wr = wid >> 2, wc = wid & 3, fr = lane & 15, fq = lane >> 4;
    const int K = g.K, nt = K / BK;
    unsigned voffA[2], voffB[2];
#pragma unroll
    for (int i = 0; i < 2; ++i) { int R, C; stage_rc(tid * 16 + i * 8192, R, C); const int Rb = Epi::PERM ? ((R & ~31) + perm32(R & 31)) : R;
        voffA[i] = (unsigned)(R * K + C) * 2u; voffB[i] = (unsigned)(Rb * K + C) * 2u; }
    const size_t kstep = (size_t)(BK * 2);
    const size_t hstep = (size_t)HALF * K * 2;
    const size_t tstep = 2 * hstep;
    const unsigned ldsw = (unsigned)wid * 1024u;
    const int aoff = lds_byte(wr * 64 + fr, fq * 8), boff = lds_byte(wc * 32 + fr, fq * 8);
#define PG8_SA(b, h) (((b) * 2 + (h)) * HTB)
#define PG8_SB(b, h) ((4 + (b) * 2 + (h)) * HTB)
#define PG8_STAGE(bufoff, gbase, voff) do { _Pragma("unroll") for (int _i = 0; _i < 2; ++_i) \
        __builtin_amdgcn_global_load_lds((const unsigned*)((const char*)(gbase) + (voff)[_i]), (PG8_LAS unsigned*)(lds + (bufoff) + ldsw + _i * 8192), 16, 0, 0); } while (0)
#define PG8_LDA(dst, b, h) do { _Pragma("unroll") for (int m = 0; m < 4; ++m) _Pragma("unroll") for (int k = 0; k < 2; ++k) dst[m][k] = *(const PG8_LAS bf16x8*)(lds + PG8_SA(b, h) + aoff + m * 2048 + k * 1024); } while (0)
#define PG8_LDB(dst, b, h) do { _Pragma("unroll") for (int n = 0; n < 2; ++n) _Pragma("unroll") for (int k = 0; k < 2; ++k) dst[n][k] = *(const PG8_LAS bf16x8*)(lds + PG8_SB(b, h) + boff + n * 2048 + k * 1024); } while (0)
#define PG8_MMA(ai, bj, At, Bt) do { __builtin_amdgcn_s_setprio(1); _Pragma("unroll") for (int m = 0; m < 4; ++m) _Pragma("unroll") for (int n = 0; n < 2; ++n) _Pragma("unroll") for (int k = 0; k < 2; ++k) \
        acc[ai][bj][m][n] = mma16<I8>(Bt[n][k], At[m][k], acc[ai][bj][m][n]); __builtin_amdgcn_s_setprio(0); } while (0)
#define PG8_WAIT_V(n) asm volatile("s_waitcnt vmcnt(" #n ")" ::: "memory")
#define PG8_WAIT_L(n) asm volatile("s_waitcnt lgkmcnt(" #n ")" ::: "memory")
#define PG8_BAR __builtin_amdgcn_s_barrier()
#define PG8_SCHED __builtin_amdgcn_sched_barrier(0)
    Unit cur, nxt; int ui = 0;
    if (!S.next(0, cur)) return;
    typedef typename AccSel<I8>::type acc_t;
    acc_t acc[2][2][4][2];
#pragma unroll
    for (int a = 0; a < 2; ++a)
#pragma unroll
        for (int b = 0; b < 2; ++b)
#pragma unroll
            for (int m = 0; m < 4; ++m)
#pragma unroll
                for (int n = 0; n < 2; ++n) acc[a][b][m][n] = AccSel<I8>::zero();
    bf16x8 At[4][2], B0[2][2], B1[2][2];
    const char* cA = (const char*)g.A + (size_t)cur.pm * tstep; const char* cB = (const char*)g.Bt + (size_t)cur.pn * tstep;
    S.a_ready(cur);
    if constexpr (SP2) {
        PG8_STAGE(PG8_SB(0, 0), cB, voffB); PG8_STAGE(PG8_SB(0, 1), cB + hstep, voffB); PG8_STAGE(PG8_SA(0, 0), cA, voffA); PG8_STAGE(PG8_SA(0, 1), cA + hstep, voffA);
        if (wr == 1) PG8_BAR;
        PG8_WAIT_V(2); PG8_BAR;
        PG8_STAGE(PG8_SB(1, 0), cB + kstep, voffB); PG8_STAGE(PG8_SA(1, 0), cA + kstep, voffA); PG8_STAGE(PG8_SB(1, 1), cB + hstep + kstep, voffB);
        PG8_WAIT_V(6); PG8_BAR;
    } else {
        PG8_STAGE(PG8_SB(0, 0), cB, voffB); PG8_STAGE(PG8_SA(0, 0), cA, voffA); PG8_STAGE(PG8_SB(0, 1), cB + hstep, voffB); PG8_STAGE(PG8_SA(0, 1), cA + hstep, voffA);
        if (wr == 1) PG8_BAR;
        PG8_WAIT_V(4); PG8_BAR;
        PG8_STAGE(PG8_SB(1, 0), cB + kstep, voffB); PG8_STAGE(PG8_SA(1, 0), cA + kstep, voffA); PG8_STAGE(PG8_SB(1, 1), cB + hstep + kstep, voffB);
        PG8_WAIT_V(6); PG8_BAR;
    }
    for (;;) {
        const bool has_next = S.next(ui + 1, nxt);
        const char* nA = has_next ? (const char*)g.A + (size_t)nxt.pm * tstep : cA; const char* nB = has_next ? (const char*)g.Bt + (size_t)nxt.pn * tstep : cB;
        const int cpart = S.part(ui); const bool d0 = cpart != 2, d1 = cpart != 1;
        for (int t = 0; t < nt; t += 2) {
            const bool last = (t == nt - 2);
            const char* a1 = cA + (size_t)(t + 1) * kstep;
            const char* a2 = last ? nA : cA + (size_t)(t + 2) * kstep; const char* b2 = last ? nB : cB + (size_t)(t + 2) * kstep;
            const char* a3 = a2 + kstep; const char* b3 = b2 + kstep;
            if (last && has_next) S.a_ready(nxt);
            if constexpr (SP2) {
            PG8_LDB(B0, 0, 0); PG8_LDB(B1, 0, 1); PG8_SCHED; PG8_LDA(At, 0, 0); PG8_STAGE(PG8_SA(1, 1), a1 + hstep, voffA);
            PG8_WAIT_V(8); PG8_WAIT_L(0); PG8_BAR; if (d0) { PG8_MMA(0, 0, At, B0); PG8_MMA(0, 1, At, B1); } PG8_BAR; PG8_SCHED;
            PG8_LDA(At, 0, 1); PG8_STAGE(PG8_SB(0, 0), b2, voffB); PG8_STAGE(PG8_SB(0, 1), b2 + hstep, voffB); PG8_STAGE(PG8_SA(0, 0), a2, voffA);
            PG8_WAIT_V(8); PG8_WAIT_L(0); PG8_BAR; if (d1) { PG8_MMA(1, 0, At, B0); PG8_MMA(1, 1, At, B1); } PG8_BAR; PG8_SCHED;
            PG8_LDB(B0, 1, 0); PG8_LDB(B1, 1, 1); PG8_SCHED; PG8_LDA(At, 1, 0); PG8_STAGE(PG8_SA(0, 1), a2 + hstep, voffA);
            PG8_WAIT_V(8); PG8_WAIT_L(0); PG8_BAR; if (d0) { PG8_MMA(0, 0, At, B0); PG8_MMA(0, 1, At, B1); } PG8_BAR; PG8_SCHED;
            PG8_LDA(At, 1, 1); PG8_STAGE(PG8_SB(1, 0), b3, voffB); PG8_STAGE(PG8_SB(1, 1), b3 + hstep, voffB); PG8_STAGE(PG8_SA(1, 0), a3, voffA);
            PG8_WAIT_V(8); PG8_WAIT_L(0); PG8_BAR; if (d1) { PG8_MMA(1, 0, At, B0); PG8_MMA(1, 1, At, B1); } PG8_BAR; PG8_SCHED;
            } else {
            PG8_LDB(B0, 0, 0); PG8_SCHED; PG8_LDA(At, 0, 0); PG8_STAGE(PG8_SA(1, 1), a1 + hstep, voffA);
            PG8_WAIT_L(8); PG8_BAR; PG8_WAIT_L(0); PG8_MMA(0, 0, At, B0); PG8_BAR; PG8_SCHED;
            PG8_LDB(B1, 0, 1); PG8_STAGE(PG8_SB(0, 0), b2, voffB);
            PG8_BAR; PG8_WAIT_L(0); PG8_MMA(0, 1, At, B1); PG8_BAR;
            PG8_LDA(At, 0, 1); PG8_STAGE(PG8_SA(0, 0), a2, voffA);
            PG8_BAR; PG8_WAIT_L(0); PG8_MMA(1, 0, At, B0); PG8_BAR; PG8_SCHED;
            PG8_STAGE(PG8_SB(0, 1), b2 + hstep, voffB);
            PG8_WAIT_V(6); PG8_BAR; PG8_MMA(1, 1, At, B1); PG8_BAR;
            PG8_LDB(B0, 1, 0); PG8_SCHED; PG8_LDA(At, 1, 0); PG8_STAGE(PG8_SA(0, 1), a2 + hstep, voffA);
            PG8_WAIT_L(8); PG8_BAR; PG8_WAIT_L(0); PG8_MMA(0, 0, At, B0); PG8_BAR; PG8_SCHED;
            PG8_LDB(B1, 1, 1); PG8_STAGE(PG8_SB(1, 0), b3, voffB);
            PG8_BAR; PG8_WAIT_L(0); PG8_MMA(0, 1, At, B1); PG8_BAR;
            PG8_LDA(At, 1, 1); PG8_STAGE(PG8_SA(1, 0), a3, voffA);
            PG8_BAR; PG8_WAIT_L(0); PG8_MMA(1, 0, At, B0); PG8_BAR; PG8_SCHED;
            PG8_STAGE(PG8_SB(1, 1), b3 + hstep, voffB);
            PG8_WAIT_V(6); PG8_BAR; PG8_MMA(1, 1, At, B1); PG8_BAR;
            }
        }
        if constexpr (ALIGN_EPI) { if (wr == 0) PG8_BAR; }
        if constexpr (!Epi::AFTER_DRAIN) { E(acc, cur, wr, wc, fr, fq, cpart); S.done(cur); }
        if (!has_next) break;
#pragma unroll
        for (int a = 0; a < 2; ++a)
#pragma unroll
            for (int b = 0; b < 2; ++b)
#pragma unroll
                for (int m = 0; m < 4; ++m)
#pragma unroll
                    for (int n = 0; n < 2; ++n) acc[a][b][m][n] = AccSel<I8>::zero();
        cur = nxt; cA = nA; cB = nB; ++ui;
        if constexpr (ALIGN_EPI) { if (wr == 1) PG8_BAR; }
    }
    PG8_WAIT_V(0);
    if constexpr (!ALIGN_EPI) { if (wr == 0) PG8_BAR; }
    PG8_BAR;
    if constexpr (Epi::AFTER_DRAIN) { E.fused(acc, cur, wr, wc, fr, fq, lds, wid, lane); S.done(cur); }
#undef PG8_SA
#undef PG8_SB
#undef PG8_STAGE
#undef PG8_LDA
#undef PG8_LDB
#undef PG8_MMA
#undef PG8_WAIT_V
#undef PG8_WAIT_L
#undef PG8_BAR
#undef PG8_SCHED
}
}

constexpr int NWAVES = 8;
constexpr int NPHASES = 12;
#ifndef MK_N_LAUNCHES
#define MK_N_LAUNCHES 1
#endif
constexpr int N_LAUNCHES = MK_N_LAUNCHES;
static_assert(N_LAUNCHES == 1 || N_LAUNCHES == NPHASES, "MK_N_LAUNCHES is 1 or NPHASES");

constexpr int BATCH = 16, SEQ = 2048, D = 1024, M = BATCH * SEQ;
constexpr int IN_W = 2304, O_Q = 0, O_K = 512, O_V = 640, O_B = 768, O_C = 1280, O_U = 1792;
constexpr int NQH = 8, NKVH = 2, HD = 64, WIN = 128;
constexpr int NKEYS = 128, NEXP = 16384, PH = 8, TOPK = 16, DKEY = 256, DHALF = 128, QW = PH * DKEY;
constexpr int ADA_W = 6 * D, ADA_KC = 8;
constexpr float EPS = 1e-6f;

constexpr size_t MiB = 1u << 20;
constexpr size_t WS_CTL = 0, CTL_ZERO_BYTES = 64 * 1024;
constexpr size_t WS_ADAP = 1 * MiB;
constexpr size_t WS_ADA = 4 * MiB;
constexpr size_t WS_WIN = 5 * MiB;
constexpr size_t WS_WOUT = 10 * MiB;
constexpr size_t WS_WQ = 12 * MiB;
constexpr size_t WS_K1 = 16 * MiB, WS_K2 = 16 * MiB + 512 * 1024;
constexpr size_t WS_U = 17 * MiB, WS_V = 33 * MiB;
constexpr float U_SCALE = 896.f, V_SCALE = 8.f, WQ_SCALE = 896.f;
constexpr size_t WS_H = 81 * MiB;
constexpr size_t WS_PROJ = 145 * MiB;
constexpr size_t WS_MIX = 289 * MiB;
constexpr size_t WS_IDX = 353 * MiB;
constexpr size_t WS_GATE = 369 * MiB;
constexpr size_t WS_H8 = 49 * MiB;
constexpr size_t WS_HS = 393 * MiB;
constexpr size_t WS_W16 = 385 * MiB;
constexpr size_t WS_X1 = 417 * MiB;
constexpr size_t WS_END = 481 * MiB;
constexpr size_t WS_PA = WS_PROJ;
constexpr size_t WS_SS = WS_MIX;
constexpr int CW_BAR = 4096;
static_assert((CW_BAR + 3456) * 4 <= (int)CTL_ZERO_BYTES, "barrier words inside the zeroed region");

constexpr int RING_OFF = 0, RING_BYTES = 131072;
constexpr int LDSCTL_OFF = 135168, MISC_OFF = LDSCTL_OFF + 320;
constexpr int LDS_BYTES = 147456;
static_assert(MISC_OFF + 128 <= LDS_BYTES, "LDS map");

#define GAS __attribute__((address_space(1)))
#define LAS __attribute__((address_space(3)))
typedef unsigned short bf16;
typedef unsigned v4u __attribute__((ext_vector_type(4)));
typedef float f32x4 __attribute__((ext_vector_type(4)));
typedef short bf16x8 __attribute__((ext_vector_type(8)));
typedef GAS unsigned gu32;
typedef GAS unsigned long long gu64;
#define RLX_AGENT __ATOMIC_RELAXED, __HIP_MEMORY_SCOPE_AGENT
#define LDS_WAIT() asm volatile("s_waitcnt lgkmcnt(0)" ::: "memory")
#define VM_WAIT() asm volatile("s_waitcnt vmcnt(0)" ::: "memory")
__device__ __forceinline__ unsigned long long rt() { return __builtin_amdgcn_s_memrealtime(); }
__device__ __forceinline__ unsigned f2bf(float f) { unsigned u = __builtin_bit_cast(unsigned, f); return (u + 0x7fffu + ((u >> 16) & 1u)) >> 16; }
__device__ __forceinline__ unsigned pk2(float lo, float hi) { return f2bf(lo) | (f2bf(hi) << 16); }

#define XB_TMO      128
#define XB_XCNT(j)  (256  + 64 * (j))
#define XB_XSUB(j)  (1280 + 64 * (j))
#define XB_XGEN(j)  (2304 + 64 * (j))
#define XB_TOP      3328
#define XB_TOPGEN   3392
#define XCD_BAR_WORDS 3456
#define XB_SPIN_CAP (1u << 22)

__device__ __forceinline__ unsigned xb_ld(unsigned* p)              { return __hip_atomic_load(p, __ATOMIC_RELAXED, __HIP_MEMORY_SCOPE_AGENT); }
__device__ __forceinline__ unsigned xb_add(unsigned* p, unsigned v) { return __hip_atomic_fetch_add(p, v, __ATOMIC_RELAXED, __HIP_MEMORY_SCOPE_AGENT); }
__device__ __forceinline__ unsigned xb_xcc_id() { return (unsigned)__builtin_amdgcn_s_getreg((3 << 11) | 20) & 0xFu; }
#define XB_SPIN(cond, bar) do { unsigned _sp = 0; while (cond) { __builtin_amdgcn_s_sleep(1); \
    if ((++_sp & 255u) == 0u) { if (xb_ld(&(bar)[XB_TMO])) break; if (_sp > XB_SPIN_CAP) { atomicAdd(&(bar)[XB_TMO], 1u); break; } } } } while (0)

struct XcdBarrier {
    unsigned* bar; unsigned x;
    volatile LAS unsigned* st;
};

__device__ __forceinline__ XcdBarrier xcd_barrier_post(unsigned* bar, volatile LAS unsigned* st) {
    XcdBarrier b; b.bar = bar; b.x = xb_xcc_id(); b.st = st;
    if (threadIdx.x == 0) (void)xb_add(&bar[XB_XCNT(b.x)], 1u);
    return b;
}
__device__ __forceinline__ void xcd_barrier_complete(unsigned* bar, unsigned x, unsigned& nloc, unsigned& nx) {
    const unsigned G = gridDim.x * gridDim.y * gridDim.z;
    unsigned sum, cnt, mine, sp = 0u;
    for (;;) {
        sum = 0u; cnt = 0u; mine = 0u;
#pragma unroll
        for (unsigned j = 0; j < 16; ++j) { const unsigned c = xb_ld(&bar[XB_XCNT(j)]); sum += c; cnt += (c > 0u) ? 1u : 0u; mine = (j == x) ? c : mine; }
        if (sum == G) break;
        __builtin_amdgcn_s_sleep(1);
        if ((++sp & 255u) == 0u) { if (xb_ld(&bar[XB_TMO])) break; if (sp > XB_SPIN_CAP) { atomicAdd(&bar[XB_TMO], 1u); break; } }
    }
    nloc = mine > 0u ? mine : 1u; nx = cnt > 0u ? cnt : 1u;
}

__device__ __forceinline__ void xcd_barrier(const XcdBarrier& b) {
    asm volatile("s_waitcnt vmcnt(0)" ::: "memory");
    __syncthreads();
    if (threadIdx.x == 0) {
        unsigned* bar = b.bar;
        __builtin_amdgcn_s_waitcnt(0);
        unsigned nloc = b.st[0], nx = b.st[1];
        if (nloc == 0u) { xcd_barrier_complete(bar, b.x, nloc, nx); b.st[0] = nloc; b.st[1] = nx; }
        const unsigned old = xb_add(&bar[XB_XSUB(b.x)], 1u);
        const unsigned gen = old / nloc;
        if (old + 1u == (gen + 1u) * nloc) {
            __builtin_amdgcn_fence(__ATOMIC_RELEASE, "agent");
            asm volatile("s_waitcnt vmcnt(0)" ::: "memory");
            const unsigned og = xb_add(&bar[XB_TOP], 1u);
            const unsigned tg = og / nx;
            if (og + 1u == (tg + 1u) * nx) xb_add(&bar[XB_TOPGEN], 1u);
            else XB_SPIN(xb_ld(&bar[XB_TOPGEN]) == tg, bar);
            __builtin_amdgcn_fence(__ATOMIC_ACQUIRE, "agent");
            xb_add(&bar[XB_XGEN(b.x)], 1u);
            asm volatile("s_waitcnt vmcnt(0)" ::: "memory");
        } else {
            XB_SPIN(xb_ld(&bar[XB_XGEN(b.x)]) == gen, bar);
            __builtin_amdgcn_fence(__ATOMIC_ACQUIRE, "agent");
            asm volatile("s_waitcnt vmcnt(0)" ::: "memory");
        }
    }
    __syncthreads();
}

struct Frame {
    LAS unsigned char* lds;
    volatile LAS unsigned* MISC;
    gu32* ctl;
    int tid, lane, wave;
    int vcu, G;
    const float* in[20]; float* out; unsigned char* ws;
};
#define IN_X 0
#define IN_C 1
#define IN_WADA 2
#define IN_BADA 3
#define IN_G1 4
#define IN_WIN 5
#define IN_BIN 6
#define IN_SINK 7
#define IN_CONVW 8
#define IN_AOG 9
#define IN_COG 10
#define IN_WOUT 11
#define IN_BOUT 12
#define IN_G2 13
#define IN_WQ 14
#define IN_PK1 15
#define IN_PK2 16
#define IN_PU 17
#define IN_PV 18
#define IN_GF 19

typedef __bf16 bf16x2_t __attribute__((ext_vector_type(2)));
typedef unsigned v2u __attribute__((ext_vector_type(2)));
__device__ __forceinline__ float dot2(unsigned a, unsigned b, float acc) { return __builtin_amdgcn_fdot2_f32_bf16(__builtin_bit_cast(bf16x2_t, a), __builtin_bit_cast(bf16x2_t, b), acc, false); }
__device__ __forceinline__ float dot8(v4u a, v4u b, float acc) { acc = dot2(a.x, b.x, acc); acc = dot2(a.y, b.y, acc); acc = dot2(a.z, b.z, acc); acc = dot2(a.w, b.w, acc); return acc; }
__device__ __forceinline__ float bflo(unsigned w) { return __uint_as_float(w << 16); }
__device__ __forceinline__ float bfhi(unsigned w) { return __uint_as_float(w & 0xffff0000u); }
__device__ __forceinline__ float wave_sum(float v) {
#pragma unroll
    for (int o = 1; o < 64; o <<= 1) v += __shfl_xor(v, o);
    return v;
}
__device__ __forceinline__ unsigned wave_umax(unsigned v) {
#pragma unroll
    for (int o = 1; o < 64; o <<= 1) { const unsigned t = (unsigned)__shfl_xor((int)v, o); v = v > t ? v : t; }
    return v;
}
__device__ __forceinline__ unsigned f2ord(float f) { const unsigned u = __float_as_uint(f); return (u & 0x80000000u) ? ~u : (u | 0x80000000u); }
__device__ __forceinline__ float ord2f(unsigned u) { return __uint_as_float((u & 0x80000000u) ? (u & 0x7fffffffu) : ~u); }

__device__ __forceinline__ unsigned pk4_i8(f32x4 a, float sc) {
    const int q0 = max(-127, min(127, __float2int_rn(a.x * sc))), q1 = max(-127, min(127, __float2int_rn(a.y * sc))), q2 = max(-127, min(127, __float2int_rn(a.z * sc))), q3 = max(-127, min(127, __float2int_rn(a.w * sc)));
    return (unsigned)(q0 & 0xff) | ((unsigned)(q1 & 0xff) << 8) | ((unsigned)(q2 & 0xff) << 16) | ((unsigned)q3 << 24); }
__device__ __forceinline__ void p0_transpose_item(const float* W, int K, int N, bf16* WT, LAS float* scr, int item, int lane) {
    const int nblk = N / 64, kb = item / nblk, nb = item % nblk, k0 = 64 * kb, n0 = 64 * nb;
#pragma unroll 16
    for (int kk = 0; kk < 64; ++kk) scr[kk * 65 + lane] = __builtin_nontemporal_load(W + (size_t)(k0 + kk) * N + n0 + lane);
    LDS_WAIT(); asm volatile("" ::: "memory");
    const int c = lane & 7;
#pragma unroll
    for (int j = 0; j < 8; ++j) { const int n = (lane >> 3) + 8 * j; const LAS float* s = scr + (8 * c) * 65 + n;
        v4u o; o.x = pk2(s[0 * 65], s[1 * 65]); o.y = pk2(s[2 * 65], s[3 * 65]); o.z = pk2(s[4 * 65], s[5 * 65]); o.w = pk2(s[6 * 65], s[7 * 65]);
        *(GAS v4u*)(WT + (size_t)(n0 + n) * K + k0 + 8 * c) = o; }
    LDS_WAIT(); asm volatile("" ::: "memory");
}
__device__ __forceinline__ void p0_transpose_item_i8(const float* W, int K, int N, unsigned char* WT, LAS float* scr, int item, int lane, float sc) {
    const int nblk = N / 64, kb = item / nblk, nb = item % nblk, k0 = 64 * kb, n0 = 64 * nb;
#pragma unroll 16
    for (int kk = 0; kk < 64; ++kk) scr[kk * 65 + lane] = __builtin_nontemporal_load(W + (size_t)(k0 + kk) * N + n0 + lane);
    LDS_WAIT(); asm volatile("" ::: "memory");
    const int c = lane & 7;
#pragma unroll
    for (int j = 0; j < 8; ++j) { const int n = (lane >> 3) + 8 * j; const LAS float* s = scr + (8 * c) * 65 + n;
        v2u o; o.x = pk4_i8((f32x4){s[0 * 65], s[1 * 65], s[2 * 65], s[3 * 65]}, sc); o.y = pk4_i8((f32x4){s[4 * 65], s[5 * 65], s[6 * 65], s[7 * 65]}, sc);
        *(GAS v2u*)(WT + (size_t)(n0 + n) * K + k0 + 8 * c) = o; }
    LDS_WAIT(); asm volatile("" ::: "memory");
}
__device__ __forceinline__ void p0_convert_item(const float* src, bf16* dst, size_t item, int lane) {
    const GAS f32x4* s = (const GAS f32x4*)(src + item * 2048) + lane * 2;
    GAS v4u* d = (GAS v4u*)(dst + item * 2048) + lane;
#pragma unroll
    for (int j = 0; j < 4; ++j) { const f32x4 a = s[j * 128], b = s[j * 128 + 1];
        v4u o; o.x = pk2(a.x, a.y); o.y = pk2(a.z, a.w); o.z = pk2(b.x, b.y); o.w = pk2(b.z, b.w); d[j * 64] = o; }
}
__device__ __forceinline__ unsigned pk4_fp8(f32x4 a, float sc) { int w = __builtin_amdgcn_cvt_pk_fp8_f32(a.x * sc, a.y * sc, 0, false); w = __builtin_amdgcn_cvt_pk_fp8_f32(a.z * sc, a.w * sc, w, true); return (unsigned)w; }
__device__ __forceinline__ void p0_convert_item_i8(const float* src, unsigned char* dst, size_t item, int lane, float sc) {
    const GAS f32x4* s = (const GAS f32x4*)(src + item * 4096) + lane * 4;
#pragma unroll
    for (int j = 0; j < 4; ++j) { v4u o; o.x = pk4_i8(__builtin_nontemporal_load(s + j * 256), sc); o.y = pk4_i8(__builtin_nontemporal_load(s + j * 256 + 1), sc); o.z = pk4_i8(__builtin_nontemporal_load(s + j * 256 + 2), sc); o.w = pk4_i8(__builtin_nontemporal_load(s + j * 256 + 3), sc);
        pg8::store16_wt(pg8::wt_rsrc(dst, (size_t)NEXP * D), (unsigned)((size_t)(lane >> 3) * NEXP * 128 + (item * 4 + j) * 128 + (lane & 7) * 16), o); }
}
__device__ __forceinline__ void p0_convert_item_fp8(const float* src, unsigned char* dst, size_t item, int lane, float sc) {
    const GAS f32x4* s = (const GAS f32x4*)(src + item * 4096) + lane * 4;
#pragma unroll
    for (int j = 0; j < 4; ++j) { v4u o; o.x = pk4_fp8(__builtin_nontemporal_load(s + j * 256), sc); o.y = pk4_fp8(__builtin_nontemporal_load(s + j * 256 + 1), sc); o.z = pk4_fp8(__builtin_nontemporal_load(s + j * 256 + 2), sc); o.w = pk4_fp8(__builtin_nontemporal_load(s + j * 256 + 3), sc);
        pg8::store16_wt(pg8::wt_rsrc(dst, (size_t)NEXP * D), (unsigned)((size_t)(lane >> 3) * NEXP * 128 + (item * 4 + j) * 128 + (lane & 7) * 16), o); }
}
__device__ __forceinline__ void p0_ada_task(Frame& F, int task, LAS float* scr) {
    const int kc = task / (ADA_W / 64), ng = task % (ADA_W / 64), lane = F.lane;
    const float* c = F.in[IN_C];
    for (int e = lane; e < BATCH * 128; e += 64) { const int b = e >> 7, kk = e & 127; const float cv = c[b * D + kc * 128 + kk]; scr[kk * 16 + b] = cv / (1.f + expf(-cv)); }
    LDS_WAIT(); asm volatile("" ::: "memory");
    float acc[BATCH];
#pragma unroll
    for (int b = 0; b < BATCH; ++b) acc[b] = 0.f;
    const float* wp = F.in[IN_WADA] + (size_t)(kc * 128) * ADA_W + ng * 64 + lane;
#pragma unroll 1
    for (int k0 = 0; k0 < 128; k0 += 16) { float wv[16];
#pragma unroll
        for (int u = 0; u < 16; ++u) wv[u] = __builtin_nontemporal_load(wp + (size_t)(k0 + u) * ADA_W);
#pragma unroll
        for (int u = 0; u < 16; ++u) { const LAS f32x4* sp = (const LAS f32x4*)(scr + (k0 + u) * 16);
#pragma unroll
            for (int q = 0; q < 4; ++q) { const f32x4 s = sp[q]; acc[4 * q] += s.x * wv[u]; acc[4 * q + 1] += s.y * wv[u]; acc[4 * q + 2] += s.z * wv[u]; acc[4 * q + 3] += s.w * wv[u]; } } }
    float* ap = (float*)(F.ws + WS_ADAP);
#pragma unroll
    for (int b = 0; b < BATCH; ++b) ap[(size_t)(kc * BATCH + b) * ADA_W + ng * 64 + lane] = acc[b];
    LDS_WAIT(); asm volatile("" ::: "memory");
}
__device__ __forceinline__ void p0_prologue(Frame& F) {
    LAS float* scr = (LAS float*)(F.lds + RING_OFF + F.wave * 16896);
    const int gw = F.vcu * NWAVES + F.wave, NGW = F.G * NWAVES;
    constexpr int I_ADA = ADA_KC * (ADA_W / 64);
    constexpr int I_T1 = (D / 64) * (IN_W / 64), I_T2 = (D / 64) * (D / 64), I_T3 = (D / 64) * (QW / 64);
    constexpr int I_K = PH * NKEYS * DHALF / 2048;
    constexpr int I_E = (int)((size_t)NEXP * D / 4096);
    constexpr int NITEMS = I_ADA + I_T1 + I_T2 + I_T3 + 2 * I_K + 2 * I_E;
    for (int it = gw; it < NITEMS; it += NGW) {
        int r = it;
        if (r < I_ADA) { p0_ada_task(F, r, scr); continue; } r -= I_ADA;
        if (r < I_T1) { p0_transpose_item_i8(F.in[IN_WIN], D, IN_W, F.ws + WS_WIN, scr, r, F.lane, WQ_SCALE); continue; } r -= I_T1;
        if (r < I_T2) { p0_transpose_item(F.in[IN_WOUT], D, D, (bf16*)(F.ws + WS_WOUT), scr, r, F.lane); continue; } r -= I_T2;
        if (r < I_T3) { p0_transpose_item_i8(F.in[IN_WQ], D, QW, F.ws + WS_WQ, scr, r, F.lane, WQ_SCALE); continue; } r -= I_T3;
        if (r < I_K) { p0_convert_item(F.in[IN_PK1], (bf16*)(F.ws + WS_K1), r, F.lane); continue; } r -= I_K;
        if (r < I_K) { p0_convert_item(F.in[IN_PK2], (bf16*)(F.ws + WS_K2), r, F.lane); continue; } r -= I_K;
        if (r < I_E) { p0_convert_item_i8(F.in[IN_PU], F.ws + WS_U, r, F.lane, U_SCALE); continue; } r -= I_E;
        p0_convert_item_fp8(F.in[IN_PV], F.ws + WS_V, r, F.lane, V_SCALE);
    }
}

__device__ __forceinline__ void mod_row(const float* xrow, bf16* orow, const LAS float* SC, const LAS float* SH, int lane) {
    const GAS f32x4* xr = (const GAS f32x4*)xrow + lane;
    f32x4 v[4]; float s = 0.f;
#pragma unroll
    for (int j = 0; j < 4; ++j) { v[j] = xr[64 * j]; s += (v[j].x * v[j].x + v[j].y * v[j].y) + (v[j].z * v[j].z + v[j].w * v[j].w); }
    const float rstd = 1.0f / sqrtf(wave_sum(s) * (1.f / D) + EPS);
    GAS unsigned long long* o8 = (GAS unsigned long long*)orow + lane;
#pragma unroll
    for (int j = 0; j < 4; ++j) { const f32x4 sc = ((const LAS f32x4*)SC)[lane + 64 * j], sh = ((const LAS f32x4*)SH)[lane + 64 * j];
        const f32x4 o = v[j] * rstd * sc + sh;
        o8[64 * j] = (unsigned long long)pk2(o.x, o.y) | ((unsigned long long)pk2(o.z, o.w) << 32); }
}
__device__ __forceinline__ void mod_row_bf(const bf16* xrow, bf16* orow, const LAS float* SC, const LAS float* SH, int lane) {
    const GAS v2u* xr = (const GAS v2u*)xrow + lane;
    f32x4 v[4]; float s = 0.f;
#pragma unroll
    for (int j = 0; j < 4; ++j) { const v2u w = xr[64 * j]; v[j] = (f32x4){bflo(w.x), bfhi(w.x), bflo(w.y), bfhi(w.y)}; s += (v[j].x * v[j].x + v[j].y * v[j].y) + (v[j].z * v[j].z + v[j].w * v[j].w); }
    const float rstd = 1.0f / sqrtf(wave_sum(s) * (1.f / D) + EPS);
    GAS unsigned long long* o8 = (GAS unsigned long long*)orow + lane;
#pragma unroll
    for (int j = 0; j < 4; ++j) { const f32x4 sc = ((const LAS f32x4*)SC)[lane + 64 * j], sh = ((const LAS f32x4*)SH)[lane + 64 * j];
        const f32x4 o = v[j] * rstd * sc + sh;
        o8[64 * j] = (unsigned long long)pk2(o.x, o.y) | ((unsigned long long)pk2(o.z, o.w) << 32); }
}
__device__ __forceinline__ void mod_load(const float* xrow, int lane, f32x4 (&v)[4]) { const GAS f32x4* xr = (const GAS f32x4*)xrow + lane;
#pragma unroll
    for (int j = 0; j < 4; ++j) v[j] = __builtin_nontemporal_load(xr + 64 * j); }
__device__ __forceinline__ void mod_load_bf(const bf16* xrow, int lane, f32x4 (&v)[4]) { const GAS v2u* xr = (const GAS v2u*)xrow + lane;
#pragma unroll
    for (int j = 0; j < 4; ++j) { const v2u w = xr[64 * j]; v[j] = (f32x4){bflo(w.x), bfhi(w.x), bflo(w.y), bfhi(w.y)}; } }
template <bool I8> __device__ __forceinline__ void mod_finish(const f32x4 (&v)[4], bf16* orow, unsigned char* o8row, float* hs_out, const LAS float* SC, const LAS float* SH, int lane) {
    float s = 0.f;
#pragma unroll
    for (int j = 0; j < 4; ++j) s += (v[j].x * v[j].x + v[j].y * v[j].y) + (v[j].z * v[j].z + v[j].w * v[j].w);
    const float rstd = 1.0f / sqrtf(wave_sum(s) * (1.f / D) + EPS);
    f32x4 o[4]; float am = 0.f;
#pragma unroll
    for (int j = 0; j < 4; ++j) { const f32x4 sc = ((const LAS f32x4*)SC)[lane + 64 * j], sh = ((const LAS f32x4*)SH)[lane + 64 * j]; o[j] = v[j] * rstd * sc + sh;
        am = fmaxf(am, fmaxf(fmaxf(fabsf(o[j].x), fabsf(o[j].y)), fmaxf(fabsf(o[j].z), fabsf(o[j].w)))); }
    if (!I8) { GAS unsigned long long* o8 = (GAS unsigned long long*)orow + lane;
#pragma unroll
        for (int j = 0; j < 4; ++j) o8[64 * j] = (unsigned long long)pk2(o[j].x, o[j].y) | ((unsigned long long)pk2(o[j].z, o[j].w) << 32);
    } else {
#pragma unroll
        for (int off = 1; off < 64; off <<= 1) am = fmaxf(am, __shfl_xor(am, off));
        const float qs = am > 0.f ? 127.f / am : 0.f;
#pragma unroll
        for (int j = 0; j < 4; ++j) ((GAS unsigned*)o8row)[lane + 64 * j] = pk4_i8(o[j], qs);
        if (lane == 0) *hs_out = am * (1.f / 127.f); }
}
__device__ __forceinline__ void p1_hpass(Frame& F) {
    LAS float* SC = (LAS float*)(F.lds); LAS float* SH = SC + D;
    const float* adap = (const float*)(F.ws + WS_ADAP); const float* bada = F.in[IN_BADA]; const float* g1 = F.in[IN_G1];
    float* ada = (float*)(F.ws + WS_ADA);
    for (int e = blockIdx.x * 512 + F.tid; e < BATCH * ADA_W; e += F.G * 512) { const int b = e / ADA_W, n = e % ADA_W; float s = bada[n];
#pragma unroll
        for (int kc = 0; kc < ADA_KC; ++kc) s += adap[(size_t)(kc * BATCH + b) * ADA_W + n];
        ada[e] = s; }
    for (int tile = blockIdx.x; tile < M / 128; tile += F.G) {
        const int b = tile / (SEQ / 128);
        for (int d = F.tid; d < D; d += 512) { float sh = bada[d], sc = bada[D + d];
#pragma unroll
            for (int kc = 0; kc < ADA_KC; ++kc) { const float* p = adap + (size_t)(kc * BATCH + b) * ADA_W; sh += p[d]; sc += p[D + d]; }
            SC[d] = g1[d] * (1.f + sc); SH[d] = sh; }
        __syncthreads();
        { f32x4 va[4], vb[4];
          mod_load(F.in[IN_X] + ((size_t)tile * 128 + F.wave) * D, F.lane, va);
#pragma unroll 1
          for (int r = F.wave; r < 128; r += 2 * NWAVES) { const size_t row = (size_t)tile * 128 + r;
              mod_load(F.in[IN_X] + (row + NWAVES) * D, F.lane, vb);
              mod_finish<true>(va, nullptr, F.ws + WS_H8 + row * D, (float*)(F.ws + WS_HS) + row, SC, SH, F.lane);
              if (r + 2 * NWAVES < 128) mod_load(F.in[IN_X] + (row + 2 * NWAVES) * D, F.lane, va);
              mod_finish<true>(vb, nullptr, F.ws + WS_H8 + (row + NWAVES) * D, (float*)(F.ws + WS_HS) + (row + NWAVES), SC, SH, F.lane); } }
        __syncthreads();
    }
}
__device__ __forceinline__ void p5_h2pass(Frame& F) {
    LAS float* SC = (LAS float*)(F.lds); LAS float* SH = SC + D;
    const float* ada = (const float*)(F.ws + WS_ADA); const float* g2 = F.in[IN_G2];
    for (int tile = blockIdx.x; tile < M / 128; tile += F.G) {
        const int b = tile / (SEQ / 128);
        for (int d = F.tid; d < D; d += 512) { SC[d] = g2[d] * (1.f + ada[(size_t)b * ADA_W + 4 * D + d]); SH[d] = ada[(size_t)b * ADA_W + 3 * D + d]; }
        __syncthreads();
        { f32x4 va[4], vb[4]; const bf16* X1 = (const bf16*)(F.ws + WS_X1);
          mod_load_bf(X1 + ((size_t)tile * 128 + F.wave) * D, F.lane, va);
#pragma unroll 1
          for (int r = F.wave; r < 128; r += 2 * NWAVES) { const size_t row = (size_t)tile * 128 + r;
              mod_load_bf(X1 + (row + NWAVES) * D, F.lane, vb);
              mod_finish<true>(va, (bf16*)(F.ws + WS_H) + row * D, F.ws + WS_H8 + row * D, (float*)(F.ws + WS_HS) + row, SC, SH, F.lane);
              if (r + 2 * NWAVES < 128) mod_load_bf(X1 + (row + 2 * NWAVES) * D, F.lane, va);
              mod_finish<true>(vb, (bf16*)(F.ws + WS_H) + (row + NWAVES) * D, F.ws + WS_H8 + (row + NWAVES) * D, (float*)(F.ws + WS_HS) + (row + NWAVES), SC, SH, F.lane); } }
        __syncthreads();
    }
}

typedef float f32x16 __attribute__((ext_vector_type(16)));
typedef short s16x4 __attribute__((ext_vector_type(4)));
typedef __bf16 bf16x8_t __attribute__((ext_vector_type(8)));
#define MFMA32(a, b, c) __builtin_amdgcn_mfma_f32_32x32x16_bf16((a), (b), (c), 0, 0, 0)
constexpr int KS = 144, VS = 192;
__device__ __forceinline__ void p3_attn_unit(Frame& F, int unit) {
    const int kh = unit & 1, nb = (unit >> 1) & 15, b = unit >> 5;
    LAS unsigned char* KL = F.lds; LAS unsigned char* VL = F.lds + 256 * KS;
    const bf16* proj = (const bf16*)(F.ws + WS_PROJ);
    const int tok0 = b * SEQ + nb * 128;
    for (int c = F.tid; c < 2048; c += 512) { const int j = c >> 3, ch = c & 7;
        v4u kv = (v4u){0u, 0u, 0u, 0u}, vv = (v4u){0u, 0u, 0u, 0u};
        if (nb > 0 || j >= 128) { const bf16* rowp = proj + (size_t)(tok0 - 128 + j) * IN_W; kv = *(const GAS v4u*)(rowp + O_K + kh * HD + ch * 8); vv = *(const GAS v4u*)(rowp + O_V + kh * HD + ch * 8); }
        *(LAS v4u*)(KL + j * KS + ch * 16) = kv; *(LAS v4u*)(VL + j * VS + ch * 16) = vv; }
    __syncthreads();
    const int lane = F.lane, r = lane & 31, hh = lane >> 5;
#pragma unroll 1
    for (int task = F.wave; task < 16; task += NWAVES) {
        const int g = task >> 2, w = task & 3, qh = kh * 4 + g, i0 = 32 * w;
        const bf16* qp = proj + (size_t)(tok0 + i0 + r) * IN_W + O_Q + qh * HD + 8 * hh;
        bf16x8 qf[4];
#pragma unroll
        for (int s = 0; s < 4; ++s) qf[s] = *(const GAS bf16x8*)(qp + 16 * s);
        f32x16 sc[5];
#pragma unroll
        for (int t = 0; t < 5; ++t) {
#pragma unroll
            for (int e = 0; e < 16; ++e) sc[t][e] = 0.f;
#pragma unroll
            for (int s = 0; s < 4; ++s) { const bf16x8 a = *(const LAS bf16x8*)(KL + ((w + t) * 32 + r) * KS + 32 * s + 16 * hh); sc[t] = MFMA32(a, qf[s], sc[t]); } }
        const float sink = F.in[IN_SINK][qh];
        float mx = sink;
#pragma unroll
        for (int t = 0; t < 5; ++t)
#pragma unroll
            for (int e = 0; e < 16; ++e) { const int kr = (e & 3) + 8 * (e >> 2) + 4 * hh;
                bool valid = (nb > 0) || (w + t >= 4);
                if (t == 0) valid = valid && (kr > r);
                if (t == 4) valid = valid && (kr <= r);
                const float v = valid ? sc[t][e] * 0.125f : -1e30f; sc[t][e] = v; mx = fmaxf(mx, v); }
        mx = fmaxf(mx, __shfl_xor(mx, 32));
        float lsum = 0.f;
#pragma unroll
        for (int t = 0; t < 5; ++t)
#pragma unroll
            for (int e = 0; e < 16; ++e) { const float p = __expf(sc[t][e] - mx); sc[t][e] = p; lsum += p; }
        lsum += __shfl_xor(lsum, 32); lsum += __expf(sink - mx);
        f32x16 o[2];
#pragma unroll
        for (int dt = 0; dt < 2; ++dt)
#pragma unroll
            for (int e = 0; e < 16; ++e) o[dt][e] = 0.f;
        const int q4 = (r & 15) >> 2, p4 = r & 3;
#pragma unroll
        for (int t = 0; t < 5; ++t)
#pragma unroll
            for (int sp = 0; sp < 2; ++sp) {
                bf16x8_t pbv;
#pragma unroll
                for (int e = 0; e < 8; ++e) pbv[e] = (__bf16)sc[t][8 * sp + e];
                const bf16x8 pb = __builtin_bit_cast(bf16x8, pbv);
#pragma unroll
                for (int dt = 0; dt < 2; ++dt) {
                    const int kb = (w + t) * 32 + 16 * sp + 4 * hh;
                    const LAS unsigned char* ap = VL + (kb + q4) * VS + (32 * dt + 16 * (r >> 4) + 4 * p4) * 2;
                    const s16x4 lo = __builtin_amdgcn_ds_read_tr16_b64_v4i16((LAS s16x4*)ap);
                    const s16x4 hi = __builtin_amdgcn_ds_read_tr16_b64_v4i16((LAS s16x4*)(ap + 8 * VS));
                    const bf16x8 a = __builtin_shufflevector(lo, hi, 0, 1, 2, 3, 4, 5, 6, 7);
                    o[dt] = MFMA32(a, pb, o[dt]); } }
        const float inv = 1.f / lsum; float ss = 0.f;
#pragma unroll
        for (int dt = 0; dt < 2; ++dt)
#pragma unroll
            for (int e = 0; e < 16; ++e) { o[dt][e] *= inv; ss += o[dt][e] * o[dt][e]; }
        ss += __shfl_xor(ss, 32);
        const float rs = 1.0f / sqrtf(ss * (1.f / HD) + EPS);
        const float* gp = F.in[IN_AOG] + qh * HD;
        bf16* op = (bf16*)(F.ws + WS_MIX) + (size_t)(tok0 + i0 + r) * D + qh * HD;
#pragma unroll
        for (int dt = 0; dt < 2; ++dt)
#pragma unroll
            for (int g4 = 0; g4 < 4; ++g4) { const int d0 = 32 * dt + 8 * g4 + 4 * hh; const f32x4 gv = *(const f32x4*)(gp + d0);
                v2u wv; wv.x = pk2(o[dt][4 * g4 + 0] * rs * gv.x, o[dt][4 * g4 + 1] * rs * gv.y); wv.y = pk2(o[dt][4 * g4 + 2] * rs * gv.z, o[dt][4 * g4 + 3] * rs * gv.w);
                *(GAS v2u*)(op + d0) = wv; }
    }
    __syncthreads();
}
__device__ __forceinline__ void p3_conv(Frame& F) {
    const bf16* proj = (const bf16*)(F.ws + WS_PROJ); const int lane = F.lane, c0 = 8 * lane;
    const float* cw = F.in[IN_CONVW]; const float* cg = F.in[IN_COG];
    float w0[8], w1[8], w2[8], gg[8];
#pragma unroll
    for (int e = 0; e < 8; ++e) { w0[e] = cw[c0 + e]; w1[e] = cw[512 + c0 + e]; w2[e] = cw[1024 + c0 + e]; gg[e] = cg[c0 + e]; }
    const int gw = F.vcu * NWAVES + F.wave, NGW = F.G * NWAVES;
    for (int tok = gw; tok < M; tok += NGW) {
        const int s = tok & (SEQ - 1); const bf16* rp = proj + (size_t)tok * IN_W;
        const v4u z4 = (v4u){0u, 0u, 0u, 0u};
        const v4u Bv = *(const GAS v4u*)(rp + O_B + c0), C0 = *(const GAS v4u*)(rp + O_C + c0), U0 = *(const GAS v4u*)(rp + O_U + c0);
        v4u C1 = z4, U1 = z4, C2 = z4, U2 = z4;
        if (s >= 1) { C1 = *(const GAS v4u*)(rp - IN_W + O_C + c0); U1 = *(const GAS v4u*)(rp - IN_W + O_U + c0); }
        if (s >= 2) { C2 = *(const GAS v4u*)(rp - 2 * IN_W + O_C + c0); U2 = *(const GAS v4u*)(rp - 2 * IN_W + O_U + c0); }
        float y[8]; float ss = 0.f;
#pragma unroll
        for (int e = 0; e < 8; ++e) { const int wi = e >> 1; const bool hi = e & 1;
            const unsigned bw = Bv[wi], c0w = C0[wi], u0w = U0[wi], c1w = C1[wi], u1w = U1[wi], c2w = C2[wi], u2w = U2[wi];
            const float bb = hi ? bfhi(bw) : bflo(bw);
            const float z0 = (hi ? bfhi(c0w) : bflo(c0w)) * (hi ? bfhi(u0w) : bflo(u0w));
            const float z1 = (hi ? bfhi(c1w) : bflo(c1w)) * (hi ? bfhi(u1w) : bflo(u1w));
            const float z2 = (hi ? bfhi(c2w) : bflo(c2w)) * (hi ? bfhi(u2w) : bflo(u2w));
            y[e] = bb * (z2 * w0[e] + z1 * w1[e] + z0 * w2[e]); ss += y[e] * y[e]; }
        ss += __shfl_xor(ss, 1); ss += __shfl_xor(ss, 2); ss += __shfl_xor(ss, 4);
        const float rs = 1.0f / sqrtf(ss * (1.f / 64.f) + EPS);
        v4u w; w.x = pk2(y[0] * rs * gg[0], y[1] * rs * gg[1]); w.y = pk2(y[2] * rs * gg[2], y[3] * rs * gg[3]);
        w.z = pk2(y[4] * rs * gg[4], y[5] * rs * gg[5]); w.w = pk2(y[6] * rs * gg[6], y[7] * rs * gg[7]);
        pg8::store16_wt(pg8::wt_rsrc(F.ws + WS_MIX, (size_t)M * D * 2), (unsigned)(((size_t)tok * D + 512 + c0) * 2), w);
    }
}
__device__ __forceinline__ void p3_mixer(Frame& F) {
    for (int unit = blockIdx.x; unit < BATCH * 16 * NKVH; unit += F.G) p3_attn_unit(F, unit);
    p3_conv(F);
}

#define DI __device__ __forceinline__
#define CE_(i, j) { const unsigned x_ = a[i], y_ = a[j]; a[i] = x_ > y_ ? x_ : y_; a[j] = x_ > y_ ? y_ : x_; }
DI void sort16_desc(unsigned (&a)[16]) {
    CE_(0,13) CE_(1,12) CE_(2,15) CE_(3,14) CE_(4,8) CE_(5,6) CE_(7,11) CE_(9,10)
    CE_(0,5) CE_(1,7) CE_(2,9) CE_(3,4) CE_(6,13) CE_(8,14) CE_(10,15) CE_(11,12)
    CE_(0,1) CE_(2,3) CE_(4,5) CE_(6,8) CE_(7,9) CE_(10,11) CE_(12,13) CE_(14,15)
    CE_(0,2) CE_(1,3) CE_(4,10) CE_(5,11) CE_(6,7) CE_(8,9) CE_(12,14) CE_(13,15)
    CE_(1,2) CE_(3,12) CE_(4,6) CE_(5,7) CE_(8,10) CE_(9,11) CE_(13,14)
    CE_(1,4) CE_(2,6) CE_(5,8) CE_(7,10) CE_(9,13) CE_(11,14)
    CE_(2,4) CE_(3,6) CE_(9,12) CE_(11,13)
    CE_(3,5) CE_(6,8) CE_(7,9) CE_(10,12)
    CE_(3,4) CE_(5,6) CE_(7,8) CE_(9,10) CE_(11,12)
    CE_(6,7) CE_(8,9)
}
DI void bitonic_merge16_desc(unsigned (&a)[16]) {
#pragma unroll
    for (int js = 3; js >= 0; --js) {
#pragma unroll
        for (int i = 0; i < 16; ++i) { const int j = 1 << js, l = i ^ j;
            if (l > i) { const unsigned x = a[i], y = a[l]; a[i] = x > y ? x : y; a[l] = x > y ? y : x; } }
    }
}
DI void merge_top16(unsigned (&a)[16], const unsigned (&b)[16]) {
#pragma unroll
    for (int i = 0; i < 16; ++i) { const unsigned x = a[i], y = b[15 - i]; a[i] = x > y ? x : y; }
    bitonic_merge16_desc(a);
}
DI void top16_of_64(unsigned (&g0)[16], unsigned (&g1)[16], unsigned (&g2)[16], unsigned (&g3)[16]) {
    sort16_desc(g0); sort16_desc(g1); sort16_desc(g2); sort16_desc(g3);
    merge_top16(g0, g1); merge_top16(g2, g3); merge_top16(g0, g2);
}
#define SBIAS 8.0f
DI unsigned skey(float biased) { return __float_as_uint(fmaxf(biased, 0.f)); }
constexpr int KEY_STRIDE = 272;
DI void route_scores_top16(const LAS unsigned char* KL, const bf16* qrow, int r, int hh, unsigned (&out)[16]) {
    bf16x8 qf[8];
#pragma unroll
    for (int s = 0; s < 8; ++s) qf[s] = *(const GAS bf16x8*)(qrow + 16 * s);
    f32x16 acc[4];
#pragma unroll
    for (int t = 0; t < 4; ++t)
#pragma unroll
        for (int e = 0; e < 16; ++e) acc[t][e] = SBIAS;
#pragma unroll
    for (int t = 0; t < 4; ++t)
#pragma unroll
        for (int s = 0; s < 8; ++s) { const bf16x8 a = *(const LAS bf16x8*)(KL + (t * 32 + r) * KEY_STRIDE + 32 * s + 16 * hh); acc[t] = MFMA32(a, qf[s], acc[t]); }
    unsigned g0[16], g1[16], g2[16], g3[16];
    const unsigned pb = (unsigned)(127 - 4 * hh);
#pragma unroll
    for (int e = 0; e < 16; ++e) { const unsigned p = pb - (unsigned)((e & 3) + 8 * (e >> 2));
        g0[e] = (skey(acc[0][e]) & ~127u) | p; g1[e] = (skey(acc[1][e]) & ~127u) | (p - 32u); g2[e] = (skey(acc[2][e]) & ~127u) | (p - 64u); g3[e] = (skey(acc[3][e]) & ~127u) | (p - 96u); }
    top16_of_64(g0, g1, g2, g3);
    unsigned oth[16];
#pragma unroll
    for (int i = 0; i < 16; ++i) oth[i] = (unsigned)__shfl_xor((int)g0[i], 32);
    merge_top16(g0, oth);
#pragma unroll
    for (int i = 0; i < 16; ++i) out[i] = g0[i];
}
DI void p7_route_tile(Frame& F, int tok0, int h, const LAS unsigned char* KL1, const LAS unsigned char* KL2, LAS unsigned char* scr) {
    const int lane = F.lane, r = lane & 31, hh = lane >> 5;
    const bf16* qrow = (const bf16*)(F.ws + WS_PROJ) + (size_t)(tok0 + r) * QW + h * DKEY + 8 * hh;
    unsigned t1[16], t2[16];
    route_scores_top16(KL1, qrow, r, hh, t1);
    route_scores_top16(KL2, qrow + DHALF, r, hh, t2);
    { v4u w;
#pragma unroll
      for (int q = 0; q < 4; ++q) { unsigned x = 0u;
#pragma unroll
          for (int bq = 0; bq < 4; ++bq) { const unsigned k = hh ? t2[4 * q + bq] : t1[4 * q + bq]; x |= (127u - (k & 127u)) << (8 * bq); }
          w[q] = x; }
      *(LAS v4u*)(scr + r * 32 + hh * 16) = w; }
    float v1[16], v2[16];
#pragma unroll
    for (int i = 0; i < 16; ++i) { v1[i] = __uint_as_float(t1[i] & ~127u); v2[i] = __uint_as_float(t2[i] & ~127u) - SBIAS; }
    unsigned c0[16], c1[16];
    { const float sa = v1[0] + v2[0], sb = v1[2] + v2[1]; c0[0] = (__float_as_uint(fmaxf(hh ? sb : sa, 0.f)) & ~255u) | (hh ? 222u : 255u); }
    { const float sa = v1[0] + v2[1], sb = v1[2] + v2[2]; c0[1] = (__float_as_uint(fmaxf(hh ? sb : sa, 0.f)) & ~255u) | (hh ? 221u : 254u); }
    { const float sa = v1[0] + v2[2], sb = v1[2] + v2[3]; c0[2] = (__float_as_uint(fmaxf(hh ? sb : sa, 0.f)) & ~255u) | (hh ? 220u : 253u); }
    { const float sa = v1[0] + v2[3], sb = v1[2] + v2[4]; c0[3] = (__float_as_uint(fmaxf(hh ? sb : sa, 0.f)) & ~255u) | (hh ? 219u : 252u); }
    { const float sa = v1[0] + v2[4], sb = v1[3] + v2[0]; c0[4] = (__float_as_uint(fmaxf(hh ? sb : sa, 0.f)) & ~255u) | (hh ? 207u : 251u); }
    { const float sa = v1[0] + v2[5], sb = v1[3] + v2[1]; c0[5] = (__float_as_uint(fmaxf(hh ? sb : sa, 0.f)) & ~255u) | (hh ? 206u : 250u); }
    { const float sa = v1[0] + v2[6], sb = v1[3] + v2[2]; c0[6] = (__float_as_uint(fmaxf(hh ? sb : sa, 0.f)) & ~255u) | (hh ? 205u : 249u); }
    { const float sa = v1[0] + v2[7], sb = v1[3] + v2[3]; c0[7] = (__float_as_uint(fmaxf(hh ? sb : sa, 0.f)) & ~255u) | (hh ? 204u : 248u); }
    { const float sa = v1[0] + v2[8], sb = v1[4] + v2[0]; c0[8] = (__float_as_uint(fmaxf(hh ? sb : sa, 0.f)) & ~255u) | (hh ? 191u : 247u); }
    { const float sa = v1[0] + v2[9], sb = v1[4] + v2[1]; c0[9] = (__float_as_uint(fmaxf(hh ? sb : sa, 0.f)) & ~255u) | (hh ? 190u : 246u); }
    { const float sa = v1[0] + v2[10], sb = v1[4] + v2[2]; c0[10] = (__float_as_uint(fmaxf(hh ? sb : sa, 0.f)) & ~255u) | (hh ? 189u : 245u); }
    { const float sa = v1[0] + v2[11], sb = v1[5] + v2[0]; c0[11] = (__float_as_uint(fmaxf(hh ? sb : sa, 0.f)) & ~255u) | (hh ? 175u : 244u); }
    { const float sa = v1[0] + v2[12], sb = v1[5] + v2[1]; c0[12] = (__float_as_uint(fmaxf(hh ? sb : sa, 0.f)) & ~255u) | (hh ? 174u : 243u); }
    { const float sa = v1[0] + v2[13], sb = v1[6] + v2[0]; c0[13] = (__float_as_uint(fmaxf(hh ? sb : sa, 0.f)) & ~255u) | (hh ? 159u : 242u); }
    { const float sa = v1[0] + v2[14], sb = v1[6] + v2[1]; c0[14] = (__float_as_uint(fmaxf(hh ? sb : sa, 0.f)) & ~255u) | (hh ? 158u : 241u); }
    { const float sa = v1[0] + v2[15], sb = v1[7] + v2[0]; c0[15] = (__float_as_uint(fmaxf(hh ? sb : sa, 0.f)) & ~255u) | (hh ? 143u : 240u); }
    { const float sa = v1[1] + v2[0], sb = v1[7] + v2[1]; c1[0] = (__float_as_uint(fmaxf(hh ? sb : sa, 0.f)) & ~255u) | (hh ? 142u : 239u); }
    { const float sa = v1[1] + v2[1], sb = v1[8] + v2[0]; c1[1] = (__float_as_uint(fmaxf(hh ? sb : sa, 0.f)) & ~255u) | (hh ? 127u : 238u); }
    { const float sa = v1[1] + v2[2], sb = v1[9] + v2[0]; c1[2] = (__float_as_uint(fmaxf(hh ? sb : sa, 0.f)) & ~255u) | (hh ? 111u : 237u); }
    { const float sa = v1[1] + v2[3], sb = v1[10] + v2[0]; c1[3] = (__float_as_uint(fmaxf(hh ? sb : sa, 0.f)) & ~255u) | (hh ? 95u : 236u); }
    { const float sa = v1[1] + v2[4], sb = v1[11] + v2[0]; c1[4] = (__float_as_uint(fmaxf(hh ? sb : sa, 0.f)) & ~255u) | (hh ? 79u : 235u); }
    { const float sa = v1[1] + v2[5], sb = v1[12] + v2[0]; c1[5] = (__float_as_uint(fmaxf(hh ? sb : sa, 0.f)) & ~255u) | (hh ? 63u : 234u); }
    { const float sa = v1[1] + v2[6], sb = v1[13] + v2[0]; c1[6] = (__float_as_uint(fmaxf(hh ? sb : sa, 0.f)) & ~255u) | (hh ? 47u : 233u); }
    { const float sa = v1[1] + v2[7], sb = v1[14] + v2[0]; c1[7] = (__float_as_uint(fmaxf(hh ? sb : sa, 0.f)) & ~255u) | (hh ? 31u : 232u); }
    { const float sa = v1[2] + v2[0], sb = v1[15] + v2[0]; c1[8] = (__float_as_uint(fmaxf(hh ? sb : sa, 0.f)) & ~255u) | (hh ? 15u : 223u); }
    c1[9] = 0u;
    c1[10] = 0u;
    c1[11] = 0u;
    c1[12] = 0u;
    c1[13] = 0u;
    c1[14] = 0u;
    c1[15] = 0u;
    sort16_desc(c0); sort16_desc(c1); merge_top16(c0, c1);
    { unsigned oth[16];
#pragma unroll
      for (int i = 0; i < 16; ++i) oth[i] = (unsigned)__shfl_xor((int)c0[i], 32);
      merge_top16(c0, oth); }
    const float mx = __uint_as_float(c0[0] & ~255u);
    LDS_WAIT(); asm volatile("" ::: "memory");
    float ex[8]; int ee[8]; float part = 0.f;
#pragma unroll
    for (int k = 0; k < 8; ++k) { const unsigned key = hh ? c0[8 + k] : c0[k]; const int ci = 255 - (int)(key & 255u);
        const int e1 = *(const LAS unsigned char*)(scr + r * 32 + (ci >> 4)), e2 = *(const LAS unsigned char*)(scr + r * 32 + 16 + (ci & 15));
        ee[k] = (e1 * NKEYS + e2) & (NEXP - 1); ex[k] = __expf(__uint_as_float(key & ~255u) - mx); part += ex[k]; }
    const float inv = 1.f / (part + __shfl_xor(part, 32));
    { const unsigned oo = (unsigned)(((size_t)(tok0 + r) * 128 + h * TOPK + 8 * hh) * 4);
      const __amdgpu_buffer_rsrc_t ir = pg8::wt_rsrc(F.ws + WS_IDX, (size_t)M * 128 * 4), gr = pg8::wt_rsrc(F.ws + WS_GATE, (size_t)M * 128 * 4);
      pg8::store16_wt(ir, oo, (v4u){(unsigned)ee[0], (unsigned)ee[1], (unsigned)ee[2], (unsigned)ee[3]}); pg8::store16_wt(ir, oo + 16, (v4u){(unsigned)ee[4], (unsigned)ee[5], (unsigned)ee[6], (unsigned)ee[7]});
      pg8::store16_wt(gr, oo, (v4u){__float_as_uint(ex[0] * inv), __float_as_uint(ex[1] * inv), __float_as_uint(ex[2] * inv), __float_as_uint(ex[3] * inv)});
      pg8::store16_wt(gr, oo + 16, (v4u){__float_as_uint(ex[4] * inv), __float_as_uint(ex[5] * inv), __float_as_uint(ex[6] * inv), __float_as_uint(ex[7] * inv)}); }
    asm volatile("" ::: "memory");
}
__device__ __forceinline__ void p7_routing(Frame& F) {
    LAS unsigned char* KL1 = F.lds; LAS unsigned char* KL2 = F.lds + 128 * KEY_STRIDE; LAS unsigned char* scr = F.lds + 2 * 128 * KEY_STRIDE + F.wave * 1024;
    const bf16* k1 = (const bf16*)(F.ws + WS_K1); const bf16* k2 = (const bf16*)(F.ws + WS_K2);
    int cur_h = -1;
    for (int item = blockIdx.x; item < (M / 256) * PH; item += F.G) {
        const int h = item & (PH - 1), tile = item >> 3;
        if (h != cur_h) {
            __syncthreads();
            for (int c = F.tid; c < 2 * 128 * 16; c += 512) { const int which = c >> 11, rr = (c >> 4) & 127, ch = c & 15;
                const v4u v = *(const GAS v4u*)((which ? k2 : k1) + (size_t)(h * NKEYS + rr) * DHALF + ch * 8);
                *(LAS v4u*)((which ? KL2 : KL1) + rr * KEY_STRIDE + ch * 16) = v; }
            __syncthreads();
            cur_h = h;
        }
        p7_route_tile(F, tile * 256 + F.wave * 32, h, KL1, KL2, scr);
    }
}

__device__ __forceinline__ float gelu_erf(float v) { return 0.5f * v * (1.f + erff(v * 0.70710678118654752f)); }
typedef float f32x2v __attribute__((ext_vector_type(2)));
__device__ __forceinline__ unsigned fp8x2_bf16x2(unsigned w, bool hi) { return hi ? __builtin_bit_cast(unsigned, __builtin_amdgcn_cvt_scalef32_pk_bf16_fp8((int)w, 1.0f, true)) : __builtin_bit_cast(unsigned, __builtin_amdgcn_cvt_scalef32_pk_bf16_fp8((int)w, 1.0f, false)); }
__device__ __forceinline__ float dot16_fp8(v4u u, v4u ha, v4u hb, float acc) {
    acc = dot2(fp8x2_bf16x2(u.x, false), ha.x, acc); acc = dot2(fp8x2_bf16x2(u.x, true), ha.y, acc);
    acc = dot2(fp8x2_bf16x2(u.y, false), ha.z, acc); acc = dot2(fp8x2_bf16x2(u.y, true), ha.w, acc);
    acc = dot2(fp8x2_bf16x2(u.z, false), hb.x, acc); acc = dot2(fp8x2_bf16x2(u.z, true), hb.y, acc);
    acc = dot2(fp8x2_bf16x2(u.w, false), hb.z, acc); acc = dot2(fp8x2_bf16x2(u.w, true), hb.w, acc);
    return acc;
}
struct SliceWork { int j0, nj, t0, ts; };
__device__ __forceinline__ SliceWork slice_work(const Frame& F) { SliceWork w;
    if ((F.G & 7) == 0) { w.j0 = blockIdx.x & 7; w.nj = 1; w.t0 = (blockIdx.x >> 3) * NWAVES + F.wave; w.ts = F.G; }
    else { w.j0 = 0; w.nj = 8; w.t0 = blockIdx.x * NWAVES + F.wave; w.ts = F.G * NWAVES; }
    return w; }
struct USet { v4u hq; float hs; v4u u[16]; };
struct UMeta { v2u id; v4u hh; float hs; };
__device__ __forceinline__ UMeta p8a_G(const int* IDX, const unsigned char* H8, const float* HS, int t, int j, int lane) { UMeta m;
    m.id = *(const GAS v2u*)(IDX + (size_t)t * 128 + 2 * lane); m.hh = *(const GAS v4u*)(H8 + (size_t)t * D + 128 * j + 16 * (lane & 7)); m.hs = HS[t]; return m; }
__device__ __forceinline__ void p8a_S(LAS unsigned char* mb, const UMeta& m, int lane) { *(LAS v2u*)(mb + 8 * lane) = m.id; if (lane < 8) *(LAS v4u*)(mb + 512 + 16 * lane) = m.hh; }
__device__ __forceinline__ void p8a_RT(const LAS unsigned char* mb, const unsigned char* Ub, int c, int g, float hs, USet& s) {
    v4u ix[4];
#pragma unroll
    for (int q = 0; q < 4; ++q) ix[q] = *(const LAS v4u*)(mb + 64 * g + 16 * q);
    s.hq = *(const LAS v4u*)(mb + 512 + 16 * c); s.hs = hs;
#pragma unroll
    for (int i = 0; i < 16; ++i) s.u[i] = *(const GAS v4u*)(Ub + (unsigned)((ix[i >> 2][i & 3] << 7) + 16u * (unsigned)c)); }
__device__ __forceinline__ void p8a_compute(const USet& s, bf16* pa_row, int lane, int c) {
    int p[16];
#pragma unroll
    for (int i = 0; i < 16; ++i) { int a = __builtin_amdgcn_sdot4((int)s.u[i].x, (int)s.hq.x, 0, false); a = __builtin_amdgcn_sdot4((int)s.u[i].y, (int)s.hq.y, a, false);
        a = __builtin_amdgcn_sdot4((int)s.u[i].z, (int)s.hq.z, a, false); p[i] = __builtin_amdgcn_sdot4((int)s.u[i].w, (int)s.hq.w, a, false); }
#pragma unroll
    for (int i = 0; i < 8; ++i) { const bool up = c & 4; const int send = up ? p[i] : p[i + 8], keep = up ? p[i + 8] : p[i]; p[i] = keep + __builtin_amdgcn_update_dpp(0, send, 0x141, 0xf, 0xf, true); }
#pragma unroll
    for (int i = 0; i < 4; ++i) { const bool up = c & 2; const int send = up ? p[i] : p[i + 4], keep = up ? p[i + 4] : p[i]; p[i] = keep + __builtin_amdgcn_update_dpp(0, send, 0x4E, 0xf, 0xf, true); }
#pragma unroll
    for (int i = 0; i < 2; ++i) { const bool up = c & 1; const int send = up ? p[i] : p[i + 2], keep = up ? p[i + 2] : p[i]; p[i] = keep + __builtin_amdgcn_update_dpp(0, send, 0xB1, 0xf, 0xf, true); }
    const float sc = s.hs * (1.f / U_SCALE);
    ((GAS unsigned*)pa_row)[lane] = pk2((float)p[0] * sc, (float)p[1] * sc);
}
__device__ __forceinline__ void p8a_udots(Frame& F) {
    const unsigned char* H8 = F.ws + WS_H8; const float* HS = (const float*)(F.ws + WS_HS); const int* IDX = (const int*)(F.ws + WS_IDX); bf16* PA = (bf16*)(F.ws + WS_PA);
    const int lane = F.lane, c = lane & 7, g = lane >> 3; const SliceWork sw = slice_work(F);
    LAS unsigned char* mb = F.lds + F.wave * 1024;
    if (sw.t0 >= M) return;
    const int nt = (M - 1 - sw.t0) / sw.ts + 1;
#define TOK(n) (sw.t0 + ((n) < nt ? (n) : nt - 1) * sw.ts)
    for (int jj = 0; jj < sw.nj; ++jj) { const int j = sw.j0 + jj; const unsigned char* Uj = F.ws + WS_U + (size_t)j * NEXP * 128;
        USet sA, sB, sC;
        UMeta mN = p8a_G(IDX, H8, HS, TOK(0), j, lane); p8a_S(mb, mN, lane); p8a_RT(mb, Uj, c, g, mN.hs, sA);
        mN = p8a_G(IDX, H8, HS, TOK(1), j, lane); p8a_S(mb, mN, lane); p8a_RT(mb, Uj, c, g, mN.hs, sB);
        mN = p8a_G(IDX, H8, HS, TOK(2), j, lane);
#define P8A_STAGE(k, SN, SC_) do { p8a_S(mb, mN, lane); p8a_RT(mb, Uj, c, g, mN.hs, SN); mN = p8a_G(IDX, H8, HS, TOK((k) + 3), j, lane); asm volatile("" ::: "memory"); \
            if ((k) < nt) p8a_compute(SC_, PA + ((size_t)j * M + TOK(k)) * 128, lane, c); asm volatile("" ::: "memory"); } while (0)
#pragma unroll 1
        for (int n = 0; n < nt; n += 3) {
            P8A_STAGE(n, sC, sA);
            P8A_STAGE(n + 1, sA, sB);
            P8A_STAGE(n + 2, sB, sC);
        }
#undef P8A_STAGE
    }
}
typedef _Float16 h2_t __attribute__((ext_vector_type(2)));
__device__ __forceinline__ h2_t cvt_h2_lo(int w) { return __builtin_bit_cast(h2_t, __builtin_amdgcn_cvt_scalef32_pk_f16_fp8(w, 1.0f, false)); }
__device__ __forceinline__ h2_t cvt_h2_hi(int w) { return __builtin_bit_cast(h2_t, __builtin_amdgcn_cvt_scalef32_pk_f16_fp8(w, 1.0f, true)); }
__device__ __forceinline__ void p8w_weights(Frame& F) {
    const bf16* PA = (const bf16*)(F.ws + WS_PA); float* GATE = (float*)(F.ws + WS_GATE);
    for (size_t e = (size_t)blockIdx.x * 512 + F.tid; e < (size_t)M * 128 / 4; e += (size_t)F.G * 512) {
        f32x4 s = (f32x4){0.f, 0.f, 0.f, 0.f};
#pragma unroll
        for (int j = 0; j < 8; ++j) { const v2u w = __builtin_nontemporal_load((const GAS v2u*)(PA + (size_t)j * M * 128 + 4 * e)); s += (f32x4){bflo(w.x), bfhi(w.x), bflo(w.y), bfhi(w.y)}; }
        const f32x4 gt = *(const GAS f32x4*)(GATE + 4 * e); f32x4 o;
#pragma unroll
        for (int q = 0; q < 4; ++q) o[q] = gt[q] * gelu_erf(s[q]);
        const h2_t w01 = (h2_t){(_Float16)o[0], (_Float16)o[1]}, w23 = (h2_t){(_Float16)o[2], (_Float16)o[3]};
        *(GAS v2u*)((_Float16*)(F.ws + WS_W16) + 4 * e) = (v2u){__builtin_bit_cast(unsigned, w01), __builtin_bit_cast(unsigned, w23)}; }
}
template <int HI> __device__ __forceinline__ h2_t pkfma_bw(h2_t a, unsigned w, h2_t c) { h2_t d;
    if (HI) asm("v_pk_fma_f16 %0, %1, %2, %3 op_sel:[0,1,0] op_sel_hi:[1,1,1]" : "=v"(d) : "v"(a), "v"(w), "v"(c));
    else asm("v_pk_fma_f16 %0, %1, %2, %3 op_sel:[0,0,0] op_sel_hi:[1,0,1]" : "=v"(d) : "v"(a), "v"(w), "v"(c));
    return d; }
template <int HI> __device__ __forceinline__ h2_t pkmul_bw(h2_t a, unsigned w) { h2_t d;
    if (HI) asm("v_pk_mul_f16 %0, %1, %2 op_sel:[0,1] op_sel_hi:[1,1]" : "=v"(d) : "v"(a), "v"(w));
    else asm("v_pk_mul_f16 %0, %1, %2 op_sel:[0,0] op_sel_hi:[1,0]" : "=v"(d) : "v"(a), "v"(w));
    return d; }
struct VSet { v4u v[16]; };
struct VMeta { v2u id; unsigned w; };
__device__ __forceinline__ VMeta p8b_G(const int* IDX, const _Float16* W, int t, int lane) { VMeta m;
    m.id = *(const GAS v2u*)(IDX + (size_t)t * 128 + 2 * lane); m.w = *(const GAS unsigned*)(W + (size_t)t * 128 + 2 * lane); return m; }
__device__ __forceinline__ void p8b_S(LAS unsigned char* mb, const VMeta& m, int lane) { *(LAS v2u*)(mb + 8 * lane) = m.id; *(LAS unsigned*)(mb + 512 + 4 * lane) = m.w; }
__device__ __forceinline__ void p8b_RT(Frame& F, const LAS unsigned char* mb, const unsigned char* Vj, int t, int j, int c, int g, VSet& s) {
    v4u ix[4];
#pragma unroll
    for (int q = 0; q < 4; ++q) ix[q] = *(const LAS v4u*)(mb + 64 * g + 16 * q);
#pragma unroll
    for (int i = 0; i < 16; ++i) s.v[i] = *(const GAS v4u*)(Vj + (unsigned)((ix[i >> 2][i & 3] << 7) + 16u * (unsigned)c)); }
__device__ __forceinline__ void p8b_step(Frame& F, const LAS unsigned char* mb, const LAS unsigned char* mbc, const unsigned char* Vj, int tn, VSet& sn, const VSet& sc, int tc, int j, int lane, int c, int g, bool do_compute) {
    v4u ix[4];
#pragma unroll
    for (int q = 0; q < 4; ++q) ix[q] = *(const LAS v4u*)(mb + 64 * g + 16 * q);
    const v4u wh0 = *(const LAS v4u*)(mbc + 512 + 32 * g), wh1 = *(const LAS v4u*)(mbc + 512 + 32 * g + 16);
    h2_t ah[8];
#pragma unroll
    for (int i = 0; i < 16; ++i) {
        sn.v[i] = *(const GAS v4u*)(Vj + (unsigned)((ix[i >> 2][i & 3] << 7) + 16u * (unsigned)c));
        const v4u v = sc.v[i]; const unsigned wu = (i >> 3) ? wh1[(i >> 1) & 3] : wh0[(i >> 1) & 3];
        if (i == 0) { ah[0] = pkmul_bw<0>(cvt_h2_lo((int)v.x), wu); ah[1] = pkmul_bw<0>(cvt_h2_hi((int)v.x), wu); ah[2] = pkmul_bw<0>(cvt_h2_lo((int)v.y), wu); ah[3] = pkmul_bw<0>(cvt_h2_hi((int)v.y), wu);
            ah[4] = pkmul_bw<0>(cvt_h2_lo((int)v.z), wu); ah[5] = pkmul_bw<0>(cvt_h2_hi((int)v.z), wu); ah[6] = pkmul_bw<0>(cvt_h2_lo((int)v.w), wu); ah[7] = pkmul_bw<0>(cvt_h2_hi((int)v.w), wu); }
        else if (i & 1) { ah[0] = pkfma_bw<1>(cvt_h2_lo((int)v.x), wu, ah[0]); ah[1] = pkfma_bw<1>(cvt_h2_hi((int)v.x), wu, ah[1]); ah[2] = pkfma_bw<1>(cvt_h2_lo((int)v.y), wu, ah[2]); ah[3] = pkfma_bw<1>(cvt_h2_hi((int)v.y), wu, ah[3]);
            ah[4] = pkfma_bw<1>(cvt_h2_lo((int)v.z), wu, ah[4]); ah[5] = pkfma_bw<1>(cvt_h2_hi((int)v.z), wu, ah[5]); ah[6] = pkfma_bw<1>(cvt_h2_lo((int)v.w), wu, ah[6]); ah[7] = pkfma_bw<1>(cvt_h2_hi((int)v.w), wu, ah[7]); }
        else { ah[0] = pkfma_bw<0>(cvt_h2_lo((int)v.x), wu, ah[0]); ah[1] = pkfma_bw<0>(cvt_h2_hi((int)v.x), wu, ah[1]); ah[2] = pkfma_bw<0>(cvt_h2_lo((int)v.y), wu, ah[2]); ah[3] = pkfma_bw<0>(cvt_h2_hi((int)v.y), wu, ah[3]);
            ah[4] = pkfma_bw<0>(cvt_h2_lo((int)v.z), wu, ah[4]); ah[5] = pkfma_bw<0>(cvt_h2_hi((int)v.z), wu, ah[5]); ah[6] = pkfma_bw<0>(cvt_h2_lo((int)v.w), wu, ah[6]); ah[7] = pkfma_bw<0>(cvt_h2_hi((int)v.w), wu, ah[7]); }
        asm volatile("" ::: "memory"); }
    if (!do_compute) return;
    asm volatile("s_nop 1");
#pragma unroll
    for (int m = 0; m < 4; ++m) { const auto r = __builtin_amdgcn_permlane32_swap(__builtin_bit_cast(unsigned, ah[m]), __builtin_bit_cast(unsigned, ah[m + 4]), false, false);
        ah[m] = __builtin_bit_cast(h2_t, (unsigned)r[0]) + __builtin_bit_cast(h2_t, (unsigned)r[1]); }
#pragma unroll
    for (int m = 0; m < 2; ++m) { const auto r = __builtin_amdgcn_permlane16_swap(__builtin_bit_cast(unsigned, ah[m]), __builtin_bit_cast(unsigned, ah[m + 2]), false, false);
        ah[m] = __builtin_bit_cast(h2_t, (unsigned)r[0]) + __builtin_bit_cast(h2_t, (unsigned)r[1]); }
    { const bool up = lane & 8;
      const h2_t s0 = ah[0] + __builtin_bit_cast(h2_t, __builtin_amdgcn_update_dpp(0, __builtin_bit_cast(int, ah[0]), 0x128, 0xf, 0xf, true));
      const h2_t s1 = ah[1] + __builtin_bit_cast(h2_t, __builtin_amdgcn_update_dpp(0, __builtin_bit_cast(int, ah[1]), 0x128, 0xf, 0xf, true));
      ah[0] = up ? s1 : s0; }
    const f32x2v peer = (f32x2v){(float)ah[0].x, (float)ah[0].y} * (1.f / V_SCALE);
    *(GAS unsigned*)((bf16*)(F.ws + WS_H) + (size_t)tc * D + 128 * j + 16 * c + 2 * g) = pk2(peer.x, peer.y);
}
__device__ __forceinline__ void p8b_vsum(Frame& F) {
    const int* IDX = (const int*)(F.ws + WS_IDX); const _Float16* W = (const _Float16*)(F.ws + WS_W16);
    const int lane = F.lane, c = lane & 7, g = lane >> 3; const SliceWork sw = slice_work(F);
    LAS unsigned char* mb = F.lds + F.wave * 1024;
    if (sw.t0 >= M) return;
    const int nt = (M - 1 - sw.t0) / sw.ts + 1;
    for (int jj = 0; jj < sw.nj; ++jj) { const int j = sw.j0 + jj; const unsigned char* Vj = F.ws + WS_V + (size_t)j * NEXP * 128;
        VSet sA, sB, sC;
        LAS unsigned char* const pg0 = mb, * const pg1 = mb + 8192, * const pg2 = mb + 16384;
        VMeta mN = p8b_G(IDX, W, TOK(0), lane); p8b_S(pg0, mN, lane); p8b_RT(F, pg0, Vj, TOK(0), j, c, g, sA);
        mN = p8b_G(IDX, W, TOK(1), lane); p8b_S(pg1, mN, lane); p8b_RT(F, pg1, Vj, TOK(1), j, c, g, sB);
        mN = p8b_G(IDX, W, TOK(2), lane);
#define P8B_STAGE(k, SN, SC_, PN, PC) do { p8b_S(PN, mN, lane); mN = p8b_G(IDX, W, TOK((k) + 3), lane); \
            p8b_step(F, PN, PC, Vj, TOK((k) + 2), SN, SC_, TOK(k), j, lane, c, g, (k) < nt); asm volatile("" ::: "memory"); } while (0)
#pragma unroll 1
        for (int n = 0; n < nt; n += 3) {
            P8B_STAGE(n, sC, sA, pg2, pg0);
            P8B_STAGE(n + 1, sA, sB, pg0, pg1);
            P8B_STAGE(n + 2, sB, sC, pg1, pg2);
        }
#undef P8B_STAGE
    }
#undef TOK
}
__device__ __forceinline__ void p8c_final(Frame& F) {
    const float* gf = F.in[IN_GF]; const float* ada = (const float*)(F.ws + WS_ADA); const int lane = F.lane;
    f32x4 gv[4];
#pragma unroll
    for (int q = 0; q < 4; ++q) gv[q] = *(const f32x4*)(gf + 4 * lane + 256 * q);
    const bf16* X1 = (const bf16*)(F.ws + WS_X1); const bf16* PE = (const bf16*)(F.ws + WS_H);
    for (int t = blockIdx.x * NWAVES + F.wave; t < M; t += F.G * NWAVES) {
        const GAS v2u* xr = (const GAS v2u*)(X1 + (size_t)t * D) + lane; const GAS v2u* pr = (const GAS v2u*)(PE + (size_t)t * D) + lane;
        const float* g2 = ada + (size_t)(t / SEQ) * ADA_W + 5 * D + 4 * lane;
        f32x4 x2[4]; float s = 0.f;
#pragma unroll
        for (int q = 0; q < 4; ++q) { const v2u a = __builtin_nontemporal_load(xr + 64 * q), p = __builtin_nontemporal_load(pr + 64 * q); const f32x4 gg = *(const f32x4*)(g2 + 256 * q);
            x2[q] = (f32x4){bflo(a.x), bfhi(a.x), bflo(a.y), bfhi(a.y)} + gg * (f32x4){bflo(p.x), bfhi(p.x), bflo(p.y), bfhi(p.y)};
            s += (x2[q].x * x2[q].x + x2[q].y * x2[q].y) + (x2[q].z * x2[q].z + x2[q].w * x2[q].w); }
        const float rstd = 1.0f / sqrtf(wave_sum(s) * (1.f / D) + EPS);
        GAS f32x4* yr = (GAS f32x4*)(F.out + (size_t)t * D) + lane;
#pragma unroll
        for (int q = 0; q < 4; ++q) __builtin_nontemporal_store(x2[q] * rstd * gv[q], yr + 64 * q);
    }
}

struct Args { const float* in[20]; float* out; unsigned char* ws; int ph_lo, ph_hi, li, pad; };
__global__ void __launch_bounds__(NWAVES * 64, 2) skel_fwd(Args args) {
    extern __shared__ __attribute__((aligned(16))) unsigned char lds[];
    Frame F;
    F.lds = (LAS unsigned char*)lds;
    F.MISC = (volatile LAS unsigned*)(F.lds + MISC_OFF);
    F.tid = threadIdx.x; F.lane = F.tid & 63; F.wave = __builtin_amdgcn_readfirstlane(F.tid >> 6);
    F.G = gridDim.x; { const int bx = blockIdx.x; F.vcu = (F.G % 8 == 0) ? (bx % 8) * (F.G / 8) + bx / 8 : bx; }
    F.ws = args.ws; F.out = args.out;
#pragma unroll
    for (int i = 0; i < 20; ++i) F.in[i] = args.in[i];
    F.ctl = (gu32*)(args.ws + WS_CTL);
    for (int u = F.tid; u < (LDS_BYTES - LDSCTL_OFF) / 4; u += NWAVES * 64) ((LAS unsigned*)(F.lds + LDSCTL_OFF))[u] = 0u;
    __syncthreads();
    XcdBarrier bar; bar.bar = (unsigned*)(F.ctl + CW_BAR); bar.x = 0; bar.st = nullptr;
    if (N_LAUNCHES == 1) bar = xcd_barrier_post((unsigned*)(F.ctl + CW_BAR), F.MISC + 8);
#define GRID_BAR() do { if (N_LAUNCHES == 1) xcd_barrier(bar); } while (0)
    const int lo = args.ph_lo, hi = args.ph_hi;
#define IN(k) (lo <= (k) && (k) < hi)
    bf16* const H = (bf16*)(args.ws + WS_H); bf16* const PROJ = (bf16*)(args.ws + WS_PROJ); bf16* const MIX = (bf16*)(args.ws + WS_MIX);

    if (IN(0)) { p0_prologue(F); GRID_BAR(); }
    if (IN(1)) { p1_hpass(F); GRID_BAR(); }
    if (IN(2)) {
        pg8::Gemm g{(const bf16*)(args.ws + WS_H8), (const bf16*)(args.ws + WS_WIN), M, IN_W, D / 2}; pg8::StaticOrder S; S.init(M, IN_W, F.G, (int)blockIdx.x);
        pg8::EpiI8Bf16 E{PROJ, IN_W, (const float*)(args.ws + WS_HS), 1.f / WQ_SCALE, F.in[IN_BIN]};
        if ((int)blockIdx.x >= 128) { __builtin_amdgcn_s_sleep(127); __builtin_amdgcn_s_sleep(127); }
        pg8::gemm_phase<pg8::EpiI8Bf16, pg8::StaticOrder, true, true, true>(F.lds + RING_OFF, g, S, E);
        GRID_BAR();
    }
    if (IN(3)) { p3_mixer(F); GRID_BAR(); }
    if (IN(4)) {
        pg8::Gemm g{MIX, (const bf16*)(args.ws + WS_WOUT), M, D, D}; pg8::StaticOrder S; S.init(M, D, F.G, (int)blockIdx.x);
        pg8::EpiResGate E{F.in[IN_X], (bf16*)(args.ws + WS_X1), D, F.in[IN_BOUT], (const float*)(args.ws + WS_ADA), ADA_W, 2 * D, SEQ / 256};
        pg8::gemm_phase<pg8::EpiResGate, pg8::StaticOrder, true, true>(F.lds + RING_OFF, g, S, E);
        GRID_BAR();
    }
    if (IN(5)) { p5_h2pass(F); GRID_BAR(); }
    if (IN(6)) {
        pg8::Gemm g{(const bf16*)(args.ws + WS_H8), (const bf16*)(args.ws + WS_WQ), M, QW, D / 2}; pg8::StaticOrder S; S.init(M, QW, F.G, (int)blockIdx.x);
        pg8::EpiI8Bf16 E{PROJ, QW, (const float*)(args.ws + WS_HS), 1.f / WQ_SCALE, nullptr};
        pg8::gemm_phase<pg8::EpiI8Bf16, pg8::StaticOrder, true, true, true>(F.lds + RING_OFF, g, S, E);
        GRID_BAR();
    }
    if (IN(7)) { p7_routing(F); GRID_BAR(); }
    if (IN(8)) { p8a_udots(F); GRID_BAR(); }
    if (IN(9)) { p8w_weights(F); GRID_BAR(); }
    if (IN(10)) { p8b_vsum(F); GRID_BAR(); }
    if (IN(11)) { p8c_final(F); }
#undef IN
}

extern "C" void kernel_launch(void* const* d_in, const int* in_sizes, int n_in, void* d_out, int out_size, void* d_ws, size_t ws_size, hipStream_t stream) {
    static int grid = 0;
    if (grid == 0) {
        if (n_in != 20 || in_sizes[0] != M * D || out_size != M * D || ws_size < WS_END) { fprintf(stderr, "kernel_launch: unexpected shapes (n_in %d, in0 %d, out %d, ws %zu); nothing launched\n", n_in, n_in > 0 ? in_sizes[0] : -1, out_size, ws_size); grid = -1; return; }
        int dev = 0, cus = 0, per_cu = 0;
        if (hipGetDevice(&dev) != hipSuccess || hipDeviceGetAttribute(&cus, hipDeviceAttributeMultiprocessorCount, dev) != hipSuccess) { fprintf(stderr, "kernel_launch: device query failed\n"); grid = -1; return; }
        if (hipFuncSetAttribute((const void*)skel_fwd, hipFuncAttributeMaxDynamicSharedMemorySize, LDS_BYTES) != hipSuccess) { fprintf(stderr, "kernel_launch: hipFuncSetAttribute failed\n"); grid = -1; return; }
        if (hipOccupancyMaxActiveBlocksPerMultiprocessor(&per_cu, (const void*)skel_fwd, NWAVES * 64, LDS_BYTES) != hipSuccess || per_cu < 1)
            fprintf(stderr, "kernel_launch: note: occupancy query reports %d workgroups per CU\n", per_cu);
        (void)hipGetLastError();
        grid = cus;
    }
    if (grid < 0) return;
    if (hipMemsetAsync((char*)d_ws + WS_CTL, 0, CTL_ZERO_BYTES, stream) != hipSuccess) { fprintf(stderr, "kernel_launch: hipMemsetAsync failed\n"); return; }
    Args a{};
    for (int i = 0; i < 20; ++i) a.in[i] = (const float*)d_in[i];
    a.out = (float*)d_out; a.ws = (unsigned char*)d_ws;
    for (int li = 0; li < N_LAUNCHES; ++li) {
        a.ph_lo = (N_LAUNCHES == 1) ? 0 : li; a.ph_hi = (N_LAUNCHES == 1) ? NPHASES : li + 1; a.li = li;
        hipLaunchKernelGGL(skel_fwd, dim3(grid), dim3(NWAVES * 64), LDS_BYTES, stream, a);
        const hipError_t le = hipPeekAtLastError();
        if (le != hipSuccess) { fprintf(stderr, "kernel_launch: launch %d failed: %s\n", li, hipGetErrorName(le)); break; }
    }
}
```

```cpp
#include <hip/hip_runtime.h>
#include <cstdio>
#include <cstdint>
#include <cmath>
namespace pg8 {
#define PG8_LAS __attribute__((address_space(3)))
typedef unsigned short bf16_t;
typedef short bf16x8 __attribute__((ext_vector_type(8)));
typedef float f32x4 __attribute__((ext_vector_type(4)));
typedef unsigned u32x4 __attribute__((ext_vector_type(4)));
constexpr int BM = 256, BK = 64, HALF = 128, HTB = HALF * BK * 2  , STAGE_BYTES = 8 * HTB, NXCD = 8, WGM = 8;

__host__ __device__ __forceinline__ int lds_byte(int r, int c) { const int st = (r >> 4) * 2 + (c >> 5), rr = r & 15, cc = c & 31, ob = rr * 64 + cc * 2; return st * 1024 + (ob ^ (((ob >> 9) & 1) << 5)); }
__host__ __device__ __forceinline__ void stage_rc(int b, int& R, int& C) { const int st = b / 1024, sb = b % 1024, swz = sb ^ (((sb >> 9) & 1) << 5); R = (st >> 1) * 16 + swz / 64; C = (st & 1) * 32 + (swz % 64) / 2; }
__host__ __device__ __forceinline__ int perm32(int rho) { const int n = rho >> 4, i = rho & 15; return 8 * (i >> 2) + 4 * n + (i & 3); }

__device__ __forceinline__ __amdgpu_buffer_rsrc_t wt_rsrc(const void* base, size_t bytes) { return __builtin_amdgcn_make_buffer_rsrc((void*)base, 0, (int)bytes, 0x00020000); }
__device__ __forceinline__ void store16_wt(__amdgpu_buffer_rsrc_t r, unsigned off, u32x4 v) { __builtin_amdgcn_raw_buffer_store_b128(v, r, (int)off, 0, 16); }
struct Unit { int pm, pn; };
struct Gemm { const bf16_t* A; const bf16_t* Bt; int M, N, K; };

struct StaticOrder {
    int nM, nN, nwg, G, c;
    __host__ __device__ void init(int M, int N, int G_, int c_) { nM = M / BM; nN = N / BM; nwg = nM * nN; G = G_; c = c_; }
    __host__ __device__ __forceinline__ bool next(int i, Unit& u) const { return at((long)i * G + c, u); }
    __host__ __device__ __forceinline__ bool at(long L, Unit& u) const {
        if (L >= nwg) return false;
        int wgid = (int)L; { const int q = nwg / NXCD, r = nwg % NXCD, xcd = wgid % NXCD, off = wgid / NXCD; wgid = (xcd < r ? xcd * (q + 1) : r * (q + 1) + (xcd - r) * q) + off; }
        const int nig = WGM * nN, gid = wgid / nig, fm = gid * WGM, gsz = (nM - fm) < WGM ? (nM - fm) : WGM;
        u.pm = fm + ((wgid % nig) % gsz); u.pn = (wgid % nig) / gsz; return true;
    }
    __host__ __device__ __forceinline__ int part(int) const { return 0; }
    __device__ __forceinline__ void a_ready(const Unit&) const {}
    __device__ __forceinline__ void done(const Unit&) const {}
};

struct StagOrder {
    StaticOrder base; int R, E, grpB, pair; bool on;
    __host__ __device__ void init(int M, int N, int G_, int c_) { base.init(M, N, G_, c_); R = base.nwg / G_; E = base.nwg - R * G_; on = (G_ % 16 == 0) && R >= 1 && (E == 0 || E == G_ / 2);
        const int slot = c_ >> 3; grpB = slot & 1; pair = (slot >> 1) * 8 + (c_ & 7); }
    __host__ __device__ __forceinline__ bool next(int i, Unit& u) const {
        if (!on) return base.next(i, u);
        if (E) {
            if (!grpB) return i < R ? base.next(i, u) : (i == R ? base.at((long)R * base.G + pair, u) : false);
            return i == 0 ? base.at((long)R * base.G + pair, u) : (i <= R ? base.next(i - 1, u) : false);
        }
        if (!grpB || i < R) return base.next(i, u);
        return i == R ? base.next(0, u) : false;
    }
    __host__ __device__ __forceinline__ int part(int i) const {
        if (!on) return 0;
        if (E) return grpB ? (i == 0 ? 2 : 0) : (i == R ? 1 : 0);
        return grpB ? (i == 0 ? 1 : (i == R ? 2 : 0)) : 0;
    }
    __device__ __forceinline__ void a_ready(const Unit&) const {}
    __device__ __forceinline__ void done(const Unit&) const {}
};

__device__ __forceinline__ unsigned cvt_pk_bf16(float lo, float hi) { unsigned r; asm volatile("v_cvt_pk_bf16_f32 %0, %1, %2" : "=v"(r) : "v"(lo), "v"(hi)); return r; }
typedef float f32x2 __attribute__((ext_vector_type(2)));
__device__ __forceinline__ f32x2 gelu_pk(f32x2 v) {
    const f32x2 av = __builtin_elementwise_abs(v), d = av * 0.2316418882f + 1.0f;
    f32x2 t; t.x = __builtin_amdgcn_rcpf(d.x); t.y = __builtin_amdgcn_rcpf(d.y);
    f32x2 q = t * 0.5307027145f + (-0.7265760135f); q = q * t + 0.7107068705f; q = q * t + (-0.142248368f); q = q * t + 0.127414796f; q = q * t;
    const f32x2 s = (v * v) * (-0.72134752044f);
    f32x2 e; e.x = __builtin_amdgcn_exp2f(s.x); e.y = __builtin_amdgcn_exp2f(s.y);
    const f32x2 m = v * (q * e), r = v - m;
    f32x2 o; o.x = v.x < 0.f ? m.x : r.x; o.y = v.y < 0.f ? m.y : r.y; return o;
}

template <int ACT  > struct EpiBf16 {
    static constexpr bool PERM = true, AFTER_DRAIN = false; static_assert(ACT == 0 || ACT == 1, "EpiBf16: ACT is 0 (none) or 1 (gelu_pk)");
    bf16_t* O; int ldc; const float* bias; int split_cols; size_t split_stride; float scale0;
    __device__ __forceinline__ void operator()(const f32x4 (&acc)[2][2][4][2], const Unit& u, int wr, int wc, int fr, int fq) const {
        const int row0 = u.pm * BM + wr * 64 + fr; int colt = u.pn * BM; bf16_t* base = O;
        float sc = 1.f; if (split_cols) { const int t = colt / split_cols; base += (size_t)t * split_stride; colt -= t * split_cols; if (t == 0) sc = scale0; }
        const int col0 = colt + wc * 32 + 8 * fq, bcol0 = u.pn * BM + wc * 32 + 8 * fq;
        f32x4 bv[2][2];
#pragma unroll
        for (int bj = 0; bj < 2; ++bj)
#pragma unroll
            for (int n = 0; n < 2; ++n) bv[bj][n] = bias ? *(const f32x4*)(bias + bcol0 + bj * HALF + 4 * n) : (f32x4){0.f, 0.f, 0.f, 0.f};
#pragma unroll
        for (int ai = 0; ai < 2; ++ai)
#pragma unroll
            for (int m = 0; m < 4; ++m) { bf16_t* rowp = base + (size_t)(row0 + ai * HALF + m * 16) * ldc + col0;
#pragma unroll
                for (int bj = 0; bj < 2; ++bj) { f32x4 v0 = acc[ai][bj][m][0] + bv[bj][0], v1 = acc[ai][bj][m][1] + bv[bj][1];
                    if (ACT == 1) { f32x2 a = gelu_pk((f32x2){v0[0], v0[1]}), b = gelu_pk((f32x2){v0[2], v0[3]}), c = gelu_pk((f32x2){v1[0], v1[1]}), d = gelu_pk((f32x2){v1[2], v1[3]});
                        v0 = (f32x4){a.x, a.y, b.x, b.y}; v1 = (f32x4){c.x, c.y, d.x, d.y}; }
                    v0 = v0 * sc; v1 = v1 * sc; u32x4 w; w.x = cvt_pk_bf16(v0[0], v0[1]); w.y = cvt_pk_bf16(v0[2], v0[3]); w.z = cvt_pk_bf16(v1[0], v1[1]); w.w = cvt_pk_bf16(v1[2], v1[3]);
                    *(u32x4*)(rowp + bj * HALF) = w; } }
    }
};

typedef unsigned u32x2 __attribute__((ext_vector_type(2)));
struct EpiResGate {
    static constexpr bool PERM = true, AFTER_DRAIN = false;
    const float* x; bf16_t* out; int ldc; const float* bias; const float* ada; int ada_ld, gate_off, tiles_per_batch;
    __device__ __forceinline__ void operator()(const f32x4 (&acc)[2][2][4][2], const Unit& u, int wr, int wc, int fr, int fq, int part) const {
        const int row0 = u.pm * BM + wr * 64 + fr, col0 = u.pn * BM + wc * 32 + 8 * fq;
        const float* gp = ada + (size_t)(u.pm / tiles_per_batch) * ada_ld + gate_off;
        f32x4 bv[2][2], gv[2][2];
#pragma unroll
        for (int bj = 0; bj < 2; ++bj)
#pragma unroll
            for (int n = 0; n < 2; ++n) { bv[bj][n] = *(const f32x4*)(bias + col0 + bj * HALF + 4 * n); gv[bj][n] = *(const f32x4*)(gp + col0 + bj * HALF + 4 * n); }
        const __amdgpu_buffer_rsrc_t orsrc = wt_rsrc(out, (size_t)32768 * ldc * 2);
#pragma unroll
        for (int ai = 0; ai < 2; ++ai) {
            if (part == (ai ? 1 : 2)) continue;
#pragma unroll
            for (int mh = 0; mh < 2; ++mh) {
            f32x4 xv[2][2][2];
#pragma unroll
            for (int m = 0; m < 2; ++m) { const size_t off = (size_t)(row0 + ai * HALF + (2 * mh + m) * 16) * ldc + col0;
#pragma unroll
                for (int bj = 0; bj < 2; ++bj)
#pragma unroll
                    for (int n = 0; n < 2; ++n) xv[m][bj][n] = __builtin_nontemporal_load((const f32x4*)(x + off + bj * HALF + 4 * n)); }
#pragma unroll
            for (int m = 0; m < 2; ++m) { const size_t off = (size_t)(row0 + ai * HALF + (2 * mh + m) * 16) * ldc + col0;
#pragma unroll
                for (int bj = 0; bj < 2; ++bj) { const f32x4 o0 = xv[m][bj][0] + gv[bj][0] * (acc[ai][bj][2 * mh + m][0] + bv[bj][0]), o1 = xv[m][bj][1] + gv[bj][1] * (acc[ai][bj][2 * mh + m][1] + bv[bj][1]);
                    u32x4 w; w.x = cvt_pk_bf16(o0[0], o0[1]); w.y = cvt_pk_bf16(o0[2], o0[3]); w.z = cvt_pk_bf16(o1[0], o1[1]); w.w = cvt_pk_bf16(o1[2], o1[3]);
                    store16_wt(orsrc, (unsigned)((off + bj * HALF) * 2), w); } }
            asm volatile("" ::: "memory"); }
            asm volatile("" ::: "memory"); }
    }
};


typedef int i32x4 __attribute__((ext_vector_type(4)));
template <bool I8> struct AccSel { typedef f32x4 type; static __device__ __forceinline__ f32x4 zero() { return (f32x4){0.f, 0.f, 0.f, 0.f}; } };
template <> struct AccSel<true> { typedef i32x4 type; static __device__ __forceinline__ i32x4 zero() { return (i32x4){0, 0, 0, 0}; } };
template <bool I8> __device__ __forceinline__ typename AccSel<I8>::type mma16(bf16x8 a, bf16x8 b, typename AccSel<I8>::type c) {
    if constexpr (I8) return __builtin_amdgcn_mfma_i32_16x16x64_i8(__builtin_bit_cast(i32x4, a), __builtin_bit_cast(i32x4, b), c, 0, 0, 0);
    else return __builtin_amdgcn_mfma_f32_16x16x32_bf16(a, b, c, 0, 0, 0);
}
struct EpiI8Bf16 {
    static constexpr bool PERM = true, AFTER_DRAIN = false;
    bf16_t* O; int ldc; const float* rowscale; float wscale; const float* bias;
    __device__ __forceinline__ void operator()(const i32x4 (&acc)[2][2][4][2], const Unit& u, int wr, int wc, int fr, int fq, int part) const {
        const int row0 = u.pm * BM + wr * 64 + fr, col0 = u.pn * BM + wc * 32 + 8 * fq;
        f32x4 bv[2][2];
#pragma unroll
        for (int bj = 0; bj < 2; ++bj)
#pragma unroll
            for (int n = 0; n < 2; ++n) bv[bj][n] = bias ? *(const f32x4*)(bias + col0 + bj * HALF + 4 * n) : (f32x4){0.f, 0.f, 0.f, 0.f};
        const __amdgpu_buffer_rsrc_t orsrc = wt_rsrc(O, (size_t)32768 * ldc * 2);
#pragma unroll
        for (int ai = 0; ai < 2; ++ai) { if (part == (ai ? 1 : 2)) continue;
#pragma unroll
            for (int m = 0; m < 4; ++m) { const int row = row0 + ai * HALF + m * 16; const float sc = rowscale[row] * wscale; const unsigned rowoff = (unsigned)(((size_t)row * ldc + col0) * 2);
#pragma unroll
                for (int bj = 0; bj < 2; ++bj) { const i32x4 a0 = acc[ai][bj][m][0], a1 = acc[ai][bj][m][1]; const f32x4 b0 = bv[bj][0], b1 = bv[bj][1];
                    u32x4 w; w.x = cvt_pk_bf16((float)a0[0] * sc + b0[0], (float)a0[1] * sc + b0[1]); w.y = cvt_pk_bf16((float)a0[2] * sc + b0[2], (float)a0[3] * sc + b0[3]);
                    w.z = cvt_pk_bf16((float)a1[0] * sc + b1[0], (float)a1[1] * sc + b1[1]); w.w = cvt_pk_bf16((float)a1[2] * sc + b1[2], (float)a1[3] * sc + b1[3]);
                    store16_wt(orsrc, rowoff + bj * HALF * 2, w); } } }
    }
};
template <class Epi, class Sched, bool ALIGN_EPI = false, bool SP2 = false, bool I8 = false>
__device__ __forceinline__ void gemm_phase(PG8_LAS unsigned char* lds, const Gemm g, const Sched& S, const Epi& E) {
    const int tid = threadIdx.x, wid = __builtin_amdgcn_readfirstlane(tid >> 6), lane = tid & 63, wr = wid >> 2, wc = wid & 3, fr = lane & 15, fq = lane >> 4;
    const int K = g.K, nt = K / BK;
    unsigned voffA[2], voffB[2];
#pragma unroll
    for (int i = 0; i < 2; ++i) { int R, C; stage_rc(tid * 16 + i * 8192, R, C); const int Rb = Epi::PERM ? ((R & ~31) + perm32(R & 31)) : R;
        voffA[i] = (unsigned)(R * K + C) * 2u; voffB[i] = (unsigned)(Rb * K + C) * 2u; }
    const size_t kstep = (size_t)(BK * 2);
    const size_t hstep = (size_t)HALF * K * 2;
    const size_t tstep = 2 * hstep;
    const unsigned ldsw = (unsigned)wid * 1024u;
    const int aoff = lds_byte(wr * 64 + fr, fq * 8), boff = lds_byte(wc * 32 + fr, fq * 8);
#define PG8_SA(b, h) (((b) * 2 + (h)) * HTB)
#define PG8_SB(b, h) ((4 + (b) * 2 + (h)) * HTB)
#define PG8_STAGE(bufoff, gbase, voff) do { _Pragma("unroll") for (int _i = 0; _i < 2; ++_i) \
        __builtin_amdgcn_global_load_lds((const unsigned*)((const char*)(gbase) + (voff)[_i]), (PG8_LAS unsigned*)(lds + (bufoff) + ldsw + _i * 8192), 16, 0, 0); } while (0)
#define PG8_LDA(dst, b, h) do { _Pragma("unroll") for (int m = 0; m < 4; ++m) _Pragma("unroll") for (int k = 0; k < 2; ++k) dst[m][k] = *(const PG8_LAS bf16x8*)(lds + PG8_SA(b, h) + aoff + m * 2048 + k * 1024); } while (0)
#define PG8_LDB(dst, b, h) do { _Pragma("unroll") for (int n = 0; n < 2; ++n) _Pragma("unroll") for (int k = 0; k < 2; ++k) dst[n][k] = *(const PG8_LAS bf16x8*)(lds + PG8_SB(b, h) + boff + n * 2048 + k * 1024); } while (0)
#define PG8_MMA(ai, bj, At, Bt) do { __builtin_amdgcn_s_setprio(1); _Pragma("unroll") for (int m = 0; m < 4; ++m) _Pragma("unroll") for (int n = 0; n < 2; ++n) _Pragma("unroll") for (int k = 0; k < 2; ++k) \
        acc[ai][bj][m][n] = mma16<I8>(Bt[n][k], At[m][k], acc[ai][bj][m][n]); __builtin_amdgcn_s_setprio(0); } while (0)
#define PG8_WAIT_V(n) asm volatile("s_waitcnt vmcnt(" #n ")" ::: "memory")
#define PG8_WAIT_L(n) asm volatile("s_waitcnt lgkmcnt(" #n ")" ::: "memory")
#define PG8_BAR __builtin_amdgcn_s_barrier()
#define PG8_SCHED __builtin_amdgcn_sched_barrier(0)
    Unit cur, nxt; int ui = 0;
    if (!S.next(0, cur)) return;
    typedef typename AccSel<I8>::type acc_t;
    acc_t acc[2][2][4][2];
#pragma unroll
    for (int a = 0; a < 2; ++a)
#pragma unroll
        for (int b = 0; b < 2; ++b)
#pragma unroll
            for (int m = 0; m < 4; ++m)
#pragma unroll
                for (int n = 0; n < 2; ++n) acc[a][b][m][n] = AccSel<I8>::zero();
    bf16x8 At[4][2], B0[2][2], B1[2][2];
    const char* cA = (const char*)g.A + (size_t)cur.pm * tstep; const char* cB = (const char*)g.Bt + (size_t)cur.pn * tstep;
    S.a_ready(cur);
    if constexpr (SP2) {
        PG8_STAGE(PG8_SB(0, 0), cB, voffB); PG8_STAGE(PG8_SB(0, 1), cB + hstep, voffB); PG8_STAGE(PG8_SA(0, 0), cA, voffA); PG8_STAGE(PG8_SA(0, 1), cA + hstep, voffA);
        if (wr == 1) PG8_BAR;
        PG8_WAIT_V(2); PG8_BAR;
        PG8_STAGE(PG8_SB(1, 0), cB + kstep, voffB); PG8_STAGE(PG8_SA(1, 0), cA + kstep, voffA); PG8_STAGE(PG8_SB(1, 1), cB + hstep + kstep, voffB);
        PG8_WAIT_V(6); PG8_BAR;
    } else {
        PG8_STAGE(PG8_SB(0, 0), cB, voffB); PG8_STAGE(PG8_SA(0, 0), cA, voffA); PG8_STAGE(PG8_SB(0, 1), cB + hstep, voffB); PG8_STAGE(PG8_SA(0, 1), cA + hstep, voffA);
        if (wr == 1) PG8_BAR;
        PG8_WAIT_V(4); PG8_BAR;
        PG8_STAGE(PG8_SB(1, 0), cB + kstep, voffB); PG8_STAGE(PG8_SA(1, 0), cA + kstep, voffA); PG8_STAGE(PG8_SB(1, 1), cB + hstep + kstep, voffB);
        PG8_WAIT_V(6); PG8_BAR;
    }
    for (;;) {
        const bool has_next = S.next(ui + 1, nxt);
        const char* nA = has_next ? (const char*)g.A + (size_t)nxt.pm * tstep : cA; const char* nB = has_next ? (const char*)g.Bt + (size_t)nxt.pn * tstep : cB;
        const int cpart = S.part(ui); const bool d0 = cpart != 2, d1 = cpart != 1;
        for (int t = 0; t < nt; t += 2) {
            const bool last = (t == nt - 2);
            const char* a1 = cA + (size_t)(t + 1) * kstep;
            const char* a2 = last ? nA : cA + (size_t)(t + 2) * kstep; const char* b2 = last ? nB : cB + (size_t)(t + 2) * kstep;
            const char* a3 = a2 + kstep; const char* b3 = b2 + kstep;
            if (last && has_next) S.a_ready(nxt);
            if constexpr (SP2) {
            PG8_LDB(B0, 0, 0); PG8_LDB(B1, 0, 1); PG8_SCHED; PG8_LDA(At, 0, 0); PG8_STAGE(PG8_SA(1, 1), a1 + hstep, voffA);
            PG8_WAIT_V(8); PG8_WAIT_L(0); PG8_BAR; if (d0) { PG8_MMA(0, 0, At, B0); PG8_MMA(0, 1, At, B1); } PG8_BAR; PG8_SCHED;
            PG8_LDA(At, 0, 1); PG8_STAGE(PG8_SB(0, 0), b2, voffB); PG8_STAGE(PG8_SB(0, 1), b2 + hstep, voffB); PG8_STAGE(PG8_SA(0, 0), a2, voffA);
            PG8_WAIT_V(8); PG8_WAIT_L(0); PG8_BAR; if (d1) { PG8_MMA(1, 0, At, B0); PG8_MMA(1, 1, At, B1); } PG8_BAR; PG8_SCHED;
            PG8_LDB(B0, 1, 0); PG8_LDB(B1, 1, 1); PG8_SCHED; PG8_LDA(At, 1, 0); PG8_STAGE(PG8_SA(0, 1), a2 + hstep, voffA);
            PG8_WAIT_V(8); PG8_WAIT_L(0); PG8_BAR; if (d0) { PG8_MMA(0, 0, At, B0); PG8_MMA(0, 1, At, B1); } PG8_BAR; PG8_SCHED;
            PG8_LDA(At, 1, 1); PG8_STAGE(PG8_SB(1, 0), b3, voffB); PG8_STAGE(PG8_SB(1, 1), b3 + hstep, voffB); PG8_STAGE(PG8_SA(1, 0), a3, voffA);
            PG8_WAIT_V(8); PG8_WAIT_L(0); PG8_BAR; if (d1) { PG8_MMA(1, 0, At, B0); PG8_MMA(1, 1, At, B1); } PG8_BAR; PG8_SCHED;
            } else {
            PG8_LDB(B0, 0, 0); PG8_SCHED; PG8_LDA(At, 0, 0); PG8_STAGE(PG8_SA(1, 1), a1 + hstep, voffA);
            PG8_WAIT_L(8); PG8_BAR; PG8_WAIT_L(0); PG8_MMA(0, 0, At, B0); PG8_BAR; PG8_SCHED;
            PG8_LDB(B1, 0, 1); PG8_STAGE(PG8_SB(0, 0), b2, voffB);
            PG8_BAR; PG8_WAIT_L(0); PG8_MMA(0, 1, At, B1); PG8_BAR;
            PG8_LDA(At, 0, 1); PG8_STAGE(PG8_SA(0, 0), a2, voffA);
            PG8_BAR; PG8_WAIT_L(0); PG8_MMA(1, 0, At, B0); PG8_BAR; PG8_SCHED;
            PG8_STAGE(PG8_SB(0, 1), b2 + hstep, voffB);
            PG8_WAIT_V(6); PG8_BAR; PG8_MMA(1, 1, At, B1); PG8_BAR;
            PG8_LDB(B0, 1, 0); PG8_SCHED; PG8_LDA(At, 1, 0); PG8_STAGE(PG8_SA(0, 1), a2 + hstep, voffA);
            PG8_WAIT_L(8); PG8_BAR; PG8_WAIT_L(0); PG8_MMA(0, 0, At, B0); PG8_BAR; PG8_SCHED;
            PG8_LDB(B1, 1, 1); PG8_STAGE(PG8_SB(1, 0), b3, voffB);
            PG8_BAR; PG8_WAIT_L(0); PG8_MMA(0, 1, At, B1); PG8_BAR;
            PG8_LDA(At, 1, 1); PG8_STAGE(PG8_SA(1, 0), a3, voffA);
            PG8_BAR; PG8_WAIT_L(0); PG8_MMA(1, 0, At, B0); PG8_BAR; PG8_SCHED;
            PG8_STAGE(PG8_SB(1, 1), b3 + hstep, voffB);
            PG8_WAIT_V(6); PG8_BAR; PG8_MMA(1, 1, At, B1); PG8_BAR;
            }
        }
        if constexpr (ALIGN_EPI) { if (wr == 0) PG8_BAR; }
        if constexpr (!Epi::AFTER_DRAIN) { E(acc, cur, wr, wc, fr, fq, cpart); S.done(cur); }
        if (!has_next) break;
#pragma unroll
        for (int a = 0; a < 2; ++a)
#pragma unroll
            for (int b = 0; b < 2; ++b)
#pragma unroll
                for (int m = 0; m < 4; ++m)
#pragma unroll
                    for (int n = 0; n < 2; ++n) acc[a][b][m][n] = AccSel<I8>::zero();
        cur = nxt; cA = nA; cB = nB; ++ui;
        if constexpr (ALIGN_EPI) { if (wr == 1) PG8_BAR; }
    }
    PG8_WAIT_V(0);
    if constexpr (!ALIGN_EPI) { if (wr == 0) PG8_BAR; }
    PG8_BAR;
    if constexpr (Epi::AFTER_DRAIN) { E.fused(acc, cur, wr, wc, fr, fq, lds, wid, lane); S.done(cur); }
#undef PG8_SA
#undef PG8_SB
#undef PG8_STAGE
#undef PG8_LDA
#undef PG8_LDB
#undef PG8_MMA
#undef PG8_WAIT_V
#undef PG8_WAIT_L
#undef PG8_BAR
#undef PG8_SCHED
}
}

constexpr int NWAVES = 8;
constexpr int NPHASES = 12;
#ifndef MK_N_LAUNCHES
#define MK_N_LAUNCHES 1
#endif
constexpr int N_LAUNCHES = MK_N_LAUNCHES;
static_assert(N_LAUNCHES == 1 || N_LAUNCHES == NPHASES, "MK_N_LAUNCHES is 1 or NPHASES");

constexpr int BATCH = 16, SEQ = 2048, D = 1024, M = BATCH * SEQ;
constexpr int IN_W = 2304, O_Q = 0, O_K = 512, O_V = 640, O_B = 768, O_C = 1280, O_U = 1792;
constexpr int NQH = 8, NKVH = 2, HD = 64, WIN = 128;
constexpr int NKEYS = 128, NEXP = 16384, PH = 8, TOPK = 16, DKEY = 256, DHALF = 128, QW = PH * DKEY;
constexpr int ADA_W = 6 * D, ADA_KC = 8;
constexpr float EPS = 1e-6f;

constexpr size_t MiB = 1u << 20;
constexpr size_t WS_CTL = 0, CTL_ZERO_BYTES = 64 * 1024;
constexpr size_t WS_ADAP = 1 * MiB;
constexpr size_t WS_ADA = 4 * MiB;
constexpr size_t WS_WIN = 5 * MiB;
constexpr size_t WS_WOUT = 10 * MiB;
constexpr size_t WS_WQ = 12 * MiB;
constexpr size_t WS_K1 = 16 * MiB, WS_K2 = 16 * MiB + 512 * 1024;
constexpr size_t WS_U = 17 * MiB, WS_V = 33 * MiB;
constexpr float U_SCALE = 896.f, V_SCALE = 8.f, WQ_SCALE = 896.f;
constexpr size_t WS_H = 81 * MiB;
constexpr size_t WS_PROJ = 145 * MiB;
constexpr size_t WS_MIX = 289 * MiB;
constexpr size_t WS_IDX = 353 * MiB;
constexpr size_t WS_GATE = 369 * MiB;
constexpr size_t WS_H8 = 49 * MiB;
constexpr size_t WS_HS = 393 * MiB;
constexpr size_t WS_W16 = 385 * MiB;
constexpr size_t WS_X1 = 417 * MiB;
constexpr size_t WS_END = 481 * MiB;
constexpr size_t WS_PA = WS_PROJ;
constexpr size_t WS_SS = WS_MIX;
constexpr int CW_BAR = 4096;
static_assert((CW_BAR + 3456) * 4 <= (int)CTL_ZERO_BYTES, "barrier words inside the zeroed region");

constexpr int RING_OFF = 0, RING_BYTES = 131072;
constexpr int LDSCTL_OFF = 135168, MISC_OFF = LDSCTL_OFF + 320;
constexpr int LDS_BYTES = 147456;
static_assert(MISC_OFF + 128 <= LDS_BYTES, "LDS map");

#define GAS __attribute__((address_space(1)))
#define LAS __attribute__((address_space(3)))
typedef unsigned short bf16;
typedef unsigned v4u __attribute__((ext_vector_type(4)));
typedef float f32x4 __attribute__((ext_vector_type(4)));
typedef short bf16x8 __attribute__((ext_vector_type(8)));
typedef GAS unsigned gu32;
typedef GAS unsigned long long gu64;
#define RLX_AGENT __ATOMIC_RELAXED, __HIP_MEMORY_SCOPE_AGENT
#define LDS_WAIT() asm volatile("s_waitcnt lgkmcnt(0)" ::: "memory")
#define VM_WAIT() asm volatile("s_waitcnt vmcnt(0)" ::: "memory")
__device__ __forceinline__ unsigned long long rt() { return __builtin_amdgcn_s_memrealtime(); }
__device__ __forceinline__ unsigned f2bf(float f) { unsigned u = __builtin_bit_cast(unsigned, f); return (u + 0x7fffu + ((u >> 16) & 1u)) >> 16; }
__device__ __forceinline__ unsigned pk2(float lo, float hi) { return f2bf(lo) | (f2bf(hi) << 16); }

#define XB_TMO      128
#define XB_XCNT(j)  (256  + 64 * (j))
#define XB_XSUB(j)  (1280 + 64 * (j))
#define XB_XGEN(j)  (2304 + 64 * (j))
#define XB_TOP      3328
#define XB_TOPGEN   3392
#define XCD_BAR_WORDS 3456
#define XB_SPIN_CAP (1u << 22)

__device__ __forceinline__ unsigned xb_ld(unsigned* p)              { return __hip_atomic_load(p, __ATOMIC_RELAXED, __HIP_MEMORY_SCOPE_AGENT); }
__device__ __forceinline__ unsigned xb_add(unsigned* p, unsigned v) { return __hip_atomic_fetch_add(p, v, __ATOMIC_RELAXED, __HIP_MEMORY_SCOPE_AGENT); }
__device__ __forceinline__ unsigned xb_xcc_id() { return (unsigned)__builtin_amdgcn_s_getreg((3 << 11) | 20) & 0xFu; }
#define XB_SPIN(cond, bar) do { unsigned _sp = 0; while (cond) { __builtin_amdgcn_s_sleep(1); \
    if ((++_sp & 255u) == 0u) { if (xb_ld(&(bar)[XB_TMO])) break; if (_sp > XB_SPIN_CAP) { atomicAdd(&(bar)[XB_TMO], 1u); break; } } } } while (0)

struct XcdBarrier {
    unsigned* bar; unsigned x;
    volatile LAS unsigned* st;
};

__device__ __forceinline__ XcdBarrier xcd_barrier_post(unsigned* bar, volatile LAS unsigned* st) {
    XcdBarrier b; b.bar = bar; b.x = xb_xcc_id(); b.st = st;
    if (threadIdx.x == 0) (void)xb_add(&bar[XB_XCNT(b.x)], 1u);
    return b;
}
__device__ __forceinline__ void xcd_barrier_complete(unsigned* bar, unsigned x, unsigned& nloc, unsigned& nx) {
    const unsigned G = gridDim.x * gridDim.y * gridDim.z;
    unsigned sum, cnt, mine, sp = 0u;
    for (;;) {
        sum = 0u; cnt = 0u; mine = 0u;
#pragma unroll
        for (unsigned j = 0; j < 16; ++j) { const unsigned c = xb_ld(&bar[XB_XCNT(j)]); sum += c; cnt += (c > 0u) ? 1u : 0u; mine = (j == x) ? c : mine; }
        if (sum == G) break;
        __builtin_amdgcn_s_sleep(1);
        if ((++sp & 255u) == 0u) { if (xb_ld(&bar[XB_TMO])) break; if (sp > XB_SPIN_CAP) { atomicAdd(&bar[XB_TMO], 1u); break; } }
    }
    nloc = mine > 0u ? mine : 1u; nx = cnt > 0u ? cnt : 1u;
}

__device__ __forceinline__ void xcd_barrier(const XcdBarrier& b) {
    asm volatile("s_waitcnt vmcnt(0)" ::: "memory");
    __syncthreads();
    if (threadIdx.x == 0) {
        unsigned* bar = b.bar;
        __builtin_amdgcn_s_waitcnt(0);
        unsigned nloc = b.st[0], nx = b.st[1];
        if (nloc == 0u) { xcd_barrier_complete(bar, b.x, nloc, nx); b.st[0] = nloc; b.st[1] = nx; }
        const unsigned old = xb_add(&bar[XB_XSUB(b.x)], 1u);
        const unsigned gen = old / nloc;
        if (old + 1u == (gen + 1u) * nloc) {
            __builtin_amdgcn_fence(__ATOMIC_RELEASE, "agent");
            asm volatile("s_waitcnt vmcnt(0)" ::: "memory");
            const unsigned og = xb_add(&bar[XB_TOP], 1u);
            const unsigned tg = og / nx;
            if (og + 1u == (tg + 1u) * nx) xb_add(&bar[XB_TOPGEN], 1u);
            else XB_SPIN(xb_ld(&bar[XB_TOPGEN]) == tg, bar);
            __builtin_amdgcn_fence(__ATOMIC_ACQUIRE, "agent");
            xb_add(&bar[XB_XGEN(b.x)], 1u);
            asm volatile("s_waitcnt vmcnt(0)" ::: "memory");
        } else {
            XB_SPIN(xb_ld(&bar[XB_XGEN(b.x)]) == gen, bar);
            __builtin_amdgcn_fence(__ATOMIC_ACQUIRE, "agent");
            asm volatile("s_waitcnt vmcnt(0)" ::: "memory");
        }
    }
    __syncthreads();
}

struct Frame {
    LAS unsigned char* lds;
    volatile LAS unsigned* MISC;
    gu32* ctl;
    int tid, lane, wave;
    int vcu, G;
    const float* in[20]; float* out; unsigned char* ws;
};
#define IN_X 0
#define IN_C 1
#define IN_WADA 2
#define IN_BADA 3
#define IN_G1 4
#define IN_WIN 5
#define IN_BIN 6
#define IN_SINK 7
#define IN_CONVW 8
#define IN_AOG 9
#define IN_COG 10
#define IN_WOUT 11
#define IN_BOUT 12
#define IN_G2 13
#define IN_WQ 14
#define IN_PK1 15
#define IN_PK2 16
#define IN_PU 17
#define IN_PV 18
#define IN_GF 19

typedef __bf16 bf16x2_t __attribute__((ext_vector_type(2)));
typedef unsigned v2u __attribute__((ext_vector_type(2)));
__device__ __forceinline__ float dot2(unsigned a, unsigned b, float acc) { return __builtin_amdgcn_fdot2_f32_bf16(__builtin_bit_cast(bf16x2_t, a), __builtin_bit_cast(bf16x2_t, b), acc, false); }
__device__ __forceinline__ float dot8(v4u a, v4u b, float acc) { acc = dot2(a.x, b.x, acc); acc = dot2(a.y, b.y, acc); acc = dot2(a.z, b.z, acc); acc = dot2(a.w, b.w, acc); return acc; }
__device__ __forceinline__ float bflo(unsigned w) { return __uint_as_float(w << 16); }
__device__ __forceinline__ float bfhi(unsigned w) { return __uint_as_float(w & 0xffff0000u); }
__device__ __forceinline__ float wave_sum(float v) {
#pragma unroll
    for (int o = 1; o < 64; o <<= 1) v += __shfl_xor(v, o);
    return v;
}
__device__ __forceinline__ unsigned wave_umax(unsigned v) {
#pragma unroll
    for (int o = 1; o < 64; o <<= 1) { const unsigned t = (unsigned)__shfl_xor((int)v, o); v = v > t ? v : t; }
    return v;
}
__device__ __forceinline__ unsigned f2ord(float f) { const unsigned u = __float_as_uint(f); return (u & 0x80000000u) ? ~u : (u | 0x80000000u); }
__device__ __forceinline__ float ord2f(unsigned u) { return __uint_as_float((u & 0x80000000u) ? (u & 0x7fffffffu) : ~u); }

__device__ __forceinline__ unsigned pk4_i8(f32x4 a, float sc) {
    const int q0 = max(-127, min(127, __float2int_rn(a.x * sc))), q1 = max(-127, min(127, __float2int_rn(a.y * sc))), q2 = max(-127, min(127, __float2int_rn(a.z * sc))), q3 = max(-127, min(127, __float2int_rn(a.w * sc)));
    return (unsigned)(q0 & 0xff) | ((unsigned)(q1 & 0xff) << 8) | ((unsigned)(q2 & 0xff) << 16) | ((unsigned)q3 << 24); }
__device__ __forceinline__ void p0_transpose_item(const float* W, int K, int N, bf16* WT, LAS float* scr, int item, int lane) {
    const int nblk = N / 64, kb = item / nblk, nb = item % nblk, k0 = 64 * kb, n0 = 64 * nb;
#pragma unroll 16
    for (int kk = 0; kk < 64; ++kk) scr[kk * 65 + lane] = __builtin_nontemporal_load(W + (size_t)(k0 + kk) * N + n0 + lane);
    LDS_WAIT(); asm volatile("" ::: "memory");
    const int c = lane & 7;
#pragma unroll
    for (int j = 0; j < 8; ++j) { const int n = (lane >> 3) + 8 * j; const LAS float* s = scr + (8 * c) * 65 + n;
        v4u o; o.x = pk2(s[0 * 65], s[1 * 65]); o.y = pk2(s[2 * 65], s[3 * 65]); o.z = pk2(s[4 * 65], s[5 * 65]); o.w = pk2(s[6 * 65], s[7 * 65]);
        *(GAS v4u*)(WT + (size_t)(n0 + n) * K + k0 + 8 * c) = o; }
    LDS_WAIT(); asm volatile("" ::: "memory");
}
__device__ __forceinline__ void p0_transpose_item_i8(const float* W, int K, int N, unsigned char* WT, LAS float* scr, int item, int lane, float sc) {
    const int nblk = N / 64, kb = item / nblk, nb = item % nblk, k0 = 64 * kb, n0 = 64 * nb;
#pragma unroll 16
    for (int kk = 0; kk < 64; ++kk) scr[kk * 65 + lane] = __builtin_nontemporal_load(W + (size_t)(k0 + kk) * N + n0 + lane);
    LDS_WAIT(); asm volatile("" ::: "memory");
    const int c = lane & 7;
#pragma unroll
    for (int j = 0; j < 8; ++j) { const int n = (lane >> 3) + 8 * j; const LAS float* s = scr + (8 * c) * 65 + n;
        v2u o; o.x = pk4_i8((f32x4){s[0 * 65], s[1 * 65], s[2 * 65], s[3 * 65]}, sc); o.y = pk4_i8((f32x4){s[4 * 65], s[5 * 65], s[6 * 65], s[7 * 65]}, sc);
        *(GAS v2u*)(WT + (size_t)(n0 + n) * K + k0 + 8 * c) = o; }
    LDS_WAIT(); asm volatile("" ::: "memory");
}
__device__ __forceinline__ void p0_convert_item(const float* src, bf16* dst, size_t item, int lane) {
    const GAS f32x4* s = (const GAS f32x4*)(src + item * 2048) + lane * 2;
    GAS v4u* d = (GAS v4u*)(dst + item * 2048) + lane;
#pragma unroll
    for (int j = 0; j < 4; ++j) { const f32x4 a = s[j * 128], b = s[j * 128 + 1];
        v4u o; o.x = pk2(a.x, a.y); o.y = pk2(a.z, a.w); o.z = pk2(b.x, b.y); o.w = pk2(b.z, b.w); d[j * 64] = o; }
}
__device__ __forceinline__ unsigned pk4_fp8(f32x4 a, float sc) { int w = __builtin_amdgcn_cvt_pk_fp8_f32(a.x * sc, a.y * sc, 0, false); w = __builtin_amdgcn_cvt_pk_fp8_f32(a.z * sc, a.w * sc, w, true); return (unsigned)w; }
__device__ __forceinline__ void quad_transpose4(unsigned (&d)[4], int lane) {
    const bool b0 = lane & 1, b1 = lane & 2;
    { const unsigned s0 = b0 ? d[0] : d[1], s1 = b0 ? d[2] : d[3];
      const unsigned r0 = (unsigned)__builtin_amdgcn_update_dpp(0, (int)s0, 0xB1, 0xf, 0xf, true), r1 = (unsigned)__builtin_amdgcn_update_dpp(0, (int)s1, 0xB1, 0xf, 0xf, true);
      if (b0) { d[0] = r0; d[2] = r1; } else { d[1] = r0; d[3] = r1; } }
    { const unsigned s0 = b1 ? d[0] : d[2], s1 = b1 ? d[1] : d[3];
      const unsigned r0 = (unsigned)__builtin_amdgcn_update_dpp(0, (int)s0, 0x4E, 0xf, 0xf, true), r1 = (unsigned)__builtin_amdgcn_update_dpp(0, (int)s1, 0x4E, 0xf, 0xf, true);
      if (b1) { d[0] = r0; d[1] = r1; } else { d[2] = r0; d[3] = r1; } }
}
template <bool FP8> __device__ __forceinline__ void p0_table_item(const float* src, unsigned char* dst, size_t item, int lane, float sc) {
    const GAS f32x4* s = (const GAS f32x4*)(src + item * 4096) + lane;
    f32x4 v[16];
#pragma unroll
    for (int i = 0; i < 16; ++i) v[i] = __builtin_nontemporal_load(s + i * 64);
    const __amdgpu_buffer_rsrc_t rs = pg8::wt_rsrc(dst, (size_t)NEXP * D);
    const int Q = lane >> 2, p = lane & 3;
#pragma unroll
    for (int j = 0; j < 4; ++j) { unsigned d[4];
#pragma unroll
        for (int q = 0; q < 4; ++q) d[q] = FP8 ? pk4_fp8(v[4 * j + q], sc) : pk4_i8(v[4 * j + q], sc);
        quad_transpose4(d, lane);
        pg8::store16_wt(rs, (unsigned)((size_t)(2 * p + (Q >> 3)) * NEXP * 128 + (item * 4 + j) * 128 + (Q & 7) * 16), (v4u){d[0], d[1], d[2], d[3]}); }
}
__device__ __forceinline__ void p0_ada_task(Frame& F, int task, LAS float* scr) {
    const int kc = task / (ADA_W / 64), ng = task % (ADA_W / 64), lane = F.lane;
    const float* c = F.in[IN_C];
    for (int e = lane; e < BATCH * 128; e += 64) { const int b = e >> 7, kk = e & 127; const float cv = c[b * D + kc * 128 + kk]; scr[kk * 16 + b] = cv / (1.f + expf(-cv)); }
    LDS_WAIT(); asm volatile("" ::: "memory");
    float acc[BATCH];
#pragma unroll
    for (int b = 0; b < BATCH; ++b) acc[b] = 0.f;
    const float* wp = F.in[IN_WADA] + (size_t)(kc * 128) * ADA_W + ng * 64 + lane;
#pragma unroll 1
    for (int k0 = 0; k0 < 128; k0 += 16) { float wv[16];
#pragma unroll
        for (int u = 0; u < 16; ++u) wv[u] = __builtin_nontemporal_load(wp + (size_t)(k0 + u) * ADA_W);
#pragma unroll
        for (int u = 0; u < 16; ++u) { const LAS f32x4* sp = (const LAS f32x4*)(scr + (k0 + u) * 16);
#pragma unroll
            for (int q = 0; q < 4; ++q) { const f32x4 s = sp[q]; acc[4 * q] += s.x * wv[u]; acc[4 * q + 1] += s.y * wv[u]; acc[4 * q + 2] += s.z * wv[u]; acc[4 * q + 3] += s.w * wv[u]; } } }
    float* ap = (float*)(F.ws + WS_ADAP);
#pragma unroll
    for (int b = 0; b < BATCH; ++b) ap[(size_t)(kc * BATCH + b) * ADA_W + ng * 64 + lane] = acc[b];
    LDS_WAIT(); asm volatile("" ::: "memory");
}
__device__ __forceinline__ void p0_prologue(Frame& F) {
    LAS float* scr = (LAS float*)(F.lds + RING_OFF + F.wave * 16896);
    const int gw = F.vcu * NWAVES + F.wave, NGW = F.G * NWAVES;
    constexpr int I_ADA = ADA_KC * (ADA_W / 64);
    constexpr int I_T1 = (D / 64) * (IN_W / 64), I_T2 = (D / 64) * (D / 64), I_T3 = (D / 64) * (QW / 64);
    constexpr int I_K = PH * NKEYS * DHALF / 2048;
    constexpr int I_E = (int)((size_t)NEXP * D / 4096);
    constexpr int NITEMS = I_ADA + I_T1 + I_T2 + I_T3 + 2 * I_K + 2 * I_E;
    for (int it = gw; it < NITEMS; it += NGW) {
        int r = it;
        if (r < I_ADA) { p0_ada_task(F, r, scr); continue; } r -= I_ADA;
        if (r < I_T1) { p0_transpose_item_i8(F.in[IN_WIN], D, IN_W, F.ws + WS_WIN, scr, r, F.lane, WQ_SCALE); continue; } r -= I_T1;
        if (r < I_T2) { p0_transpose_item(F.in[IN_WOUT], D, D, (bf16*)(F.ws + WS_WOUT), scr, r, F.lane); continue; } r -= I_T2;
        if (r < I_T3) { p0_transpose_item_i8(F.in[IN_WQ], D, QW, F.ws + WS_WQ, scr, r, F.lane, WQ_SCALE); continue; } r -= I_T3;
        if (r < I_K) { p0_convert_item(F.in[IN_PK1], (bf16*)(F.ws + WS_K1), r, F.lane); continue; } r -= I_K;
        if (r < I_K) { p0_convert_item(F.in[IN_PK2], (bf16*)(F.ws + WS_K2), r, F.lane); continue; } r -= I_K;
        if (r < I_E) { p0_table_item<false>(F.in[IN_PU], F.ws + WS_U, r, F.lane, U_SCALE); continue; } r -= I_E;
        p0_table_item<true>(F.in[IN_PV], F.ws + WS_V, r, F.lane, V_SCALE);
    }
}

__device__ __forceinline__ void mod_row(const float* xrow, bf16* orow, const LAS float* SC, const LAS float* SH, int lane) {
    const GAS f32x4* xr = (const GAS f32x4*)xrow + lane;
    f32x4 v[4]; float s = 0.f;
#pragma unroll
    for (int j = 0; j < 4; ++j) { v[j] = xr[64 * j]; s += (v[j].x * v[j].x + v[j].y * v[j].y) + (v[j].z * v[j].z + v[j].w * v[j].w); }
    const float rstd = 1.0f / sqrtf(wave_sum(s) * (1.f / D) + EPS);
    GAS unsigned long long* o8 = (GAS unsigned long long*)orow + lane;
#pragma unroll
    for (int j = 0; j < 4; ++j) { const f32x4 sc = ((const LAS f32x4*)SC)[lane + 64 * j], sh = ((const LAS f32x4*)SH)[lane + 64 * j];
        const f32x4 o = v[j] * rstd * sc + sh;
        o8[64 * j] = (unsigned long long)pk2(o.x, o.y) | ((unsigned long long)pk2(o.z, o.w) << 32); }
}
__device__ __forceinline__ void mod_row_bf(const bf16* xrow, bf16* orow, const LAS float* SC, const LAS float* SH, int lane) {
    const GAS v2u* xr = (const GAS v2u*)xrow + lane;
    f32x4 v[4]; float s = 0.f;
#pragma unroll
    for (int j = 0; j < 4; ++j) { const v2u w = xr[64 * j]; v[j] = (f32x4){bflo(w.x), bfhi(w.x), bflo(w.y), bfhi(w.y)}; s += (v[j].x * v[j].x + v[j].y * v[j].y) + (v[j].z * v[j].z + v[j].w * v[j].w); }
    const float rstd = 1.0f / sqrtf(wave_sum(s) * (1.f / D) + EPS);
    GAS unsigned long long* o8 = (GAS unsigned long long*)orow + lane;
#pragma unroll
    for (int j = 0; j < 4; ++j) { const f32x4 sc = ((const LAS f32x4*)SC)[lane + 64 * j], sh = ((const LAS f32x4*)SH)[lane + 64 * j];
        const f32x4 o = v[j] * rstd * sc + sh;
        o8[64 * j] = (unsigned long long)pk2(o.x, o.y) | ((unsigned long long)pk2(o.z, o.w) << 32); }
}
__device__ __forceinline__ void mod_load(const float* xrow, int lane, f32x4 (&v)[4]) { const GAS f32x4* xr = (const GAS f32x4*)xrow + lane;
#pragma unroll
    for (int j = 0; j < 4; ++j) v[j] = __builtin_nontemporal_load(xr + 64 * j); }
__device__ __forceinline__ void mod_load_bf(const bf16* xrow, int lane, f32x4 (&v)[4]) { const GAS v2u* xr = (const GAS v2u*)xrow + lane;
#pragma unroll
    for (int j = 0; j < 4; ++j) { const v2u w = xr[64 * j]; v[j] = (f32x4){bflo(w.x), bfhi(w.x), bflo(w.y), bfhi(w.y)}; } }
template <bool I8> __device__ __forceinline__ void mod_finish(const f32x4 (&v)[4], bf16* orow, unsigned char* o8row, float* hs_out, const LAS float* SC, const LAS float* SH, int lane) {
    float s = 0.f;
#pragma unroll
    for (int j = 0; j < 4; ++j) s += (v[j].x * v[j].x + v[j].y * v[j].y) + (v[j].z * v[j].z + v[j].w * v[j].w);
    const float rstd = 1.0f / sqrtf(wave_sum(s) * (1.f / D) + EPS);
    f32x4 o[4]; float am = 0.f;
#pragma unroll
    for (int j = 0; j < 4; ++j) { const f32x4 sc = ((const LAS f32x4*)SC)[lane + 64 * j], sh = ((const LAS f32x4*)SH)[lane + 64 * j]; o[j] = v[j] * rstd * sc + sh;
        am = fmaxf(am, fmaxf(fmaxf(fabsf(o[j].x), fabsf(o[j].y)), fmaxf(fabsf(o[j].z), fabsf(o[j].w)))); }
    if (!I8) { GAS unsigned long long* o8 = (GAS unsigned long long*)orow + lane;
#pragma unroll
        for (int j = 0; j < 4; ++j) o8[64 * j] = (unsigned long long)pk2(o[j].x, o[j].y) | ((unsigned long long)pk2(o[j].z, o[j].w) << 32);
    } else {
#pragma unroll
        for (int off = 1; off < 64; off <<= 1) am = fmaxf(am, __shfl_xor(am, off));
        const float qs = am > 0.f ? 127.f / am : 0.f;
#pragma unroll
        for (int j = 0; j < 4; ++j) ((GAS unsigned*)o8row)[lane + 64 * j] = pk4_i8(o[j], qs);
        if (lane == 0) *hs_out = am * (1.f / 127.f); }
}
__device__ __forceinline__ void p1_hpass(Frame& F) {
    LAS float* SC = (LAS float*)(F.lds); LAS float* SH = SC + D;
    const float* adap = (const float*)(F.ws + WS_ADAP); const float* bada = F.in[IN_BADA]; const float* g1 = F.in[IN_G1];
    float* ada = (float*)(F.ws + WS_ADA);
    for (int e = blockIdx.x * 512 + F.tid; e < BATCH * ADA_W; e += F.G * 512) { const int b = e / ADA_W, n = e % ADA_W; float s = bada[n];
#pragma unroll
        for (int kc = 0; kc < ADA_KC; ++kc) s += adap[(size_t)(kc * BATCH + b) * ADA_W + n];
        ada[e] = s; }
    for (int tile = blockIdx.x; tile < M / 128; tile += F.G) {
        const int b = tile / (SEQ / 128);
        for (int d = F.tid; d < D; d += 512) { float sh = bada[d], sc = bada[D + d];
#pragma unroll
            for (int kc = 0; kc < ADA_KC; ++kc) { const float* p = adap + (size_t)(kc * BATCH + b) * ADA_W; sh += p[d]; sc += p[D + d]; }
            SC[d] = g1[d] * (1.f + sc); SH[d] = sh; }
        __syncthreads();
        { f32x4 va[4], vb[4];
          mod_load(F.in[IN_X] + ((size_t)tile * 128 + F.wave) * D, F.lane, va);
#pragma unroll 1
          for (int r = F.wave; r < 128; r += 2 * NWAVES) { const size_t row = (size_t)tile * 128 + r;
              mod_load(F.in[IN_X] + (row + NWAVES) * D, F.lane, vb);
              mod_finish<true>(va, nullptr, F.ws + WS_H8 + row * D, (float*)(F.ws + WS_HS) + row, SC, SH, F.lane);
              if (r + 2 * NWAVES < 128) mod_load(F.in[IN_X] + (row + 2 * NWAVES) * D, F.lane, va);
              mod_finish<true>(vb, nullptr, F.ws + WS_H8 + (row + NWAVES) * D, (float*)(F.ws + WS_HS) + (row + NWAVES), SC, SH, F.lane); } }
        __syncthreads();
    }
}
__device__ __forceinline__ void p5_h2pass(Frame& F) {
    LAS float* SC = (LAS float*)(F.lds); LAS float* SH = SC + D;
    const float* ada = (const float*)(F.ws + WS_ADA); const float* g2 = F.in[IN_G2];
    for (int tile = blockIdx.x; tile < M / 128; tile += F.G) {
        const int b = tile / (SEQ / 128);
        for (int d = F.tid; d < D; d += 512) { SC[d] = g2[d] * (1.f + ada[(size_t)b * ADA_W + 4 * D + d]); SH[d] = ada[(size_t)b * ADA_W + 3 * D + d]; }
        __syncthreads();
        { f32x4 va[4], vb[4]; const bf16* X1 = (const bf16*)(F.ws + WS_X1);
          mod_load_bf(X1 + ((size_t)tile * 128 + F.wave) * D, F.lane, va);
#pragma unroll 1
          for (int r = F.wave; r < 128; r += 2 * NWAVES) { const size_t row = (size_t)tile * 128 + r;
              mod_load_bf(X1 + (row + NWAVES) * D, F.lane, vb);
              mod_finish<true>(va, (bf16*)(F.ws + WS_H) + row * D, F.ws + WS_H8 + row * D, (float*)(F.ws + WS_HS) + row, SC, SH, F.lane);
              if (r + 2 * NWAVES < 128) mod_load_bf(X1 + (row + 2 * NWAVES) * D, F.lane, va);
              mod_finish<true>(vb, (bf16*)(F.ws + WS_H) + (row + NWAVES) * D, F.ws + WS_H8 + (row + NWAVES) * D, (float*)(F.ws + WS_HS) + (row + NWAVES), SC, SH, F.lane); } }
        __syncthreads();
    }
}

typedef float f32x16 __attribute__((ext_vector_type(16)));
typedef short s16x4 __attribute__((ext_vector_type(4)));
typedef __bf16 bf16x8_t __attribute__((ext_vector_type(8)));
#define MFMA32(a, b, c) __builtin_amdgcn_mfma_f32_32x32x16_bf16((a), (b), (c), 0, 0, 0)
constexpr int KS = 144, VS = 192;
__device__ __forceinline__ void p3_attn_unit(Frame& F, int unit) {
    const int kh = unit & 1, nb = (unit >> 1) & 15, b = unit >> 5;
    LAS unsigned char* KL = F.lds; LAS unsigned char* VL = F.lds + 256 * KS;
    const bf16* proj = (const bf16*)(F.ws + WS_PROJ);
    const int tok0 = b * SEQ + nb * 128;
    for (int c = F.tid; c < 2048; c += 512) { const int j = c >> 3, ch = c & 7;
        v4u kv = (v4u){0u, 0u, 0u, 0u}, vv = (v4u){0u, 0u, 0u, 0u};
        if (nb > 0 || j >= 128) { const bf16* rowp = proj + (size_t)(tok0 - 128 + j) * IN_W; kv = *(const GAS v4u*)(rowp + O_K + kh * HD + ch * 8); vv = *(const GAS v4u*)(rowp + O_V + kh * HD + ch * 8); }
        *(LAS v4u*)(KL + j * KS + ch * 16) = kv; *(LAS v4u*)(VL + j * VS + ch * 16) = vv; }
    __syncthreads();
    const int lane = F.lane, r = lane & 31, hh = lane >> 5;
#pragma unroll 1
    for (int task = F.wave; task < 16; task += NWAVES) {
        const int g = task >> 2, w = task & 3, qh = kh * 4 + g, i0 = 32 * w;
        const bf16* qp = proj + (size_t)(tok0 + i0 + r) * IN_W + O_Q + qh * HD + 8 * hh;
        bf16x8 qf[4];
#pragma unroll
        for (int s = 0; s < 4; ++s) qf[s] = *(const GAS bf16x8*)(qp + 16 * s);
        f32x16 sc[5];
#pragma unroll
        for (int t = 0; t < 5; ++t) {
#pragma unroll
            for (int e = 0; e < 16; ++e) sc[t][e] = 0.f;
#pragma unroll
            for (int s = 0; s < 4; ++s) { const bf16x8 a = *(const LAS bf16x8*)(KL + ((w + t) * 32 + r) * KS + 32 * s + 16 * hh); sc[t] = MFMA32(a, qf[s], sc[t]); } }
        const float sink = F.in[IN_SINK][qh];
        float mx = sink;
#pragma unroll
        for (int t = 0; t < 5; ++t)
#pragma unroll
            for (int e = 0; e < 16; ++e) { const int kr = (e & 3) + 8 * (e >> 2) + 4 * hh;
                bool valid = (nb > 0) || (w + t >= 4);
                if (t == 0) valid = valid && (kr > r);
                if (t == 4) valid = valid && (kr <= r);
                const float v = valid ? sc[t][e] * 0.125f : -1e30f; sc[t][e] = v; mx = fmaxf(mx, v); }
        mx = fmaxf(mx, __shfl_xor(mx, 32));
        float lsum = 0.f;
#pragma unroll
        for (int t = 0; t < 5; ++t)
#pragma unroll
            for (int e = 0; e < 16; ++e) { const float p = __expf(sc[t][e] - mx); sc[t][e] = p; lsum += p; }
        lsum += __shfl_xor(lsum, 32); lsum += __expf(sink - mx);
        f32x16 o[2];
#pragma unroll
        for (int dt = 0; dt < 2; ++dt)
#pragma unroll
            for (int e = 0; e < 16; ++e) o[dt][e] = 0.f;
        const int q4 = (r & 15) >> 2, p4 = r & 3;
#pragma unroll
        for (int t = 0; t < 5; ++t)
#pragma unroll
            for (int sp = 0; sp < 2; ++sp) {
                bf16x8_t pbv;
#pragma unroll
                for (int e = 0; e < 8; ++e) pbv[e] = (__bf16)sc[t][8 * sp + e];
                const bf16x8 pb = __builtin_bit_cast(bf16x8, pbv);
#pragma unroll
                for (int dt = 0; dt < 2; ++dt) {
                    const int kb = (w + t) * 32 + 16 * sp + 4 * hh;
                    const LAS unsigned char* ap = VL + (kb + q4) * VS + (32 * dt + 16 * (r >> 4) + 4 * p4) * 2;
                    const s16x4 lo = __builtin_amdgcn_ds_read_tr16_b64_v4i16((LAS s16x4*)ap);
                    const s16x4 hi = __builtin_amdgcn_ds_read_tr16_b64_v4i16((LAS s16x4*)(ap + 8 * VS));
                    const bf16x8 a = __builtin_shufflevector(lo, hi, 0, 1, 2, 3, 4, 5, 6, 7);
                    o[dt] = MFMA32(a, pb, o[dt]); } }
        const float inv = 1.f / lsum; float ss = 0.f;
#pragma unroll
        for (int dt = 0; dt < 2; ++dt)
#pragma unroll
            for (int e = 0; e < 16; ++e) { o[dt][e] *= inv; ss += o[dt][e] * o[dt][e]; }
        ss += __shfl_xor(ss, 32);
        const float rs = 1.0f / sqrtf(ss * (1.f / HD) + EPS);
        const float* gp = F.in[IN_AOG] + qh * HD;
        bf16* op = (bf16*)(F.ws + WS_MIX) + (size_t)(tok0 + i0 + r) * D + qh * HD;
#pragma unroll
        for (int dt = 0; dt < 2; ++dt)
#pragma unroll
            for (int g4 = 0; g4 < 4; ++g4) { const int d0 = 32 * dt + 8 * g4 + 4 * hh; const f32x4 gv = *(const f32x4*)(gp + d0);
                v2u wv; wv.x = pk2(o[dt][4 * g4 + 0] * rs * gv.x, o[dt][4 * g4 + 1] * rs * gv.y); wv.y = pk2(o[dt][4 * g4 + 2] * rs * gv.z, o[dt][4 * g4 + 3] * rs * gv.w);
                *(GAS v2u*)(op + d0) = wv; }
    }
    __syncthreads();
}
__device__ __forceinline__ void p3_conv(Frame& F) {
    const bf16* proj = (const bf16*)(F.ws + WS_PROJ); const int lane = F.lane, c0 = 8 * lane;
    const float* cw = F.in[IN_CONVW]; const float* cg = F.in[IN_COG];
    float w0[8], w1[8], w2[8], gg[8];
#pragma unroll
    for (int e = 0; e < 8; ++e) { w0[e] = cw[c0 + e]; w1[e] = cw[512 + c0 + e]; w2[e] = cw[1024 + c0 + e]; gg[e] = cg[c0 + e]; }
    const int gw = F.vcu * NWAVES + F.wave, NGW = F.G * NWAVES;
    for (int tok = gw; tok < M; tok += NGW) {
        const int s = tok & (SEQ - 1); const bf16* rp = proj + (size_t)tok * IN_W;
        const v4u z4 = (v4u){0u, 0u, 0u, 0u};
        const v4u Bv = *(const GAS v4u*)(rp + O_B + c0), C0 = *(const GAS v4u*)(rp + O_C + c0), U0 = *(const GAS v4u*)(rp + O_U + c0);
        v4u C1 = z4, U1 = z4, C2 = z4, U2 = z4;
        if (s >= 1) { C1 = *(const GAS v4u*)(rp - IN_W + O_C + c0); U1 = *(const GAS v4u*)(rp - IN_W + O_U + c0); }
        if (s >= 2) { C2 = *(const GAS v4u*)(rp - 2 * IN_W + O_C + c0); U2 = *(const GAS v4u*)(rp - 2 * IN_W + O_U + c0); }
        float y[8]; float ss = 0.f;
#pragma unroll
        for (int e = 0; e < 8; ++e) { const int wi = e >> 1; const bool hi = e & 1;
            const unsigned bw = Bv[wi], c0w = C0[wi], u0w = U0[wi], c1w = C1[wi], u1w = U1[wi], c2w = C2[wi], u2w = U2[wi];
            const float bb = hi ? bfhi(bw) : bflo(bw);
            const float z0 = (hi ? bfhi(c0w) : bflo(c0w)) * (hi ? bfhi(u0w) : bflo(u0w));
            const float z1 = (hi ? bfhi(c1w) : bflo(c1w)) * (hi ? bfhi(u1w) : bflo(u1w));
            const float z2 = (hi ? bfhi(c2w) : bflo(c2w)) * (hi ? bfhi(u2w) : bflo(u2w));
            y[e] = bb * (z2 * w0[e] + z1 * w1[e] + z0 * w2[e]); ss += y[e] * y[e]; }
        ss += __shfl_xor(ss, 1); ss += __shfl_xor(ss, 2); ss += __shfl_xor(ss, 4);
        const float rs = 1.0f / sqrtf(ss * (1.f / 64.f) + EPS);
        v4u w; w.x = pk2(y[0] * rs * gg[0], y[1] * rs * gg[1]); w.y = pk2(y[2] * rs * gg[2], y[3] * rs * gg[3]);
        w.z = pk2(y[4] * rs * gg[4], y[5] * rs * gg[5]); w.w = pk2(y[6] * rs * gg[6], y[7] * rs * gg[7]);
        pg8::store16_wt(pg8::wt_rsrc(F.ws + WS_MIX, (size_t)M * D * 2), (unsigned)(((size_t)tok * D + 512 + c0) * 2), w);
    }
}
__device__ __forceinline__ void p3_mixer(Frame& F) {
    for (int unit = blockIdx.x; unit < BATCH * 16 * NKVH; unit += F.G) p3_attn_unit(F, unit);
    p3_conv(F);
}

#define DI __device__ __forceinline__
#define CE_(i, j) { const unsigned x_ = a[i], y_ = a[j]; a[i] = x_ > y_ ? x_ : y_; a[j] = x_ > y_ ? y_ : x_; }
DI void sort16_desc(unsigned (&a)[16]) {
    CE_(0,13) CE_(1,12) CE_(2,15) CE_(3,14) CE_(4,8) CE_(5,6) CE_(7,11) CE_(9,10)
    CE_(0,5) CE_(1,7) CE_(2,9) CE_(3,4) CE_(6,13) CE_(8,14) CE_(10,15) CE_(11,12)
    CE_(0,1) CE_(2,3) CE_(4,5) CE_(6,8) CE_(7,9) CE_(10,11) CE_(12,13) CE_(14,15)
    CE_(0,2) CE_(1,3) CE_(4,10) CE_(5,11) CE_(6,7) CE_(8,9) CE_(12,14) CE_(13,15)
    CE_(1,2) CE_(3,12) CE_(4,6) CE_(5,7) CE_(8,10) CE_(9,11) CE_(13,14)
    CE_(1,4) CE_(2,6) CE_(5,8) CE_(7,10) CE_(9,13) CE_(11,14)
    CE_(2,4) CE_(3,6) CE_(9,12) CE_(11,13)
    CE_(3,5) CE_(6,8) CE_(7,9) CE_(10,12)
    CE_(3,4) CE_(5,6) CE_(7,8) CE_(9,10) CE_(11,12)
    CE_(6,7) CE_(8,9)
}
DI void bitonic_merge16_desc(unsigned (&a)[16]) {
#pragma unroll
    for (int js = 3; js >= 0; --js) {
#pragma unroll
        for (int i = 0; i < 16; ++i) { const int j = 1 << js, l = i ^ j;
            if (l > i) { const unsigned x = a[i], y = a[l]; a[i] = x > y ? x : y; a[l] = x > y ? y : x; } }
    }
}
DI void merge_top16(unsigned (&a)[16], const unsigned (&b)[16]) {
#pragma unroll
    for (int i = 0; i < 16; ++i) { const unsigned x = a[i], y = b[15 - i]; a[i] = x > y ? x : y; }
    bitonic_merge16_desc(a);
}
DI void top16_of_64(unsigned (&g0)[16], unsigned (&g1)[16], unsigned (&g2)[16], unsigned (&g3)[16]) {
    sort16_desc(g0); sort16_desc(g1); sort16_desc(g2); sort16_desc(g3);
    merge_top16(g0, g1); merge_top16(g2, g3); merge_top16(g0, g2);
}
#define SBIAS 8.0f
DI unsigned skey(float biased) { return __float_as_uint(fmaxf(biased, 0.f)); }
constexpr int KEY_STRIDE = 272;
DI void route_scores_top16(const LAS unsigned char* KL, const bf16* qrow, int r, int hh, unsigned (&out)[16]) {
    bf16x8 qf[8];
#pragma unroll
    for (int s = 0; s < 8; ++s) qf[s] = *(const GAS bf16x8*)(qrow + 16 * s);
    f32x16 acc[4];
#pragma unroll
    for (int t = 0; t < 4; ++t)
#pragma unroll
        for (int e = 0; e < 16; ++e) acc[t][e] = SBIAS;
#pragma unroll
    for (int t = 0; t < 4; ++t)
#pragma unroll
        for (int s = 0; s < 8; ++s) { const bf16x8 a = *(const LAS bf16x8*)(KL + (t * 32 + r) * KEY_STRIDE + 32 * s + 16 * hh); acc[t] = MFMA32(a, qf[s], acc[t]); }
    unsigned g0[16], g1[16], g2[16], g3[16];
    const unsigned pb = (unsigned)(127 - 4 * hh);
#pragma unroll
    for (int e = 0; e < 16; ++e) { const unsigned p = pb - (unsigned)((e & 3) + 8 * (e >> 2));
        g0[e] = (skey(acc[0][e]) & ~127u) | p; g1[e] = (skey(acc[1][e]) & ~127u) | (p - 32u); g2[e] = (skey(acc[2][e]) & ~127u) | (p - 64u); g3[e] = (skey(acc[3][e]) & ~127u) | (p - 96u); }
    top16_of_64(g0, g1, g2, g3);
    unsigned oth[16];
#pragma unroll
    for (int i = 0; i < 16; ++i) oth[i] = (unsigned)__shfl_xor((int)g0[i], 32);
    merge_top16(g0, oth);
#pragma unroll
    for (int i = 0; i < 16; ++i) out[i] = g0[i];
}
DI void p7_route_tile(Frame& F, int tok0, int h, const LAS unsigned char* KL1, const LAS unsigned char* KL2, LAS unsigned char* scr) {
    const int lane = F.lane, r = lane & 31, hh = lane >> 5;
    const bf16* qrow = (const bf16*)(F.ws + WS_PROJ) + (size_t)(tok0 + r) * QW + h * DKEY + 8 * hh;
    unsigned t1[16], t2[16];
    route_scores_top16(KL1, qrow, r, hh, t1);
    route_scores_top16(KL2, qrow + DHALF, r, hh, t2);
    { v4u w;
#pragma unroll
      for (int q = 0; q < 4; ++q) { unsigned x = 0u;
#pragma unroll
          for (int bq = 0; bq < 4; ++bq) { const unsigned k = hh ? t2[4 * q + bq] : t1[4 * q + bq]; x |= (127u - (k & 127u)) << (8 * bq); }
          w[q] = x; }
      *(LAS v4u*)(scr + r * 32 + hh * 16) = w; }
    float v1[16], v2[16];
#pragma unroll
    for (int i = 0; i < 16; ++i) { v1[i] = __uint_as_float(t1[i] & ~127u); v2[i] = __uint_as_float(t2[i] & ~127u) - SBIAS; }
    unsigned c0[16], c1[16];
    { const float sa = v1[0] + v2[0], sb = v1[2] + v2[1]; c0[0] = (__float_as_uint(fmaxf(hh ? sb : sa, 0.f)) & ~255u) | (hh ? 222u : 255u); }
    { const float sa = v1[0] + v2[1], sb = v1[2] + v2[2]; c0[1] = (__float_as_uint(fmaxf(hh ? sb : sa, 0.f)) & ~255u) | (hh ? 221u : 254u); }
    { const float sa = v1[0] + v2[2], sb = v1[2] + v2[3]; c0[2] = (__float_as_uint(fmaxf(hh ? sb : sa, 0.f)) & ~255u) | (hh ? 220u : 253u); }
    { const float sa = v1[0] + v2[3], sb = v1[2] + v2[4]; c0[3] = (__float_as_uint(fmaxf(hh ? sb : sa, 0.f)) & ~255u) | (hh ? 219u : 252u); }
    { const float sa = v1[0] + v2[4], sb = v1[3] + v2[0]; c0[4] = (__float_as_uint(fmaxf(hh ? sb : sa, 0.f)) & ~255u) | (hh ? 207u : 251u); }
    { const float sa = v1[0] + v2[5], sb = v1[3] + v2[1]; c0[5] = (__float_as_uint(fmaxf(hh ? sb : sa, 0.f)) & ~255u) | (hh ? 206u : 250u); }
    { const float sa = v1[0] + v2[6], sb = v1[3] + v2[2]; c0[6] = (__float_as_uint(fmaxf(hh ? sb : sa, 0.f)) & ~255u) | (hh ? 205u : 249u); }
    { const float sa = v1[0] + v2[7], sb = v1[3] + v2[3]; c0[7] = (__float_as_uint(fmaxf(hh ? sb : sa, 0.f)) & ~255u) | (hh ? 204u : 248u); }
    { const float sa = v1[0] + v2[8], sb = v1[4] + v2[0]; c0[8] = (__float_as_uint(fmaxf(hh ? sb : sa, 0.f)) & ~255u) | (hh ? 191u : 247u); }
    { const float sa = v1[0] + v2[9], sb = v1[4] + v2[1]; c0[9] = (__float_as_uint(fmaxf(hh ? sb : sa, 0.f)) & ~255u) | (hh ? 190u : 246u); }
    { const float sa = v1[0] + v2[10], sb = v1[4] + v2[2]; c0[10] = (__float_as_uint(fmaxf(hh ? sb : sa, 0.f)) & ~255u) | (hh ? 189u : 245u); }
    { const float sa = v1[0] + v2[11], sb = v1[5] + v2[0]; c0[11] = (__float_as_uint(fmaxf(hh ? sb : sa, 0.f)) & ~255u) | (hh ? 175u : 244u); }
    { const float sa = v1[0] + v2[12], sb = v1[5] + v2[1]; c0[12] = (__float_as_uint(fmaxf(hh ? sb : sa, 0.f)) & ~255u) | (hh ? 174u : 243u); }
    { const float sa = v1[0] + v2[13], sb = v1[6] + v2[0]; c0[13] = (__float_as_uint(fmaxf(hh ? sb : sa, 0.f)) & ~255u) | (hh ? 159u : 242u); }
    { const float sa = v1[0] + v2[14], sb = v1[6] + v2[1]; c0[14] = (__float_as_uint(fmaxf(hh ? sb : sa, 0.f)) & ~255u) | (hh ? 158u : 241u); }
    { const float sa = v1[0] + v2[15], sb = v1[7] + v2[0]; c0[15] = (__float_as_uint(fmaxf(hh ? sb : sa, 0.f)) & ~255u) | (hh ? 143u : 240u); }
    { const float sa = v1[1] + v2[0], sb = v1[7] + v2[1]; c1[0] = (__float_as_uint(fmaxf(hh ? sb : sa, 0.f)) & ~255u) | (hh ? 142u : 239u); }
    { const float sa = v1[1] + v2[1], sb = v1[8] + v2[0]; c1[1] = (__float_as_uint(fmaxf(hh ? sb : sa, 0.f)) & ~255u) | (hh ? 127u : 238u); }
    { const float sa = v1[1] + v2[2], sb = v1[9] + v2[0]; c1[2] = (__float_as_uint(fmaxf(hh ? sb : sa, 0.f)) & ~255u) | (hh ? 111u : 237u); }
    { const float sa = v1[1] + v2[3], sb = v1[10] + v2[0]; c1[3] = (__float_as_uint(fmaxf(hh ? sb : sa, 0.f)) & ~255u) | (hh ? 95u : 236u); }
    { const float sa = v1[1] + v2[4], sb = v1[11] + v2[0]; c1[4] = (__float_as_uint(fmaxf(hh ? sb : sa, 0.f)) & ~255u) | (hh ? 79u : 235u); }
    { const float sa = v1[1] + v2[5], sb = v1[12] + v2[0]; c1[5] = (__float_as_uint(fmaxf(hh ? sb : sa, 0.f)) & ~255u) | (hh ? 63u : 234u); }
    { const float sa = v1[1] + v2[6], sb = v1[13] + v2[0]; c1[6] = (__float_as_uint(fmaxf(hh ? sb : sa, 0.f)) & ~255u) | (hh ? 47u : 233u); }
    { const float sa = v1[1] + v2[7], sb = v1[14] + v2[0]; c1[7] = (__float_as_uint(fmaxf(hh ? sb : sa, 0.f)) & ~255u) | (hh ? 31u : 232u); }
    { const float sa = v1[2] + v2[0], sb = v1[15] + v2[0]; c1[8] = (__float_as_uint(fmaxf(hh ? sb : sa, 0.f)) & ~255u) | (hh ? 15u : 223u); }
    c1[9] = 0u;
    c1[10] = 0u;
    c1[11] = 0u;
    c1[12] = 0u;
    c1[13] = 0u;
    c1[14] = 0u;
    c1[15] = 0u;
    sort16_desc(c0); sort16_desc(c1); merge_top16(c0, c1);
    { unsigned oth[16];
#pragma unroll
      for (int i = 0; i < 16; ++i) oth[i] = (unsigned)__shfl_xor((int)c0[i], 32);
      merge_top16(c0, oth); }
    const float mx = __uint_as_float(c0[0] & ~255u);
    LDS_WAIT(); asm volatile("" ::: "memory");
    float ex[8]; int ee[8]; float part = 0.f;
#pragma unroll
    for (int k = 0; k < 8; ++k) { const unsigned key = hh ? c0[8 + k] : c0[k]; const int ci = 255 - (int)(key & 255u);
        const int e1 = *(const LAS unsigned char*)(scr + r * 32 + (ci >> 4)), e2 = *(const LAS unsigned char*)(scr + r * 32 + 16 + (ci & 15));
        ee[k] = (e1 * NKEYS + e2) & (NEXP - 1); ex[k] = __expf(__uint_as_float(key & ~255u) - mx); part += ex[k]; }
    const float inv = 1.f / (part + __shfl_xor(part, 32));
    { const unsigned oo = (unsigned)(((size_t)(tok0 + r) * 128 + h * TOPK + 8 * hh) * 4);
      const __amdgpu_buffer_rsrc_t ir = pg8::wt_rsrc(F.ws + WS_IDX, (size_t)M * 128 * 4), gr = pg8::wt_rsrc(F.ws + WS_GATE, (size_t)M * 128 * 4);
      pg8::store16_wt(ir, oo, (v4u){(unsigned)ee[0], (unsigned)ee[1], (unsigned)ee[2], (unsigned)ee[3]}); pg8::store16_wt(ir, oo + 16, (v4u){(unsigned)ee[4], (unsigned)ee[5], (unsigned)ee[6], (unsigned)ee[7]});
      pg8::store16_wt(gr, oo, (v4u){__float_as_uint(ex[0] * inv), __float_as_uint(ex[1] * inv), __float_as_uint(ex[2] * inv), __float_as_uint(ex[3] * inv)});
      pg8::store16_wt(gr, oo + 16, (v4u){__float_as_uint(ex[4] * inv), __float_as_uint(ex[5] * inv), __float_as_uint(ex[6] * inv), __float_as_uint(ex[7] * inv)}); }
    asm volatile("" ::: "memory");
}
__device__ __forceinline__ void p7_routing(Frame& F) {
    LAS unsigned char* KL1 = F.lds; LAS unsigned char* KL2 = F.lds + 128 * KEY_STRIDE; LAS unsigned char* scr = F.lds + 2 * 128 * KEY_STRIDE + F.wave * 1024;
    const bf16* k1 = (const bf16*)(F.ws + WS_K1); const bf16* k2 = (const bf16*)(F.ws + WS_K2);
    int cur_h = -1;
    for (int item = blockIdx.x; item < (M / 256) * PH; item += F.G) {
        const int h = item & (PH - 1), tile = item >> 3;
        if (h != cur_h) {
            __syncthreads();
            for (int c = F.tid; c < 2 * 128 * 16; c += 512) { const int which = c >> 11, rr = (c >> 4) & 127, ch = c & 15;
                const v4u v = *(const GAS v4u*)((which ? k2 : k1) + (size_t)(h * NKEYS + rr) * DHALF + ch * 8);
                *(LAS v4u*)((which ? KL2 : KL1) + rr * KEY_STRIDE + ch * 16) = v; }
            __syncthreads();
            cur_h = h;
        }
        p7_route_tile(F, tile * 256 + F.wave * 32, h, KL1, KL2, scr);
    }
}

__device__ __forceinline__ float gelu_erf(float v) { return 0.5f * v * (1.f + erff(v * 0.70710678118654752f)); }
typedef float f32x2v __attribute__((ext_vector_type(2)));
__device__ __forceinline__ unsigned fp8x2_bf16x2(unsigned w, bool hi) { return hi ? __builtin_bit_cast(unsigned, __builtin_amdgcn_cvt_scalef32_pk_bf16_fp8((int)w, 1.0f, true)) : __builtin_bit_cast(unsigned, __builtin_amdgcn_cvt_scalef32_pk_bf16_fp8((int)w, 1.0f, false)); }
__device__ __forceinline__ float dot16_fp8(v4u u, v4u ha, v4u hb, float acc) {
    acc = dot2(fp8x2_bf16x2(u.x, false), ha.x, acc); acc = dot2(fp8x2_bf16x2(u.x, true), ha.y, acc);
    acc = dot2(fp8x2_bf16x2(u.y, false), ha.z, acc); acc = dot2(fp8x2_bf16x2(u.y, true), ha.w, acc);
    acc = dot2(fp8x2_bf16x2(u.z, false), hb.x, acc); acc = dot2(fp8x2_bf16x2(u.z, true), hb.y, acc);
    acc = dot2(fp8x2_bf16x2(u.w, false), hb.z, acc); acc = dot2(fp8x2_bf16x2(u.w, true), hb.w, acc);
    return acc;
}
struct SliceWork { int j0, nj, t0, ts; };
__device__ __forceinline__ SliceWork slice_work(const Frame& F) { SliceWork w;
    if ((F.G & 7) == 0) { w.j0 = blockIdx.x & 7; w.nj = 1; w.t0 = (blockIdx.x >> 3) * NWAVES + F.wave; w.ts = F.G; }
    else { w.j0 = 0; w.nj = 8; w.t0 = blockIdx.x * NWAVES + F.wave; w.ts = F.G * NWAVES; }
    return w; }
struct USet { v4u hq; float hs; v4u u[16]; };
struct UMeta { v2u id; v4u hh; float hs; };
__device__ __forceinline__ UMeta p8a_G(const int* IDX, const unsigned char* H8, const float* HS, int t, int j, int lane) { UMeta m;
    m.id = *(const GAS v2u*)(IDX + (size_t)t * 128 + 2 * lane); m.hh = *(const GAS v4u*)(H8 + (size_t)t * D + 128 * j + 16 * (lane & 7)); m.hs = HS[t]; return m; }
__device__ __forceinline__ void p8a_S(LAS unsigned char* mb, const UMeta& m, int lane) { *(LAS v2u*)(mb + 8 * lane) = m.id; if (lane < 8) *(LAS v4u*)(mb + 512 + 16 * lane) = m.hh; }
__device__ __forceinline__ void p8a_RT(const LAS unsigned char* mb, const unsigned char* Ub, int c, int g, float hs, USet& s) {
    v4u ix[4];
#pragma unroll
    for (int q = 0; q < 4; ++q) ix[q] = *(const LAS v4u*)(mb + 64 * g + 16 * q);
    s.hq = *(const LAS v4u*)(mb + 512 + 16 * c); s.hs = hs;
#pragma unroll
    for (int i = 0; i < 16; ++i) s.u[i] = *(const GAS v4u*)(Ub + (unsigned)((ix[i >> 2][i & 3] << 7) + 16u * (unsigned)c)); }
__device__ __forceinline__ void p8a_compute(const USet& s, bf16* pa_row, int lane, int c) {
    int p[16];
#pragma unroll
    for (int i = 0; i < 16; ++i) { int a = __builtin_amdgcn_sdot4((int)s.u[i].x, (int)s.hq.x, 0, false); a = __builtin_amdgcn_sdot4((int)s.u[i].y, (int)s.hq.y, a, false);
        a = __builtin_amdgcn_sdot4((int)s.u[i].z, (int)s.hq.z, a, false); p[i] = __builtin_amdgcn_sdot4((int)s.u[i].w, (int)s.hq.w, a, false); }
#pragma unroll
    for (int i = 0; i < 8; ++i) { const bool up = c & 4; const int send = up ? p[i] : p[i + 8], keep = up ? p[i + 8] : p[i]; p[i] = keep + __builtin_amdgcn_update_dpp(0, send, 0x141, 0xf, 0xf, true); }
#pragma unroll
    for (int i = 0; i < 4; ++i) { const bool up = c & 2; const int send = up ? p[i] : p[i + 4], keep = up ? p[i + 4] : p[i]; p[i] = keep + __builtin_amdgcn_update_dpp(0, send, 0x4E, 0xf, 0xf, true); }
#pragma unroll
    for (int i = 0; i < 2; ++i) { const bool up = c & 1; const int send = up ? p[i] : p[i + 2], keep = up ? p[i + 2] : p[i]; p[i] = keep + __builtin_amdgcn_update_dpp(0, send, 0xB1, 0xf, 0xf, true); }
    const float sc = s.hs * (1.f / U_SCALE);
    ((GAS unsigned*)pa_row)[lane] = pk2((float)p[0] * sc, (float)p[1] * sc);
}
__device__ __forceinline__ void p8a_udots(Frame& F) {
    const unsigned char* H8 = F.ws + WS_H8; const float* HS = (const float*)(F.ws + WS_HS); const int* IDX = (const int*)(F.ws + WS_IDX); bf16* PA = (bf16*)(F.ws + WS_PA);
    const int lane = F.lane, c = lane & 7, g = lane >> 3; const SliceWork sw = slice_work(F);
    LAS unsigned char* mb = F.lds + F.wave * 1024;
    if (sw.t0 >= M) return;
    const int nt = (M - 1 - sw.t0) / sw.ts + 1;
#define TOK(n) (sw.t0 + ((n) < nt ? (n) : nt - 1) * sw.ts)
    for (int jj = 0; jj < sw.nj; ++jj) { const int j = sw.j0 + jj; const unsigned char* Uj = F.ws + WS_U + (size_t)j * NEXP * 128;
        USet sA, sB, sC;
        UMeta mN = p8a_G(IDX, H8, HS, TOK(0), j, lane); p8a_S(mb, mN, lane); p8a_RT(mb, Uj, c, g, mN.hs, sA);
        mN = p8a_G(IDX, H8, HS, TOK(1), j, lane); p8a_S(mb, mN, lane); p8a_RT(mb, Uj, c, g, mN.hs, sB);
        mN = p8a_G(IDX, H8, HS, TOK(2), j, lane);
#define P8A_STAGE(k, SN, SC_) do { p8a_S(mb, mN, lane); p8a_RT(mb, Uj, c, g, mN.hs, SN); mN = p8a_G(IDX, H8, HS, TOK((k) + 3), j, lane); asm volatile("" ::: "memory"); \
            if ((k) < nt) p8a_compute(SC_, PA + ((size_t)j * M + TOK(k)) * 128, lane, c); asm volatile("" ::: "memory"); } while (0)
#pragma unroll 1
        for (int n = 0; n < nt; n += 3) {
            P8A_STAGE(n, sC, sA);
            P8A_STAGE(n + 1, sA, sB);
            P8A_STAGE(n + 2, sB, sC);
        }
#undef P8A_STAGE
    }
}
typedef _Float16 h2_t __attribute__((ext_vector_type(2)));
__device__ __forceinline__ h2_t cvt_h2_lo(int w) { return __builtin_bit_cast(h2_t, __builtin_amdgcn_cvt_scalef32_pk_f16_fp8(w, 1.0f, false)); }
__device__ __forceinline__ h2_t cvt_h2_hi(int w) { return __builtin_bit_cast(h2_t, __builtin_amdgcn_cvt_scalef32_pk_f16_fp8(w, 1.0f, true)); }
__device__ __forceinline__ void p8w_weights(Frame& F) {
    const bf16* PA = (const bf16*)(F.ws + WS_PA); float* GATE = (float*)(F.ws + WS_GATE);
    for (size_t e = (size_t)blockIdx.x * 512 + F.tid; e < (size_t)M * 128 / 4; e += (size_t)F.G * 512) {
        f32x4 s = (f32x4){0.f, 0.f, 0.f, 0.f};
#pragma unroll
        for (int j = 0; j < 8; ++j) { const v2u w = __builtin_nontemporal_load((const GAS v2u*)(PA + (size_t)j * M * 128 + 4 * e)); s += (f32x4){bflo(w.x), bfhi(w.x), bflo(w.y), bfhi(w.y)}; }
        const f32x4 gt = *(const GAS f32x4*)(GATE + 4 * e); f32x4 o;
#pragma unroll
        for (int q = 0; q < 4; ++q) o[q] = gt[q] * gelu_erf(s[q]);
        const h2_t w01 = (h2_t){(_Float16)o[0], (_Float16)o[1]}, w23 = (h2_t){(_Float16)o[2], (_Float16)o[3]};
        *(GAS v2u*)((_Float16*)(F.ws + WS_W16) + 4 * e) = (v2u){__builtin_bit_cast(unsigned, w01), __builtin_bit_cast(unsigned, w23)}; }
}
template <int HI> __device__ __forceinline__ h2_t pkfma_bw(h2_t a, unsigned w, h2_t c) { h2_t d;
    if (HI) asm("v_pk_fma_f16 %0, %1, %2, %3 op_sel:[0,1,0] op_sel_hi:[1,1,1]" : "=v"(d) : "v"(a), "v"(w), "v"(c));
    else asm("v_pk_fma_f16 %0, %1, %2, %3 op_sel:[0,0,0] op_sel_hi:[1,0,1]" : "=v"(d) : "v"(a), "v"(w), "v"(c));
    return d; }
template <int HI> __device__ __forceinline__ h2_t pkmul_bw(h2_t a, unsigned w) { h2_t d;
    if (HI) asm("v_pk_mul_f16 %0, %1, %2 op_sel:[0,1] op_sel_hi:[1,1]" : "=v"(d) : "v"(a), "v"(w));
    else asm("v_pk_mul_f16 %0, %1, %2 op_sel:[0,0] op_sel_hi:[1,0]" : "=v"(d) : "v"(a), "v"(w));
    return d; }
struct VSet { v4u v[16]; };
struct VMeta { v2u id; unsigned w; };
__device__ __forceinline__ VMeta p8b_G(const int* IDX, const _Float16* W, int t, int lane) { VMeta m;
    m.id = *(const GAS v2u*)(IDX + (size_t)t * 128 + 2 * lane); m.w = *(const GAS unsigned*)(W + (size_t)t * 128 + 2 * lane); return m; }
__device__ __forceinline__ void p8b_S(LAS unsigned char* mb, const VMeta& m, int lane) { *(LAS v2u*)(mb + 8 * lane) = m.id; *(LAS unsigned*)(mb + 512 + 4 * lane) = m.w; }
__device__ __forceinline__ void p8b_RT(Frame& F, const LAS unsigned char* mb, const unsigned char* Vj, int t, int j, int c, int g, VSet& s) {
    v4u ix[4];
#pragma unroll
    for (int q = 0; q < 4; ++q) ix[q] = *(const LAS v4u*)(mb + 64 * g + 16 * q);
#pragma unroll
    for (int i = 0; i < 16; ++i) s.v[i] = *(const GAS v4u*)(Vj + (unsigned)((ix[i >> 2][i & 3] << 7) + 16u * (unsigned)c)); }
__device__ __forceinline__ void p8b_step(Frame& F, const LAS unsigned char* mb, const LAS unsigned char* mbc, const unsigned char* Vj, int tn, VSet& sn, const VSet& sc, int tc, int j, int lane, int c, int g, bool do_compute) {
    v4u ix[4];
#pragma unroll
    for (int q = 0; q < 4; ++q) ix[q] = *(const LAS v4u*)(mb + 64 * g + 16 * q);
    const v4u wh0 = *(const LAS v4u*)(mbc + 512 + 32 * g), wh1 = *(const LAS v4u*)(mbc + 512 + 32 * g + 16);
    h2_t ah[8];
#pragma unroll
    for (int i = 0; i < 16; ++i) {
        sn.v[i] = *(const GAS v4u*)(Vj + (unsigned)((ix[i >> 2][i & 3] << 7) + 16u * (unsigned)c));
        const v4u v = sc.v[i]; const unsigned wu = (i >> 3) ? wh1[(i >> 1) & 3] : wh0[(i >> 1) & 3];
        if (i == 0) { ah[0] = pkmul_bw<0>(cvt_h2_lo((int)v.x), wu); ah[1] = pkmul_bw<0>(cvt_h2_hi((int)v.x), wu); ah[2] = pkmul_bw<0>(cvt_h2_lo((int)v.y), wu); ah[3] = pkmul_bw<0>(cvt_h2_hi((int)v.y), wu);
            ah[4] = pkmul_bw<0>(cvt_h2_lo((int)v.z), wu); ah[5] = pkmul_bw<0>(cvt_h2_hi((int)v.z), wu); ah[6] = pkmul_bw<0>(cvt_h2_lo((int)v.w), wu); ah[7] = pkmul_bw<0>(cvt_h2_hi((int)v.w), wu); }
        else if (i & 1) { ah[0] = pkfma_bw<1>(cvt_h2_lo((int)v.x), wu, ah[0]); ah[1] = pkfma_bw<1>(cvt_h2_hi((int)v.x), wu, ah[1]); ah[2] = pkfma_bw<1>(cvt_h2_lo((int)v.y), wu, ah[2]); ah[3] = pkfma_bw<1>(cvt_h2_hi((int)v.y), wu, ah[3]);
            ah[4] = pkfma_bw<1>(cvt_h2_lo((int)v.z), wu, ah[4]); ah[5] = pkfma_bw<1>(cvt_h2_hi((int)v.z), wu, ah[5]); ah[6] = pkfma_bw<1>(cvt_h2_lo((int)v.w), wu, ah[6]); ah[7] = pkfma_bw<1>(cvt_h2_hi((int)v.w), wu, ah[7]); }
        else { ah[0] = pkfma_bw<0>(cvt_h2_lo((int)v.x), wu, ah[0]); ah[1] = pkfma_bw<0>(cvt_h2_hi((int)v.x), wu, ah[1]); ah[2] = pkfma_bw<0>(cvt_h2_lo((int)v.y), wu, ah[2]); ah[3] = pkfma_bw<0>(cvt_h2_hi((int)v.y), wu, ah[3]);
            ah[4] = pkfma_bw<0>(cvt_h2_lo((int)v.z), wu, ah[4]); ah[5] = pkfma_bw<0>(cvt_h2_hi((int)v.z), wu, ah[5]); ah[6] = pkfma_bw<0>(cvt_h2_lo((int)v.w), wu, ah[6]); ah[7] = pkfma_bw<0>(cvt_h2_hi((int)v.w), wu, ah[7]); }
        asm volatile("" ::: "memory"); }
    if (!do_compute) return;
    asm volatile("s_nop 1");
#pragma unroll
    for (int m = 0; m < 4; ++m) { const auto r = __builtin_amdgcn_permlane32_swap(__builtin_bit_cast(unsigned, ah[m]), __builtin_bit_cast(unsigned, ah[m + 4]), false, false);
        ah[m] = __builtin_bit_cast(h2_t, (unsigned)r[0]) + __builtin_bit_cast(h2_t, (unsigned)r[1]); }
#pragma unroll
    for (int m = 0; m < 2; ++m) { const auto r = __builtin_amdgcn_permlane16_swap(__builtin_bit_cast(unsigned, ah[m]), __builtin_bit_cast(unsigned, ah[m + 2]), false, false);
        ah[m] = __builtin_bit_cast(h2_t, (unsigned)r[0]) + __builtin_bit_cast(h2_t, (unsigned)r[1]); }
    { const bool up = lane & 8;
      const h2_t s0 = ah[0] + __builtin_bit_cast(h2_t, __builtin_amdgcn_update_dpp(0, __builtin_bit_cast(int, ah[0]), 0x128, 0xf, 0xf, true));
      const h2_t s1 = ah[1] + __builtin_bit_cast(h2_t, __builtin_amdgcn_update_dpp(0, __builtin_bit_cast(int, ah[1]), 0x128, 0xf, 0xf, true));
      ah[0] = up ? s1 : s0; }
    const f32x2v peer = (f32x2v){(float)ah[0].x, (float)ah[0].y} * (1.f / V_SCALE);
    *(GAS unsigned*)((bf16*)(F.ws + WS_H) + (size_t)tc * D + 128 * j + 16 * c + 2 * g) = pk2(peer.x, peer.y);
}
__device__ __forceinline__ void p8b_vsum(Frame& F) {
    const int* IDX = (const int*)(F.ws + WS_IDX); const _Float16* W = (const _Float16*)(F.ws + WS_W16);
    const int lane = F.lane, c = lane & 7, g = lane >> 3; const SliceWork sw = slice_work(F);
    LAS unsigned char* mb = F.lds + F.wave * 1024;
    if (sw.t0 >= M) return;
    const int nt = (M - 1 - sw.t0) / sw.ts + 1;
    for (int jj = 0; jj < sw.nj; ++jj) { const int j = sw.j0 + jj; const unsigned char* Vj = F.ws + WS_V + (size_t)j * NEXP * 128;
        VSet sA, sB, sC;
        LAS unsigned char* const pg0 = mb, * const pg1 = mb + 8192, * const pg2 = mb + 16384;
        VMeta mN = p8b_G(IDX, W, TOK(0), lane); p8b_S(pg0, mN, lane); p8b_RT(F, pg0, Vj, TOK(0), j, c, g, sA);
        mN = p8b_G(IDX, W, TOK(1), lane); p8b_S(pg1, mN, lane); p8b_RT(F, pg1, Vj, TOK(1), j, c, g, sB);
        mN = p8b_G(IDX, W, TOK(2), lane);
#define P8B_STAGE(k, SN, SC_, PN, PC) do { p8b_S(PN, mN, lane); mN = p8b_G(IDX, W, TOK((k) + 3), lane); \
            p8b_step(F, PN, PC, Vj, TOK((k) + 2), SN, SC_, TOK(k), j, lane, c, g, (k) < nt); asm volatile("" ::: "memory"); } while (0)
#pragma unroll 1
        for (int n = 0; n < nt; n += 3) {
            P8B_STAGE(n, sC, sA, pg2, pg0);
            P8B_STAGE(n + 1, sA, sB, pg0, pg1);
            P8B_STAGE(n + 2, sB, sC, pg1, pg2);
        }
#undef P8B_STAGE
    }
#undef TOK
}
__device__ __forceinline__ void p8c_final(Frame& F) {
    const float* gf = F.in[IN_GF]; const float* ada = (const float*)(F.ws + WS_ADA); const int lane = F.lane;
    f32x4 gv[4];
#pragma unroll
    for (int q = 0; q < 4; ++q) gv[q] = *(const f32x4*)(gf + 4 * lane + 256 * q);
    const bf16* X1 = (const bf16*)(F.ws + WS_X1); const bf16* PE = (const bf16*)(F.ws + WS_H);
    for (int t = blockIdx.x * NWAVES + F.wave; t < M; t += F.G * NWAVES) {
        const GAS v2u* xr = (const GAS v2u*)(X1 + (size_t)t * D) + lane; const GAS v2u* pr = (const GAS v2u*)(PE + (size_t)t * D) + lane;
        const float* g2 = ada + (size_t)(t / SEQ) * ADA_W + 5 * D + 4 * lane;
        f32x4 x2[4]; float s = 0.f;
#pragma unroll
        for (int q = 0; q < 4; ++q) { const v2u a = __builtin_nontemporal_load(xr + 64 * q), p = __builtin_nontemporal_load(pr + 64 * q); const f32x4 gg = *(const f32x4*)(g2 + 256 * q);
            x2[q] = (f32x4){bflo(a.x), bfhi(a.x), bflo(a.y), bfhi(a.y)} + gg * (f32x4){bflo(p.x), bfhi(p.x), bflo(p.y), bfhi(p.y)};
            s += (x2[q].x * x2[q].x + x2[q].y * x2[q].y) + (x2[q].z * x2[q].z + x2[q].w * x2[q].w); }
        const float rstd = 1.0f / sqrtf(wave_sum(s) * (1.f / D) + EPS);
        GAS f32x4* yr = (GAS f32x4*)(F.out + (size_t)t * D) + lane;
#pragma unroll
        for (int q = 0; q < 4; ++q) __builtin_nontemporal_store(x2[q] * rstd * gv[q], yr + 64 * q);
    }
}

struct Args { const float* in[20]; float* out; unsigned char* ws; int ph_lo, ph_hi, li, pad; };
__global__ void __launch_bounds__(NWAVES * 64, 2) skel_fwd(Args args) {
    extern __shared__ __attribute__((aligned(16))) unsigned char lds[];
    Frame F;
    F.lds = (LAS unsigned char*)lds;
    F.MISC = (volatile LAS unsigned*)(F.lds + MISC_OFF);
    F.tid = threadIdx.x; F.lane = F.tid & 63; F.wave = __builtin_amdgcn_readfirstlane(F.tid >> 6);
    F.G = gridDim.x; { const int bx = blockIdx.x; F.vcu = (F.G % 8 == 0) ? (bx % 8) * (F.G / 8) + bx / 8 : bx; }
    F.ws = args.ws; F.out = args.out;
#pragma unroll
    for (int i = 0; i < 20; ++i) F.in[i] = args.in[i];
    F.ctl = (gu32*)(args.ws + WS_CTL);
    for (int u = F.tid; u < (LDS_BYTES - LDSCTL_OFF) / 4; u += NWAVES * 64) ((LAS unsigned*)(F.lds + LDSCTL_OFF))[u] = 0u;
    __syncthreads();
    XcdBarrier bar; bar.bar = (unsigned*)(F.ctl + CW_BAR); bar.x = 0; bar.st = nullptr;
    if (N_LAUNCHES == 1) bar = xcd_barrier_post((unsigned*)(F.ctl + CW_BAR), F.MISC + 8);
#define GRID_BAR() do { if (N_LAUNCHES == 1) xcd_barrier(bar); } while (0)
    const int lo = args.ph_lo, hi = args.ph_hi;
#define IN(k) (lo <= (k) && (k) < hi)
    bf16* const H = (bf16*)(args.ws + WS_H); bf16* const PROJ = (bf16*)(args.ws + WS_PROJ); bf16* const MIX = (bf16*)(args.ws + WS_MIX);

    if (IN(0)) { p0_prologue(F); GRID_BAR(); }
    if (IN(1)) { p1_hpass(F); GRID_BAR(); }
    if (IN(2)) {
        pg8::Gemm g{(const bf16*)(args.ws + WS_H8), (const bf16*)(args.ws + WS_WIN), M, IN_W, D / 2}; pg8::StaticOrder S; S.init(M, IN_W, F.G, (int)blockIdx.x);
        pg8::EpiI8Bf16 E{PROJ, IN_W, (const float*)(args.ws + WS_HS), 1.f / WQ_SCALE, F.in[IN_BIN]};
        if ((int)blockIdx.x >= 128) { __builtin_amdgcn_s_sleep(127); __builtin_amdgcn_s_sleep(127); }
        pg8::gemm_phase<pg8::EpiI8Bf16, pg8::StaticOrder, true, true, true>(F.lds + RING_OFF, g, S, E);
        GRID_BAR();
    }
    if (IN(3)) { p3_mixer(F); GRID_BAR(); }
    if (IN(4)) {
        pg8::Gemm g{MIX, (const bf16*)(args.ws + WS_WOUT), M, D, D}; pg8::StaticOrder S; S.init(M, D, F.G, (int)blockIdx.x);
        pg8::EpiResGate E{F.in[IN_X], (bf16*)(args.ws + WS_X1), D, F.in[IN_BOUT], (const float*)(args.ws + WS_ADA), ADA_W, 2 * D, SEQ / 256};
        pg8::gemm_phase<pg8::EpiResGate, pg8::StaticOrder, true, true>(F.lds + RING_OFF, g, S, E);
        GRID_BAR();
    }
    if (IN(5)) { p5_h2pass(F); GRID_BAR(); }
    if (IN(6)) {
        pg8::Gemm g{(const bf16*)(args.ws + WS_H8), (const bf16*)(args.ws + WS_WQ), M, QW, D / 2}; pg8::StaticOrder S; S.init(M, QW, F.G, (int)blockIdx.x);
        pg8::EpiI8Bf16 E{PROJ, QW, (const float*)(args.ws + WS_HS), 1.f / WQ_SCALE, nullptr};
        pg8::gemm_phase<pg8::EpiI8Bf16, pg8::StaticOrder, true, true, true>(F.lds + RING_OFF, g, S, E);
        GRID_BAR();
    }
    if (IN(7)) { p7_routing(F); GRID_BAR(); }
    if (IN(8)) { p8a_udots(F); GRID_BAR(); }
    if (IN(9)) { p8w_weights(F); GRID_BAR(); }
    if (IN(10)) { p8b_vsum(F); GRID_BAR(); }
    if (IN(11)) { p8c_final(F); }
#undef IN
}

extern "C" void kernel_launch(void* const* d_in, const int* in_sizes, int n_in, void* d_out, int out_size, void* d_ws, size_t ws_size, hipStream_t stream) {
    static int grid = 0;
    if (grid == 0) {
        if (n_in != 20 || in_sizes[0] != M * D || out_size != M * D || ws_size < WS_END) { fprintf(stderr, "kernel_launch: unexpected shapes (n_in %d, in0 %d, out %d, ws %zu); nothing launched\n", n_in, n_in > 0 ? in_sizes[0] : -1, out_size, ws_size); grid = -1; return; }
        int dev = 0, cus = 0, per_cu = 0;
        if (hipGetDevice(&dev) != hipSuccess || hipDeviceGetAttribute(&cus, hipDeviceAttributeMultiprocessorCount, dev) != hipSuccess) { fprintf(stderr, "kernel_launch: device query failed\n"); grid = -1; return; }
        if (hipFuncSetAttribute((const void*)skel_fwd, hipFuncAttributeMaxDynamicSharedMemorySize, LDS_BYTES) != hipSuccess) { fprintf(stderr, "kernel_launch: hipFuncSetAttribute failed\n"); grid = -1; return; }
        if (hipOccupancyMaxActiveBlocksPerMultiprocessor(&per_cu, (const void*)skel_fwd, NWAVES * 64, LDS_BYTES) != hipSuccess || per_cu < 1)
            fprintf(stderr, "kernel_launch: note: occupancy query reports %d workgroups per CU\n", per_cu);
        (void)hipGetLastError();
        grid = cus;
    }
    if (grid < 0) return;
    if (hipMemsetAsync((char*)d_ws + WS_CTL, 0, CTL_ZERO_BYTES, stream) != hipSuccess) { fprintf(stderr, "kernel_launch: hipMemsetAsync failed\n"); return; }
    Args a{};
    for (int i = 0; i < 20; ++i) a.in[i] = (const float*)d_in[i];
    a.out = (float*)d_out; a.ws = (unsigned char*)d_ws;
    for (int li = 0; li < N_LAUNCHES; ++li) {
        a.ph_lo = (N_LAUNCHES == 1) ? 0 : li; a.ph_hi = (N_LAUNCHES == 1) ? NPHASES : li + 1; a.li = li;
        hipLaunchKernelGGL(skel_fwd, dim3(grid), dim3(NWAVES * 64), LDS_BYTES, stream, a);
        const hipError_t le = hipPeekAtLastError();
        if (le != hipSuccess) { fprintf(stderr, "kernel_launch: launch %d failed: %s\n", li, hipGetErrorName(le)); break; }
    }
}
```

```cpp
#include <hip/hip_runtime.h>
#include <cstdio>
#include <cstdint>
#include <cmath>
namespace pg8 {
#define PG8_LAS __attribute__((address_space(3)))
typedef unsigned short bf16_t;
typedef short bf16x8 __attribute__((ext_vector_type(8)));
typedef float f32x4 __attribute__((ext_vector_type(4)));
typedef unsigned u32x4 __attribute__((ext_vector_type(4)));
constexpr int BM = 256, BK = 64, HALF = 128, HTB = HALF * BK * 2  , STAGE_BYTES = 8 * HTB, NXCD = 8, WGM = 8;

__host__ __device__ __forceinline__ int lds_byte(int r, int c) { const int st = (r >> 4) * 2 + (c >> 5), rr = r & 15, cc = c & 31, ob = rr * 64 + cc * 2; return st * 1024 + (ob ^ (((ob >> 9) & 1) << 5)); }
__host__ __device__ __forceinline__ void stage_rc(int b, int& R, int& C) { const int st = b / 1024, sb = b % 1024, swz = sb ^ (((sb >> 9) & 1) << 5); R = (st >> 1) * 16 + swz / 64; C = (st & 1) * 32 + (swz % 64) / 2; }
__host__ __device__ __forceinline__ int perm32(int rho) { const int n = rho >> 4, i = rho & 15; return 8 * (i >> 2) + 4 * n + (i & 3); }

__device__ __forceinline__ __amdgpu_buffer_rsrc_t wt_rsrc(const void* base, size_t bytes) { return __builtin_amdgcn_make_buffer_rsrc((void*)base, 0, (int)bytes, 0x00020000); }
__device__ __forceinline__ void store16_wt(__amdgpu_buffer_rsrc_t r, unsigned off, u32x4 v) { __builtin_amdgcn_raw_buffer_store_b128(v, r, (int)off, 0, 16); }
struct Unit { int pm, pn; };
struct Gemm { const bf16_t* A; const bf16_t* Bt; int M, N, K; };

struct StaticOrder {
    int nM, nN, nwg, G, c;
    __host__ __device__ void init(int M, int N, int G_, int c_) { nM = M / BM; nN = N / BM; nwg = nM * nN; G = G_; c = c_; }
    __host__ __device__ __forceinline__ bool next(int i, Unit& u) const { return at((long)i * G + c, u); }
    __host__ __device__ __forceinline__ bool at(long L, Unit& u) const {
        if (L >= nwg) return false;
        int wgid = (int)L; { const int q = nwg / NXCD, r = nwg % NXCD, xcd = wgid % NXCD, off = wgid / NXCD; wgid = (xcd < r ? xcd * (q + 1) : r * (q + 1) + (xcd - r) * q) + off; }
        const int nig = WGM * nN, gid = wgid / nig, fm = gid * WGM, gsz = (nM - fm) < WGM ? (nM - fm) : WGM;
        u.pm = fm + ((wgid % nig) % gsz); u.pn = (wgid % nig) / gsz; return true;
    }
    __host__ __device__ __forceinline__ int part(int) const { return 0; }
    __device__ __forceinline__ void a_ready(const Unit&) const {}
    __device__ __forceinline__ void done(const Unit&) const {}
};

struct StagOrder {
    StaticOrder base; int R, E, grpB, pair; bool on;
    __host__ __device__ void init(int M, int N, int G_, int c_) { base.init(M, N, G_, c_); R = base.nwg / G_; E = base.nwg - R * G_; on = (G_ % 16 == 0) && R >= 1 && (E == 0 || E == G_ / 2);
        const int slot = c_ >> 3; grpB = slot & 1; pair = (slot >> 1) * 8 + (c_ & 7); }
    __host__ __device__ __forceinline__ bool next(int i, Unit& u) const {
        if (!on) return base.next(i, u);
        if (E) {
            if (!grpB) return i < R ? base.next(i, u) : (i == R ? base.at((long)R * base.G + pair, u) : false);
            return i == 0 ? base.at((long)R * base.G + pair, u) : (i <= R ? base.next(i - 1, u) : false);
        }
        if (!grpB || i < R) return base.next(i, u);
        return i == R ? base.next(0, u) : false;
    }
    __host__ __device__ __forceinline__ int part(int i) const {
        if (!on) return 0;
        if (E) return grpB ? (i == 0 ? 2 : 0) : (i == R ? 1 : 0);
        return grpB ? (i == 0 ? 1 : (i == R ? 2 : 0)) : 0;
    }
    __device__ __forceinline__ void a_ready(const Unit&) const {}
    __device__ __forceinline__ void done(const Unit&) const {}
};

__device__ __forceinline__ unsigned cvt_pk_bf16(float lo, float hi) { unsigned r; asm volatile("v_cvt_pk_bf16_f32 %0, %1, %2" : "=v"(r) : "v"(lo), "v"(hi)); return r; }
typedef float f32x2 __attribute__((ext_vector_type(2)));
__device__ __forceinline__ f32x2 gelu_pk(f32x2 v) {
    const f32x2 av = __builtin_elementwise_abs(v), d = av * 0.2316418882f + 1.0f;
    f32x2 t; t.x = __builtin_amdgcn_rcpf(d.x); t.y = __builtin_amdgcn_rcpf(d.y);
    f32x2 q = t * 0.5307027145f + (-0.7265760135f); q = q * t + 0.7107068705f; q = q * t + (-0.142248368f); q = q * t + 0.127414796f; q = q * t;
    const f32x2 s = (v * v) * (-0.72134752044f);
    f32x2 e; e.x = __builtin_amdgcn_exp2f(s.x); e.y = __builtin_amdgcn_exp2f(s.y);
    const f32x2 m = v * (q * e), r = v - m;
    f32x2 o; o.x = v.x < 0.f ? m.x : r.x; o.y = v.y < 0.f ? m.y : r.y; return o;
}

template <int ACT  > struct EpiBf16 {
    static constexpr bool PERM = true, AFTER_DRAIN = false; static_assert(ACT == 0 || ACT == 1, "EpiBf16: ACT is 0 (none) or 1 (gelu_pk)");
    bf16_t* O; int ldc; const float* bias; int split_cols; size_t split_stride; float scale0;
    __device__ __forceinline__ void operator()(const f32x4 (&acc)[2][2][4][2], const Unit& u, int wr, int wc, int fr, int fq) const {
        const int row0 = u.pm * BM + wr * 64 + fr; int colt = u.pn * BM; bf16_t* base = O;
        float sc = 1.f; if (split_cols) { const int t = colt / split_cols; base += (size_t)t * split_stride; colt -= t * split_cols; if (t == 0) sc = scale0; }
        const int col0 = colt + wc * 32 + 8 * fq, bcol0 = u.pn * BM + wc * 32 + 8 * fq;
        f32x4 bv[2][2];
#pragma unroll
        for (int bj = 0; bj < 2; ++bj)
#pragma unroll
            for (int n = 0; n < 2; ++n) bv[bj][n] = bias ? *(const f32x4*)(bias + bcol0 + bj * HALF + 4 * n) : (f32x4){0.f, 0.f, 0.f, 0.f};
#pragma unroll
        for (int ai = 0; ai < 2; ++ai)
#pragma unroll
            for (int m = 0; m < 4; ++m) { bf16_t* rowp = base + (size_t)(row0 + ai * HALF + m * 16) * ldc + col0;
#pragma unroll
                for (int bj = 0; bj < 2; ++bj) { f32x4 v0 = acc[ai][bj][m][0] + bv[bj][0], v1 = acc[ai][bj][m][1] + bv[bj][1];
                    if (ACT == 1) { f32x2 a = gelu_pk((f32x2){v0[0], v0[1]}), b = gelu_pk((f32x2){v0[2], v0[3]}), c = gelu_pk((f32x2){v1[0], v1[1]}), d = gelu_pk((f32x2){v1[2], v1[3]});
                        v0 = (f32x4){a.x, a.y, b.x, b.y}; v1 = (f32x4){c.x, c.y, d.x, d.y}; }
                    v0 = v0 * sc; v1 = v1 * sc; u32x4 w; w.x = cvt_pk_bf16(v0[0], v0[1]); w.y = cvt_pk_bf16(v0[2], v0[3]); w.z = cvt_pk_bf16(v1[0], v1[1]); w.w = cvt_pk_bf16(v1[2], v1[3]);
                    *(u32x4*)(rowp + bj * HALF) = w; } }
    }
};

typedef unsigned u32x2 __attribute__((ext_vector_type(2)));
struct EpiResGate {
    static constexpr bool PERM = true, AFTER_DRAIN = false;
    const float* x; bf16_t* out; int ldc; const float* bias; const float* ada; int ada_ld, gate_off, tiles_per_batch;
    __device__ __forceinline__ void operator()(const f32x4 (&acc)[2][2][4][2], const Unit& u, int wr, int wc, int fr, int fq, int part) const {
        const int row0 = u.pm * BM + wr * 64 + fr, col0 = u.pn * BM + wc * 32 + 8 * fq;
        const float* gp = ada + (size_t)(u.pm / tiles_per_batch) * ada_ld + gate_off;
        f32x4 bv[2][2], gv[2][2];
#pragma unroll
        for (int bj = 0; bj < 2; ++bj)
#pragma unroll
            for (int n = 0; n < 2; ++n) { bv[bj][n] = *(const f32x4*)(bias + col0 + bj * HALF + 4 * n); gv[bj][n] = *(const f32x4*)(gp + col0 + bj * HALF + 4 * n); }
        const __amdgpu_buffer_rsrc_t orsrc = wt_rsrc(out, (size_t)32768 * ldc * 2);
#pragma unroll
        for (int ai = 0; ai < 2; ++ai) {
            if (part == (ai ? 1 : 2)) continue;
#pragma unroll
            for (int mh = 0; mh < 2; ++mh) {
            f32x4 xv[2][2][2];
#pragma unroll
            for (int m = 0; m < 2; ++m) { const size_t off = (size_t)(row0 + ai * HALF + (2 * mh + m) * 16) * ldc + col0;
#pragma unroll
                for (int bj = 0; bj < 2; ++bj)
#pragma unroll
                    for (int n = 0; n < 2; ++n) xv[m][bj][n] = __builtin_nontemporal_load((const f32x4*)(x + off + bj * HALF + 4 * n)); }
#pragma unroll
            for (int m = 0; m < 2; ++m) { const size_t off = (size_t)(row0 + ai * HALF + (2 * mh + m) * 16) * ldc + col0;
#pragma unroll
                for (int bj = 0; bj < 2; ++bj) { const f32x4 o0 = xv[m][bj][0] + gv[bj][0] * (acc[ai][bj][2 * mh + m][0] + bv[bj][0]), o1 = xv[m][bj][1] + gv[bj][1] * (acc[ai][bj][2 * mh + m][1] + bv[bj][1]);
                    u32x4 w; w.x = cvt_pk_bf16(o0[0], o0[1]); w.y = cvt_pk_bf16(o0[2], o0[3]); w.z = cvt_pk_bf16(o1[0], o1[1]); w.w = cvt_pk_bf16(o1[2], o1[3]);
                    store16_wt(orsrc, (unsigned)((off + bj * HALF) * 2), w); } }
            asm volatile("" ::: "memory"); }
            asm volatile("" ::: "memory"); }
    }
};


typedef int i32x4 __attribute__((ext_vector_type(4)));
template <bool I8> struct AccSel { typedef f32x4 type; static __device__ __forceinline__ f32x4 zero() { return (f32x4){0.f, 0.f, 0.f, 0.f}; } };
template <> struct AccSel<true> { typedef i32x4 type; static __device__ __forceinline__ i32x4 zero() { return (i32x4){0, 0, 0, 0}; } };
template <bool I8> __device__ __forceinline__ typename AccSel<I8>::type mma16(bf16x8 a, bf16x8 b, typename AccSel<I8>::type c) {
    if constexpr (I8) return __builtin_amdgcn_mfma_i32_16x16x64_i8(__builtin_bit_cast(i32x4, a), __builtin_bit_cast(i32x4, b), c, 0, 0, 0);
    else return __builtin_amdgcn_mfma_f32_16x16x32_bf16(a, b, c, 0, 0, 0);
}
struct EpiI8Bf16 {
    static constexpr bool PERM = true, AFTER_DRAIN = false;
    bf16_t* O; int ldc; const float* rowscale; float wscale; const float* bias;
    __device__ __forceinline__ void operator()(const i32x4 (&acc)[2][2][4][2], const Unit& u, int wr, int wc, int fr, int fq, int part) const {
        const int row0 = u.pm * BM + wr * 64 + fr, col0 = u.pn * BM + wc * 32 + 8 * fq;
        f32x4 bv[2][2];
#pragma unroll
        for (int bj = 0; bj < 2; ++bj)
#pragma unroll
            for (int n = 0; n < 2; ++n) bv[bj][n] = bias ? *(const f32x4*)(bias + col0 + bj * HALF + 4 * n) : (f32x4){0.f, 0.f, 0.f, 0.f};
        const __amdgpu_buffer_rsrc_t orsrc = wt_rsrc(O, (size_t)32768 * ldc * 2);
#pragma unroll
        for (int ai = 0; ai < 2; ++ai) { if (part == (ai ? 1 : 2)) continue;
#pragma unroll
            for (int m = 0; m < 4; ++m) { const int row = row0 + ai * HALF + m * 16; const float sc = rowscale[row] * wscale; const unsigned rowoff = (unsigned)(((size_t)row * ldc + col0) * 2);
#pragma unroll
                for (int bj = 0; bj < 2; ++bj) { const i32x4 a0 = acc[ai][bj][m][0], a1 = acc[ai][bj][m][1]; const f32x4 b0 = bv[bj][0], b1 = bv[bj][1];
                    u32x4 w; w.x = cvt_pk_bf16((float)a0[0] * sc + b0[0], (float)a0[1] * sc + b0[1]); w.y = cvt_pk_bf16((float)a0[2] * sc + b0[2], (float)a0[3] * sc + b0[3]);
                    w.z = cvt_pk_bf16((float)a1[0] * sc + b1[0], (float)a1[1] * sc + b1[1]); w.w = cvt_pk_bf16((float)a1[2] * sc + b1[2], (float)a1[3] * sc + b1[3]);
                    store16_wt(orsrc, rowoff + bj * HALF * 2, w); } } }
    }
};
template <class Epi, class Sched, bool ALIGN_EPI = false, bool SP2 = false, bool I8 = false>
__device__ __forceinline__ void gemm_phase(PG8_LAS unsigned char* lds, const Gemm g, const Sched& S, const Epi& E) {
    const int tid = threadIdx.x, wid = __builtin_amdgcn_readfirstlane(tid >> 6), lane = tid & 63, wr = wid >> 2, wc = wid & 3, fr = lane & 15, fq = lane >> 4;
    const int K = g.K, nt = K / BK;
    unsigned voffA[2], voffB[2];
#pragma unroll
    for (int i = 0; i < 2; ++i) { int R, C; stage_rc(tid * 16 + i * 8192, R, C); const int Rb = Epi::PERM ? ((R & ~31) + perm32(R & 31)) : R;
        voffA[i] = (unsigned)(R * K + C) * 2u; voffB[i] = (unsigned)(Rb * K + C) * 2u; }
    const size_t kstep = (size_t)(BK * 2);
    const size_t hstep = (size_t)HALF * K * 2;
    const size_t tstep = 2 * hstep;
    const unsigned ldsw = (unsigned)wid * 1024u;
    const int aoff = lds_byte(wr * 64 + fr, fq * 8), boff = lds_byte(wc * 32 + fr, fq * 8);
#define PG8_SA(b, h) (((b) * 2 + (h)) * HTB)
#define PG8_SB(b, h) ((4 + (b) * 2 + (h)) * HTB)
#define PG8_STAGE(bufoff, gbase, voff) do { _Pragma("unroll") for (int _i = 0; _i < 2; ++_i) \
        __builtin_amdgcn_global_load_lds((const unsigned*)((const char*)(gbase) + (voff)[_i]), (PG8_LAS unsigned*)(lds + (bufoff) + ldsw + _i * 8192), 16, 0, 0); } while (0)
#define PG8_LDA(dst, b, h) do { _Pragma("unroll") for (int m = 0; m < 4; ++m) _Pragma("unroll") for (int k = 0; k < 2; ++k) dst[m][k] = *(const PG8_LAS bf16x8*)(lds + PG8_SA(b, h) + aoff + m * 2048 + k * 1024); } while (0)
#define PG8_LDB(dst, b, h) do { _Pragma("unroll") for (int n = 0; n < 2; ++n) _Pragma("unroll") for (int k = 0; k < 2; ++k) dst[n][k] = *(const PG8_LAS bf16x8*)(lds + PG8_SB(b, h) + boff + n * 2048 + k * 1024); } while (0)
#define PG8_MMA(ai, bj, At, Bt) do { __builtin_amdgcn_s_setprio(1); _Pragma("unroll") for (int m = 0; m < 4; ++m) _Pragma("unroll") for (int n = 0; n < 2; ++n) _Pragma("unroll") for (int k = 0; k < 2; ++k) \
        acc[ai][bj][m][n] = mma16<I8>(Bt[n][k], At[m][k], acc[ai][bj][m][n]); __builtin_amdgcn_s_setprio(0); } while (0)
#define PG8_WAIT_V(n) asm volatile("s_waitcnt vmcnt(" #n ")" ::: "memory")
#define PG8_WAIT_L(n) asm volatile("s_waitcnt lgkmcnt(" #n ")" ::: "memory")
#define PG8_BAR __builtin_amdgcn_s_barrier()
#define PG8_SCHED __builtin_amdgcn_sched_barrier(0)
    Unit cur, nxt; int ui = 0;
    if (!S.next(0, cur)) return;
    typedef typename AccSel<I8>::type acc_t;
    acc_t acc[2][2][4][2];
#pragma unroll
    for (int a = 0; a < 2; ++a)
#pragma unroll
        for (int b = 0; b < 2; ++b)
#pragma unroll
            for (int m = 0; m < 4; ++m)
#pragma unroll
                for (int n = 0; n < 2; ++n) acc[a][b][m][n] = AccSel<I8>::zero();
    bf16x8 At[4][2], B0[2][2], B1[2][2];
    const char* cA = (const char*)g.A + (size_t)cur.pm * tstep; const char* cB = (const char*)g.Bt + (size_t)cur.pn * tstep;
    S.a_ready(cur);
    if constexpr (SP2) {
        PG8_STAGE(PG8_SB(0, 0), cB, voffB); PG8_STAGE(PG8_SB(0, 1), cB + hstep, voffB); PG8_STAGE(PG8_SA(0, 0), cA, voffA); PG8_STAGE(PG8_SA(0, 1), cA + hstep, voffA);
        if (wr == 1) PG8_BAR;
        PG8_WAIT_V(2); PG8_BAR;
        PG8_STAGE(PG8_SB(1, 0), cB + kstep, voffB); PG8_STAGE(PG8_SA(1, 0), cA + kstep, voffA); PG8_STAGE(PG8_SB(1, 1), cB + hstep + kstep, voffB);
        PG8_WAIT_V(6); PG8_BAR;
    } else {
        PG8_STAGE(PG8_SB(0, 0), cB, voffB); PG8_STAGE(PG8_SA(0, 0), cA, voffA); PG8_STAGE(PG8_SB(0, 1), cB + hstep, voffB); PG8_STAGE(PG8_SA(0, 1), cA + hstep, voffA);
        if (wr == 1) PG8_BAR;
        PG8_WAIT_V(4); PG8_BAR;
        PG8_STAGE(PG8_SB(1, 0), cB + kstep, voffB); PG8_STAGE(PG8_SA(1, 0), cA + kstep, voffA); PG8_STAGE(PG8_SB(1, 1), cB + hstep + kstep, voffB);
        PG8_WAIT_V(6); PG8_BAR;
    }
    for (;;) {
        const bool has_next = S.next(ui + 1, nxt);
        const char* nA = has_next ? (const char*)g.A + (size_t)nxt.pm * tstep : cA; const char* nB = has_next ? (const char*)g.Bt + (size_t)nxt.pn * tstep : cB;
        const int cpart = S.part(ui); const bool d0 = cpart != 2, d1 = cpart != 1;
        for (int t = 0; t < nt; t += 2) {
            const bool last = (t == nt - 2);
            const char* a1 = cA + (size_t)(t + 1) * kstep;
            const char* a2 = last ? nA : cA + (size_t)(t + 2) * kstep; const char* b2 = last ? nB : cB + (size_t)(t + 2) * kstep;
            const char* a3 = a2 + kstep; const char* b3 = b2 + kstep;
            if (last && has_next) S.a_ready(nxt);
            if constexpr (SP2) {
            PG8_LDB(B0, 0, 0); PG8_LDB(B1, 0, 1); PG8_SCHED; PG8_LDA(At, 0, 0); PG8_STAGE(PG8_SA(1, 1), a1 + hstep, voffA);
            PG8_WAIT_V(8); PG8_WAIT_L(0); PG8_BAR; if (d0) { PG8_MMA(0, 0, At, B0); PG8_MMA(0, 1, At, B1); } PG8_BAR; PG8_SCHED;
            PG8_LDA(At, 0, 1); PG8_STAGE(PG8_SB(0, 0), b2, voffB); PG8_STAGE(PG8_SB(0, 1), b2 + hstep, voffB); PG8_STAGE(PG8_SA(0, 0), a2, voffA);
            PG8_WAIT_V(8); PG8_WAIT_L(0); PG8_BAR; if (d1) { PG8_MMA(1, 0, At, B0); PG8_MMA(1, 1, At, B1); } PG8_BAR; PG8_SCHED;
            PG8_LDB(B0, 1, 0); PG8_LDB(B1, 1, 1); PG8_SCHED; PG8_LDA(At, 1, 0); PG8_STAGE(PG8_SA(0, 1), a2 + hstep, voffA);
            PG8_WAIT_V(8); PG8_WAIT_L(0); PG8_BAR; if (d0) { PG8_MMA(0, 0, At, B0); PG8_MMA(0, 1, At, B1); } PG8_BAR; PG8_SCHED;
            PG8_LDA(At, 1, 1); PG8_STAGE(PG8_SB(1, 0), b3, voffB); PG8_STAGE(PG8_SB(1, 1), b3 + hstep, voffB); PG8_STAGE(PG8_SA(1, 0), a3, voffA);
            PG8_WAIT_V(8); PG8_WAIT_L(0); PG8_BAR; if (d1) { PG8_MMA(1, 0, At, B0); PG8_MMA(1, 1, At, B1); } PG8_BAR; PG8_SCHED;
            } else {
            PG8_LDB(B0, 0, 0); PG8_SCHED; PG8_LDA(At, 0, 0); PG8_STAGE(PG8_SA(1, 1), a1 + hstep, voffA);
            PG8_WAIT_L(8); PG8_BAR; PG8_WAIT_L(0); PG8_MMA(0, 0, At, B0); PG8_BAR; PG8_SCHED;
            PG8_LDB(B1, 0, 1); PG8_STAGE(PG8_SB(0, 0), b2, voffB);
            PG8_BAR; PG8_WAIT_L(0); PG8_MMA(0, 1, At, B1); PG8_BAR;
            PG8_LDA(At, 0, 1); PG8_STAGE(PG8_SA(0, 0), a2, voffA);
            PG8_BAR; PG8_WAIT_L(0); PG8_MMA(1, 0, At, B0); PG8_BAR; PG8_SCHED;
            PG8_STAGE(PG8_SB(0, 1), b2 + hstep, voffB);
            PG8_WAIT_V(6); PG8_BAR; PG8_MMA(1, 1, At, B1); PG8_BAR;
            PG8_LDB(B0, 1, 0); PG8_SCHED; PG8_LDA(At, 1, 0); PG8_STAGE(PG8_SA(0, 1), a2 + hstep, voffA);
            PG8_WAIT_L(8); PG8_BAR; PG8_WAIT_L(0); PG8_MMA(0, 0, At, B0); PG8_BAR; PG8_SCHED;
            PG8_LDB(B1, 1, 1); PG8_STAGE(PG8_SB(1, 0), b3, voffB);
            PG8_BAR; PG8_WAIT_L(0); PG8_MMA(0, 1, At, B1); PG8_BAR;
            PG8_LDA(At, 1, 1); PG8_STAGE(PG8_SA(1, 0), a3, voffA);
            PG8_BAR; PG8_WAIT_L(0); PG8_MMA(1, 0, At, B0); PG8_BAR; PG8_SCHED;
            PG8_STAGE(PG8_SB(1, 1), b3 + hstep, voffB);
            PG8_WAIT_V(6); PG8_BAR; PG8_MMA(1, 1, At, B1); PG8_BAR;
            }
        }
        if constexpr (ALIGN_EPI) { if (wr == 0) PG8_BAR; }
        if constexpr (!Epi::AFTER_DRAIN) { E(acc, cur, wr, wc, fr, fq, cpart); S.done(cur); }
        if (!has_next) break;
#pragma unroll
        for (int a = 0; a < 2; ++a)
#pragma unroll
            for (int b = 0; b < 2; ++b)
#pragma unroll
                for (int m = 0; m < 4; ++m)
#pragma unroll
                    for (int n = 0; n < 2; ++n) acc[a][b][m][n] = AccSel<I8>::zero();
        cur = nxt; cA = nA; cB = nB; ++ui;
        if constexpr (ALIGN_EPI) { if (wr == 1) PG8_BAR; }
    }
    PG8_WAIT_V(0);
    if constexpr (!ALIGN_EPI) { if (wr == 0) PG8_BAR; }
    PG8_BAR;
    if constexpr (Epi::AFTER_DRAIN) { E.fused(acc, cur, wr, wc, fr, fq, lds, wid, lane); S.done(cur); }
#undef PG8_SA
#undef PG8_SB
#undef PG8_STAGE
#undef PG8_LDA
#undef PG8_LDB
#undef PG8_MMA
#undef PG8_WAIT_V
#undef PG8_WAIT_L
#undef PG8_BAR
#undef PG8_SCHED
}
}

constexpr int NWAVES = 8;
constexpr int NPHASES = 12;
#ifndef MK_N_LAUNCHES
#define MK_N_LAUNCHES 1
#endif
constexpr int N_LAUNCHES = MK_N_LAUNCHES;
static_assert(N_LAUNCHES == 1 || N_LAUNCHES == NPHASES, "MK_N_LAUNCHES is 1 or NPHASES");

constexpr int BATCH = 16, SEQ = 2048, D = 1024, M = BATCH * SEQ;
constexpr int IN_W = 2304, O_Q = 0, O_K = 512, O_V = 640, O_B = 768, O_C = 1280, O_U = 1792;
constexpr int NQH = 8, NKVH = 2, HD = 64, WIN = 128;
constexpr int NKEYS = 128, NEXP = 16384, PH = 8, TOPK = 16, DKEY = 256, DHALF = 128, QW = PH * DKEY;
constexpr int ADA_W = 6 * D, ADA_KC = 8;
constexpr float EPS = 1e-6f;

constexpr size_t MiB = 1u << 20;
constexpr size_t WS_CTL = 0, CTL_ZERO_BYTES = 64 * 1024;
constexpr size_t WS_ADAP = 1 * MiB;
constexpr size_t WS_ADA = 4 * MiB;
constexpr size_t WS_WIN = 5 * MiB;
constexpr size_t WS_WOUT = 10 * MiB;
constexpr size_t WS_WQ = 12 * MiB;
constexpr size_t WS_K1 = 16 * MiB, WS_K2 = 16 * MiB + 512 * 1024;
constexpr size_t WS_U = 17 * MiB, WS_V = 33 * MiB;
constexpr float U_SCALE = 896.f, V_SCALE = 8.f, WQ_SCALE = 896.f;
constexpr size_t WS_H = 81 * MiB;
constexpr size_t WS_PROJ = 145 * MiB;
constexpr size_t WS_MIX = 289 * MiB;
constexpr size_t WS_IDX = 353 * MiB;
constexpr size_t WS_GATE = 369 * MiB;
constexpr size_t WS_H8 = 49 * MiB;
constexpr size_t WS_HS = 393 * MiB;
constexpr size_t WS_W16 = 385 * MiB;
constexpr size_t WS_X1 = 417 * MiB;
constexpr size_t WS_END = 481 * MiB;
constexpr size_t WS_PA = WS_PROJ;
constexpr size_t WS_SS = WS_MIX;
constexpr int CW_BAR = 4096;
static_assert((CW_BAR + 3456) * 4 <= (int)CTL_ZERO_BYTES, "barrier words inside the zeroed region");

constexpr int RING_OFF = 0, RING_BYTES = 131072;
constexpr int LDSCTL_OFF = 135168, MISC_OFF = LDSCTL_OFF + 320;
constexpr int LDS_BYTES = 147456;
static_assert(MISC_OFF + 128 <= LDS_BYTES, "LDS map");

#define GAS __attribute__((address_space(1)))
#define LAS __attribute__((address_space(3)))
typedef unsigned short bf16;
typedef unsigned v4u __attribute__((ext_vector_type(4)));
typedef float f32x4 __attribute__((ext_vector_type(4)));
typedef short bf16x8 __attribute__((ext_vector_type(8)));
typedef GAS unsigned gu32;
typedef GAS unsigned long long gu64;
#define RLX_AGENT __ATOMIC_RELAXED, __HIP_MEMORY_SCOPE_AGENT
#define LDS_WAIT() asm volatile("s_waitcnt lgkmcnt(0)" ::: "memory")
#define VM_WAIT() asm volatile("s_waitcnt vmcnt(0)" ::: "memory")
__device__ __forceinline__ unsigned long long rt() { return __builtin_amdgcn_s_memrealtime(); }
__device__ __forceinline__ unsigned f2bf(float f) { unsigned u = __builtin_bit_cast(unsigned, f); return (u + 0x7fffu + ((u >> 16) & 1u)) >> 16; }
__device__ __forceinline__ unsigned pk2(float lo, float hi) { return f2bf(lo) | (f2bf(hi) << 16); }

#define XB_TMO      128
#define XB_XCNT(j)  (256  + 64 * (j))
#define XB_XSUB(j)  (1280 + 64 * (j))
#define XB_XGEN(j)  (2304 + 64 * (j))
#define XB_TOP      3328
#define XB_TOPGEN   3392
#define XCD_BAR_WORDS 3456
#define XB_SPIN_CAP (1u << 22)

__device__ __forceinline__ unsigned xb_ld(unsigned* p)              { return __hip_atomic_load(p, __ATOMIC_RELAXED, __HIP_MEMORY_SCOPE_AGENT); }
__device__ __forceinline__ unsigned xb_add(unsigned* p, unsigned v) { return __hip_atomic_fetch_add(p, v, __ATOMIC_RELAXED, __HIP_MEMORY_SCOPE_AGENT); }
__device__ __forceinline__ unsigned xb_xcc_id() { return (unsigned)__builtin_amdgcn_s_getreg((3 << 11) | 20) & 0xFu; }
#define XB_SPIN(cond, bar) do { unsigned _sp = 0; while (cond) { __builtin_amdgcn_s_sleep(1); \
    if ((++_sp & 255u) == 0u) { if (xb_ld(&(bar)[XB_TMO])) break; if (_sp > XB_SPIN_CAP) { atomicAdd(&(bar)[XB_TMO], 1u); break; } } } } while (0)

struct XcdBarrier {
    unsigned* bar; unsigned x;
    volatile LAS unsigned* st;
};

__device__ __forceinline__ XcdBarrier xcd_barrier_post(unsigned* bar, volatile LAS unsigned* st) {
    XcdBarrier b; b.bar = bar; b.x = xb_xcc_id(); b.st = st;
    if (threadIdx.x == 0) (void)xb_add(&bar[XB_XCNT(b.x)], 1u);
    return b;
}
__device__ __forceinline__ void xcd_barrier_complete(unsigned* bar, unsigned x, unsigned& nloc, unsigned& nx) {
    const unsigned G = gridDim.x * gridDim.y * gridDim.z;
    unsigned sum, cnt, mine, sp = 0u;
    for (;;) {
        sum = 0u; cnt = 0u; mine = 0u;
#pragma unroll
        for (unsigned j = 0; j < 16; ++j) { const unsigned c = xb_ld(&bar[XB_XCNT(j)]); sum += c; cnt += (c > 0u) ? 1u : 0u; mine = (j == x) ? c : mine; }
        if (sum == G) break;
        __builtin_amdgcn_s_sleep(1);
        if ((++sp & 255u) == 0u) { if (xb_ld(&bar[XB_TMO])) break; if (sp > XB_SPIN_CAP) { atomicAdd(&bar[XB_TMO], 1u); break; } }
    }
    nloc = mine > 0u ? mine : 1u; nx = cnt > 0u ? cnt : 1u;
}

__device__ __forceinline__ void xcd_barrier(const XcdBarrier& b) {
    asm volatile("s_waitcnt vmcnt(0)" ::: "memory");
    __syncthreads();
    if (threadIdx.x == 0) {
        unsigned* bar = b.bar;
        __builtin_amdgcn_s_waitcnt(0);
        unsigned nloc = b.st[0], nx = b.st[1];
        if (nloc == 0u) { xcd_barrier_complete(bar, b.x, nloc, nx); b.st[0] = nloc; b.st[1] = nx; }
        const unsigned old = xb_add(&bar[XB_XSUB(b.x)], 1u);
        const unsigned gen = old / nloc;
        if (old + 1u == (gen + 1u) * nloc) {
            __builtin_amdgcn_fence(__ATOMIC_RELEASE, "agent");
            asm volatile("s_waitcnt vmcnt(0)" ::: "memory");
            const unsigned og = xb_add(&bar[XB_TOP], 1u);
            const unsigned tg = og / nx;
            if (og + 1u == (tg + 1u) * nx) xb_add(&bar[XB_TOPGEN], 1u);
            else XB_SPIN(xb_ld(&bar[XB_TOPGEN]) == tg, bar);
            __builtin_amdgcn_fence(__ATOMIC_ACQUIRE, "agent");
            xb_add(&bar[XB_XGEN(b.x)], 1u);
            asm volatile("s_waitcnt vmcnt(0)" ::: "memory");
        } else {
            XB_SPIN(xb_ld(&bar[XB_XGEN(b.x)]) == gen, bar);
            __builtin_amdgcn_fence(__ATOMIC_ACQUIRE, "agent");
            asm volatile("s_waitcnt vmcnt(0)" ::: "memory");
        }
    }
    __syncthreads();
}

struct Frame {
    LAS unsigned char* lds;
    volatile LAS unsigned* MISC;
    gu32* ctl;
    int tid, lane, wave;
    int vcu, G;
    const float* in[20]; float* out; unsigned char* ws;
};
#define IN_X 0
#define IN_C 1
#define IN_WADA 2
#define IN_BADA 3
#define IN_G1 4
#define IN_WIN 5
#define IN_BIN 6
#define IN_SINK 7
#define IN_CONVW 8
#define IN_AOG 9
#define IN_COG 10
#define IN_WOUT 11
#define IN_BOUT 12
#define IN_G2 13
#define IN_WQ 14
#define IN_PK1 15
#define IN_PK2 16
#define IN_PU 17
#define IN_PV 18
#define IN_GF 19

typedef __bf16 bf16x2_t __attribute__((ext_vector_type(2)));
typedef unsigned v2u __attribute__((ext_vector_type(2)));
__device__ __forceinline__ float dot2(unsigned a, unsigned b, float acc) { return __builtin_amdgcn_fdot2_f32_bf16(__builtin_bit_cast(bf16x2_t, a), __builtin_bit_cast(bf16x2_t, b), acc, false); }
__device__ __forceinline__ float dot8(v4u a, v4u b, float acc) { acc = dot2(a.x, b.x, acc); acc = dot2(a.y, b.y, acc); acc = dot2(a.z, b.z, acc); acc = dot2(a.w, b.w, acc); return acc; }
__device__ __forceinline__ float bflo(unsigned w) { return __uint_as_float(w << 16); }
__device__ __forceinline__ float bfhi(unsigned w) { return __uint_as_float(w & 0xffff0000u); }
__device__ __forceinline__ float wave_sum(float v) {
#pragma unroll
    for (int o = 1; o < 64; o <<= 1) v += __shfl_xor(v, o);
    return v;
}
__device__ __forceinline__ unsigned wave_umax(unsigned v) {
#pragma unroll
    for (int o = 1; o < 64; o <<= 1) { const unsigned t = (unsigned)__shfl_xor((int)v, o); v = v > t ? v : t; }
    return v;
}
__device__ __forceinline__ unsigned f2ord(float f) { const unsigned u = __float_as_uint(f); return (u & 0x80000000u) ? ~u : (u | 0x80000000u); }
__device__ __forceinline__ float ord2f(unsigned u) { return __uint_as_float((u & 0x80000000u) ? (u & 0x7fffffffu) : ~u); }

__device__ __forceinline__ unsigned pk4_i8(f32x4 a, float sc) {
    const int q0 = max(-127, min(127, __float2int_rn(a.x * sc))), q1 = max(-127, min(127, __float2int_rn(a.y * sc))), q2 = max(-127, min(127, __float2int_rn(a.z * sc))), q3 = max(-127, min(127, __float2int_rn(a.w * sc)));
    return (unsigned)(q0 & 0xff) | ((unsigned)(q1 & 0xff) << 8) | ((unsigned)(q2 & 0xff) << 16) | ((unsigned)q3 << 24); }
__device__ __forceinline__ void p0_transpose_item(const float* W, int K, int N, bf16* WT, LAS float* scr, int item, int lane) {
    const int nblk = N / 64, kb = item / nblk, nb = item % nblk, k0 = 64 * kb, n0 = 64 * nb;
#pragma unroll 16
    for (int kk = 0; kk < 64; ++kk) scr[kk * 65 + lane] = __builtin_nontemporal_load(W + (size_t)(k0 + kk) * N + n0 + lane);
    LDS_WAIT(); asm volatile("" ::: "memory");
    const int c = lane & 7;
#pragma unroll
    for (int j = 0; j < 8; ++j) { const int n = (lane >> 3) + 8 * j; const LAS float* s = scr + (8 * c) * 65 + n;
        v4u o; o.x = pk2(s[0 * 65], s[1 * 65]); o.y = pk2(s[2 * 65], s[3 * 65]); o.z = pk2(s[4 * 65], s[5 * 65]); o.w = pk2(s[6 * 65], s[7 * 65]);
        *(GAS v4u*)(WT + (size_t)(n0 + n) * K + k0 + 8 * c) = o; }
    LDS_WAIT(); asm volatile("" ::: "memory");
}
__device__ __forceinline__ void p0_transpose_item_i8(const float* W, int K, int N, unsigned char* WT, LAS float* scr, int item, int lane, float sc) {
    const int nblk = N / 64, kb = item / nblk, nb = item % nblk, k0 = 64 * kb, n0 = 64 * nb;
#pragma unroll 16
    for (int kk = 0; kk < 64; ++kk) scr[kk * 65 + lane] = __builtin_nontemporal_load(W + (size_t)(k0 + kk) * N + n0 + lane);
    LDS_WAIT(); asm volatile("" ::: "memory");
    const int c = lane & 7;
#pragma unroll
    for (int j = 0; j < 8; ++j) { const int n = (lane >> 3) + 8 * j; const LAS float* s = scr + (8 * c) * 65 + n;
        v2u o; o.x = pk4_i8((f32x4){s[0 * 65], s[1 * 65], s[2 * 65], s[3 * 65]}, sc); o.y = pk4_i8((f32x4){s[4 * 65], s[5 * 65], s[6 * 65], s[7 * 65]}, sc);
        *(GAS v2u*)(WT + (size_t)(n0 + n) * K + k0 + 8 * c) = o; }
    LDS_WAIT(); asm volatile("" ::: "memory");
}
__device__ __forceinline__ void p0_convert_item(const float* src, bf16* dst, size_t item, int lane) {
    const GAS f32x4* s = (const GAS f32x4*)(src + item * 2048) + lane * 2;
    GAS v4u* d = (GAS v4u*)(dst + item * 2048) + lane;
#pragma unroll
    for (int j = 0; j < 4; ++j) { const f32x4 a = s[j * 128], b = s[j * 128 + 1];
        v4u o; o.x = pk2(a.x, a.y); o.y = pk2(a.z, a.w); o.z = pk2(b.x, b.y); o.w = pk2(b.z, b.w); d[j * 64] = o; }
}
__device__ __forceinline__ unsigned pk4_fp8(f32x4 a, float sc) { int w = __builtin_amdgcn_cvt_pk_fp8_f32(a.x * sc, a.y * sc, 0, false); w = __builtin_amdgcn_cvt_pk_fp8_f32(a.z * sc, a.w * sc, w, true); return (unsigned)w; }
__device__ __forceinline__ void quad_transpose4(unsigned (&d)[4], int lane) {
    const bool b0 = lane & 1, b1 = lane & 2;
    { const unsigned s0 = b0 ? d[0] : d[1], s1 = b0 ? d[2] : d[3];
      const unsigned r0 = (unsigned)__builtin_amdgcn_update_dpp(0, (int)s0, 0xB1, 0xf, 0xf, true), r1 = (unsigned)__builtin_amdgcn_update_dpp(0, (int)s1, 0xB1, 0xf, 0xf, true);
      if (b0) { d[0] = r0; d[2] = r1; } else { d[1] = r0; d[3] = r1; } }
    { const unsigned s0 = b1 ? d[0] : d[2], s1 = b1 ? d[1] : d[3];
      const unsigned r0 = (unsigned)__builtin_amdgcn_update_dpp(0, (int)s0, 0x4E, 0xf, 0xf, true), r1 = (unsigned)__builtin_amdgcn_update_dpp(0, (int)s1, 0x4E, 0xf, 0xf, true);
      if (b1) { d[0] = r0; d[1] = r1; } else { d[2] = r0; d[3] = r1; } }
}
template <bool FP8> __device__ __forceinline__ void p0_table_item(const float* src, unsigned char* dst, size_t item, int lane, float sc) {
    const GAS f32x4* s = (const GAS f32x4*)(src + item * 4096) + lane;
    f32x4 v[16];
#pragma unroll
    for (int i = 0; i < 16; ++i) v[i] = __builtin_nontemporal_load(s + i * 64);
    const __amdgpu_buffer_rsrc_t rs = pg8::wt_rsrc(dst, (size_t)NEXP * D);
    const int Q = lane >> 2, p = lane & 3;
#pragma unroll
    for (int j = 0; j < 4; ++j) { unsigned d[4];
#pragma unroll
        for (int q = 0; q < 4; ++q) d[q] = FP8 ? pk4_fp8(v[4 * j + q], sc) : pk4_i8(v[4 * j + q], sc);
        quad_transpose4(d, lane);
        pg8::store16_wt(rs, (unsigned)((size_t)(2 * p + (Q >> 3)) * NEXP * 128 + (item * 4 + j) * 128 + (Q & 7) * 16), (v4u){d[0], d[1], d[2], d[3]}); }
}
__device__ __forceinline__ void p0_ada_task(Frame& F, int task, LAS float* scr) {
    const int kc = task / (ADA_W / 64), ng = task % (ADA_W / 64), lane = F.lane;
    const float* c = F.in[IN_C];
    for (int e = lane; e < BATCH * 128; e += 64) { const int b = e >> 7, kk = e & 127; const float cv = c[b * D + kc * 128 + kk]; scr[kk * 16 + b] = cv / (1.f + expf(-cv)); }
    LDS_WAIT(); asm volatile("" ::: "memory");
    float acc[BATCH];
#pragma unroll
    for (int b = 0; b < BATCH; ++b) acc[b] = 0.f;
    const float* wp = F.in[IN_WADA] + (size_t)(kc * 128) * ADA_W + ng * 64 + lane;
#pragma unroll 1
    for (int k0 = 0; k0 < 128; k0 += 16) { float wv[16];
#pragma unroll
        for (int u = 0; u < 16; ++u) wv[u] = __builtin_nontemporal_load(wp + (size_t)(k0 + u) * ADA_W);
#pragma unroll
        for (int u = 0; u < 16; ++u) { const LAS f32x4* sp = (const LAS f32x4*)(scr + (k0 + u) * 16);
#pragma unroll
            for (int q = 0; q < 4; ++q) { const f32x4 s = sp[q]; acc[4 * q] += s.x * wv[u]; acc[4 * q + 1] += s.y * wv[u]; acc[4 * q + 2] += s.z * wv[u]; acc[4 * q + 3] += s.w * wv[u]; } } }
    float* ap = (float*)(F.ws + WS_ADAP);
#pragma unroll
    for (int b = 0; b < BATCH; ++b) ap[(size_t)(kc * BATCH + b) * ADA_W + ng * 64 + lane] = acc[b];
    LDS_WAIT(); asm volatile("" ::: "memory");
}
__device__ __forceinline__ void p0_prologue(Frame& F) {
    LAS float* scr = (LAS float*)(F.lds + RING_OFF + F.wave * 16896);
    const int gw = F.vcu * NWAVES + F.wave, NGW = F.G * NWAVES;
    constexpr int I_ADA = ADA_KC * (ADA_W / 64);
    constexpr int I_T1 = (D / 64) * (IN_W / 64), I_T2 = (D / 64) * (D / 64), I_T3 = (D / 64) * (QW / 64);
    constexpr int I_K = PH * NKEYS * DHALF / 2048;
    constexpr int I_E = (int)((size_t)NEXP * D / 4096);
    constexpr int NITEMS = I_ADA + I_T1 + I_T2 + I_T3 + 2 * I_K + 2 * I_E;
    for (int it = gw; it < NITEMS; it += NGW) {
        int r = it;
        if (r < I_ADA) { p0_ada_task(F, r, scr); continue; } r -= I_ADA;
        if (r < I_T1) { p0_transpose_item_i8(F.in[IN_WIN], D, IN_W, F.ws + WS_WIN, scr, r, F.lane, WQ_SCALE); continue; } r -= I_T1;
        if (r < I_T2) { p0_transpose_item(F.in[IN_WOUT], D, D, (bf16*)(F.ws + WS_WOUT), scr, r, F.lane); continue; } r -= I_T2;
        if (r < I_T3) { p0_transpose_item_i8(F.in[IN_WQ], D, QW, F.ws + WS_WQ, scr, r, F.lane, WQ_SCALE); continue; } r -= I_T3;
        if (r < I_K) { p0_convert_item(F.in[IN_PK1], (bf16*)(F.ws + WS_K1), r, F.lane); continue; } r -= I_K;
        if (r < I_K) { p0_convert_item(F.in[IN_PK2], (bf16*)(F.ws + WS_K2), r, F.lane); continue; } r -= I_K;
        if (r < I_E) { p0_table_item<false>(F.in[IN_PU], F.ws + WS_U, r, F.lane, U_SCALE); continue; } r -= I_E;
        p0_table_item<true>(F.in[IN_PV], F.ws + WS_V, r, F.lane, V_SCALE);
    }
}

__device__ __forceinline__ void mod_row(const float* xrow, bf16* orow, const LAS float* SC, const LAS float* SH, int lane) {
    const GAS f32x4* xr = (const GAS f32x4*)xrow + lane;
    f32x4 v[4]; float s = 0.f;
#pragma unroll
    for (int j = 0; j < 4; ++j) { v[j] = xr[64 * j]; s += (v[j].x * v[j].x + v[j].y * v[j].y) + (v[j].z * v[j].z + v[j].w * v[j].w); }
    const float rstd = 1.0f / sqrtf(wave_sum(s) * (1.f / D) + EPS);
    GAS unsigned long long* o8 = (GAS unsigned long long*)orow + lane;
#pragma unroll
    for (int j = 0; j < 4; ++j) { const f32x4 sc = ((const LAS f32x4*)SC)[lane + 64 * j], sh = ((const LAS f32x4*)SH)[lane + 64 * j];
        const f32x4 o = v[j] * rstd * sc + sh;
        o8[64 * j] = (unsigned long long)pk2(o.x, o.y) | ((unsigned long long)pk2(o.z, o.w) << 32); }
}
__device__ __forceinline__ void mod_row_bf(const bf16* xrow, bf16* orow, const LAS float* SC, const LAS float* SH, int lane) {
    const GAS v2u* xr = (const GAS v2u*)xrow + lane;
    f32x4 v[4]; float s = 0.f;
#pragma unroll
    for (int j = 0; j < 4; ++j) { const v2u w = xr[64 * j]; v[j] = (f32x4){bflo(w.x), bfhi(w.x), bflo(w.y), bfhi(w.y)}; s += (v[j].x * v[j].x + v[j].y * v[j].y) + (v[j].z * v[j].z + v[j].w * v[j].w); }
    const float rstd = 1.0f / sqrtf(wave_sum(s) * (1.f / D) + EPS);
    GAS unsigned long long* o8 = (GAS unsigned long long*)orow + lane;
#pragma unroll
    for (int j = 0; j < 4; ++j) { const f32x4 sc = ((const LAS f32x4*)SC)[lane + 64 * j], sh = ((const LAS f32x4*)SH)[lane + 64 * j];
        const f32x4 o = v[j] * rstd * sc + sh;
        o8[64 * j] = (unsigned long long)pk2(o.x, o.y) | ((unsigned long long)pk2(o.z, o.w) << 32); }
}
__device__ __forceinline__ void mod_load(const float* xrow, int lane, f32x4 (&v)[4]) { const GAS f32x4* xr = (const GAS f32x4*)xrow + lane;
#pragma unroll
    for (int j = 0; j < 4; ++j) v[j] = __builtin_nontemporal_load(xr + 64 * j); }
__device__ __forceinline__ void mod_load_bf(const bf16* xrow, int lane, f32x4 (&v)[4]) { const GAS v4u* xr = (const GAS v4u*)xrow + lane;
#pragma unroll
    for (int jj = 0; jj < 2; ++jj) { const v4u w = xr[64 * jj]; v[2 * jj] = (f32x4){bflo(w.x), bfhi(w.x), bflo(w.y), bfhi(w.y)}; v[2 * jj + 1] = (f32x4){bflo(w.z), bfhi(w.z), bflo(w.w), bfhi(w.w)}; } }
template <bool I8, int LAYOUT = 0> __device__ __forceinline__ void mod_finish(const f32x4 (&v)[4], bf16* orow, unsigned char* h8base, size_t row, float* hs_out, const LAS float* SC, const LAS float* SH, int lane) {
    float s = 0.f;
#pragma unroll
    for (int j = 0; j < 4; ++j) s += (v[j].x * v[j].x + v[j].y * v[j].y) + (v[j].z * v[j].z + v[j].w * v[j].w);
    const float rstd = 1.0f / sqrtf(wave_sum(s) * (1.f / D) + EPS);
    f32x4 o[4]; float am = 0.f;
#pragma unroll
    for (int j = 0; j < 4; ++j) { const int q4 = LAYOUT ? 2 * lane + 128 * (j >> 1) + (j & 1) : lane + 64 * j; const f32x4 sc = ((const LAS f32x4*)SC)[q4], sh = ((const LAS f32x4*)SH)[q4]; o[j] = v[j] * rstd * sc + sh;
        am = fmaxf(am, fmaxf(fmaxf(fabsf(o[j].x), fabsf(o[j].y)), fmaxf(fabsf(o[j].z), fabsf(o[j].w)))); }
    static_assert(I8, "only the int8 form is used");
#pragma unroll
    for (int off = 1; off < 64; off <<= 1) am = fmaxf(am, __shfl_xor(am, off));
    const float qs = am > 0.f ? 127.f / am : 0.f;
    unsigned d[4];
#pragma unroll
    for (int j = 0; j < 4; ++j) d[j] = pk4_i8(o[j], qs);
    unsigned col;
    if (LAYOUT == 0) { quad_transpose4(d, lane); col = 256u * (lane & 3) + 16u * (lane >> 2); }
    else { const bool b0 = lane & 1; const unsigned s0 = b0 ? d[0] : d[2], s1 = b0 ? d[1] : d[3];
        const unsigned r0 = (unsigned)__builtin_amdgcn_update_dpp(0, (int)s0, 0xB1, 0xf, 0xf, true), r1 = (unsigned)__builtin_amdgcn_update_dpp(0, (int)s1, 0xB1, 0xf, 0xf, true);
        if (b0) { d[0] = r0; d[1] = r1; col = 512u + 8u * (lane - 1); } else { d[2] = r0; d[3] = r1; col = 8u * lane; } }
    pg8::store16_wt(pg8::wt_rsrc(h8base, (size_t)M * D), (unsigned)(row * D) + col, (v4u){d[0], d[1], d[2], d[3]});
    if (lane == 0) *hs_out = am * (1.f / 127.f);
}
__device__ __forceinline__ void p1_hpass(Frame& F) {
    LAS float* SC = (LAS float*)(F.lds); LAS float* SH = SC + D;
    const float* adap = (const float*)(F.ws + WS_ADAP); const float* bada = F.in[IN_BADA]; const float* g1 = F.in[IN_G1];
    float* ada = (float*)(F.ws + WS_ADA);
    for (int e = blockIdx.x * 512 + F.tid; e < BATCH * ADA_W; e += F.G * 512) { const int b = e / ADA_W, n = e % ADA_W; float s = bada[n];
#pragma unroll
        for (int kc = 0; kc < ADA_KC; ++kc) s += adap[(size_t)(kc * BATCH + b) * ADA_W + n];
        ada[e] = s; }
    for (int tile = blockIdx.x; tile < M / 128; tile += F.G) {
        const int b = tile / (SEQ / 128);
        for (int d = F.tid; d < D; d += 512) { float sh = bada[d], sc = bada[D + d];
#pragma unroll
            for (int kc = 0; kc < ADA_KC; ++kc) { const float* p = adap + (size_t)(kc * BATCH + b) * ADA_W; sh += p[d]; sc += p[D + d]; }
            SC[d] = g1[d] * (1.f + sc); SH[d] = sh; }
        __syncthreads();
        { f32x4 va[4], vb[4];
          mod_load(F.in[IN_X] + ((size_t)tile * 128 + F.wave) * D, F.lane, va);
#pragma unroll 1
          for (int r = F.wave; r < 128; r += 2 * NWAVES) { const size_t row = (size_t)tile * 128 + r;
              mod_load(F.in[IN_X] + (row + NWAVES) * D, F.lane, vb);
              mod_finish<true, 0>(va, nullptr, F.ws + WS_H8, row, (float*)(F.ws + WS_HS) + row, SC, SH, F.lane);
              if (r + 2 * NWAVES < 128) mod_load(F.in[IN_X] + (row + 2 * NWAVES) * D, F.lane, va);
              mod_finish<true, 0>(vb, nullptr, F.ws + WS_H8, row + NWAVES, (float*)(F.ws + WS_HS) + (row + NWAVES), SC, SH, F.lane); } }
        __syncthreads();
    }
}
__device__ __forceinline__ void p5_h2pass(Frame& F) {
    LAS float* SC = (LAS float*)(F.lds); LAS float* SH = SC + D;
    const float* ada = (const float*)(F.ws + WS_ADA); const float* g2 = F.in[IN_G2];
    for (int tile = blockIdx.x; tile < M / 128; tile += F.G) {
        const int b = tile / (SEQ / 128);
        for (int d = F.tid; d < D; d += 512) { SC[d] = g2[d] * (1.f + ada[(size_t)b * ADA_W + 4 * D + d]); SH[d] = ada[(size_t)b * ADA_W + 3 * D + d]; }
        __syncthreads();
        { f32x4 va[4], vb[4]; const bf16* X1 = (const bf16*)(F.ws + WS_X1);
          mod_load_bf(X1 + ((size_t)tile * 128 + F.wave) * D, F.lane, va);
#pragma unroll 1
          for (int r = F.wave; r < 128; r += 2 * NWAVES) { const size_t row = (size_t)tile * 128 + r;
              mod_load_bf(X1 + (row + NWAVES) * D, F.lane, vb);
              mod_finish<true, 1>(va, nullptr, F.ws + WS_H8, row, (float*)(F.ws + WS_HS) + row, SC, SH, F.lane);
              if (r + 2 * NWAVES < 128) mod_load_bf(X1 + (row + 2 * NWAVES) * D, F.lane, va);
              mod_finish<true, 1>(vb, nullptr, F.ws + WS_H8, row + NWAVES, (float*)(F.ws + WS_HS) + (row + NWAVES), SC, SH, F.lane); } }
        __syncthreads();
    }
}

typedef float f32x16 __attribute__((ext_vector_type(16)));
typedef short s16x4 __attribute__((ext_vector_type(4)));
typedef __bf16 bf16x8_t __attribute__((ext_vector_type(8)));
#define MFMA32(a, b, c) __builtin_amdgcn_mfma_f32_32x32x16_bf16((a), (b), (c), 0, 0, 0)
constexpr int KS = 144, VS = 192;
__device__ __forceinline__ void p3_attn_unit(Frame& F, int unit) {
    const int kh = unit & 1, nb = (unit >> 1) & 15, b = unit >> 5;
    LAS unsigned char* KL = F.lds; LAS unsigned char* VL = F.lds + 256 * KS;
    const bf16* proj = (const bf16*)(F.ws + WS_PROJ);
    const int tok0 = b * SEQ + nb * 128;
    for (int c = F.tid; c < 2048; c += 512) { const int j = c >> 3, ch = c & 7;
        v4u kv = (v4u){0u, 0u, 0u, 0u}, vv = (v4u){0u, 0u, 0u, 0u};
        if (nb > 0 || j >= 128) { const bf16* rowp = proj + (size_t)(tok0 - 128 + j) * IN_W; kv = *(const GAS v4u*)(rowp + O_K + kh * HD + ch * 8); vv = *(const GAS v4u*)(rowp + O_V + kh * HD + ch * 8); }
        *(LAS v4u*)(KL + j * KS + ch * 16) = kv; *(LAS v4u*)(VL + j * VS + ch * 16) = vv; }
    __syncthreads();
    const int lane = F.lane, r = lane & 31, hh = lane >> 5;
#pragma unroll 1
    for (int task = F.wave; task < 16; task += NWAVES) {
        const int g = task >> 2, w = task & 3, qh = kh * 4 + g, i0 = 32 * w;
        const bf16* qp = proj + (size_t)(tok0 + i0 + r) * IN_W + O_Q + qh * HD + 8 * hh;
        bf16x8 qf[4];
#pragma unroll
        for (int s = 0; s < 4; ++s) qf[s] = *(const GAS bf16x8*)(qp + 16 * s);
        f32x16 sc[5];
#pragma unroll
        for (int t = 0; t < 5; ++t) {
#pragma unroll
            for (int e = 0; e < 16; ++e) sc[t][e] = 0.f;
#pragma unroll
            for (int s = 0; s < 4; ++s) { const bf16x8 a = *(const LAS bf16x8*)(KL + ((w + t) * 32 + r) * KS + 32 * s + 16 * hh); sc[t] = MFMA32(a, qf[s], sc[t]); } }
        const float sink = F.in[IN_SINK][qh];
        float mx = sink;
#pragma unroll
        for (int t = 0; t < 5; ++t)
#pragma unroll
            for (int e = 0; e < 16; ++e) { const int kr = (e & 3) + 8 * (e >> 2) + 4 * hh;
                bool valid = (nb > 0) || (w + t >= 4);
                if (t == 0) valid = valid && (kr > r);
                if (t == 4) valid = valid && (kr <= r);
                const float v = valid ? sc[t][e] * 0.125f : -1e30f; sc[t][e] = v; mx = fmaxf(mx, v); }
        mx = fmaxf(mx, __shfl_xor(mx, 32));
        float lsum = 0.f;
#pragma unroll
        for (int t = 0; t < 5; ++t)
#pragma unroll
            for (int e = 0; e < 16; ++e) { const float p = __expf(sc[t][e] - mx); sc[t][e] = p; lsum += p; }
        lsum += __shfl_xor(lsum, 32); lsum += __expf(sink - mx);
        f32x16 o[2];
#pragma unroll
        for (int dt = 0; dt < 2; ++dt)
#pragma unroll
            for (int e = 0; e < 16; ++e) o[dt][e] = 0.f;
        const int q4 = (r & 15) >> 2, p4 = r & 3;
#pragma unroll
        for (int t = 0; t < 5; ++t)
#pragma unroll
            for (int sp = 0; sp < 2; ++sp) {
                bf16x8_t pbv;
#pragma unroll
                for (int e = 0; e < 8; ++e) pbv[e] = (__bf16)sc[t][8 * sp + e];
                const bf16x8 pb = __builtin_bit_cast(bf16x8, pbv);
#pragma unroll
                for (int dt = 0; dt < 2; ++dt) {
                    const int kb = (w + t) * 32 + 16 * sp + 4 * hh;
                    const LAS unsigned char* ap = VL + (kb + q4) * VS + (32 * dt + 16 * (r >> 4) + 4 * p4) * 2;
                    const s16x4 lo = __builtin_amdgcn_ds_read_tr16_b64_v4i16((LAS s16x4*)ap);
                    const s16x4 hi = __builtin_amdgcn_ds_read_tr16_b64_v4i16((LAS s16x4*)(ap + 8 * VS));
                    const bf16x8 a = __builtin_shufflevector(lo, hi, 0, 1, 2, 3, 4, 5, 6, 7);
                    o[dt] = MFMA32(a, pb, o[dt]); } }
        const float inv = 1.f / lsum; float ss = 0.f;
#pragma unroll
        for (int dt = 0; dt < 2; ++dt)
#pragma unroll
            for (int e = 0; e < 16; ++e) { o[dt][e] *= inv; ss += o[dt][e] * o[dt][e]; }
        ss += __shfl_xor(ss, 32);
        const float rs = 1.0f / sqrtf(ss * (1.f / HD) + EPS);
        const float* gp = F.in[IN_AOG] + qh * HD;
        bf16* op = (bf16*)(F.ws + WS_MIX) + (size_t)(tok0 + i0 + r) * D + qh * HD;
#pragma unroll
        for (int dt = 0; dt < 2; ++dt)
#pragma unroll
            for (int g4 = 0; g4 < 4; ++g4) { const int d0 = 32 * dt + 8 * g4 + 4 * hh; const f32x4 gv = *(const f32x4*)(gp + d0);
                v2u wv; wv.x = pk2(o[dt][4 * g4 + 0] * rs * gv.x, o[dt][4 * g4 + 1] * rs * gv.y); wv.y = pk2(o[dt][4 * g4 + 2] * rs * gv.z, o[dt][4 * g4 + 3] * rs * gv.w);
                *(GAS v2u*)(op + d0) = wv; }
    }
    __syncthreads();
}
__device__ __forceinline__ void p3_conv(Frame& F) {
    const bf16* proj = (const bf16*)(F.ws + WS_PROJ); const int lane = F.lane, c0 = 8 * lane;
    const float* cw = F.in[IN_CONVW]; const float* cg = F.in[IN_COG];
    float w0[8], w1[8], w2[8], gg[8];
#pragma unroll
    for (int e = 0; e < 8; ++e) { w0[e] = cw[c0 + e]; w1[e] = cw[512 + c0 + e]; w2[e] = cw[1024 + c0 + e]; gg[e] = cg[c0 + e]; }
    const int gw = F.vcu * NWAVES + F.wave, NGW = F.G * NWAVES;
    for (int tok = gw; tok < M; tok += NGW) {
        const int s = tok & (SEQ - 1); const bf16* rp = proj + (size_t)tok * IN_W;
        const v4u z4 = (v4u){0u, 0u, 0u, 0u};
        const v4u Bv = *(const GAS v4u*)(rp + O_B + c0), C0 = *(const GAS v4u*)(rp + O_C + c0), U0 = *(const GAS v4u*)(rp + O_U + c0);
        v4u C1 = z4, U1 = z4, C2 = z4, U2 = z4;
        if (s >= 1) { C1 = *(const GAS v4u*)(rp - IN_W + O_C + c0); U1 = *(const GAS v4u*)(rp - IN_W + O_U + c0); }
        if (s >= 2) { C2 = *(const GAS v4u*)(rp - 2 * IN_W + O_C + c0); U2 = *(const GAS v4u*)(rp - 2 * IN_W + O_U + c0); }
        float y[8]; float ss = 0.f;
#pragma unroll
        for (int e = 0; e < 8; ++e) { const int wi = e >> 1; const bool hi = e & 1;
            const unsigned bw = Bv[wi], c0w = C0[wi], u0w = U0[wi], c1w = C1[wi], u1w = U1[wi], c2w = C2[wi], u2w = U2[wi];
            const float bb = hi ? bfhi(bw) : bflo(bw);
            const float z0 = (hi ? bfhi(c0w) : bflo(c0w)) * (hi ? bfhi(u0w) : bflo(u0w));
            const float z1 = (hi ? bfhi(c1w) : bflo(c1w)) * (hi ? bfhi(u1w) : bflo(u1w));
            const float z2 = (hi ? bfhi(c2w) : bflo(c2w)) * (hi ? bfhi(u2w) : bflo(u2w));
            y[e] = bb * (z2 * w0[e] + z1 * w1[e] + z0 * w2[e]); ss += y[e] * y[e]; }
        ss += __shfl_xor(ss, 1); ss += __shfl_xor(ss, 2); ss += __shfl_xor(ss, 4);
        const float rs = 1.0f / sqrtf(ss * (1.f / 64.f) + EPS);
        v4u w; w.x = pk2(y[0] * rs * gg[0], y[1] * rs * gg[1]); w.y = pk2(y[2] * rs * gg[2], y[3] * rs * gg[3]);
        w.z = pk2(y[4] * rs * gg[4], y[5] * rs * gg[5]); w.w = pk2(y[6] * rs * gg[6], y[7] * rs * gg[7]);
        pg8::store16_wt(pg8::wt_rsrc(F.ws + WS_MIX, (size_t)M * D * 2), (unsigned)(((size_t)tok * D + 512 + c0) * 2), w);
    }
}
__device__ __forceinline__ void p3_mixer(Frame& F) {
    for (int unit = blockIdx.x; unit < BATCH * 16 * NKVH; unit += F.G) p3_attn_unit(F, unit);
    p3_conv(F);
}

#define DI __device__ __forceinline__
#define CE_(i, j) { const unsigned x_ = a[i], y_ = a[j]; a[i] = x_ > y_ ? x_ : y_; a[j] = x_ > y_ ? y_ : x_; }
DI void sort16_desc(unsigned (&a)[16]) {
    CE_(0,13) CE_(1,12) CE_(2,15) CE_(3,14) CE_(4,8) CE_(5,6) CE_(7,11) CE_(9,10)
    CE_(0,5) CE_(1,7) CE_(2,9) CE_(3,4) CE_(6,13) CE_(8,14) CE_(10,15) CE_(11,12)
    CE_(0,1) CE_(2,3) CE_(4,5) CE_(6,8) CE_(7,9) CE_(10,11) CE_(12,13) CE_(14,15)
    CE_(0,2) CE_(1,3) CE_(4,10) CE_(5,11) CE_(6,7) CE_(8,9) CE_(12,14) CE_(13,15)
    CE_(1,2) CE_(3,12) CE_(4,6) CE_(5,7) CE_(8,10) CE_(9,11) CE_(13,14)
    CE_(1,4) CE_(2,6) CE_(5,8) CE_(7,10) CE_(9,13) CE_(11,14)
    CE_(2,4) CE_(3,6) CE_(9,12) CE_(11,13)
    CE_(3,5) CE_(6,8) CE_(7,9) CE_(10,12)
    CE_(3,4) CE_(5,6) CE_(7,8) CE_(9,10) CE_(11,12)
    CE_(6,7) CE_(8,9)
}
DI void bitonic_merge16_desc(unsigned (&a)[16]) {
#pragma unroll
    for (int js = 3; js >= 0; --js) {
#pragma unroll
        for (int i = 0; i < 16; ++i) { const int j = 1 << js, l = i ^ j;
            if (l > i) { const unsigned x = a[i], y = a[l]; a[i] = x > y ? x : y; a[l] = x > y ? y : x; } }
    }
}
DI void merge_top16(unsigned (&a)[16], const unsigned (&b)[16]) {
#pragma unroll
    for (int i = 0; i < 16; ++i) { const unsigned x = a[i], y = b[15 - i]; a[i] = x > y ? x : y; }
    bitonic_merge16_desc(a);
}
DI void top16_of_64(unsigned (&g0)[16], unsigned (&g1)[16], unsigned (&g2)[16], unsigned (&g3)[16]) {
    sort16_desc(g0); sort16_desc(g1); sort16_desc(g2); sort16_desc(g3);
    merge_top16(g0, g1); merge_top16(g2, g3); merge_top16(g0, g2);
}
#define SBIAS 8.0f
DI unsigned skey(float biased) { return __float_as_uint(fmaxf(biased, 0.f)); }
constexpr int KEY_STRIDE = 272;
DI void route_scores_top16(const LAS unsigned char* KL, const bf16* qrow, int r, int hh, unsigned (&out)[16]) {
    bf16x8 qf[8];
#pragma unroll
    for (int s = 0; s < 8; ++s) qf[s] = *(const GAS bf16x8*)(qrow + 16 * s);
    f32x16 acc[4];
#pragma unroll
    for (int t = 0; t < 4; ++t)
#pragma unroll
        for (int e = 0; e < 16; ++e) acc[t][e] = SBIAS;
#pragma unroll
    for (int t = 0; t < 4; ++t)
#pragma unroll
        for (int s = 0; s < 8; ++s) { const bf16x8 a = *(const LAS bf16x8*)(KL + (t * 32 + r) * KEY_STRIDE + 32 * s + 16 * hh); acc[t] = MFMA32(a, qf[s], acc[t]); }
    unsigned g0[16], g1[16], g2[16], g3[16];
    const unsigned pb = (unsigned)(127 - 4 * hh);
#pragma unroll
    for (int e = 0; e < 16; ++e) { const unsigned p = pb - (unsigned)((e & 3) + 8 * (e >> 2));
        g0[e] = (skey(acc[0][e]) & ~127u) | p; g1[e] = (skey(acc[1][e]) & ~127u) | (p - 32u); g2[e] = (skey(acc[2][e]) & ~127u) | (p - 64u); g3[e] = (skey(acc[3][e]) & ~127u) | (p - 96u); }
    top16_of_64(g0, g1, g2, g3);
    unsigned oth[16];
#pragma unroll
    for (int i = 0; i < 16; ++i) oth[i] = (unsigned)__shfl_xor((int)g0[i], 32);
    merge_top16(g0, oth);
#pragma unroll
    for (int i = 0; i < 16; ++i) out[i] = g0[i];
}
DI void p7_route_tile(Frame& F, int tok0, int h, const LAS unsigned char* KL1, const LAS unsigned char* KL2, LAS unsigned char* scr) {
    const int lane = F.lane, r = lane & 31, hh = lane >> 5;
    const bf16* qrow = (const bf16*)(F.ws + WS_PROJ) + (size_t)(tok0 + r) * QW + h * DKEY + 8 * hh;
    unsigned t1[16], t2[16];
    route_scores_top16(KL1, qrow, r, hh, t1);
    route_scores_top16(KL2, qrow + DHALF, r, hh, t2);
    { v4u w;
#pragma unroll
      for (int q = 0; q < 4; ++q) { unsigned x = 0u;
#pragma unroll
          for (int bq = 0; bq < 4; ++bq) { const unsigned k = hh ? t2[4 * q + bq] : t1[4 * q + bq]; x |= (127u - (k & 127u)) << (8 * bq); }
          w[q] = x; }
      *(LAS v4u*)(scr + r * 32 + hh * 16) = w; }
    float v1[16], v2[16];
#pragma unroll
    for (int i = 0; i < 16; ++i) { v1[i] = __uint_as_float(t1[i] & ~127u); v2[i] = __uint_as_float(t2[i] & ~127u) - SBIAS; }
    unsigned c0[16], c1[16];
    { const float sa = v1[0] + v2[0], sb = v1[2] + v2[1]; c0[0] = (__float_as_uint(fmaxf(hh ? sb : sa, 0.f)) & ~255u) | (hh ? 222u : 255u); }
    { const float sa = v1[0] + v2[1], sb = v1[2] + v2[2]; c0[1] = (__float_as_uint(fmaxf(hh ? sb : sa, 0.f)) & ~255u) | (hh ? 221u : 254u); }
    { const float sa = v1[0] + v2[2], sb = v1[2] + v2[3]; c0[2] = (__float_as_uint(fmaxf(hh ? sb : sa, 0.f)) & ~255u) | (hh ? 220u : 253u); }
    { const float sa = v1[0] + v2[3], sb = v1[2] + v2[4]; c0[3] = (__float_as_uint(fmaxf(hh ? sb : sa, 0.f)) & ~255u) | (hh ? 219u : 252u); }
    { const float sa = v1[0] + v2[4], sb = v1[3] + v2[0]; c0[4] = (__float_as_uint(fmaxf(hh ? sb : sa, 0.f)) & ~255u) | (hh ? 207u : 251u); }
    { const float sa = v1[0] + v2[5], sb = v1[3] + v2[1]; c0[5] = (__float_as_uint(fmaxf(hh ? sb : sa, 0.f)) & ~255u) | (hh ? 206u : 250u); }
    { const float sa = v1[0] + v2[6], sb = v1[3] + v2[2]; c0[6] = (__float_as_uint(fmaxf(hh ? sb : sa, 0.f)) & ~255u) | (hh ? 205u : 249u); }
    { const float sa = v1[0] + v2[7], sb = v1[3] + v2[3]; c0[7] = (__float_as_uint(fmaxf(hh ? sb : sa, 0.f)) & ~255u) | (hh ? 204u : 248u); }
    { const float sa = v1[0] + v2[8], sb = v1[4] + v2[0]; c0[8] = (__float_as_uint(fmaxf(hh ? sb : sa, 0.f)) & ~255u) | (hh ? 191u : 247u); }
    { const float sa = v1[0] + v2[9], sb = v1[4] + v2[1]; c0[9] = (__float_as_uint(fmaxf(hh ? sb : sa, 0.f)) & ~255u) | (hh ? 190u : 246u); }
    { const float sa = v1[0] + v2[10], sb = v1[4] + v2[2]; c0[10] = (__float_as_uint(fmaxf(hh ? sb : sa, 0.f)) & ~255u) | (hh ? 189u : 245u); }
    { const float sa = v1[0] + v2[11], sb = v1[5] + v2[0]; c0[11] = (__float_as_uint(fmaxf(hh ? sb : sa, 0.f)) & ~255u) | (hh ? 175u : 244u); }
    { const float sa = v1[0] + v2[12], sb = v1[5] + v2[1]; c0[12] = (__float_as_uint(fmaxf(hh ? sb : sa, 0.f)) & ~255u) | (hh ? 174u : 243u); }
    { const float sa = v1[0] + v2[13], sb = v1[6] + v2[0]; c0[13] = (__float_as_uint(fmaxf(hh ? sb : sa, 0.f)) & ~255u) | (hh ? 159u : 242u); }
    { const float sa = v1[0] + v2[14], sb = v1[6] + v2[1]; c0[14] = (__float_as_uint(fmaxf(hh ? sb : sa, 0.f)) & ~255u) | (hh ? 158u : 241u); }
    { const float sa = v1[0] + v2[15], sb = v1[7] + v2[0]; c0[15] = (__float_as_uint(fmaxf(hh ? sb : sa, 0.f)) & ~255u) | (hh ? 143u : 240u); }
    { const float sa = v1[1] + v2[0], sb = v1[7] + v2[1]; c1[0] = (__float_as_uint(fmaxf(hh ? sb : sa, 0.f)) & ~255u) | (hh ? 142u : 239u); }
    { const float sa = v1[1] + v2[1], sb = v1[8] + v2[0]; c1[1] = (__float_as_uint(fmaxf(hh ? sb : sa, 0.f)) & ~255u) | (hh ? 127u : 238u); }
    { const float sa = v1[1] + v2[2], sb = v1[9] + v2[0]; c1[2] = (__float_as_uint(fmaxf(hh ? sb : sa, 0.f)) & ~255u) | (hh ? 111u : 237u); }
    { const float sa = v1[1] + v2[3], sb = v1[10] + v2[0]; c1[3] = (__float_as_uint(fmaxf(hh ? sb : sa, 0.f)) & ~255u) | (hh ? 95u : 236u); }
    { const float sa = v1[1] + v2[4], sb = v1[11] + v2[0]; c1[4] = (__float_as_uint(fmaxf(hh ? sb : sa, 0.f)) & ~255u) | (hh ? 79u : 235u); }
    { const float sa = v1[1] + v2[5], sb = v1[12] + v2[0]; c1[5] = (__float_as_uint(fmaxf(hh ? sb : sa, 0.f)) & ~255u) | (hh ? 63u : 234u); }
    { const float sa = v1[1] + v2[6], sb = v1[13] + v2[0]; c1[6] = (__float_as_uint(fmaxf(hh ? sb : sa, 0.f)) & ~255u) | (hh ? 47u : 233u); }
    { const float sa = v1[1] + v2[7], sb = v1[14] + v2[0]; c1[7] = (__float_as_uint(fmaxf(hh ? sb : sa, 0.f)) & ~255u) | (hh ? 31u : 232u); }
    { const float sa = v1[2] + v2[0], sb = v1[15] + v2[0]; c1[8] = (__float_as_uint(fmaxf(hh ? sb : sa, 0.f)) & ~255u) | (hh ? 15u : 223u); }
    c1[9] = 0u;
    c1[10] = 0u;
    c1[11] = 0u;
    c1[12] = 0u;
    c1[13] = 0u;
    c1[14] = 0u;
    c1[15] = 0u;
    sort16_desc(c0); sort16_desc(c1); merge_top16(c0, c1);
    { unsigned oth[16];
#pragma unroll
      for (int i = 0; i < 16; ++i) oth[i] = (unsigned)__shfl_xor((int)c0[i], 32);
      merge_top16(c0, oth); }
    const float mx = __uint_as_float(c0[0] & ~255u);
    LDS_WAIT(); asm volatile("" ::: "memory");
    float ex[8]; int ee[8]; float part = 0.f;
#pragma unroll
    for (int k = 0; k < 8; ++k) { const unsigned key = hh ? c0[8 + k] : c0[k]; const int ci = 255 - (int)(key & 255u);
        const int e1 = *(const LAS unsigned char*)(scr + r * 32 + (ci >> 4)), e2 = *(const LAS unsigned char*)(scr + r * 32 + 16 + (ci & 15));
        ee[k] = (e1 * NKEYS + e2) & (NEXP - 1); ex[k] = __expf(__uint_as_float(key & ~255u) - mx); part += ex[k]; }
    const float inv = 1.f / (part + __shfl_xor(part, 32));
    { const unsigned oo = (unsigned)(((size_t)(tok0 + r) * 128 + h * TOPK + 8 * hh) * 4);
      const __amdgpu_buffer_rsrc_t ir = pg8::wt_rsrc(F.ws + WS_IDX, (size_t)M * 128 * 4), gr = pg8::wt_rsrc(F.ws + WS_GATE, (size_t)M * 128 * 4);
      pg8::store16_wt(ir, oo, (v4u){(unsigned)ee[0], (unsigned)ee[1], (unsigned)ee[2], (unsigned)ee[3]}); pg8::store16_wt(ir, oo + 16, (v4u){(unsigned)ee[4], (unsigned)ee[5], (unsigned)ee[6], (unsigned)ee[7]});
      pg8::store16_wt(gr, oo, (v4u){__float_as_uint(ex[0] * inv), __float_as_uint(ex[1] * inv), __float_as_uint(ex[2] * inv), __float_as_uint(ex[3] * inv)});
      pg8::store16_wt(gr, oo + 16, (v4u){__float_as_uint(ex[4] * inv), __float_as_uint(ex[5] * inv), __float_as_uint(ex[6] * inv), __float_as_uint(ex[7] * inv)}); }
    asm volatile("" ::: "memory");
}
__device__ __forceinline__ void p7_routing(Frame& F) {
    LAS unsigned char* KL1 = F.lds; LAS unsigned char* KL2 = F.lds + 128 * KEY_STRIDE; LAS unsigned char* scr = F.lds + 2 * 128 * KEY_STRIDE + F.wave * 1024;
    const bf16* k1 = (const bf16*)(F.ws + WS_K1); const bf16* k2 = (const bf16*)(F.ws + WS_K2);
    int cur_h = -1;
    for (int item = blockIdx.x; item < (M / 256) * PH; item += F.G) {
        const int h = item & (PH - 1), tile = item >> 3;
        if (h != cur_h) {
            __syncthreads();
            for (int c = F.tid; c < 2 * 128 * 16; c += 512) { const int which = c >> 11, rr = (c >> 4) & 127, ch = c & 15;
                const v4u v = *(const GAS v4u*)((which ? k2 : k1) + (size_t)(h * NKEYS + rr) * DHALF + ch * 8);
                *(LAS v4u*)((which ? KL2 : KL1) + rr * KEY_STRIDE + ch * 16) = v; }
            __syncthreads();
            cur_h = h;
        }
        p7_route_tile(F, tile * 256 + F.wave * 32, h, KL1, KL2, scr);
    }
}

__device__ __forceinline__ float gelu_erf(float v) { return 0.5f * v * (1.f + erff(v * 0.70710678118654752f)); }
typedef float f32x2v __attribute__((ext_vector_type(2)));
__device__ __forceinline__ unsigned fp8x2_bf16x2(unsigned w, bool hi) { return hi ? __builtin_bit_cast(unsigned, __builtin_amdgcn_cvt_scalef32_pk_bf16_fp8((int)w, 1.0f, true)) : __builtin_bit_cast(unsigned, __builtin_amdgcn_cvt_scalef32_pk_bf16_fp8((int)w, 1.0f, false)); }
__device__ __forceinline__ float dot16_fp8(v4u u, v4u ha, v4u hb, float acc) {
    acc = dot2(fp8x2_bf16x2(u.x, false), ha.x, acc); acc = dot2(fp8x2_bf16x2(u.x, true), ha.y, acc);
    acc = dot2(fp8x2_bf16x2(u.y, false), ha.z, acc); acc = dot2(fp8x2_bf16x2(u.y, true), ha.w, acc);
    acc = dot2(fp8x2_bf16x2(u.z, false), hb.x, acc); acc = dot2(fp8x2_bf16x2(u.z, true), hb.y, acc);
    acc = dot2(fp8x2_bf16x2(u.w, false), hb.z, acc); acc = dot2(fp8x2_bf16x2(u.w, true), hb.w, acc);
    return acc;
}
struct SliceWork { int j0, nj, t0, ts; };
__device__ __forceinline__ SliceWork slice_work(const Frame& F) { SliceWork w;
    if ((F.G & 7) == 0) { w.j0 = blockIdx.x & 7; w.nj = 1; w.t0 = (blockIdx.x >> 3) * NWAVES + F.wave; w.ts = F.G; }
    else { w.j0 = 0; w.nj = 8; w.t0 = blockIdx.x * NWAVES + F.wave; w.ts = F.G * NWAVES; }
    return w; }
struct USet { v4u hq; float hs; v4u u[16]; };
struct UMeta { v2u id; v4u hh; float hs; };
__device__ __forceinline__ UMeta p8a_G(const int* IDX, const unsigned char* H8, const float* HS, int t, int j, int lane) { UMeta m;
    m.id = *(const GAS v2u*)(IDX + (size_t)t * 128 + 2 * lane); m.hh = *(const GAS v4u*)(H8 + (size_t)t * D + 128 * j + 16 * (lane & 7)); m.hs = HS[t]; return m; }
__device__ __forceinline__ void p8a_S(LAS unsigned char* mb, const UMeta& m, int lane) { *(LAS v2u*)(mb + 8 * lane) = m.id; if (lane < 8) *(LAS v4u*)(mb + 512 + 16 * lane) = m.hh; }
__device__ __forceinline__ void p8a_RT(const LAS unsigned char* mb, const unsigned char* Ub, int c, int g, float hs, USet& s) {
    v4u ix[4];
#pragma unroll
    for (int q = 0; q < 4; ++q) ix[q] = *(const LAS v4u*)(mb + 64 * g + 16 * q);
    s.hq = *(const LAS v4u*)(mb + 512 + 16 * c); s.hs = hs;
#pragma unroll
    for (int i = 0; i < 16; ++i) s.u[i] = *(const GAS v4u*)(Ub + (unsigned)((ix[i >> 2][i & 3] << 7) + 16u * (unsigned)c)); }
__device__ __forceinline__ void p8a_compute(const USet& s, bf16* pa_row, int lane, int c) {
    int p[16];
#pragma unroll
    for (int i = 0; i < 16; ++i) { int a = __builtin_amdgcn_sdot4((int)s.u[i].x, (int)s.hq.x, 0, false); a = __builtin_amdgcn_sdot4((int)s.u[i].y, (int)s.hq.y, a, false);
        a = __builtin_amdgcn_sdot4((int)s.u[i].z, (int)s.hq.z, a, false); p[i] = __builtin_amdgcn_sdot4((int)s.u[i].w, (int)s.hq.w, a, false); }
#pragma unroll
    for (int i = 0; i < 8; ++i) { const bool up = c & 4; const int send = up ? p[i] : p[i + 8], keep = up ? p[i + 8] : p[i]; p[i] = keep + __builtin_amdgcn_update_dpp(0, send, 0x141, 0xf, 0xf, true); }
#pragma unroll
    for (int i = 0; i < 4; ++i) { const bool up = c & 2; const int send = up ? p[i] : p[i + 4], keep = up ? p[i + 4] : p[i]; p[i] = keep + __builtin_amdgcn_update_dpp(0, send, 0x4E, 0xf, 0xf, true); }
#pragma unroll
    for (int i = 0; i < 2; ++i) { const bool up = c & 1; const int send = up ? p[i] : p[i + 2], keep = up ? p[i + 2] : p[i]; p[i] = keep + __builtin_amdgcn_update_dpp(0, send, 0xB1, 0xf, 0xf, true); }
    const float sc = s.hs * (1.f / U_SCALE);
    ((GAS unsigned*)pa_row)[lane] = pk2((float)p[0] * sc, (float)p[1] * sc);
}
__device__ __forceinline__ void p8a_udots(Frame& F) {
    const unsigned char* H8 = F.ws + WS_H8; const float* HS = (const float*)(F.ws + WS_HS); const int* IDX = (const int*)(F.ws + WS_IDX); bf16* PA = (bf16*)(F.ws + WS_PA);
    const int lane = F.lane, c = lane & 7, g = lane >> 3; const SliceWork sw = slice_work(F);
    LAS unsigned char* mb = F.lds + F.wave * 1024;
    if (sw.t0 >= M) return;
    const int nt = (M - 1 - sw.t0) / sw.ts + 1;
#define TOK(n) (sw.t0 + ((n) < nt ? (n) : nt - 1) * sw.ts)
    for (int jj = 0; jj < sw.nj; ++jj) { const int j = sw.j0 + jj; const unsigned char* Uj = F.ws + WS_U + (size_t)j * NEXP * 128;
        USet sA, sB, sC;
        UMeta mN = p8a_G(IDX, H8, HS, TOK(0), j, lane); p8a_S(mb, mN, lane); p8a_RT(mb, Uj, c, g, mN.hs, sA);
        mN = p8a_G(IDX, H8, HS, TOK(1), j, lane); p8a_S(mb, mN, lane); p8a_RT(mb, Uj, c, g, mN.hs, sB);
        mN = p8a_G(IDX, H8, HS, TOK(2), j, lane);
#define P8A_STAGE(k, SN, SC_) do { p8a_S(mb, mN, lane); p8a_RT(mb, Uj, c, g, mN.hs, SN); mN = p8a_G(IDX, H8, HS, TOK((k) + 3), j, lane); asm volatile("" ::: "memory"); \
            if ((k) < nt) p8a_compute(SC_, PA + ((size_t)j * M + TOK(k)) * 128, lane, c); asm volatile("" ::: "memory"); } while (0)
#pragma unroll 1
        for (int n = 0; n < nt; n += 3) {
            P8A_STAGE(n, sC, sA);
            P8A_STAGE(n + 1, sA, sB);
            P8A_STAGE(n + 2, sB, sC);
        }
#undef P8A_STAGE
    }
}
typedef _Float16 h2_t __attribute__((ext_vector_type(2)));
__device__ __forceinline__ h2_t cvt_h2_lo(int w) { return __builtin_bit_cast(h2_t, __builtin_amdgcn_cvt_scalef32_pk_f16_fp8(w, 1.0f, false)); }
__device__ __forceinline__ h2_t cvt_h2_hi(int w) { return __builtin_bit_cast(h2_t, __builtin_amdgcn_cvt_scalef32_pk_f16_fp8(w, 1.0f, true)); }
__device__ __forceinline__ void p8w_weights(Frame& F) {
    const bf16* PA = (const bf16*)(F.ws + WS_PA); float* GATE = (float*)(F.ws + WS_GATE);
    for (size_t e = (size_t)blockIdx.x * 512 + F.tid; e < (size_t)M * 128 / 4; e += (size_t)F.G * 512) {
        f32x4 s = (f32x4){0.f, 0.f, 0.f, 0.f};
#pragma unroll
        for (int j = 0; j < 8; ++j) { const v2u w = __builtin_nontemporal_load((const GAS v2u*)(PA + (size_t)j * M * 128 + 4 * e)); s += (f32x4){bflo(w.x), bfhi(w.x), bflo(w.y), bfhi(w.y)}; }
        const f32x4 gt = *(const GAS f32x4*)(GATE + 4 * e); f32x4 o;
#pragma unroll
        for (int q = 0; q < 4; ++q) o[q] = gt[q] * gelu_erf(s[q]);
        const h2_t w01 = (h2_t){(_Float16)o[0], (_Float16)o[1]}, w23 = (h2_t){(_Float16)o[2], (_Float16)o[3]};
        *(GAS v2u*)((_Float16*)(F.ws + WS_W16) + 4 * e) = (v2u){__builtin_bit_cast(unsigned, w01), __builtin_bit_cast(unsigned, w23)}; }
}
template <int HI> __device__ __forceinline__ h2_t pkfma_bw(h2_t a, unsigned w, h2_t c) { h2_t d;
    if (HI) asm("v_pk_fma_f16 %0, %1, %2, %3 op_sel:[0,1,0] op_sel_hi:[1,1,1]" : "=v"(d) : "v"(a), "v"(w), "v"(c));
    else asm("v_pk_fma_f16 %0, %1, %2, %3 op_sel:[0,0,0] op_sel_hi:[1,0,1]" : "=v"(d) : "v"(a), "v"(w), "v"(c));
    return d; }
template <int HI> __device__ __forceinline__ h2_t pkmul_bw(h2_t a, unsigned w) { h2_t d;
    if (HI) asm("v_pk_mul_f16 %0, %1, %2 op_sel:[0,1] op_sel_hi:[1,1]" : "=v"(d) : "v"(a), "v"(w));
    else asm("v_pk_mul_f16 %0, %1, %2 op_sel:[0,0] op_sel_hi:[1,0]" : "=v"(d) : "v"(a), "v"(w));
    return d; }
struct VSet { v4u v[16]; };
struct VMeta { v2u id; unsigned w; };
__device__ __forceinline__ VMeta p8b_G(const int* IDX, const _Float16* W, int t, int lane) { VMeta m;
    m.id = *(const GAS v2u*)(IDX + (size_t)t * 128 + 2 * lane); m.w = *(const GAS unsigned*)(W + (size_t)t * 128 + 2 * lane); return m; }
__device__ __forceinline__ void p8b_S(LAS unsigned char* mb, const VMeta& m, int lane) { *(LAS v2u*)(mb + 8 * lane) = m.id; *(LAS unsigned*)(mb + 512 + 4 * lane) = m.w; }
__device__ __forceinline__ void p8b_RT(Frame& F, const LAS unsigned char* mb, const unsigned char* Vj, int t, int j, int c, int g, VSet& s) {
    v4u ix[4];
#pragma unroll
    for (int q = 0; q < 4; ++q) ix[q] = *(const LAS v4u*)(mb + 64 * g + 16 * q);
#pragma unroll
    for (int i = 0; i < 16; ++i) s.v[i] = *(const GAS v4u*)(Vj + (unsigned)((ix[i >> 2][i & 3] << 7) + 16u * (unsigned)c)); }
__device__ __forceinline__ void p8b_step(Frame& F, const LAS unsigned char* mb, const LAS unsigned char* mbc, const unsigned char* Vj, int tn, VSet& sn, const VSet& sc, int tc, int j, int lane, int c, int g, bool do_compute) {
    v4u ix[4];
#pragma unroll
    for (int q = 0; q < 4; ++q) ix[q] = *(const LAS v4u*)(mb + 64 * g + 16 * q);
    const v4u wh0 = *(const LAS v4u*)(mbc + 512 + 32 * g), wh1 = *(const LAS v4u*)(mbc + 512 + 32 * g + 16);
    h2_t ah[8];
#pragma unroll
    for (int i = 0; i < 16; ++i) {
        sn.v[i] = *(const GAS v4u*)(Vj + (unsigned)((ix[i >> 2][i & 3] << 7) + 16u * (unsigned)c));
        const v4u v = sc.v[i]; const unsigned wu = (i >> 3) ? wh1[(i >> 1) & 3] : wh0[(i >> 1) & 3];
        if (i == 0) { ah[0] = pkmul_bw<0>(cvt_h2_lo((int)v.x), wu); ah[1] = pkmul_bw<0>(cvt_h2_hi((int)v.x), wu); ah[2] = pkmul_bw<0>(cvt_h2_lo((int)v.y), wu); ah[3] = pkmul_bw<0>(cvt_h2_hi((int)v.y), wu);
            ah[4] = pkmul_bw<0>(cvt_h2_lo((int)v.z), wu); ah[5] = pkmul_bw<0>(cvt_h2_hi((int)v.z), wu); ah[6] = pkmul_bw<0>(cvt_h2_lo((int)v.w), wu); ah[7] = pkmul_bw<0>(cvt_h2_hi((int)v.w), wu); }
        else if (i & 1) { ah[0] = pkfma_bw<1>(cvt_h2_lo((int)v.x), wu, ah[0]); ah[1] = pkfma_bw<1>(cvt_h2_hi((int)v.x), wu, ah[1]); ah[2] = pkfma_bw<1>(cvt_h2_lo((int)v.y), wu, ah[2]); ah[3] = pkfma_bw<1>(cvt_h2_hi((int)v.y), wu, ah[3]);
            ah[4] = pkfma_bw<1>(cvt_h2_lo((int)v.z), wu, ah[4]); ah[5] = pkfma_bw<1>(cvt_h2_hi((int)v.z), wu, ah[5]); ah[6] = pkfma_bw<1>(cvt_h2_lo((int)v.w), wu, ah[6]); ah[7] = pkfma_bw<1>(cvt_h2_hi((int)v.w), wu, ah[7]); }
        else { ah[0] = pkfma_bw<0>(cvt_h2_lo((int)v.x), wu, ah[0]); ah[1] = pkfma_bw<0>(cvt_h2_hi((int)v.x), wu, ah[1]); ah[2] = pkfma_bw<0>(cvt_h2_lo((int)v.y), wu, ah[2]); ah[3] = pkfma_bw<0>(cvt_h2_hi((int)v.y), wu, ah[3]);
            ah[4] = pkfma_bw<0>(cvt_h2_lo((int)v.z), wu, ah[4]); ah[5] = pkfma_bw<0>(cvt_h2_hi((int)v.z), wu, ah[5]); ah[6] = pkfma_bw<0>(cvt_h2_lo((int)v.w), wu, ah[6]); ah[7] = pkfma_bw<0>(cvt_h2_hi((int)v.w), wu, ah[7]); }
        asm volatile("" ::: "memory"); }
    if (!do_compute) return;
    asm volatile("s_nop 1");
#pragma unroll
    for (int m = 0; m < 4; ++m) { const auto r = __builtin_amdgcn_permlane32_swap(__builtin_bit_cast(unsigned, ah[m]), __builtin_bit_cast(unsigned, ah[m + 4]), false, false);
        ah[m] = __builtin_bit_cast(h2_t, (unsigned)r[0]) + __builtin_bit_cast(h2_t, (unsigned)r[1]); }
#pragma unroll
    for (int m = 0; m < 2; ++m) { const auto r = __builtin_amdgcn_permlane16_swap(__builtin_bit_cast(unsigned, ah[m]), __builtin_bit_cast(unsigned, ah[m + 2]), false, false);
        ah[m] = __builtin_bit_cast(h2_t, (unsigned)r[0]) + __builtin_bit_cast(h2_t, (unsigned)r[1]); }
    { const bool up = lane & 8;
      const h2_t s0 = ah[0] + __builtin_bit_cast(h2_t, __builtin_amdgcn_update_dpp(0, __builtin_bit_cast(int, ah[0]), 0x128, 0xf, 0xf, true));
      const h2_t s1 = ah[1] + __builtin_bit_cast(h2_t, __builtin_amdgcn_update_dpp(0, __builtin_bit_cast(int, ah[1]), 0x128, 0xf, 0xf, true));
      ah[0] = up ? s1 : s0; }
    const f32x2v peer = (f32x2v){(float)ah[0].x, (float)ah[0].y} * (1.f / V_SCALE);
    *(GAS unsigned*)((bf16*)(F.ws + WS_H) + (size_t)tc * D + 128 * j + 16 * c + 2 * g) = pk2(peer.x, peer.y);
}
__device__ __forceinline__ void p8b_vsum(Frame& F) {
    const int* IDX = (const int*)(F.ws + WS_IDX); const _Float16* W = (const _Float16*)(F.ws + WS_W16);
    const int lane = F.lane, c = lane & 7, g = lane >> 3; const SliceWork sw = slice_work(F);
    LAS unsigned char* mb = F.lds + F.wave * 1024;
    if (sw.t0 >= M) return;
    const int nt = (M - 1 - sw.t0) / sw.ts + 1;
    for (int jj = 0; jj < sw.nj; ++jj) { const int j = sw.j0 + jj; const unsigned char* Vj = F.ws + WS_V + (size_t)j * NEXP * 128;
        VSet sA, sB, sC;
        LAS unsigned char* const pg0 = mb, * const pg1 = mb + 8192, * const pg2 = mb + 16384;
        VMeta mN = p8b_G(IDX, W, TOK(0), lane); p8b_S(pg0, mN, lane); p8b_RT(F, pg0, Vj, TOK(0), j, c, g, sA);
        mN = p8b_G(IDX, W, TOK(1), lane); p8b_S(pg1, mN, lane); p8b_RT(F, pg1, Vj, TOK(1), j, c, g, sB);
        mN = p8b_G(IDX, W, TOK(2), lane);
#define P8B_STAGE(k, SN, SC_, PN, PC) do { p8b_S(PN, mN, lane); mN = p8b_G(IDX, W, TOK((k) + 3), lane); \
            p8b_step(F, PN, PC, Vj, TOK((k) + 2), SN, SC_, TOK(k), j, lane, c, g, (k) < nt); asm volatile("" ::: "memory"); } while (0)
#pragma unroll 1
        for (int n = 0; n < nt; n += 3) {
            P8B_STAGE(n, sC, sA, pg2, pg0);
            P8B_STAGE(n + 1, sA, sB, pg0, pg1);
            P8B_STAGE(n + 2, sB, sC, pg1, pg2);
        }
#undef P8B_STAGE
    }
#undef TOK
}
__device__ __forceinline__ void p8c_final(Frame& F) {
    const float* gf = F.in[IN_GF]; const float* ada = (const float*)(F.ws + WS_ADA); const int lane = F.lane;
    f32x4 gv[4];
#pragma unroll
    for (int q = 0; q < 4; ++q) gv[q] = *(const f32x4*)(gf + 4 * lane + 256 * q);
    const bf16* X1 = (const bf16*)(F.ws + WS_X1); const bf16* PE = (const bf16*)(F.ws + WS_H);
    for (int t = blockIdx.x * NWAVES + F.wave; t < M; t += F.G * NWAVES) {
        const GAS v2u* xr = (const GAS v2u*)(X1 + (size_t)t * D) + lane; const GAS v2u* pr = (const GAS v2u*)(PE + (size_t)t * D) + lane;
        const float* g2 = ada + (size_t)(t / SEQ) * ADA_W + 5 * D + 4 * lane;
        f32x4 x2[4]; float s = 0.f;
#pragma unroll
        for (int q = 0; q < 4; ++q) { const v2u a = __builtin_nontemporal_load(xr + 64 * q), p = __builtin_nontemporal_load(pr + 64 * q); const f32x4 gg = *(const f32x4*)(g2 + 256 * q);
            x2[q] = (f32x4){bflo(a.x), bfhi(a.x), bflo(a.y), bfhi(a.y)} + gg * (f32x4){bflo(p.x), bfhi(p.x), bflo(p.y), bfhi(p.y)};
            s += (x2[q].x * x2[q].x + x2[q].y * x2[q].y) + (x2[q].z * x2[q].z + x2[q].w * x2[q].w); }
        const float rstd = 1.0f / sqrtf(wave_sum(s) * (1.f / D) + EPS);
        GAS f32x4* yr = (GAS f32x4*)(F.out + (size_t)t * D) + lane;
#pragma unroll
        for (int q = 0; q < 4; ++q) __builtin_nontemporal_store(x2[q] * rstd * gv[q], yr + 64 * q);
    }
}

struct Args { const float* in[20]; float* out; unsigned char* ws; int ph_lo, ph_hi, li, pad; };
__global__ void __launch_bounds__(NWAVES * 64, 2) skel_fwd(Args args) {
    extern __shared__ __attribute__((aligned(16))) unsigned char lds[];
    Frame F;
    F.lds = (LAS unsigned char*)lds;
    F.MISC = (volatile LAS unsigned*)(F.lds + MISC_OFF);
    F.tid = threadIdx.x; F.lane = F.tid & 63; F.wave = __builtin_amdgcn_readfirstlane(F.tid >> 6);
    F.G = gridDim.x; { const int bx = blockIdx.x; F.vcu = (F.G % 8 == 0) ? (bx % 8) * (F.G / 8) + bx / 8 : bx; }
    F.ws = args.ws; F.out = args.out;
#pragma unroll
    for (int i = 0; i < 20; ++i) F.in[i] = args.in[i];
    F.ctl = (gu32*)(args.ws + WS_CTL);
    for (int u = F.tid; u < (LDS_BYTES - LDSCTL_OFF) / 4; u += NWAVES * 64) ((LAS unsigned*)(F.lds + LDSCTL_OFF))[u] = 0u;
    __syncthreads();
    XcdBarrier bar; bar.bar = (unsigned*)(F.ctl + CW_BAR); bar.x = 0; bar.st = nullptr;
    if (N_LAUNCHES == 1) bar = xcd_barrier_post((unsigned*)(F.ctl + CW_BAR), F.MISC + 8);
#define GRID_BAR() do { if (N_LAUNCHES == 1) xcd_barrier(bar); } while (0)
    const int lo = args.ph_lo, hi = args.ph_hi;
#define IN(k) (lo <= (k) && (k) < hi)
    bf16* const H = (bf16*)(args.ws + WS_H); bf16* const PROJ = (bf16*)(args.ws + WS_PROJ); bf16* const MIX = (bf16*)(args.ws + WS_MIX);

    if (IN(0)) { p0_prologue(F); GRID_BAR(); }
    if (IN(1)) { p1_hpass(F); GRID_BAR(); }
    if (IN(2)) {
        pg8::Gemm g{(const bf16*)(args.ws + WS_H8), (const bf16*)(args.ws + WS_WIN), M, IN_W, D / 2}; pg8::StaticOrder S; S.init(M, IN_W, F.G, (int)blockIdx.x);
        pg8::EpiI8Bf16 E{PROJ, IN_W, (const float*)(args.ws + WS_HS), 1.f / WQ_SCALE, F.in[IN_BIN]};
        if ((int)blockIdx.x >= 128) { __builtin_amdgcn_s_sleep(127); __builtin_amdgcn_s_sleep(127); }
        pg8::gemm_phase<pg8::EpiI8Bf16, pg8::StaticOrder, true, true, true>(F.lds + RING_OFF, g, S, E);
        GRID_BAR();
    }
    if (IN(3)) { p3_mixer(F); GRID_BAR(); }
    if (IN(4)) {
        pg8::Gemm g{MIX, (const bf16*)(args.ws + WS_WOUT), M, D, D}; pg8::StaticOrder S; S.init(M, D, F.G, (int)blockIdx.x);
        pg8::EpiResGate E{F.in[IN_X], (bf16*)(args.ws + WS_X1), D, F.in[IN_BOUT], (const float*)(args.ws + WS_ADA), ADA_W, 2 * D, SEQ / 256};
        pg8::gemm_phase<pg8::EpiResGate, pg8::StaticOrder, true, true>(F.lds + RING_OFF, g, S, E);
        GRID_BAR();
    }
    if (IN(5)) { p5_h2pass(F); GRID_BAR(); }
    if (IN(6)) {
        pg8::Gemm g{(const bf16*)(args.ws + WS_H8), (const bf16*)(args.ws + WS_WQ), M, QW, D / 2}; pg8::StaticOrder S; S.init(M, QW, F.G, (int)blockIdx.x);
        pg8::EpiI8Bf16 E{PROJ, QW, (const float*)(args.ws + WS_HS), 1.f / WQ_SCALE, nullptr};
        pg8::gemm_phase<pg8::EpiI8Bf16, pg8::StaticOrder, true, true, true>(F.lds + RING_OFF, g, S, E);
        GRID_BAR();
    }
    if (IN(7)) { p7_routing(F); GRID_BAR(); }
    if (IN(8)) { p8a_udots(F); GRID_BAR(); }
    if (IN(9)) { p8w_weights(F); GRID_BAR(); }
    if (IN(10)) { p8b_vsum(F); GRID_BAR(); }
    if (IN(11)) { p8c_final(F); }
#undef IN
}

extern "C" void kernel_launch(void* const* d_in, const int* in_sizes, int n_in, void* d_out, int out_size, void* d_ws, size_t ws_size, hipStream_t stream) {
    static int grid = 0;
    if (grid == 0) {
        if (n_in != 20 || in_sizes[0] != M * D || out_size != M * D || ws_size < WS_END) { fprintf(stderr, "kernel_launch: unexpected shapes (n_in %d, in0 %d, out %d, ws %zu); nothing launched\n", n_in, n_in > 0 ? in_sizes[0] : -1, out_size, ws_size); grid = -1; return; }
        int dev = 0, cus = 0, per_cu = 0;
        if (hipGetDevice(&dev) != hipSuccess || hipDeviceGetAttribute(&cus, hipDeviceAttributeMultiprocessorCount, dev) != hipSuccess) { fprintf(stderr, "kernel_launch: device query failed\n"); grid = -1; return; }
        if (hipFuncSetAttribute((const void*)skel_fwd, hipFuncAttributeMaxDynamicSharedMemorySize, LDS_BYTES) != hipSuccess) { fprintf(stderr, "kernel_launch: hipFuncSetAttribute failed\n"); grid = -1; return; }
        if (hipOccupancyMaxActiveBlocksPerMultiprocessor(&per_cu, (const void*)skel_fwd, NWAVES * 64, LDS_BYTES) != hipSuccess || per_cu < 1)
            fprintf(stderr, "kernel_launch: note: occupancy query reports %d workgroups per CU\n", per_cu);
        (void)hipGetLastError();
        grid = cus;
    }
    if (grid < 0) return;
    if (hipMemsetAsync((char*)d_ws + WS_CTL, 0, CTL_ZERO_BYTES, stream) != hipSuccess) { fprintf(stderr, "kernel_launch: hipMemsetAsync failed\n"); return; }
    Args a{};
    for (int i = 0; i < 20; ++i) a.in[i] = (const float*)d_in[i];
    a.out = (float*)d_out; a.ws = (unsigned char*)d_ws;
    for (int li = 0; li < N_LAUNCHES; ++li) {
        a.ph_lo = (N_LAUNCHES == 1) ? 0 : li; a.ph_hi = (N_LAUNCHES == 1) ? NPHASES : li + 1; a.li = li;
        hipLaunchKernelGGL(skel_fwd, dim3(grid), dim3(NWAVES * 64), LDS_BYTES, stream, a);
        const hipError_t le = hipPeekAtLastError();
        if (le != hipSuccess) { fprintf(stderr, "kernel_launch: launch %d failed: %s\n", li, hipGetErrorName(le)); break; }
    }
}
```

```cpp
#include <hip/hip_runtime.h>
#include <cstdio>
#include <cstdint>
#include <cmath>
namespace pg8 {
#define PG8_LAS __attribute__((address_space(3)))
typedef unsigned short bf16_t;
typedef short bf16x8 __attribute__((ext_vector_type(8)));
typedef float f32x4 __attribute__((ext_vector_type(4)));
typedef unsigned u32x4 __attribute__((ext_vector_type(4)));
constexpr int BM = 256, BK = 64, HALF = 128, HTB = HALF * BK * 2  , STAGE_BYTES = 8 * HTB, NXCD = 8, WGM = 8;

__host__ __device__ __forceinline__ int lds_byte(int r, int c) { const int st = (r >> 4) * 2 + (c >> 5), rr = r & 15, cc = c & 31, ob = rr * 64 + cc * 2; return st * 1024 + (ob ^ (((ob >> 9) & 1) << 5)); }
__host__ __device__ __forceinline__ void stage_rc(int b, int& R, int& C) { const int st = b / 1024, sb = b % 1024, swz = sb ^ (((sb >> 9) & 1) << 5); R = (st >> 1) * 16 + swz / 64; C = (st & 1) * 32 + (swz % 64) / 2; }
__host__ __device__ __forceinline__ int perm32(int rho) { const int n = rho >> 4, i = rho & 15; return 8 * (i >> 2) + 4 * n + (i & 3); }

__device__ __forceinline__ __amdgpu_buffer_rsrc_t wt_rsrc(const void* base, size_t bytes) { return __builtin_amdgcn_make_buffer_rsrc((void*)base, 0, (int)bytes, 0x00020000); }
__device__ __forceinline__ void store16_wt(__amdgpu_buffer_rsrc_t r, unsigned off, u32x4 v) { __builtin_amdgcn_raw_buffer_store_b128(v, r, (int)off, 0, 16); }
struct Unit { int pm, pn; };
struct Gemm { const bf16_t* A; const bf16_t* Bt; int M, N, K; };

struct StaticOrder {
    int nM, nN, nwg, G, c;
    __host__ __device__ void init(int M, int N, int G_, int c_) { nM = M / BM; nN = N / BM; nwg = nM * nN; G = G_; c = c_; }
    __host__ __device__ __forceinline__ bool next(int i, Unit& u) const { return at((long)i * G + c, u); }
    __host__ __device__ __forceinline__ bool at(long L, Unit& u) const {
        if (L >= nwg) return false;
        int wgid = (int)L; { const int q = nwg / NXCD, r = nwg % NXCD, xcd = wgid % NXCD, off = wgid / NXCD; wgid = (xcd < r ? xcd * (q + 1) : r * (q + 1) + (xcd - r) * q) + off; }
        const int nig = WGM * nN, gid = wgid / nig, fm = gid * WGM, gsz = (nM - fm) < WGM ? (nM - fm) : WGM;
        u.pm = fm + ((wgid % nig) % gsz); u.pn = (wgid % nig) / gsz; return true;
    }
    __host__ __device__ __forceinline__ int part(int) const { return 0; }
    __device__ __forceinline__ void a_ready(const Unit&) const {}
    __device__ __forceinline__ void done(const Unit&) const {}
};

struct StagOrder {
    StaticOrder base; int R, E, grpB, pair; bool on;
    __host__ __device__ void init(int M, int N, int G_, int c_) { base.init(M, N, G_, c_); R = base.nwg / G_; E = base.nwg - R * G_; on = (G_ % 16 == 0) && R >= 1 && (E == 0 || E == G_ / 2);
        const int slot = c_ >> 3; grpB = slot & 1; pair = (slot >> 1) * 8 + (c_ & 7); }
    __host__ __device__ __forceinline__ bool next(int i, Unit& u) const {
        if (!on) return base.next(i, u);
        if (E) {
            if (!grpB) return i < R ? base.next(i, u) : (i == R ? base.at((long)R * base.G + pair, u) : false);
            return i == 0 ? base.at((long)R * base.G + pair, u) : (i <= R ? base.next(i - 1, u) : false);
        }
        if (!grpB || i < R) return base.next(i, u);
        return i == R ? base.next(0, u) : false;
    }
    __host__ __device__ __forceinline__ int part(int i) const {
        if (!on) return 0;
        if (E) return grpB ? (i == 0 ? 2 : 0) : (i == R ? 1 : 0);
        return grpB ? (i == 0 ? 1 : (i == R ? 2 : 0)) : 0;
    }
    __device__ __forceinline__ void a_ready(const Unit&) const {}
    __device__ __forceinline__ void done(const Unit&) const {}
};

__device__ __forceinline__ unsigned cvt_pk_bf16(float lo, float hi) { unsigned r; asm volatile("v_cvt_pk_bf16_f32 %0, %1, %2" : "=v"(r) : "v"(lo), "v"(hi)); return r; }
typedef float f32x2 __attribute__((ext_vector_type(2)));
__device__ __forceinline__ f32x2 gelu_pk(f32x2 v) {
    const f32x2 av = __builtin_elementwise_abs(v), d = av * 0.2316418882f + 1.0f;
    f32x2 t; t.x = __builtin_amdgcn_rcpf(d.x); t.y = __builtin_amdgcn_rcpf(d.y);
    f32x2 q = t * 0.5307027145f + (-0.7265760135f); q = q * t + 0.7107068705f; q = q * t + (-0.142248368f); q = q * t + 0.127414796f; q = q * t;
    const f32x2 s = (v * v) * (-0.72134752044f);
    f32x2 e; e.x = __builtin_amdgcn_exp2f(s.x); e.y = __builtin_amdgcn_exp2f(s.y);
    const f32x2 m = v * (q * e), r = v - m;
    f32x2 o; o.x = v.x < 0.f ? m.x : r.x; o.y = v.y < 0.f ? m.y : r.y; return o;
}

template <int ACT  > struct EpiBf16 {
    static constexpr bool PERM = true, AFTER_DRAIN = false; static_assert(ACT == 0 || ACT == 1, "EpiBf16: ACT is 0 (none) or 1 (gelu_pk)");
    bf16_t* O; int ldc; const float* bias; int split_cols; size_t split_stride; float scale0;
    __device__ __forceinline__ void operator()(const f32x4 (&acc)[2][2][4][2], const Unit& u, int wr, int wc, int fr, int fq) const {
        const int row0 = u.pm * BM + wr * 64 + fr; int colt = u.pn * BM; bf16_t* base = O;
        float sc = 1.f; if (split_cols) { const int t = colt / split_cols; base += (size_t)t * split_stride; colt -= t * split_cols; if (t == 0) sc = scale0; }
        const int col0 = colt + wc * 32 + 8 * fq, bcol0 = u.pn * BM + wc * 32 + 8 * fq;
        f32x4 bv[2][2];
#pragma unroll
        for (int bj = 0; bj < 2; ++bj)
#pragma unroll
            for (int n = 0; n < 2; ++n) bv[bj][n] = bias ? *(const f32x4*)(bias + bcol0 + bj * HALF + 4 * n) : (f32x4){0.f, 0.f, 0.f, 0.f};
#pragma unroll
        for (int ai = 0; ai < 2; ++ai)
#pragma unroll
            for (int m = 0; m < 4; ++m) { bf16_t* rowp = base + (size_t)(row0 + ai * HALF + m * 16) * ldc + col0;
#pragma unroll
                for (int bj = 0; bj < 2; ++bj) { f32x4 v0 = acc[ai][bj][m][0] + bv[bj][0], v1 = acc[ai][bj][m][1] + bv[bj][1];
                    if (ACT == 1) { f32x2 a = gelu_pk((f32x2){v0[0], v0[1]}), b = gelu_pk((f32x2){v0[2], v0[3]}), c = gelu_pk((f32x2){v1[0], v1[1]}), d = gelu_pk((f32x2){v1[2], v1[3]});
                        v0 = (f32x4){a.x, a.y, b.x, b.y}; v1 = (f32x4){c.x, c.y, d.x, d.y}; }
                    v0 = v0 * sc; v1 = v1 * sc; u32x4 w; w.x = cvt_pk_bf16(v0[0], v0[1]); w.y = cvt_pk_bf16(v0[2], v0[3]); w.z = cvt_pk_bf16(v1[0], v1[1]); w.w = cvt_pk_bf16(v1[2], v1[3]);
                    *(u32x4*)(rowp + bj * HALF) = w; } }
    }
};

typedef unsigned u32x2 __attribute__((ext_vector_type(2)));
struct EpiResGate {
    static constexpr bool PERM = true, AFTER_DRAIN = false;
    const float* x; bf16_t* out; int ldc; const float* bias; const float* ada; int ada_ld, gate_off, tiles_per_batch;
    __device__ __forceinline__ void operator()(const f32x4 (&acc)[2][2][4][2], const Unit& u, int wr, int wc, int fr, int fq, int part) const {
        const int row0 = u.pm * BM + wr * 64 + fr, col0 = u.pn * BM + wc * 32 + 8 * fq;
        const float* gp = ada + (size_t)(u.pm / tiles_per_batch) * ada_ld + gate_off;
        f32x4 bv[2][2], gv[2][2];
#pragma unroll
        for (int bj = 0; bj < 2; ++bj)
#pragma unroll
            for (int n = 0; n < 2; ++n) { bv[bj][n] = *(const f32x4*)(bias + col0 + bj * HALF + 4 * n); gv[bj][n] = *(const f32x4*)(gp + col0 + bj * HALF + 4 * n); }
        const __amdgpu_buffer_rsrc_t orsrc = wt_rsrc(out, (size_t)32768 * ldc * 2);
#pragma unroll
        for (int ai = 0; ai < 2; ++ai) {
            if (part == (ai ? 1 : 2)) continue;
#pragma unroll
            for (int mh = 0; mh < 2; ++mh) {
            f32x4 xv[2][2][2];
#pragma unroll
            for (int m = 0; m < 2; ++m) { const size_t off = (size_t)(row0 + ai * HALF + (2 * mh + m) * 16) * ldc + col0;
#pragma unroll
                for (int bj = 0; bj < 2; ++bj)
#pragma unroll
                    for (int n = 0; n < 2; ++n) xv[m][bj][n] = __builtin_nontemporal_load((const f32x4*)(x + off + bj * HALF + 4 * n)); }
#pragma unroll
            for (int m = 0; m < 2; ++m) { const size_t off = (size_t)(row0 + ai * HALF + (2 * mh + m) * 16) * ldc + col0;
#pragma unroll
                for (int bj = 0; bj < 2; ++bj) { const f32x4 o0 = xv[m][bj][0] + gv[bj][0] * (acc[ai][bj][2 * mh + m][0] + bv[bj][0]), o1 = xv[m][bj][1] + gv[bj][1] * (acc[ai][bj][2 * mh + m][1] + bv[bj][1]);
                    u32x4 w; w.x = cvt_pk_bf16(o0[0], o0[1]); w.y = cvt_pk_bf16(o0[2], o0[3]); w.z = cvt_pk_bf16(o1[0], o1[1]); w.w = cvt_pk_bf16(o1[2], o1[3]);
                    store16_wt(orsrc, (unsigned)((off + bj * HALF) * 2), w); } }
            asm volatile("" ::: "memory"); }
            asm volatile("" ::: "memory"); }
    }
};


typedef int i32x4 __attribute__((ext_vector_type(4)));
template <bool I8> struct AccSel { typedef f32x4 type; static __device__ __forceinline__ f32x4 zero() { return (f32x4){0.f, 0.f, 0.f, 0.f}; } };
template <> struct AccSel<true> { typedef i32x4 type; static __device__ __forceinline__ i32x4 zero() { return (i32x4){0, 0, 0, 0}; } };
template <bool I8> __device__ __forceinline__ typename AccSel<I8>::type mma16(bf16x8 a, bf16x8 b, typename AccSel<I8>::type c) {
    if constexpr (I8) return __builtin_amdgcn_mfma_i32_16x16x64_i8(__builtin_bit_cast(i32x4, a), __builtin_bit_cast(i32x4, b), c, 0, 0, 0);
    else return __builtin_amdgcn_mfma_f32_16x16x32_bf16(a, b, c, 0, 0, 0);
}
struct EpiI8Bf16 {
    static constexpr bool PERM = true, AFTER_DRAIN = false;
    bf16_t* O; int ldc; const float* rowscale; float wscale; const float* bias;
    __device__ __forceinline__ void operator()(const i32x4 (&acc)[2][2][4][2], const Unit& u, int wr, int wc, int fr, int fq, int part) const {
        const int row0 = u.pm * BM + wr * 64 + fr, col0 = u.pn * BM + wc * 32 + 8 * fq;
        f32x4 bv[2][2];
#pragma unroll
        for (int bj = 0; bj < 2; ++bj)
#pragma unroll
            for (int n = 0; n < 2; ++n) bv[bj][n] = bias ? *(const f32x4*)(bias + col0 + bj * HALF + 4 * n) : (f32x4){0.f, 0.f, 0.f, 0.f};
        const __amdgpu_buffer_rsrc_t orsrc = wt_rsrc(O, (size_t)32768 * ldc * 2);
#pragma unroll
        for (int ai = 0; ai < 2; ++ai) { if (part == (ai ? 1 : 2)) continue;
#pragma unroll
            for (int m = 0; m < 4; ++m) { const int row = row0 + ai * HALF + m * 16; const float sc = rowscale[row] * wscale; const unsigned rowoff = (unsigned)(((size_t)row * ldc + col0) * 2);
#pragma unroll
                for (int bj = 0; bj < 2; ++bj) { const i32x4 a0 = acc[ai][bj][m][0], a1 = acc[ai][bj][m][1]; const f32x4 b0 = bv[bj][0], b1 = bv[bj][1];
                    u32x4 w; w.x = cvt_pk_bf16((float)a0[0] * sc + b0[0], (float)a0[1] * sc + b0[1]); w.y = cvt_pk_bf16((float)a0[2] * sc + b0[2], (float)a0[3] * sc + b0[3]);
                    w.z = cvt_pk_bf16((float)a1[0] * sc + b1[0], (float)a1[1] * sc + b1[1]); w.w = cvt_pk_bf16((float)a1[2] * sc + b1[2], (float)a1[3] * sc + b1[3]);
                    store16_wt(orsrc, rowoff + bj * HALF * 2, w); } } }
    }
};
template <class Epi, class Sched, bool ALIGN_EPI = false, bool SP2 = false, bool I8 = false>
__device__ __forceinline__ void gemm_phase(PG8_LAS unsigned char* lds, const Gemm g, const Sched& S, const Epi& E) {
    const int tid = threadIdx.x, wid = __builtin_amdgcn_readfirstlane(tid >> 6), lane = tid & 63, wr = wid >> 2, wc = wid & 3, fr = lane & 15, fq = lane >> 4;
    const int K = g.K, nt = K / BK;
    unsigned voffA[2], voffB[2];
#pragma unroll
    for (int i = 0; i < 2; ++i) { int R, C; stage_rc(tid * 16 + i * 8192, R, C); const int Rb = Epi::PERM ? ((R & ~31) + perm32(R & 31)) : R;
        voffA[i] = (unsigned)(R * K + C) * 2u; voffB[i] = (unsigned)(Rb * K + C) * 2u; }
    const size_t kstep = (size_t)(BK * 2);
    const size_t hstep = (size_t)HALF * K * 2;
    const size_t tstep = 2 * hstep;
    const unsigned ldsw = (unsigned)wid * 1024u;
    const int aoff = lds_byte(wr * 64 + fr, fq * 8), boff = lds_byte(wc * 32 + fr, fq * 8);
#define PG8_SA(b, h) (((b) * 2 + (h)) * HTB)
#define PG8_SB(b, h) ((4 + (b) * 2 + (h)) * HTB)
#define PG8_STAGE(bufoff, gbase, voff) do { _Pragma("unroll") for (int _i = 0; _i < 2; ++_i) \
        __builtin_amdgcn_global_load_lds((const unsigned*)((const char*)(gbase) + (voff)[_i]), (PG8_LAS unsigned*)(lds + (bufoff) + ldsw + _i * 8192), 16, 0, 0); } while (0)
#define PG8_LDA(dst, b, h) do { _Pragma("unroll") for (int m = 0; m < 4; ++m) _Pragma("unroll") for (int k = 0; k < 2; ++k) dst[m][k] = *(const PG8_LAS bf16x8*)(lds + PG8_SA(b, h) + aoff + m * 2048 + k * 1024); } while (0)
#define PG8_LDB(dst, b, h) do { _Pragma("unroll") for (int n = 0; n < 2; ++n) _Pragma("unroll") for (int k = 0; k < 2; ++k) dst[n][k] = *(const PG8_LAS bf16x8*)(lds + PG8_SB(b, h) + boff + n * 2048 + k * 1024); } while (0)
#define PG8_MMA(ai, bj, At, Bt) do { __builtin_amdgcn_s_setprio(1); _Pragma("unroll") for (int m = 0; m < 4; ++m) _Pragma("unroll") for (int n = 0; n < 2; ++n) _Pragma("unroll") for (int k = 0; k < 2; ++k) \
        acc[ai][bj][m][n] = mma16<I8>(Bt[n][k], At[m][k], acc[ai][bj][m][n]); __builtin_amdgcn_s_setprio(0); } while (0)
#define PG8_WAIT_V(n) asm volatile("s_waitcnt vmcnt(" #n ")" ::: "memory")
#define PG8_WAIT_L(n) asm volatile("s_waitcnt lgkmcnt(" #n ")" ::: "memory")
#define PG8_BAR __builtin_amdgcn_s_barrier()
#define PG8_SCHED __builtin_amdgcn_sched_barrier(0)
    Unit cur, nxt; int ui = 0;
    if (!S.next(0, cur)) return;
    typedef typename AccSel<I8>::type acc_t;
    acc_t acc[2][2][4][2];
#pragma unroll
    for (int a = 0; a < 2; ++a)
#pragma unroll
        for (int b = 0; b < 2; ++b)
#pragma unroll
            for (int m = 0; m < 4; ++m)
#pragma unroll
                for (int n = 0; n < 2; ++n) acc[a][b][m][n] = AccSel<I8>::zero();
    bf16x8 At[4][2], B0[2][2], B1[2][2];
    const char* cA = (const char*)g.A + (size_t)cur.pm * tstep; const char* cB = (const char*)g.Bt + (size_t)cur.pn * tstep;
    S.a_ready(cur);
    if constexpr (SP2) {
        PG8_STAGE(PG8_SB(0, 0), cB, voffB); PG8_STAGE(PG8_SB(0, 1), cB + hstep, voffB); PG8_STAGE(PG8_SA(0, 0), cA, voffA); PG8_STAGE(PG8_SA(0, 1), cA + hstep, voffA);
        if (wr == 1) PG8_BAR;
        PG8_WAIT_V(2); PG8_BAR;
        PG8_STAGE(PG8_SB(1, 0), cB + kstep, voffB); PG8_STAGE(PG8_SA(1, 0), cA + kstep, voffA); PG8_STAGE(PG8_SB(1, 1), cB + hstep + kstep, voffB);
        PG8_WAIT_V(6); PG8_BAR;
    } else {
        PG8_STAGE(PG8_SB(0, 0), cB, voffB); PG8_STAGE(PG8_SA(0, 0), cA, voffA); PG8_STAGE(PG8_SB(0, 1), cB + hstep, voffB); PG8_STAGE(PG8_SA(0, 1), cA + hstep, voffA);
        if (wr == 1) PG8_BAR;
        PG8_WAIT_V(4); PG8_BAR;
        PG8_STAGE(PG8_SB(1, 0), cB + kstep, voffB); PG8_STAGE(PG8_SA(1, 0), cA + kstep, voffA); PG8_STAGE(PG8_SB(1, 1), cB + hstep + kstep, voffB);
        PG8_WAIT_V(6); PG8_BAR;
    }
    for (;;) {
        const bool has_next = S.next(ui + 1, nxt);
        const char* nA = has_next ? (const char*)g.A + (size_t)nxt.pm * tstep : cA; const char* nB = has_next ? (const char*)g.Bt + (size_t)nxt.pn * tstep : cB;
        const int cpart = S.part(ui); const bool d0 = cpart != 2, d1 = cpart != 1;
        for (int t = 0; t < nt; t += 2) {
            const bool last = (t == nt - 2);
            const char* a1 = cA + (size_t)(t + 1) * kstep;
            const char* a2 = last ? nA : cA + (size_t)(t + 2) * kstep; const char* b2 = last ? nB : cB + (size_t)(t + 2) * kstep;
            const char* a3 = a2 + kstep; const char* b3 = b2 + kstep;
            if (last && has_next) S.a_ready(nxt);
            if constexpr (SP2) {
            PG8_LDB(B0, 0, 0); PG8_LDB(B1, 0, 1); PG8_SCHED; PG8_LDA(At, 0, 0); PG8_STAGE(PG8_SA(1, 1), a1 + hstep, voffA);
            PG8_WAIT_V(8); PG8_WAIT_L(0); PG8_BAR; if (d0) { PG8_MMA(0, 0, At, B0); PG8_MMA(0, 1, At, B1); } PG8_BAR; PG8_SCHED;
            PG8_LDA(At, 0, 1); PG8_STAGE(PG8_SB(0, 0), b2, voffB); PG8_STAGE(PG8_SB(0, 1), b2 + hstep, voffB); PG8_STAGE(PG8_SA(0, 0), a2, voffA);
            PG8_WAIT_V(8); PG8_WAIT_L(0); PG8_BAR; if (d1) { PG8_MMA(1, 0, At, B0); PG8_MMA(1, 1, At, B1); } PG8_BAR; PG8_SCHED;
            PG8_LDB(B0, 1, 0); PG8_LDB(B1, 1, 1); PG8_SCHED; PG8_LDA(At, 1, 0); PG8_STAGE(PG8_SA(0, 1), a2 + hstep, voffA);
            PG8_WAIT_V(8); PG8_WAIT_L(0); PG8_BAR; if (d0) { PG8_MMA(0, 0, At, B0); PG8_MMA(0, 1, At, B1); } PG8_BAR; PG8_SCHED;
            PG8_LDA(At, 1, 1); PG8_STAGE(PG8_SB(1, 0), b3, voffB); PG8_STAGE(PG8_SB(1, 1), b3 + hstep, voffB); PG8_STAGE(PG8_SA(1, 0), a3, voffA);
            PG8_WAIT_V(8); PG8_WAIT_L(0); PG8_BAR; if (d1) { PG8_MMA(1, 0, At, B0); PG8_MMA(1, 1, At, B1); } PG8_BAR; PG8_SCHED;
            } else {
            PG8_LDB(B0, 0, 0); PG8_SCHED; PG8_LDA(At, 0, 0); PG8_STAGE(PG8_SA(1, 1), a1 + hstep, voffA);
            PG8_WAIT_L(8); PG8_BAR; PG8_WAIT_L(0); PG8_MMA(0, 0, At, B0); PG8_BAR; PG8_SCHED;
            PG8_LDB(B1, 0, 1); PG8_STAGE(PG8_SB(0, 0), b2, voffB);
            PG8_BAR; PG8_WAIT_L(0); PG8_MMA(0, 1, At, B1); PG8_BAR;
            PG8_LDA(At, 0, 1); PG8_STAGE(PG8_SA(0, 0), a2, voffA);
            PG8_BAR; PG8_WAIT_L(0); PG8_MMA(1, 0, At, B0); PG8_BAR; PG8_SCHED;
            PG8_STAGE(PG8_SB(0, 1), b2 + hstep, voffB);
            PG8_WAIT_V(6); PG8_BAR; PG8_MMA(1, 1, At, B1); PG8_BAR;
            PG8_LDB(B0, 1, 0); PG8_SCHED; PG8_LDA(At, 1, 0); PG8_STAGE(PG8_SA(0, 1), a2 + hstep, voffA);
            PG8_WAIT_L(8); PG8_BAR; PG8_WAIT_L(0); PG8_MMA(0, 0, At, B0); PG8_BAR; PG8_SCHED;
            PG8_LDB(B1, 1, 1); PG8_STAGE(PG8_SB(1, 0), b3, voffB);
            PG8_BAR; PG8_WAIT_L(0); PG8_MMA(0, 1, At, B1); PG8_BAR;
            PG8_LDA(At, 1, 1); PG8_STAGE(PG8_SA(1, 0), a3, voffA);
            PG8_BAR; PG8_WAIT_L(0); PG8_MMA(1, 0, At, B0); PG8_BAR; PG8_SCHED;
            PG8_STAGE(PG8_SB(1, 1), b3 + hstep, voffB);
            PG8_WAIT_V(6); PG8_BAR; PG8_MMA(1, 1, At, B1); PG8_BAR;
            }
        }
        if constexpr (ALIGN_EPI) { if (wr == 0) PG8_BAR; }
        if constexpr (!Epi::AFTER_DRAIN) { E(acc, cur, wr, wc, fr, fq, cpart); S.done(cur); }
        if (!has_next) break;
#pragma unroll
        for (int a = 0; a < 2; ++a)
#pragma unroll
            for (int b = 0; b < 2; ++b)
#pragma unroll
                for (int m = 0; m < 4; ++m)
#pragma unroll
                    for (int n = 0; n < 2; ++n) acc[a][b][m][n] = AccSel<I8>::zero();
        cur = nxt; cA = nA; cB = nB; ++ui;
        if constexpr (ALIGN_EPI) { if (wr == 1) PG8_BAR; }
    }
    PG8_WAIT_V(0);
    if constexpr (!ALIGN_EPI) { if (wr == 0) PG8_BAR; }
    PG8_BAR;
    if constexpr (Epi::AFTER_DRAIN) { E.fused(acc, cur, wr, wc, fr, fq, lds, wid, lane); S.done(cur); }
#undef PG8_SA
#undef PG8_SB
#undef PG8_STAGE
#undef PG8_LDA
#undef PG8_LDB
#undef PG8_MMA
#undef PG8_WAIT_V
#undef PG8_WAIT_L
#undef PG8_BAR
#undef PG8_SCHED
}
}

constexpr int NWAVES = 8;
constexpr int NPHASES = 12;
#ifndef MK_N_LAUNCHES
#define MK_N_LAUNCHES 1
#endif
constexpr int N_LAUNCHES = MK_N_LAUNCHES;
static_assert(N_LAUNCHES == 1 || N_LAUNCHES == NPHASES, "MK_N_LAUNCHES is 1 or NPHASES");

constexpr int BATCH = 16, SEQ = 2048, D = 1024, M = BATCH * SEQ;
constexpr int IN_W = 2304, O_Q = 0, O_K = 512, O_V = 640, O_B = 768, O_C = 1280, O_U = 1792;
constexpr int NQH = 8, NKVH = 2, HD = 64, WIN = 128;
constexpr int NKEYS = 128, NEXP = 16384, PH = 8, TOPK = 16, DKEY = 256, DHALF = 128, QW = PH * DKEY;
constexpr int ADA_W = 6 * D, ADA_KC = 8;
constexpr float EPS = 1e-6f;

constexpr size_t MiB = 1u << 20;
constexpr size_t WS_CTL = 0, CTL_ZERO_BYTES = 64 * 1024;
constexpr size_t WS_ADAP = 1 * MiB;
constexpr size_t WS_ADA = 4 * MiB;
constexpr size_t WS_WIN = 5 * MiB;
constexpr size_t WS_WOUT = 10 * MiB;
constexpr size_t WS_WQ = 12 * MiB;
constexpr size_t WS_K1 = 16 * MiB, WS_K2 = 16 * MiB + 512 * 1024;
constexpr size_t WS_U = 17 * MiB, WS_V = 33 * MiB;
constexpr float U_SCALE = 896.f, V_SCALE = 8.f, WQ_SCALE = 896.f;
constexpr size_t WS_H = 81 * MiB;
constexpr size_t WS_PROJ = 145 * MiB;
constexpr size_t WS_MIX = 289 * MiB;
constexpr size_t WS_IDX = 353 * MiB;
constexpr size_t WS_GATE = 369 * MiB;
constexpr size_t WS_H8 = 49 * MiB;
constexpr size_t WS_HS = 393 * MiB;
constexpr size_t WS_W16 = 385 * MiB;
constexpr size_t WS_X1 = 417 * MiB;
constexpr size_t WS_END = 481 * MiB;
constexpr size_t WS_PA = WS_PROJ;
constexpr size_t WS_SS = WS_MIX;
constexpr int CW_BAR = 4096;
static_assert((CW_BAR + 3456) * 4 <= (int)CTL_ZERO_BYTES, "barrier words inside the zeroed region");

constexpr int RING_OFF = 0, RING_BYTES = 131072;
constexpr int LDSCTL_OFF = 135168, MISC_OFF = LDSCTL_OFF + 320;
constexpr int LDS_BYTES = 147456;
static_assert(MISC_OFF + 128 <= LDS_BYTES, "LDS map");

#define GAS __attribute__((address_space(1)))
#define LAS __attribute__((address_space(3)))
typedef unsigned short bf16;
typedef unsigned v4u __attribute__((ext_vector_type(4)));
typedef float f32x4 __attribute__((ext_vector_type(4)));
typedef short bf16x8 __attribute__((ext_vector_type(8)));
typedef GAS unsigned gu32;
typedef GAS unsigned long long gu64;
#define RLX_AGENT __ATOMIC_RELAXED, __HIP_MEMORY_SCOPE_AGENT
#define LDS_WAIT() asm volatile("s_waitcnt lgkmcnt(0)" ::: "memory")
#define VM_WAIT() asm volatile("s_waitcnt vmcnt(0)" ::: "memory")
__device__ __forceinline__ unsigned long long rt() { return __builtin_amdgcn_s_memrealtime(); }
__device__ __forceinline__ unsigned f2bf(float f) { unsigned u = __builtin_bit_cast(unsigned, f); return (u + 0x7fffu + ((u >> 16) & 1u)) >> 16; }
__device__ __forceinline__ unsigned pk2(float lo, float hi) { return f2bf(lo) | (f2bf(hi) << 16); }

#define XB_TMO      128
#define XB_XCNT(j)  (256  + 64 * (j))
#define XB_XSUB(j)  (1280 + 64 * (j))
#define XB_XGEN(j)  (2304 + 64 * (j))
#define XB_TOP      3328
#define XB_TOPGEN   3392
#define XCD_BAR_WORDS 3456
#define XB_SPIN_CAP (1u << 22)

__device__ __forceinline__ unsigned xb_ld(unsigned* p)              { return __hip_atomic_load(p, __ATOMIC_RELAXED, __HIP_MEMORY_SCOPE_AGENT); }
__device__ __forceinline__ unsigned xb_add(unsigned* p, unsigned v) { return __hip_atomic_fetch_add(p, v, __ATOMIC_RELAXED, __HIP_MEMORY_SCOPE_AGENT); }
__device__ __forceinline__ unsigned xb_xcc_id() { return (unsigned)__builtin_amdgcn_s_getreg((3 << 11) | 20) & 0xFu; }
#define XB_SPIN(cond, bar) do { unsigned _sp = 0; while (cond) { __builtin_amdgcn_s_sleep(1); \
    if ((++_sp & 255u) == 0u) { if (xb_ld(&(bar)[XB_TMO])) break; if (_sp > XB_SPIN_CAP) { atomicAdd(&(bar)[XB_TMO], 1u); break; } } } } while (0)

struct XcdBarrier {
    unsigned* bar; unsigned x;
    volatile LAS unsigned* st;
};

__device__ __forceinline__ XcdBarrier xcd_barrier_post(unsigned* bar, volatile LAS unsigned* st) {
    XcdBarrier b; b.bar = bar; b.x = xb_xcc_id(); b.st = st;
    if (threadIdx.x == 0) (void)xb_add(&bar[XB_XCNT(b.x)], 1u);
    return b;
}
__device__ __forceinline__ void xcd_barrier_complete(unsigned* bar, unsigned x, unsigned& nloc, unsigned& nx) {
    const unsigned G = gridDim.x * gridDim.y * gridDim.z;
    unsigned sum, cnt, mine, sp = 0u;
    for (;;) {
        sum = 0u; cnt = 0u; mine = 0u;
#pragma unroll
        for (unsigned j = 0; j < 16; ++j) { const unsigned c = xb_ld(&bar[XB_XCNT(j)]); sum += c; cnt += (c > 0u) ? 1u : 0u; mine = (j == x) ? c : mine; }
        if (sum == G) break;
        __builtin_amdgcn_s_sleep(1);
        if ((++sp & 255u) == 0u) { if (xb_ld(&bar[XB_TMO])) break; if (sp > XB_SPIN_CAP) { atomicAdd(&bar[XB_TMO], 1u); break; } }
    }
    nloc = mine > 0u ? mine : 1u; nx = cnt > 0u ? cnt : 1u;
}

__device__ __forceinline__ void xcd_barrier(const XcdBarrier& b) {
    asm volatile("s_waitcnt vmcnt(0)" ::: "memory");
    __syncthreads();
    if (threadIdx.x == 0) {
        unsigned* bar = b.bar;
        __builtin_amdgcn_s_waitcnt(0);
        unsigned nloc = b.st[0], nx = b.st[1];
        if (nloc == 0u) { xcd_barrier_complete(bar, b.x, nloc, nx); b.st[0] = nloc; b.st[1] = nx; }
        const unsigned old = xb_add(&bar[XB_XSUB(b.x)], 1u);
        const unsigned gen = old / nloc;
        if (old + 1u == (gen + 1u) * nloc) {
            __builtin_amdgcn_fence(__ATOMIC_RELEASE, "agent");
            asm volatile("s_waitcnt vmcnt(0)" ::: "memory");
            const unsigned og = xb_add(&bar[XB_TOP], 1u);
            const unsigned tg = og / nx;
            if (og + 1u == (tg + 1u) * nx) xb_add(&bar[XB_TOPGEN], 1u);
            else XB_SPIN(xb_ld(&bar[XB_TOPGEN]) == tg, bar);
            __builtin_amdgcn_fence(__ATOMIC_ACQUIRE, "agent");
            xb_add(&bar[XB_XGEN(b.x)], 1u);
            asm volatile("s_waitcnt vmcnt(0)" ::: "memory");
        } else {
            XB_SPIN(xb_ld(&bar[XB_XGEN(b.x)]) == gen, bar);
            __builtin_amdgcn_fence(__ATOMIC_ACQUIRE, "agent");
            asm volatile("s_waitcnt vmcnt(0)" ::: "memory");
        }
    }
    __syncthreads();
}

struct Frame {
    LAS unsigned char* lds;
    volatile LAS unsigned* MISC;
    gu32* ctl;
    int tid, lane, wave;
    int vcu, G;
    const float* in[20]; float* out; unsigned char* ws;
};
#define IN_X 0
#define IN_C 1
#define IN_WADA 2
#define IN_BADA 3
#define IN_G1 4
#define IN_WIN 5
#define IN_BIN 6
#define IN_SINK 7
#define IN_CONVW 8
#define IN_AOG 9
#define IN_COG 10
#define IN_WOUT 11
#define IN_BOUT 12
#define IN_G2 13
#define IN_WQ 14
#define IN_PK1 15
#define IN_PK2 16
#define IN_PU 17
#define IN_PV 18
#define IN_GF 19

typedef __bf16 bf16x2_t __attribute__((ext_vector_type(2)));
typedef unsigned v2u __attribute__((ext_vector_type(2)));
__device__ __forceinline__ float dot2(unsigned a, unsigned b, float acc) { return __builtin_amdgcn_fdot2_f32_bf16(__builtin_bit_cast(bf16x2_t, a), __builtin_bit_cast(bf16x2_t, b), acc, false); }
__device__ __forceinline__ float dot8(v4u a, v4u b, float acc) { acc = dot2(a.x, b.x, acc); acc = dot2(a.y, b.y, acc); acc = dot2(a.z, b.z, acc); acc = dot2(a.w, b.w, acc); return acc; }
__device__ __forceinline__ float bflo(unsigned w) { return __uint_as_float(w << 16); }
__device__ __forceinline__ float bfhi(unsigned w) { return __uint_as_float(w & 0xffff0000u); }
__device__ __forceinline__ float wave_sum(float v) {
#pragma unroll
    for (int o = 1; o < 64; o <<= 1) v += __shfl_xor(v, o);
    return v;
}
__device__ __forceinline__ unsigned wave_umax(unsigned v) {
#pragma unroll
    for (int o = 1; o < 64; o <<= 1) { const unsigned t = (unsigned)__shfl_xor((int)v, o); v = v > t ? v : t; }
    return v;
}
__device__ __forceinline__ unsigned f2ord(float f) { const unsigned u = __float_as_uint(f); return (u & 0x80000000u) ? ~u : (u | 0x80000000u); }
__device__ __forceinline__ float ord2f(unsigned u) { return __uint_as_float((u & 0x80000000u) ? (u & 0x7fffffffu) : ~u); }

__device__ __forceinline__ unsigned pk4_i8(f32x4 a, float sc) {
    const int q0 = max(-127, min(127, __float2int_rn(a.x * sc))), q1 = max(-127, min(127, __float2int_rn(a.y * sc))), q2 = max(-127, min(127, __float2int_rn(a.z * sc))), q3 = max(-127, min(127, __float2int_rn(a.w * sc)));
    return (unsigned)(q0 & 0xff) | ((unsigned)(q1 & 0xff) << 8) | ((unsigned)(q2 & 0xff) << 16) | ((unsigned)q3 << 24); }
__device__ __forceinline__ void p0_transpose_item(const float* W, int K, int N, bf16* WT, LAS float* scr, int item, int lane) {
    const int nblk = N / 64, kb = item / nblk, nb = item % nblk, k0 = 64 * kb, n0 = 64 * nb;
#pragma unroll 16
    for (int kk = 0; kk < 64; ++kk) scr[kk * 65 + lane] = __builtin_nontemporal_load(W + (size_t)(k0 + kk) * N + n0 + lane);
    LDS_WAIT(); asm volatile("" ::: "memory");
    const int c = lane & 7;
#pragma unroll
    for (int j = 0; j < 8; ++j) { const int n = (lane >> 3) + 8 * j; const LAS float* s = scr + (8 * c) * 65 + n;
        v4u o; o.x = pk2(s[0 * 65], s[1 * 65]); o.y = pk2(s[2 * 65], s[3 * 65]); o.z = pk2(s[4 * 65], s[5 * 65]); o.w = pk2(s[6 * 65], s[7 * 65]);
        *(GAS v4u*)(WT + (size_t)(n0 + n) * K + k0 + 8 * c) = o; }
    LDS_WAIT(); asm volatile("" ::: "memory");
}
__device__ __forceinline__ void p0_transpose_item_i8(const float* W, int K, int N, unsigned char* WT, LAS float* scr, int item, int lane, float sc) {
    const int nblk = N / 64, kb = item / nblk, nb = item % nblk, k0 = 64 * kb, n0 = 64 * nb;
#pragma unroll 16
    for (int kk = 0; kk < 64; ++kk) scr[kk * 65 + lane] = __builtin_nontemporal_load(W + (size_t)(k0 + kk) * N + n0 + lane);
    LDS_WAIT(); asm volatile("" ::: "memory");
    const int c = lane & 7;
#pragma unroll
    for (int j = 0; j < 8; ++j) { const int n = (lane >> 3) + 8 * j; const LAS float* s = scr + (8 * c) * 65 + n;
        v2u o; o.x = pk4_i8((f32x4){s[0 * 65], s[1 * 65], s[2 * 65], s[3 * 65]}, sc); o.y = pk4_i8((f32x4){s[4 * 65], s[5 * 65], s[6 * 65], s[7 * 65]}, sc);
        *(GAS v2u*)(WT + (size_t)(n0 + n) * K + k0 + 8 * c) = o; }
    LDS_WAIT(); asm volatile("" ::: "memory");
}
__device__ __forceinline__ void p0_convert_item(const float* src, bf16* dst, size_t item, int lane) {
    const GAS f32x4* s = (const GAS f32x4*)(src + item * 2048) + lane * 2;
    GAS v4u* d = (GAS v4u*)(dst + item * 2048) + lane;
#pragma unroll
    for (int j = 0; j < 4; ++j) { const f32x4 a = s[j * 128], b = s[j * 128 + 1];
        v4u o; o.x = pk2(a.x, a.y); o.y = pk2(a.z, a.w); o.z = pk2(b.x, b.y); o.w = pk2(b.z, b.w); d[j * 64] = o; }
}
__device__ __forceinline__ unsigned pk4_fp8(f32x4 a, float sc) { int w = __builtin_amdgcn_cvt_pk_fp8_f32(a.x * sc, a.y * sc, 0, false); w = __builtin_amdgcn_cvt_pk_fp8_f32(a.z * sc, a.w * sc, w, true); return (unsigned)w; }
__device__ __forceinline__ void quad_transpose4(unsigned (&d)[4], int lane) {
    const bool b0 = lane & 1, b1 = lane & 2;
    { const unsigned s0 = b0 ? d[0] : d[1], s1 = b0 ? d[2] : d[3];
      const unsigned r0 = (unsigned)__builtin_amdgcn_update_dpp(0, (int)s0, 0xB1, 0xf, 0xf, true), r1 = (unsigned)__builtin_amdgcn_update_dpp(0, (int)s1, 0xB1, 0xf, 0xf, true);
      if (b0) { d[0] = r0; d[2] = r1; } else { d[1] = r0; d[3] = r1; } }
    { const unsigned s0 = b1 ? d[0] : d[2], s1 = b1 ? d[1] : d[3];
      const unsigned r0 = (unsigned)__builtin_amdgcn_update_dpp(0, (int)s0, 0x4E, 0xf, 0xf, true), r1 = (unsigned)__builtin_amdgcn_update_dpp(0, (int)s1, 0x4E, 0xf, 0xf, true);
      if (b1) { d[0] = r0; d[1] = r1; } else { d[2] = r0; d[3] = r1; } }
}
template <bool FP8> __device__ __forceinline__ void p0_table_item(const float* src, unsigned char* dst, size_t item, int lane, float sc) {
    const GAS f32x4* s = (const GAS f32x4*)(src + item * 4096) + lane;
    f32x4 v[16];
#pragma unroll
    for (int i = 0; i < 16; ++i) v[i] = __builtin_nontemporal_load(s + i * 64);
    const __amdgpu_buffer_rsrc_t rs = pg8::wt_rsrc(dst, (size_t)NEXP * D);
    const int Q = lane >> 2, p = lane & 3;
#pragma unroll
    for (int j = 0; j < 4; ++j) { unsigned d[4];
#pragma unroll
        for (int q = 0; q < 4; ++q) d[q] = FP8 ? pk4_fp8(v[4 * j + q], sc) : pk4_i8(v[4 * j + q], sc);
        quad_transpose4(d, lane);
        pg8::store16_wt(rs, (unsigned)((size_t)(2 * p + (Q >> 3)) * NEXP * 128 + (item * 4 + j) * 128 + (Q & 7) * 16), (v4u){d[0], d[1], d[2], d[3]}); }
}
__device__ __forceinline__ void p0_ada_task(Frame& F, int task, LAS float* scr) {
    const int kc = task / (ADA_W / 64), ng = task % (ADA_W / 64), lane = F.lane;
    const float* c = F.in[IN_C];
    for (int e = lane; e < BATCH * 128; e += 64) { const int b = e >> 7, kk = e & 127; const float cv = c[b * D + kc * 128 + kk]; scr[kk * 16 + b] = cv / (1.f + expf(-cv)); }
    LDS_WAIT(); asm volatile("" ::: "memory");
    float acc[BATCH];
#pragma unroll
    for (int b = 0; b < BATCH; ++b) acc[b] = 0.f;
    const float* wp = F.in[IN_WADA] + (size_t)(kc * 128) * ADA_W + ng * 64 + lane;
#pragma unroll 1
    for (int k0 = 0; k0 < 128; k0 += 16) { float wv[16];
#pragma unroll
        for (int u = 0; u < 16; ++u) wv[u] = __builtin_nontemporal_load(wp + (size_t)(k0 + u) * ADA_W);
#pragma unroll
        for (int u = 0; u < 16; ++u) { const LAS f32x4* sp = (const LAS f32x4*)(scr + (k0 + u) * 16);
#pragma unroll
            for (int q = 0; q < 4; ++q) { const f32x4 s = sp[q]; acc[4 * q] += s.x * wv[u]; acc[4 * q + 1] += s.y * wv[u]; acc[4 * q + 2] += s.z * wv[u]; acc[4 * q + 3] += s.w * wv[u]; } } }
    float* ap = (float*)(F.ws + WS_ADAP);
#pragma unroll
    for (int b = 0; b < BATCH; ++b) ap[(size_t)(kc * BATCH + b) * ADA_W + ng * 64 + lane] = acc[b];
    LDS_WAIT(); asm volatile("" ::: "memory");
}
__device__ __forceinline__ void p0_prologue(Frame& F) {
    LAS float* scr = (LAS float*)(F.lds + RING_OFF + F.wave * 16896);
    const int gw = F.vcu * NWAVES + F.wave, NGW = F.G * NWAVES;
    constexpr int I_ADA = ADA_KC * (ADA_W / 64);
    constexpr int I_T1 = (D / 64) * (IN_W / 64), I_T2 = (D / 64) * (D / 64), I_T3 = (D / 64) * (QW / 64);
    constexpr int I_K = PH * NKEYS * DHALF / 2048;
    constexpr int I_E = (int)((size_t)NEXP * D / 4096);
    constexpr int NITEMS = I_ADA + I_T1 + I_T2 + I_T3 + 2 * I_K + 2 * I_E;
    for (int it = gw; it < NITEMS; it += NGW) {
        int r = it;
        if (r < I_ADA) { p0_ada_task(F, r, scr); continue; } r -= I_ADA;
        if (r < I_T1) { p0_transpose_item_i8(F.in[IN_WIN], D, IN_W, F.ws + WS_WIN, scr, r, F.lane, WQ_SCALE); continue; } r -= I_T1;
        if (r < I_T2) { p0_transpose_item(F.in[IN_WOUT], D, D, (bf16*)(F.ws + WS_WOUT), scr, r, F.lane); continue; } r -= I_T2;
        if (r < I_T3) { p0_transpose_item_i8(F.in[IN_WQ], D, QW, F.ws + WS_WQ, scr, r, F.lane, WQ_SCALE); continue; } r -= I_T3;
        if (r < I_K) { p0_convert_item(F.in[IN_PK1], (bf16*)(F.ws + WS_K1), r, F.lane); continue; } r -= I_K;
        if (r < I_K) { p0_convert_item(F.in[IN_PK2], (bf16*)(F.ws + WS_K2), r, F.lane); continue; } r -= I_K;
        if (r < I_E) { p0_table_item<false>(F.in[IN_PU], F.ws + WS_U, r, F.lane, U_SCALE); continue; } r -= I_E;
        p0_table_item<true>(F.in[IN_PV], F.ws + WS_V, r, F.lane, V_SCALE);
    }
}

__device__ __forceinline__ void mod_row(const float* xrow, bf16* orow, const LAS float* SC, const LAS float* SH, int lane) {
    const GAS f32x4* xr = (const GAS f32x4*)xrow + lane;
    f32x4 v[4]; float s = 0.f;
#pragma unroll
    for (int j = 0; j < 4; ++j) { v[j] = xr[64 * j]; s += (v[j].x * v[j].x + v[j].y * v[j].y) + (v[j].z * v[j].z + v[j].w * v[j].w); }
    const float rstd = 1.0f / sqrtf(wave_sum(s) * (1.f / D) + EPS);
    GAS unsigned long long* o8 = (GAS unsigned long long*)orow + lane;
#pragma unroll
    for (int j = 0; j < 4; ++j) { const f32x4 sc = ((const LAS f32x4*)SC)[lane + 64 * j], sh = ((const LAS f32x4*)SH)[lane + 64 * j];
        const f32x4 o = v[j] * rstd * sc + sh;
        o8[64 * j] = (unsigned long long)pk2(o.x, o.y) | ((unsigned long long)pk2(o.z, o.w) << 32); }
}
__device__ __forceinline__ void mod_row_bf(const bf16* xrow, bf16* orow, const LAS float* SC, const LAS float* SH, int lane) {
    const GAS v2u* xr = (const GAS v2u*)xrow + lane;
    f32x4 v[4]; float s = 0.f;
#pragma unroll
    for (int j = 0; j < 4; ++j) { const v2u w = xr[64 * j]; v[j] = (f32x4){bflo(w.x), bfhi(w.x), bflo(w.y), bfhi(w.y)}; s += (v[j].x * v[j].x + v[j].y * v[j].y) + (v[j].z * v[j].z + v[j].w * v[j].w); }
    const float rstd = 1.0f / sqrtf(wave_sum(s) * (1.f / D) + EPS);
    GAS unsigned long long* o8 = (GAS unsigned long long*)orow + lane;
#pragma unroll
    for (int j = 0; j < 4; ++j) { const f32x4 sc = ((const LAS f32x4*)SC)[lane + 64 * j], sh = ((const LAS f32x4*)SH)[lane + 64 * j];
        const f32x4 o = v[j] * rstd * sc + sh;
        o8[64 * j] = (unsigned long long)pk2(o.x, o.y) | ((unsigned long long)pk2(o.z, o.w) << 32); }
}
__device__ __forceinline__ void mod_load(const float* xrow, int lane, f32x4 (&v)[4]) { const GAS f32x4* xr = (const GAS f32x4*)xrow + lane;
#pragma unroll
    for (int j = 0; j < 4; ++j) v[j] = __builtin_nontemporal_load(xr + 64 * j); }
__device__ __forceinline__ void mod_load_bf(const bf16* xrow, int lane, f32x4 (&v)[4]) { const GAS v4u* xr = (const GAS v4u*)xrow + lane;
#pragma unroll
    for (int jj = 0; jj < 2; ++jj) { const v4u w = xr[64 * jj]; v[2 * jj] = (f32x4){bflo(w.x), bfhi(w.x), bflo(w.y), bfhi(w.y)}; v[2 * jj + 1] = (f32x4){bflo(w.z), bfhi(w.z), bflo(w.w), bfhi(w.w)}; } }
template <bool I8, int LAYOUT = 0> __device__ __forceinline__ void mod_finish(const f32x4 (&v)[4], bf16* orow, unsigned char* h8base, size_t row, float* hs_out, const LAS float* SC, const LAS float* SH, int lane) {
    float s = 0.f;
#pragma unroll
    for (int j = 0; j < 4; ++j) s += (v[j].x * v[j].x + v[j].y * v[j].y) + (v[j].z * v[j].z + v[j].w * v[j].w);
    const float rstd = 1.0f / sqrtf(wave_sum(s) * (1.f / D) + EPS);
    f32x4 o[4]; float am = 0.f;
#pragma unroll
    for (int j = 0; j < 4; ++j) { const int q4 = LAYOUT ? 2 * lane + 128 * (j >> 1) + (j & 1) : lane + 64 * j; const f32x4 sc = ((const LAS f32x4*)SC)[q4], sh = ((const LAS f32x4*)SH)[q4]; o[j] = v[j] * rstd * sc + sh;
        am = fmaxf(am, fmaxf(fmaxf(fabsf(o[j].x), fabsf(o[j].y)), fmaxf(fabsf(o[j].z), fabsf(o[j].w)))); }
    static_assert(I8, "only the int8 form is used");
#pragma unroll
    for (int off = 1; off < 64; off <<= 1) am = fmaxf(am, __shfl_xor(am, off));
    const float qs = am > 0.f ? 127.f / am : 0.f;
    unsigned d[4];
#pragma unroll
    for (int j = 0; j < 4; ++j) d[j] = pk4_i8(o[j], qs);
    unsigned col;
    if (LAYOUT == 0) { quad_transpose4(d, lane); col = 256u * (lane & 3) + 16u * (lane >> 2); }
    else { const bool b0 = lane & 1; const unsigned s0 = b0 ? d[0] : d[2], s1 = b0 ? d[1] : d[3];
        const unsigned r0 = (unsigned)__builtin_amdgcn_update_dpp(0, (int)s0, 0xB1, 0xf, 0xf, true), r1 = (unsigned)__builtin_amdgcn_update_dpp(0, (int)s1, 0xB1, 0xf, 0xf, true);
        if (b0) { d[0] = r0; d[1] = r1; col = 512u + 8u * (lane - 1); } else { d[2] = r0; d[3] = r1; col = 8u * lane; } }
    pg8::store16_wt(pg8::wt_rsrc(h8base, (size_t)M * D), (unsigned)(row * D) + col, (v4u){d[0], d[1], d[2], d[3]});
    if (lane == 0) *hs_out = am * (1.f / 127.f);
}
__device__ __forceinline__ void p1_hpass(Frame& F) {
    LAS float* SC = (LAS float*)(F.lds); LAS float* SH = SC + D;
    const float* adap = (const float*)(F.ws + WS_ADAP); const float* bada = F.in[IN_BADA]; const float* g1 = F.in[IN_G1];
    float* ada = (float*)(F.ws + WS_ADA);
    bool fin = false;
    for (int tile = blockIdx.x; tile < M / 128; tile += F.G) {
        const int b = tile / (SEQ / 128);
        f32x4 va[4], vb[4];
        mod_load(F.in[IN_X] + ((size_t)tile * 128 + F.wave) * D, F.lane, va);
        if (!fin) { fin = true;   { for (int e = blockIdx.x * 512 + F.tid; e < BATCH * ADA_W; e += F.G * 512) { const int bb = e / ADA_W, n = e % ADA_W; float s = bada[n];
#pragma unroll
            for (int kc = 0; kc < ADA_KC; ++kc) s += adap[(size_t)(kc * BATCH + bb) * ADA_W + n];
            ada[e] = s; } } }
        for (int d = F.tid; d < D; d += 512) { float sh = bada[d], sc = bada[D + d];
#pragma unroll
            for (int kc = 0; kc < ADA_KC; ++kc) { const float* p = adap + (size_t)(kc * BATCH + b) * ADA_W; sh += p[d]; sc += p[D + d]; }
            SC[d] = g1[d] * (1.f + sc); SH[d] = sh; }
        __syncthreads();
        {
#pragma unroll 1
          for (int r = F.wave; r < 128; r += 2 * NWAVES) { const size_t row = (size_t)tile * 128 + r;
              mod_load(F.in[IN_X] + (row + NWAVES) * D, F.lane, vb);
              mod_finish<true, 0>(va, nullptr, F.ws + WS_H8, row, (float*)(F.ws + WS_HS) + row, SC, SH, F.lane);
              if (r + 2 * NWAVES < 128) mod_load(F.in[IN_X] + (row + 2 * NWAVES) * D, F.lane, va);
              mod_finish<true, 0>(vb, nullptr, F.ws + WS_H8, row + NWAVES, (float*)(F.ws + WS_HS) + (row + NWAVES), SC, SH, F.lane); } }
        __syncthreads();
    }
    if (!fin) { for (int e = blockIdx.x * 512 + F.tid; e < BATCH * ADA_W; e += F.G * 512) { const int bb = e / ADA_W, n = e % ADA_W; float s = bada[n];
#pragma unroll
            for (int kc = 0; kc < ADA_KC; ++kc) s += adap[(size_t)(kc * BATCH + bb) * ADA_W + n];
            ada[e] = s; } }
}
__device__ __forceinline__ void p5_h2pass(Frame& F) {
    LAS float* SC = (LAS float*)(F.lds); LAS float* SH = SC + D;
    const float* ada = (const float*)(F.ws + WS_ADA); const float* g2 = F.in[IN_G2];
    for (int tile = blockIdx.x; tile < M / 128; tile += F.G) {
        const int b = tile / (SEQ / 128);
        for (int d = F.tid; d < D; d += 512) { SC[d] = g2[d] * (1.f + ada[(size_t)b * ADA_W + 4 * D + d]); SH[d] = ada[(size_t)b * ADA_W + 3 * D + d]; }
        __syncthreads();
        { f32x4 va[4], vb[4]; const bf16* X1 = (const bf16*)(F.ws + WS_X1);
          mod_load_bf(X1 + ((size_t)tile * 128 + F.wave) * D, F.lane, va);
#pragma unroll 1
          for (int r = F.wave; r < 128; r += 2 * NWAVES) { const size_t row = (size_t)tile * 128 + r;
              mod_load_bf(X1 + (row + NWAVES) * D, F.lane, vb);
              mod_finish<true, 1>(va, nullptr, F.ws + WS_H8, row, (float*)(F.ws + WS_HS) + row, SC, SH, F.lane);
              if (r + 2 * NWAVES < 128) mod_load_bf(X1 + (row + 2 * NWAVES) * D, F.lane, va);
              mod_finish<true, 1>(vb, nullptr, F.ws + WS_H8, row + NWAVES, (float*)(F.ws + WS_HS) + (row + NWAVES), SC, SH, F.lane); } }
        __syncthreads();
    }
}

typedef float f32x16 __attribute__((ext_vector_type(16)));
typedef short s16x4 __attribute__((ext_vector_type(4)));
typedef __bf16 bf16x8_t __attribute__((ext_vector_type(8)));
#define MFMA32(a, b, c) __builtin_amdgcn_mfma_f32_32x32x16_bf16((a), (b), (c), 0, 0, 0)
constexpr int KS = 144, VS = 192;
__device__ __forceinline__ void p3_attn_unit(Frame& F, int unit) {
    const int kh = unit & 1, nb = (unit >> 1) & 15, b = unit >> 5;
    LAS unsigned char* KL = F.lds; LAS unsigned char* VL = F.lds + 256 * KS;
    const bf16* proj = (const bf16*)(F.ws + WS_PROJ);
    const int tok0 = b * SEQ + nb * 128;
    for (int c = F.tid; c < 2048; c += 512) { const int j = c >> 3, ch = c & 7;
        v4u kv = (v4u){0u, 0u, 0u, 0u}, vv = (v4u){0u, 0u, 0u, 0u};
        if (nb > 0 || j >= 128) { const bf16* rowp = proj + (size_t)(tok0 - 128 + j) * IN_W; kv = *(const GAS v4u*)(rowp + O_K + kh * HD + ch * 8); vv = *(const GAS v4u*)(rowp + O_V + kh * HD + ch * 8); }
        *(LAS v4u*)(KL + j * KS + ch * 16) = kv; *(LAS v4u*)(VL + j * VS + ch * 16) = vv; }
    __syncthreads();
    const int lane = F.lane, r = lane & 31, hh = lane >> 5;
#pragma unroll 1
    for (int task = F.wave; task < 16; task += NWAVES) {
        const int g = task >> 2, w = task & 3, qh = kh * 4 + g, i0 = 32 * w;
        const bf16* qp = proj + (size_t)(tok0 + i0 + r) * IN_W + O_Q + qh * HD + 8 * hh;
        bf16x8 qf[4];
#pragma unroll
        for (int s = 0; s < 4; ++s) qf[s] = *(const GAS bf16x8*)(qp + 16 * s);
        f32x16 sc[5];
#pragma unroll
        for (int t = 0; t < 5; ++t) {
#pragma unroll
            for (int e = 0; e < 16; ++e) sc[t][e] = 0.f;
#pragma unroll
            for (int s = 0; s < 4; ++s) { const bf16x8 a = *(const LAS bf16x8*)(KL + ((w + t) * 32 + r) * KS + 32 * s + 16 * hh); sc[t] = MFMA32(a, qf[s], sc[t]); } }
        const float sink = F.in[IN_SINK][qh];
        float mx = sink;
#pragma unroll
        for (int t = 0; t < 5; ++t)
#pragma unroll
            for (int e = 0; e < 16; ++e) { const int kr = (e & 3) + 8 * (e >> 2) + 4 * hh;
                bool valid = (nb > 0) || (w + t >= 4);
                if (t == 0) valid = valid && (kr > r);
                if (t == 4) valid = valid && (kr <= r);
                const float v = valid ? sc[t][e] * 0.125f : -1e30f; sc[t][e] = v; mx = fmaxf(mx, v); }
        mx = fmaxf(mx, __shfl_xor(mx, 32));
        float lsum = 0.f;
#pragma unroll
        for (int t = 0; t < 5; ++t)
#pragma unroll
            for (int e = 0; e < 16; ++e) { const float p = __expf(sc[t][e] - mx); sc[t][e] = p; lsum += p; }
        lsum += __shfl_xor(lsum, 32); lsum += __expf(sink - mx);
        f32x16 o[2];
#pragma unroll
        for (int dt = 0; dt < 2; ++dt)
#pragma unroll
            for (int e = 0; e < 16; ++e) o[dt][e] = 0.f;
        const int q4 = (r & 15) >> 2, p4 = r & 3;
#pragma unroll
        for (int t = 0; t < 5; ++t)
#pragma unroll
            for (int sp = 0; sp < 2; ++sp) {
                bf16x8_t pbv;
#pragma unroll
                for (int e = 0; e < 8; ++e) pbv[e] = (__bf16)sc[t][8 * sp + e];
                const bf16x8 pb = __builtin_bit_cast(bf16x8, pbv);
#pragma unroll
                for (int dt = 0; dt < 2; ++dt) {
                    const int kb = (w + t) * 32 + 16 * sp + 4 * hh;
                    const LAS unsigned char* ap = VL + (kb + q4) * VS + (32 * dt + 16 * (r >> 4) + 4 * p4) * 2;
                    const s16x4 lo = __builtin_amdgcn_ds_read_tr16_b64_v4i16((LAS s16x4*)ap);
                    const s16x4 hi = __builtin_amdgcn_ds_read_tr16_b64_v4i16((LAS s16x4*)(ap + 8 * VS));
                    const bf16x8 a = __builtin_shufflevector(lo, hi, 0, 1, 2, 3, 4, 5, 6, 7);
                    o[dt] = MFMA32(a, pb, o[dt]); } }
        const float inv = 1.f / lsum; float ss = 0.f;
#pragma unroll
        for (int dt = 0; dt < 2; ++dt)
#pragma unroll
            for (int e = 0; e < 16; ++e) { o[dt][e] *= inv; ss += o[dt][e] * o[dt][e]; }
        ss += __shfl_xor(ss, 32);
        const float rs = 1.0f / sqrtf(ss * (1.f / HD) + EPS);
        const float* gp = F.in[IN_AOG] + qh * HD;
        bf16* op = (bf16*)(F.ws + WS_MIX) + (size_t)(tok0 + i0 + r) * D + qh * HD;
#pragma unroll
        for (int dt = 0; dt < 2; ++dt)
#pragma unroll
            for (int g4 = 0; g4 < 4; ++g4) { const int d0 = 32 * dt + 8 * g4 + 4 * hh; const f32x4 gv = *(const f32x4*)(gp + d0);
                v2u wv; wv.x = pk2(o[dt][4 * g4 + 0] * rs * gv.x, o[dt][4 * g4 + 1] * rs * gv.y); wv.y = pk2(o[dt][4 * g4 + 2] * rs * gv.z, o[dt][4 * g4 + 3] * rs * gv.w);
                *(GAS v2u*)(op + d0) = wv; }
    }
    __syncthreads();
}
__device__ __forceinline__ void p3_conv(Frame& F) {
    const bf16* proj = (const bf16*)(F.ws + WS_PROJ); const int lane = F.lane, c0 = 8 * lane;
    const float* cw = F.in[IN_CONVW]; const float* cg = F.in[IN_COG];
    float w0[8], w1[8], w2[8], gg[8];
#pragma unroll
    for (int e = 0; e < 8; ++e) { w0[e] = cw[c0 + e]; w1[e] = cw[512 + c0 + e]; w2[e] = cw[1024 + c0 + e]; gg[e] = cg[c0 + e]; }
    const int gw = F.vcu * NWAVES + F.wave, NGW = F.G * NWAVES;
    for (int tok = gw; tok < M; tok += NGW) {
        const int s = tok & (SEQ - 1); const bf16* rp = proj + (size_t)tok * IN_W;
        const v4u z4 = (v4u){0u, 0u, 0u, 0u};
        const v4u Bv = *(const GAS v4u*)(rp + O_B + c0), C0 = *(const GAS v4u*)(rp + O_C + c0), U0 = *(const GAS v4u*)(rp + O_U + c0);
        v4u C1 = z4, U1 = z4, C2 = z4, U2 = z4;
        if (s >= 1) { C1 = *(const GAS v4u*)(rp - IN_W + O_C + c0); U1 = *(const GAS v4u*)(rp - IN_W + O_U + c0); }
        if (s >= 2) { C2 = *(const GAS v4u*)(rp - 2 * IN_W + O_C + c0); U2 = *(const GAS v4u*)(rp - 2 * IN_W + O_U + c0); }
        float y[8]; float ss = 0.f;
#pragma unroll
        for (int e = 0; e < 8; ++e) { const int wi = e >> 1; const bool hi = e & 1;
            const unsigned bw = Bv[wi], c0w = C0[wi], u0w = U0[wi], c1w = C1[wi], u1w = U1[wi], c2w = C2[wi], u2w = U2[wi];
            const float bb = hi ? bfhi(bw) : bflo(bw);
            const float z0 = (hi ? bfhi(c0w) : bflo(c0w)) * (hi ? bfhi(u0w) : bflo(u0w));
            const float z1 = (hi ? bfhi(c1w) : bflo(c1w)) * (hi ? bfhi(u1w) : bflo(u1w));
            const float z2 = (hi ? bfhi(c2w) : bflo(c2w)) * (hi ? bfhi(u2w) : bflo(u2w));
            y[e] = bb * (z2 * w0[e] + z1 * w1[e] + z0 * w2[e]); ss += y[e] * y[e]; }
        ss += __shfl_xor(ss, 1); ss += __shfl_xor(ss, 2); ss += __shfl_xor(ss, 4);
        const float rs = 1.0f / sqrtf(ss * (1.f / 64.f) + EPS);
        v4u w; w.x = pk2(y[0] * rs * gg[0], y[1] * rs * gg[1]); w.y = pk2(y[2] * rs * gg[2], y[3] * rs * gg[3]);
        w.z = pk2(y[4] * rs * gg[4], y[5] * rs * gg[5]); w.w = pk2(y[6] * rs * gg[6], y[7] * rs * gg[7]);
        pg8::store16_wt(pg8::wt_rsrc(F.ws + WS_MIX, (size_t)M * D * 2), (unsigned)(((size_t)tok * D + 512 + c0) * 2), w);
    }
}
__device__ __forceinline__ void p3_mixer(Frame& F) {
    for (int unit = blockIdx.x; unit < BATCH * 16 * NKVH; unit += F.G) p3_attn_unit(F, unit);
    p3_conv(F);
}

#define DI __device__ __forceinline__
#define CE_(i, j) { const unsigned x_ = a[i], y_ = a[j]; a[i] = (int)x_ > (int)y_ ? x_ : y_; a[j] = (int)x_ > (int)y_ ? y_ : x_; }
DI void sort16_desc(unsigned (&a)[16]) {
    CE_(0,13) CE_(1,12) CE_(2,15) CE_(3,14) CE_(4,8) CE_(5,6) CE_(7,11) CE_(9,10)
    CE_(0,5) CE_(1,7) CE_(2,9) CE_(3,4) CE_(6,13) CE_(8,14) CE_(10,15) CE_(11,12)
    CE_(0,1) CE_(2,3) CE_(4,5) CE_(6,8) CE_(7,9) CE_(10,11) CE_(12,13) CE_(14,15)
    CE_(0,2) CE_(1,3) CE_(4,10) CE_(5,11) CE_(6,7) CE_(8,9) CE_(12,14) CE_(13,15)
    CE_(1,2) CE_(3,12) CE_(4,6) CE_(5,7) CE_(8,10) CE_(9,11) CE_(13,14)
    CE_(1,4) CE_(2,6) CE_(5,8) CE_(7,10) CE_(9,13) CE_(11,14)
    CE_(2,4) CE_(3,6) CE_(9,12) CE_(11,13)
    CE_(3,5) CE_(6,8) CE_(7,9) CE_(10,12)
    CE_(3,4) CE_(5,6) CE_(7,8) CE_(9,10) CE_(11,12)
    CE_(6,7) CE_(8,9)
}
DI void bitonic_merge16_desc(unsigned (&a)[16]) {
#pragma unroll
    for (int js = 3; js >= 0; --js) {
#pragma unroll
        for (int i = 0; i < 16; ++i) { const int j = 1 << js, l = i ^ j;
            if (l > i) { const unsigned x = a[i], y = a[l]; a[i] = (int)x > (int)y ? x : y; a[l] = (int)x > (int)y ? y : x; } }
    }
}
DI void merge_top16(unsigned (&a)[16], const unsigned (&b)[16]) {
#pragma unroll
    for (int i = 0; i < 16; ++i) { const unsigned x = a[i], y = b[15 - i]; a[i] = (int)x > (int)y ? x : y; }
    bitonic_merge16_desc(a);
}
DI void top16_of_64(unsigned (&g0)[16], unsigned (&g1)[16], unsigned (&g2)[16], unsigned (&g3)[16]) {
    sort16_desc(g0); sort16_desc(g1); sort16_desc(g2); sort16_desc(g3);
    merge_top16(g0, g1); merge_top16(g2, g3); merge_top16(g0, g2);
}
#define SBIAS 8.0f
DI unsigned skey(float biased) { return __float_as_uint(biased); }
constexpr int KEY_STRIDE = 272;
DI void route_load_q(const bf16* qrow, bf16x8 (&qf)[8]) {
#pragma unroll
    for (int s = 0; s < 8; ++s) qf[s] = *(const GAS bf16x8*)(qrow + 16 * s); }
DI void route_scores_top16(const LAS unsigned char* KL, const bf16x8 (&qf)[8], int r, int hh, unsigned (&out)[16]) {
    f32x16 acc[4];
#pragma unroll
    for (int t = 0; t < 4; ++t)
#pragma unroll
        for (int e = 0; e < 16; ++e) acc[t][e] = SBIAS;
#pragma unroll
    for (int t = 0; t < 4; ++t)
#pragma unroll
        for (int s = 0; s < 8; ++s) { const bf16x8 a = *(const LAS bf16x8*)(KL + (t * 32 + r) * KEY_STRIDE + 32 * s + 16 * hh); acc[t] = MFMA32(a, qf[s], acc[t]); }
    unsigned g0[16], g1[16], g2[16], g3[16];
    const unsigned pb = (unsigned)(127 - 4 * hh);
#pragma unroll
    for (int e = 0; e < 16; ++e) { const unsigned p = pb - (unsigned)((e & 3) + 8 * (e >> 2));
        g0[e] = (skey(acc[0][e]) & ~127u) | p; g1[e] = (skey(acc[1][e]) & ~127u) | (p - 32u); g2[e] = (skey(acc[2][e]) & ~127u) | (p - 64u); g3[e] = (skey(acc[3][e]) & ~127u) | (p - 96u); }
    top16_of_64(g0, g1, g2, g3);
    unsigned oth[16];
#pragma unroll
    for (int i = 0; i < 16; ++i) oth[i] = (unsigned)__shfl_xor((int)g0[i], 32);
    merge_top16(g0, oth);
#pragma unroll
    for (int i = 0; i < 16; ++i) out[i] = g0[i];
}
DI void p7_route_tile(Frame& F, int tok0, int tok0_next, int h, const LAS unsigned char* KL1, const LAS unsigned char* KL2, LAS unsigned char* scr, bf16x8 (&q1)[8]) {
    const int lane = F.lane, r = lane & 31, hh = lane >> 5;
    const bf16* qrow = (const bf16*)(F.ws + WS_PROJ) + (size_t)(tok0 + r) * QW + h * DKEY + 8 * hh;
    unsigned t1[16], t2[16];
    route_load_q(qrow, q1); bf16x8 q2[8]; route_load_q(qrow + DHALF, q2);
    route_scores_top16(KL1, q1, r, hh, t1);
    route_scores_top16(KL2, q2, r, hh, t2);
    { v4u w;
#pragma unroll
      for (int q = 0; q < 4; ++q) { unsigned x = 0u;
#pragma unroll
          for (int bq = 0; bq < 4; ++bq) { const unsigned k = hh ? t2[4 * q + bq] : t1[4 * q + bq]; x |= (127u - (k & 127u)) << (8 * bq); }
          w[q] = x; }
      *(LAS v4u*)(scr + r * 32 + hh * 16) = w; }
    float v1[16], v2[16];
#pragma unroll
    for (int i = 0; i < 16; ++i) { v1[i] = __uint_as_float(t1[i] & ~127u); v2[i] = __uint_as_float(t2[i] & ~127u) - SBIAS; }
    unsigned c0[16], c1[16];
    { const float sa = v1[0] + v2[0], sb = v1[2] + v2[1]; c0[0] = (__float_as_uint(fmaxf(hh ? sb : sa, 0.f)) & ~255u) | (hh ? 222u : 255u); }
    { const float sa = v1[0] + v2[1], sb = v1[2] + v2[2]; c0[1] = (__float_as_uint(fmaxf(hh ? sb : sa, 0.f)) & ~255u) | (hh ? 221u : 254u); }
    { const float sa = v1[0] + v2[2], sb = v1[2] + v2[3]; c0[2] = (__float_as_uint(fmaxf(hh ? sb : sa, 0.f)) & ~255u) | (hh ? 220u : 253u); }
    { const float sa = v1[0] + v2[3], sb = v1[2] + v2[4]; c0[3] = (__float_as_uint(fmaxf(hh ? sb : sa, 0.f)) & ~255u) | (hh ? 219u : 252u); }
    { const float sa = v1[0] + v2[4], sb = v1[3] + v2[0]; c0[4] = (__float_as_uint(fmaxf(hh ? sb : sa, 0.f)) & ~255u) | (hh ? 207u : 251u); }
    { const float sa = v1[0] + v2[5], sb = v1[3] + v2[1]; c0[5] = (__float_as_uint(fmaxf(hh ? sb : sa, 0.f)) & ~255u) | (hh ? 206u : 250u); }
    { const float sa = v1[0] + v2[6], sb = v1[3] + v2[2]; c0[6] = (__float_as_uint(fmaxf(hh ? sb : sa, 0.f)) & ~255u) | (hh ? 205u : 249u); }
    { const float sa = v1[0] + v2[7], sb = v1[3] + v2[3]; c0[7] = (__float_as_uint(fmaxf(hh ? sb : sa, 0.f)) & ~255u) | (hh ? 204u : 248u); }
    { const float sa = v1[0] + v2[8], sb = v1[4] + v2[0]; c0[8] = (__float_as_uint(fmaxf(hh ? sb : sa, 0.f)) & ~255u) | (hh ? 191u : 247u); }
    { const float sa = v1[0] + v2[9], sb = v1[4] + v2[1]; c0[9] = (__float_as_uint(fmaxf(hh ? sb : sa, 0.f)) & ~255u) | (hh ? 190u : 246u); }
    { const float sa = v1[0] + v2[10], sb = v1[4] + v2[2]; c0[10] = (__float_as_uint(fmaxf(hh ? sb : sa, 0.f)) & ~255u) | (hh ? 189u : 245u); }
    { const float sa = v1[0] + v2[11], sb = v1[5] + v2[0]; c0[11] = (__float_as_uint(fmaxf(hh ? sb : sa, 0.f)) & ~255u) | (hh ? 175u : 244u); }
    { const float sa = v1[0] + v2[12], sb = v1[5] + v2[1]; c0[12] = (__float_as_uint(fmaxf(hh ? sb : sa, 0.f)) & ~255u) | (hh ? 174u : 243u); }
    { const float sa = v1[0] + v2[13], sb = v1[6] + v2[0]; c0[13] = (__float_as_uint(fmaxf(hh ? sb : sa, 0.f)) & ~255u) | (hh ? 159u : 242u); }
    { const float sa = v1[0] + v2[14], sb = v1[6] + v2[1]; c0[14] = (__float_as_uint(fmaxf(hh ? sb : sa, 0.f)) & ~255u) | (hh ? 158u : 241u); }
    { const float sa = v1[0] + v2[15], sb = v1[7] + v2[0]; c0[15] = (__float_as_uint(fmaxf(hh ? sb : sa, 0.f)) & ~255u) | (hh ? 143u : 240u); }
    { const float sa = v1[1] + v2[0], sb = v1[7] + v2[1]; c1[0] = (__float_as_uint(fmaxf(hh ? sb : sa, 0.f)) & ~255u) | (hh ? 142u : 239u); }
    { const float sa = v1[1] + v2[1], sb = v1[8] + v2[0]; c1[1] = (__float_as_uint(fmaxf(hh ? sb : sa, 0.f)) & ~255u) | (hh ? 127u : 238u); }
    { const float sa = v1[1] + v2[2], sb = v1[9] + v2[0]; c1[2] = (__float_as_uint(fmaxf(hh ? sb : sa, 0.f)) & ~255u) | (hh ? 111u : 237u); }
    { const float sa = v1[1] + v2[3], sb = v1[10] + v2[0]; c1[3] = (__float_as_uint(fmaxf(hh ? sb : sa, 0.f)) & ~255u) | (hh ? 95u : 236u); }
    { const float sa = v1[1] + v2[4], sb = v1[11] + v2[0]; c1[4] = (__float_as_uint(fmaxf(hh ? sb : sa, 0.f)) & ~255u) | (hh ? 79u : 235u); }
    { const float sa = v1[1] + v2[5], sb = v1[12] + v2[0]; c1[5] = (__float_as_uint(fmaxf(hh ? sb : sa, 0.f)) & ~255u) | (hh ? 63u : 234u); }
    { const float sa = v1[1] + v2[6], sb = v1[13] + v2[0]; c1[6] = (__float_as_uint(fmaxf(hh ? sb : sa, 0.f)) & ~255u) | (hh ? 47u : 233u); }
    { const float sa = v1[1] + v2[7], sb = v1[14] + v2[0]; c1[7] = (__float_as_uint(fmaxf(hh ? sb : sa, 0.f)) & ~255u) | (hh ? 31u : 232u); }
    { const float sa = v1[2] + v2[0], sb = v1[15] + v2[0]; c1[8] = (__float_as_uint(fmaxf(hh ? sb : sa, 0.f)) & ~255u) | (hh ? 15u : 223u); }
    c1[9] = 0u;
    c1[10] = 0u;
    c1[11] = 0u;
    c1[12] = 0u;
    c1[13] = 0u;
    c1[14] = 0u;
    c1[15] = 0u;
    sort16_desc(c0); sort16_desc(c1); merge_top16(c0, c1);
    { unsigned oth[16];
#pragma unroll
      for (int i = 0; i < 16; ++i) oth[i] = (unsigned)__shfl_xor((int)c0[i], 32);
      merge_top16(c0, oth); }
    const float mx = __uint_as_float(c0[0] & ~255u);
    LDS_WAIT(); asm volatile("" ::: "memory");
    float ex[8]; int ee[8]; float part = 0.f;
#pragma unroll
    for (int k = 0; k < 8; ++k) { const unsigned key = hh ? c0[8 + k] : c0[k]; const int ci = 255 - (int)(key & 255u);
        const int e1 = *(const LAS unsigned char*)(scr + r * 32 + (ci >> 4)), e2 = *(const LAS unsigned char*)(scr + r * 32 + 16 + (ci & 15));
        ee[k] = (e1 * NKEYS + e2) & (NEXP - 1); ex[k] = __expf(__uint_as_float(key & ~255u) - mx); part += ex[k]; }
    const float inv = 1.f / (part + __shfl_xor(part, 32));
    { const unsigned oo = (unsigned)(((size_t)(tok0 + r) * 128 + h * TOPK + 8 * hh) * 4);
      const __amdgpu_buffer_rsrc_t ir = pg8::wt_rsrc(F.ws + WS_IDX, (size_t)M * 128 * 4), gr = pg8::wt_rsrc(F.ws + WS_GATE, (size_t)M * 128 * 4);
      pg8::store16_wt(ir, oo, (v4u){(unsigned)ee[0], (unsigned)ee[1], (unsigned)ee[2], (unsigned)ee[3]}); pg8::store16_wt(ir, oo + 16, (v4u){(unsigned)ee[4], (unsigned)ee[5], (unsigned)ee[6], (unsigned)ee[7]});
      pg8::store16_wt(gr, oo, (v4u){__float_as_uint(ex[0] * inv), __float_as_uint(ex[1] * inv), __float_as_uint(ex[2] * inv), __float_as_uint(ex[3] * inv)});
      pg8::store16_wt(gr, oo + 16, (v4u){__float_as_uint(ex[4] * inv), __float_as_uint(ex[5] * inv), __float_as_uint(ex[6] * inv), __float_as_uint(ex[7] * inv)}); }
    asm volatile("" ::: "memory");
}
__device__ __forceinline__ void p7_routing(Frame& F) {
    LAS unsigned char* KL1 = F.lds; LAS unsigned char* KL2 = F.lds + 128 * KEY_STRIDE; LAS unsigned char* scr = F.lds + 2 * 128 * KEY_STRIDE + F.wave * 1024;
    const bf16* k1 = (const bf16*)(F.ws + WS_K1); const bf16* k2 = (const bf16*)(F.ws + WS_K2);
    int cur_h = -1;
    bf16x8 q1[8];
    for (int item = blockIdx.x; item < (M / 256) * PH; item += F.G) {
        const int h = item & (PH - 1), tile = item >> 3;
        const int nitem = item + F.G; const bool pre = nitem < (M / 256) * PH && (nitem & (PH - 1)) == h;
        if (h != cur_h) {
            __syncthreads();
            for (int c = F.tid; c < 2 * 128 * 16; c += 512) { const int which = c >> 11, rr = (c >> 4) & 127, ch = c & 15;
                const v4u v = *(const GAS v4u*)((which ? k2 : k1) + (size_t)(h * NKEYS + rr) * DHALF + ch * 8);
                *(LAS v4u*)((which ? KL2 : KL1) + rr * KEY_STRIDE + ch * 16) = v; }
            __syncthreads();
            cur_h = h;
        }
        p7_route_tile(F, tile * 256 + F.wave * 32, -1, h, KL1, KL2, scr, q1);
    }
}

__device__ __forceinline__ float gelu_erf(float v) { return 0.5f * v * (1.f + erff(v * 0.70710678118654752f)); }
typedef float f32x2v __attribute__((ext_vector_type(2)));
__device__ __forceinline__ unsigned fp8x2_bf16x2(unsigned w, bool hi) { return hi ? __builtin_bit_cast(unsigned, __builtin_amdgcn_cvt_scalef32_pk_bf16_fp8((int)w, 1.0f, true)) : __builtin_bit_cast(unsigned, __builtin_amdgcn_cvt_scalef32_pk_bf16_fp8((int)w, 1.0f, false)); }
__device__ __forceinline__ float dot16_fp8(v4u u, v4u ha, v4u hb, float acc) {
    acc = dot2(fp8x2_bf16x2(u.x, false), ha.x, acc); acc = dot2(fp8x2_bf16x2(u.x, true), ha.y, acc);
    acc = dot2(fp8x2_bf16x2(u.y, false), ha.z, acc); acc = dot2(fp8x2_bf16x2(u.y, true), ha.w, acc);
    acc = dot2(fp8x2_bf16x2(u.z, false), hb.x, acc); acc = dot2(fp8x2_bf16x2(u.z, true), hb.y, acc);
    acc = dot2(fp8x2_bf16x2(u.w, false), hb.z, acc); acc = dot2(fp8x2_bf16x2(u.w, true), hb.w, acc);
    return acc;
}
struct SliceWork { int j0, nj, t0, ts; };
__device__ __forceinline__ SliceWork slice_work(const Frame& F) { SliceWork w;
    if ((F.G & 7) == 0) { w.j0 = blockIdx.x & 7; w.nj = 1; w.t0 = (blockIdx.x >> 3) * NWAVES + F.wave; w.ts = F.G; }
    else { w.j0 = 0; w.nj = 8; w.t0 = blockIdx.x * NWAVES + F.wave; w.ts = F.G * NWAVES; }
    return w; }
struct USet { v4u hq; float hs; v4u u[16]; };
struct UMeta { v2u id; v4u hh; float hs; };
__device__ __forceinline__ UMeta p8a_G(const int* IDX, const unsigned char* H8, const float* HS, int t, int j, int lane) { UMeta m;
    m.id = *(const GAS v2u*)(IDX + (size_t)t * 128 + 2 * lane); m.hh = *(const GAS v4u*)(H8 + (size_t)t * D + 128 * j + 16 * (lane & 7)); m.hs = HS[t]; return m; }
__device__ __forceinline__ void p8a_S(LAS unsigned char* mb, const UMeta& m, int lane) { *(LAS v2u*)(mb + 8 * lane) = m.id; if (lane < 8) *(LAS v4u*)(mb + 512 + 16 * lane) = m.hh; }
__device__ __forceinline__ void p8a_RT(const LAS unsigned char* mb, const unsigned char* Ub, int c, int g, float hs, USet& s) {
    v4u ix[4];
#pragma unroll
    for (int q = 0; q < 4; ++q) ix[q] = *(const LAS v4u*)(mb + 64 * g + 16 * q);
    s.hq = *(const LAS v4u*)(mb + 512 + 16 * c); s.hs = hs;
#pragma unroll
    for (int i = 0; i < 16; ++i) s.u[i] = *(const GAS v4u*)(Ub + (unsigned)((ix[i >> 2][i & 3] << 7) + 16u * (unsigned)c)); }
__device__ __forceinline__ void p8a_compute(const USet& s, bf16* pa_row, int lane, int c) {
    int p[16];
#pragma unroll
    for (int i = 0; i < 16; ++i) { int a = __builtin_amdgcn_sdot4((int)s.u[i].x, (int)s.hq.x, 0, false); a = __builtin_amdgcn_sdot4((int)s.u[i].y, (int)s.hq.y, a, false);
        a = __builtin_amdgcn_sdot4((int)s.u[i].z, (int)s.hq.z, a, false); p[i] = __builtin_amdgcn_sdot4((int)s.u[i].w, (int)s.hq.w, a, false); }
#pragma unroll
    for (int i = 0; i < 8; ++i) { const bool up = c & 4; const int send = up ? p[i] : p[i + 8], keep = up ? p[i + 8] : p[i]; p[i] = keep + __builtin_amdgcn_update_dpp(0, send, 0x141, 0xf, 0xf, true); }
#pragma unroll
    for (int i = 0; i < 4; ++i) { const bool up = c & 2; const int send = up ? p[i] : p[i + 4], keep = up ? p[i + 4] : p[i]; p[i] = keep + __builtin_amdgcn_update_dpp(0, send, 0x4E, 0xf, 0xf, true); }
#pragma unroll
    for (int i = 0; i < 2; ++i) { const bool up = c & 1; const int send = up ? p[i] : p[i + 2], keep = up ? p[i + 2] : p[i]; p[i] = keep + __builtin_amdgcn_update_dpp(0, send, 0xB1, 0xf, 0xf, true); }
    const float sc = s.hs * (1.f / U_SCALE);
    ((GAS unsigned*)pa_row)[lane] = pk2((float)p[0] * sc, (float)p[1] * sc);
}
__device__ __forceinline__ void p8a_udots(Frame& F) {
    const unsigned char* H8 = F.ws + WS_H8; const float* HS = (const float*)(F.ws + WS_HS); const int* IDX = (const int*)(F.ws + WS_IDX); bf16* PA = (bf16*)(F.ws + WS_PA);
    const int lane = F.lane, c = lane & 7, g = lane >> 3; const SliceWork sw = slice_work(F);
    LAS unsigned char* mb = F.lds + F.wave * 1024;
    if (sw.t0 >= M) return;
    const int nt = (M - 1 - sw.t0) / sw.ts + 1;
#define TOK(n) (sw.t0 + ((n) < nt ? (n) : nt - 1) * sw.ts)
    for (int jj = 0; jj < sw.nj; ++jj) { const int j = sw.j0 + jj; const unsigned char* Uj = F.ws + WS_U + (size_t)j * NEXP * 128;
        USet sA, sB, sC;
        UMeta mN = p8a_G(IDX, H8, HS, TOK(0), j, lane); p8a_S(mb, mN, lane); p8a_RT(mb, Uj, c, g, mN.hs, sA);
        mN = p8a_G(IDX, H8, HS, TOK(1), j, lane); p8a_S(mb, mN, lane); p8a_RT(mb, Uj, c, g, mN.hs, sB);
        mN = p8a_G(IDX, H8, HS, TOK(2), j, lane);
#define P8A_STAGE(k, SN, SC_) do { p8a_S(mb, mN, lane); p8a_RT(mb, Uj, c, g, mN.hs, SN); mN = p8a_G(IDX, H8, HS, TOK((k) + 3), j, lane); asm volatile("" ::: "memory"); \
            if ((k) < nt) p8a_compute(SC_, PA + ((size_t)j * M + TOK(k)) * 128, lane, c); asm volatile("" ::: "memory"); } while (0)
#pragma unroll 1
        for (int n = 0; n < nt; n += 3) {
            P8A_STAGE(n, sC, sA);
            P8A_STAGE(n + 1, sA, sB);
            P8A_STAGE(n + 2, sB, sC);
        }
#undef P8A_STAGE
    }
}
typedef _Float16 h2_t __attribute__((ext_vector_type(2)));
__device__ __forceinline__ h2_t cvt_h2_lo(int w) { return __builtin_bit_cast(h2_t, __builtin_amdgcn_cvt_scalef32_pk_f16_fp8(w, 1.0f, false)); }
__device__ __forceinline__ h2_t cvt_h2_hi(int w) { return __builtin_bit_cast(h2_t, __builtin_amdgcn_cvt_scalef32_pk_f16_fp8(w, 1.0f, true)); }
__device__ __forceinline__ void p8w_weights(Frame& F) {
    const bf16* PA = (const bf16*)(F.ws + WS_PA); float* GATE = (float*)(F.ws + WS_GATE);
    for (size_t e = (size_t)blockIdx.x * 512 + F.tid; e < (size_t)M * 128 / 4; e += (size_t)F.G * 512) {
        f32x4 s = (f32x4){0.f, 0.f, 0.f, 0.f};
#pragma unroll
        for (int j = 0; j < 8; ++j) { const v2u w = __builtin_nontemporal_load((const GAS v2u*)(PA + (size_t)j * M * 128 + 4 * e)); s += (f32x4){bflo(w.x), bfhi(w.x), bflo(w.y), bfhi(w.y)}; }
        const f32x4 gt = *(const GAS f32x4*)(GATE + 4 * e); f32x4 o;
#pragma unroll
        for (int q = 0; q < 4; ++q) o[q] = gt[q] * gelu_erf(s[q]);
        const h2_t w01 = (h2_t){(_Float16)o[0], (_Float16)o[1]}, w23 = (h2_t){(_Float16)o[2], (_Float16)o[3]};
        *(GAS v2u*)((_Float16*)(F.ws + WS_W16) + 4 * e) = (v2u){__builtin_bit_cast(unsigned, w01), __builtin_bit_cast(unsigned, w23)}; }
}
template <int HI> __device__ __forceinline__ h2_t pkfma_bw(h2_t a, unsigned w, h2_t c) { h2_t d;
    if (HI) asm("v_pk_fma_f16 %0, %1, %2, %3 op_sel:[0,1,0] op_sel_hi:[1,1,1]" : "=v"(d) : "v"(a), "v"(w), "v"(c));
    else asm("v_pk_fma_f16 %0, %1, %2, %3 op_sel:[0,0,0] op_sel_hi:[1,0,1]" : "=v"(d) : "v"(a), "v"(w), "v"(c));
    return d; }
template <int HI> __device__ __forceinline__ h2_t pkmul_bw(h2_t a, unsigned w) { h2_t d;
    if (HI) asm("v_pk_mul_f16 %0, %1, %2 op_sel:[0,1] op_sel_hi:[1,1]" : "=v"(d) : "v"(a), "v"(w));
    else asm("v_pk_mul_f16 %0, %1, %2 op_sel:[0,0] op_sel_hi:[1,0]" : "=v"(d) : "v"(a), "v"(w));
    return d; }
struct VSet { v4u v[16]; };
struct VMeta { v2u id; unsigned w; };
__device__ __forceinline__ VMeta p8b_G(const int* IDX, const _Float16* W, int t, int lane) { VMeta m;
    m.id = *(const GAS v2u*)(IDX + (size_t)t * 128 + 2 * lane); m.w = *(const GAS unsigned*)(W + (size_t)t * 128 + 2 * lane); return m; }
__device__ __forceinline__ void p8b_S(LAS unsigned char* mb, const VMeta& m, int lane) { *(LAS v2u*)(mb + 8 * lane) = m.id; *(LAS unsigned*)(mb + 512 + 4 * lane) = m.w; }
__device__ __forceinline__ void p8b_RT(Frame& F, const LAS unsigned char* mb, const unsigned char* Vj, int t, int j, int c, int g, VSet& s) {
    v4u ix[4];
#pragma unroll
    for (int q = 0; q < 4; ++q) ix[q] = *(const LAS v4u*)(mb + 64 * g + 16 * q);
#pragma unroll
    for (int i = 0; i < 16; ++i) s.v[i] = *(const GAS v4u*)(Vj + (unsigned)((ix[i >> 2][i & 3] << 7) + 16u * (unsigned)c)); }
__device__ __forceinline__ void p8b_step(Frame& F, const LAS unsigned char* mb, const LAS unsigned char* mbc, const unsigned char* Vj, int tn, VSet& sn, const VSet& sc, int tc, int j, int lane, int c, int g, bool do_compute) {
    v4u ix[4];
#pragma unroll
    for (int q = 0; q < 4; ++q) ix[q] = *(const LAS v4u*)(mb + 64 * g + 16 * q);
    const v4u wh0 = *(const LAS v4u*)(mbc + 512 + 32 * g), wh1 = *(const LAS v4u*)(mbc + 512 + 32 * g + 16);
    h2_t ah[8];
#pragma unroll
    for (int i = 0; i < 16; ++i) {
        sn.v[i] = *(const GAS v4u*)(Vj + (unsigned)((ix[i >> 2][i & 3] << 7) + 16u * (unsigned)c));
        const v4u v = sc.v[i]; const unsigned wu = (i >> 3) ? wh1[(i >> 1) & 3] : wh0[(i >> 1) & 3];
        if (i == 0) { ah[0] = pkmul_bw<0>(cvt_h2_lo((int)v.x), wu); ah[1] = pkmul_bw<0>(cvt_h2_hi((int)v.x), wu); ah[2] = pkmul_bw<0>(cvt_h2_lo((int)v.y), wu); ah[3] = pkmul_bw<0>(cvt_h2_hi((int)v.y), wu);
            ah[4] = pkmul_bw<0>(cvt_h2_lo((int)v.z), wu); ah[5] = pkmul_bw<0>(cvt_h2_hi((int)v.z), wu); ah[6] = pkmul_bw<0>(cvt_h2_lo((int)v.w), wu); ah[7] = pkmul_bw<0>(cvt_h2_hi((int)v.w), wu); }
        else if (i & 1) { ah[0] = pkfma_bw<1>(cvt_h2_lo((int)v.x), wu, ah[0]); ah[1] = pkfma_bw<1>(cvt_h2_hi((int)v.x), wu, ah[1]); ah[2] = pkfma_bw<1>(cvt_h2_lo((int)v.y), wu, ah[2]); ah[3] = pkfma_bw<1>(cvt_h2_hi((int)v.y), wu, ah[3]);
            ah[4] = pkfma_bw<1>(cvt_h2_lo((int)v.z), wu, ah[4]); ah[5] = pkfma_bw<1>(cvt_h2_hi((int)v.z), wu, ah[5]); ah[6] = pkfma_bw<1>(cvt_h2_lo((int)v.w), wu, ah[6]); ah[7] = pkfma_bw<1>(cvt_h2_hi((int)v.w), wu, ah[7]); }
        else { ah[0] = pkfma_bw<0>(cvt_h2_lo((int)v.x), wu, ah[0]); ah[1] = pkfma_bw<0>(cvt_h2_hi((int)v.x), wu, ah[1]); ah[2] = pkfma_bw<0>(cvt_h2_lo((int)v.y), wu, ah[2]); ah[3] = pkfma_bw<0>(cvt_h2_hi((int)v.y), wu, ah[3]);
            ah[4] = pkfma_bw<0>(cvt_h2_lo((int)v.z), wu, ah[4]); ah[5] = pkfma_bw<0>(cvt_h2_hi((int)v.z), wu, ah[5]); ah[6] = pkfma_bw<0>(cvt_h2_lo((int)v.w), wu, ah[6]); ah[7] = pkfma_bw<0>(cvt_h2_hi((int)v.w), wu, ah[7]); }
        asm volatile("" ::: "memory"); }
    if (!do_compute) return;
    asm volatile("s_nop 1");
#pragma unroll
    for (int m = 0; m < 4; ++m) { const auto r = __builtin_amdgcn_permlane32_swap(__builtin_bit_cast(unsigned, ah[m]), __builtin_bit_cast(unsigned, ah[m + 4]), false, false);
        ah[m] = __builtin_bit_cast(h2_t, (unsigned)r[0]) + __builtin_bit_cast(h2_t, (unsigned)r[1]); }
#pragma unroll
    for (int m = 0; m < 2; ++m) { const auto r = __builtin_amdgcn_permlane16_swap(__builtin_bit_cast(unsigned, ah[m]), __builtin_bit_cast(unsigned, ah[m + 2]), false, false);
        ah[m] = __builtin_bit_cast(h2_t, (unsigned)r[0]) + __builtin_bit_cast(h2_t, (unsigned)r[1]); }
    { const bool up = lane & 8;
      const h2_t s0 = ah[0] + __builtin_bit_cast(h2_t, __builtin_amdgcn_update_dpp(0, __builtin_bit_cast(int, ah[0]), 0x128, 0xf, 0xf, true));
      const h2_t s1 = ah[1] + __builtin_bit_cast(h2_t, __builtin_amdgcn_update_dpp(0, __builtin_bit_cast(int, ah[1]), 0x128, 0xf, 0xf, true));
      ah[0] = up ? s1 : s0; }
    const f32x2v peer = (f32x2v){(float)ah[0].x, (float)ah[0].y} * (1.f / V_SCALE);
    *(GAS unsigned*)((bf16*)(F.ws + WS_H) + (size_t)tc * D + 128 * j + 16 * c + 2 * g) = pk2(peer.x, peer.y);
}
__device__ __forceinline__ void p8b_vsum(Frame& F) {
    const int* IDX = (const int*)(F.ws + WS_IDX); const _Float16* W = (const _Float16*)(F.ws + WS_W16);
    const int lane = F.lane, c = lane & 7, g = lane >> 3; const SliceWork sw = slice_work(F);
    LAS unsigned char* mb = F.lds + F.wave * 1024;
    if (sw.t0 >= M) return;
    const int nt = (M - 1 - sw.t0) / sw.ts + 1;
    for (int jj = 0; jj < sw.nj; ++jj) { const int j = sw.j0 + jj; const unsigned char* Vj = F.ws + WS_V + (size_t)j * NEXP * 128;
        VSet sA, sB, sC;
        LAS unsigned char* const pg0 = mb, * const pg1 = mb + 8192, * const pg2 = mb + 16384;
        VMeta mN = p8b_G(IDX, W, TOK(0), lane); p8b_S(pg0, mN, lane); p8b_RT(F, pg0, Vj, TOK(0), j, c, g, sA);
        mN = p8b_G(IDX, W, TOK(1), lane); p8b_S(pg1, mN, lane); p8b_RT(F, pg1, Vj, TOK(1), j, c, g, sB);
        mN = p8b_G(IDX, W, TOK(2), lane);
#define P8B_STAGE(k, SN, SC_, PN, PC) do { p8b_S(PN, mN, lane); mN = p8b_G(IDX, W, TOK((k) + 3), lane); \
            p8b_step(F, PN, PC, Vj, TOK((k) + 2), SN, SC_, TOK(k), j, lane, c, g, (k) < nt); asm volatile("" ::: "memory"); } while (0)
#pragma unroll 1
        for (int n = 0; n < nt; n += 3) {
            P8B_STAGE(n, sC, sA, pg2, pg0);
            P8B_STAGE(n + 1, sA, sB, pg0, pg1);
            P8B_STAGE(n + 2, sB, sC, pg1, pg2);
        }
#undef P8B_STAGE
    }
#undef TOK
}
__device__ __forceinline__ void p8c_final(Frame& F) {
    const float* gf = F.in[IN_GF]; const float* ada = (const float*)(F.ws + WS_ADA); const int lane = F.lane;
    f32x4 gv[4];
#pragma unroll
    for (int q = 0; q < 4; ++q) gv[q] = *(const f32x4*)(gf + 4 * lane + 256 * q);
    const bf16* X1 = (const bf16*)(F.ws + WS_X1); const bf16* PE = (const bf16*)(F.ws + WS_H);
    const int t0 = blockIdx.x * NWAVES + F.wave, ts = F.G * NWAVES;
    if (t0 >= M) return;
    v2u an[4], pn[4];
#pragma unroll
    for (int q = 0; q < 4; ++q) { an[q] = __builtin_nontemporal_load((const GAS v2u*)(X1 + (size_t)t0 * D) + lane + 64 * q); pn[q] = __builtin_nontemporal_load((const GAS v2u*)(PE + (size_t)t0 * D) + lane + 64 * q); }
#pragma unroll 1
    for (int t = t0; t < M; t += ts) {
        v2u a[4], p[4];
#pragma unroll
        for (int q = 0; q < 4; ++q) { a[q] = an[q]; p[q] = pn[q]; }
        if (t + ts < M) {
#pragma unroll
            for (int q = 0; q < 4; ++q) { an[q] = __builtin_nontemporal_load((const GAS v2u*)(X1 + (size_t)(t + ts) * D) + lane + 64 * q); pn[q] = __builtin_nontemporal_load((const GAS v2u*)(PE + (size_t)(t + ts) * D) + lane + 64 * q); } }
        const float* g2 = ada + (size_t)(t / SEQ) * ADA_W + 5 * D + 4 * lane;
        f32x4 x2[4]; float s = 0.f;
#pragma unroll
        for (int q = 0; q < 4; ++q) { const f32x4 gg = *(const f32x4*)(g2 + 256 * q);
            x2[q] = (f32x4){bflo(a[q].x), bfhi(a[q].x), bflo(a[q].y), bfhi(a[q].y)} + gg * (f32x4){bflo(p[q].x), bfhi(p[q].x), bflo(p[q].y), bfhi(p[q].y)};
            s += (x2[q].x * x2[q].x + x2[q].y * x2[q].y) + (x2[q].z * x2[q].z + x2[q].w * x2[q].w); }
        const float rstd = 1.0f / sqrtf(wave_sum(s) * (1.f / D) + EPS);
        GAS f32x4* yr = (GAS f32x4*)(F.out + (size_t)t * D) + lane;
#pragma unroll
        for (int q = 0; q < 4; ++q) __builtin_nontemporal_store(x2[q] * rstd * gv[q], yr + 64 * q);
    }
}

struct Args { const float* in[20]; float* out; unsigned char* ws; int ph_lo, ph_hi, li, pad; };
__global__ void __launch_bounds__(NWAVES * 64, 2) skel_fwd(Args args) {
    extern __shared__ __attribute__((aligned(16))) unsigned char lds[];
    Frame F;
    F.lds = (LAS unsigned char*)lds;
    F.MISC = (volatile LAS unsigned*)(F.lds + MISC_OFF);
    F.tid = threadIdx.x; F.lane = F.tid & 63; F.wave = __builtin_amdgcn_readfirstlane(F.tid >> 6);
    F.G = gridDim.x; { const int bx = blockIdx.x; F.vcu = (F.G % 8 == 0) ? (bx % 8) * (F.G / 8) + bx / 8 : bx; }
    F.ws = args.ws; F.out = args.out;
#pragma unroll
    for (int i = 0; i < 20; ++i) F.in[i] = args.in[i];
    F.ctl = (gu32*)(args.ws + WS_CTL);
    for (int u = F.tid; u < (LDS_BYTES - LDSCTL_OFF) / 4; u += NWAVES * 64) ((LAS unsigned*)(F.lds + LDSCTL_OFF))[u] = 0u;
    __syncthreads();
    XcdBarrier bar; bar.bar = (unsigned*)(F.ctl + CW_BAR); bar.x = 0; bar.st = nullptr;
    if (N_LAUNCHES == 1) bar = xcd_barrier_post((unsigned*)(F.ctl + CW_BAR), F.MISC + 8);
#define GRID_BAR() do { if (N_LAUNCHES == 1) xcd_barrier(bar); } while (0)
    const int lo = args.ph_lo, hi = args.ph_hi;
#define IN(k) (lo <= (k) && (k) < hi)
    bf16* const H = (bf16*)(args.ws + WS_H); bf16* const PROJ = (bf16*)(args.ws + WS_PROJ); bf16* const MIX = (bf16*)(args.ws + WS_MIX);

    if (IN(0)) { p0_prologue(F); GRID_BAR(); }
    if (IN(1)) { p1_hpass(F); GRID_BAR(); }
    if (IN(2)) {
        pg8::Gemm g{(const bf16*)(args.ws + WS_H8), (const bf16*)(args.ws + WS_WIN), M, IN_W, D / 2}; pg8::StaticOrder S; S.init(M, IN_W, F.G, (int)blockIdx.x);
        pg8::EpiI8Bf16 E{PROJ, IN_W, (const float*)(args.ws + WS_HS), 1.f / WQ_SCALE, F.in[IN_BIN]};
        if ((int)blockIdx.x >= 128) { __builtin_amdgcn_s_sleep(127); __builtin_amdgcn_s_sleep(127); }
        pg8::gemm_phase<pg8::EpiI8Bf16, pg8::StaticOrder, true, true, true>(F.lds + RING_OFF, g, S, E);
        GRID_BAR();
    }
    if (IN(3)) { p3_mixer(F); GRID_BAR(); }
    if (IN(4)) {
        pg8::Gemm g{MIX, (const bf16*)(args.ws + WS_WOUT), M, D, D}; pg8::StaticOrder S; S.init(M, D, F.G, (int)blockIdx.x);
        pg8::EpiResGate E{F.in[IN_X], (bf16*)(args.ws + WS_X1), D, F.in[IN_BOUT], (const float*)(args.ws + WS_ADA), ADA_W, 2 * D, SEQ / 256};
        pg8::gemm_phase<pg8::EpiResGate, pg8::StaticOrder, true, true>(F.lds + RING_OFF, g, S, E);
        GRID_BAR();
    }
    if (IN(5)) { p5_h2pass(F); GRID_BAR(); }
    if (IN(6)) {
        pg8::Gemm g{(const bf16*)(args.ws + WS_H8), (const bf16*)(args.ws + WS_WQ), M, QW, D / 2}; pg8::StaticOrder S; S.init(M, QW, F.G, (int)blockIdx.x);
        pg8::EpiI8Bf16 E{PROJ, QW, (const float*)(args.ws + WS_HS), 1.f / WQ_SCALE, nullptr};
        pg8::gemm_phase<pg8::EpiI8Bf16, pg8::StaticOrder, true, true, true>(F.lds + RING_OFF, g, S, E);
        GRID_BAR();
    }
    if (IN(7)) { p7_routing(F); GRID_BAR(); }
    if (IN(8)) { p8a_udots(F); GRID_BAR(); }
    if (IN(9)) { p8w_weights(F); GRID_BAR(); }
    if (IN(10)) { p8b_vsum(F); GRID_BAR(); }
    if (IN(11)) { p8c_final(F); }
#undef IN
}

extern "C" void kernel_launch(void* const* d_in, const int* in_sizes, int n_in, void* d_out, int out_size, void* d_ws, size_t ws_size, hipStream_t stream) {
    static int grid = 0;
    if (grid == 0) {
        if (n_in != 20 || in_sizes[0] != M * D || out_size != M * D || ws_size < WS_END) { fprintf(stderr, "kernel_launch: unexpected shapes (n_in %d, in0 %d, out %d, ws %zu); nothing launched\n", n_in, n_in > 0 ? in_sizes[0] : -1, out_size, ws_size); grid = -1; return; }
        int dev = 0, cus = 0, per_cu = 0;
        if (hipGetDevice(&dev) != hipSuccess || hipDeviceGetAttribute(&cus, hipDeviceAttributeMultiprocessorCount, dev) != hipSuccess) { fprintf(stderr, "kernel_launch: device query failed\n"); grid = -1; return; }
        if (hipFuncSetAttribute((const void*)skel_fwd, hipFuncAttributeMaxDynamicSharedMemorySize, LDS_BYTES) != hipSuccess) { fprintf(stderr, "kernel_launch: hipFuncSetAttribute failed\n"); grid = -1; return; }
        if (hipOccupancyMaxActiveBlocksPerMultiprocessor(&per_cu, (const void*)skel_fwd, NWAVES * 64, LDS_BYTES) != hipSuccess || per_cu < 1)
            fprintf(stderr, "kernel_launch: note: occupancy query reports %d workgroups per CU\n", per_cu);
        (void)hipGetLastError();
        grid = cus;
    }
    if (grid < 0) return;
    if (hipMemsetAsync((char*)d_ws + WS_CTL, 0, CTL_ZERO_BYTES, stream) != hipSuccess) { fprintf(stderr, "kernel_launch: hipMemsetAsync failed\n"); return; }
    Args a{};
    for (int i = 0; i < 20; ++i) a.in[i] = (const float*)d_in[i];
    a.out = (float*)d_out; a.ws = (unsigned char*)d_ws;
    for (int li = 0; li < N_LAUNCHES; ++li) {
        a.ph_lo = (N_LAUNCHES == 1) ? 0 : li; a.ph_hi = (N_LAUNCHES == 1) ? NPHASES : li + 1; a.li = li;
        hipLaunchKernelGGL(skel_fwd, dim3(grid), dim3(NWAVES * 64), LDS_BYTES, stream, a);
        const hipError_t le = hipPeekAtLastError();
        if (le != hipSuccess) { fprintf(stderr, "kernel_launch: launch %d failed: %s\n", li, hipGetErrorName(le)); break; }
    }
}
```
